# Optimizing an MI355X kernel written in HIP

```python
import jax, jax.numpy as jnp
from jax import lax
import numpy as np

D_MODEL = 1024
BATCH = 2
SEQ = 8192
DEPTH = 1

N_META = 16
NORM_EPS = 1e-6
D_MIX = D_MODEL
D_LRU = D_MIX // 2
D_RWKV = D_MIX - D_LRU
LRU_HEADS = 8
LRU_HEAD_DIM = D_LRU // LRU_HEADS
CONV_WIDTH = 4
LRU_C = 8.0
RWKV_HEAD_DIM = 64
RWKV_HEADS = D_RWKV // RWKV_HEAD_DIM
D_DECAY_LORA = 64
D_AAA_LORA = 64
D_GATE_LORA = 128
RWKV_GN_EPS = 64e-5
PEER_HEADS = 8
PEER_N_KEYS = 128
PEER_N_EXPERTS = PEER_N_KEYS * PEER_N_KEYS
PEER_D_QUERY = 256
PEER_HALF = PEER_D_QUERY // 2
PEER_TOPK = 16
PEER_BLOCK = 256
D_RWKV_IN = 3 * D_RWKV + D_DECAY_LORA + D_AAA_LORA + D_GATE_LORA
D_IN = 2 * D_LRU + D_RWKV_IN
RWKV_SPLITS = [D_RWKV, 2 * D_RWKV, 3 * D_RWKV, 3 * D_RWKV + D_DECAY_LORA,
               3 * D_RWKV + D_DECAY_LORA + D_AAA_LORA]

kernel_name = "hymba_rglru_rwkv7_peer_block"


def rmsnorm(x, gain):
    xf = x.astype(jnp.float32)
    y = xf * lax.rsqrt(jnp.mean(xf * xf, axis=-1, keepdims=True) + NORM_EPS)
    return (y * gain.astype(jnp.float32)).astype(x.dtype)


def causal_depthwise_conv(x, w, b):
    y = lax.conv_general_dilated(
        x, w[:, None, :].astype(x.dtype), window_strides=(1,),
        padding=[(CONV_WIDTH - 1, 0)], dimension_numbers=("NWC", "WIO", "NWC"),
        feature_group_count=x.shape[-1])
    return y + b


def rg_lru(x, w_ga, b_ga, w_gx, b_gx, lam):
    B, T, _ = x.shape
    xh = x.reshape(B, T, LRU_HEADS, LRU_HEAD_DIM)
    r = jax.nn.sigmoid(jnp.einsum("bthi,hij->bthj", xh, w_ga).reshape(B, T, D_LRU) + b_ga)
    i = jax.nn.sigmoid(jnp.einsum("bthi,hij->bthj", xh, w_gx).reshape(B, T, D_LRU) + b_gx)
    log_a = -LRU_C * r.astype(jnp.float32) * jax.nn.softplus(-lam.astype(jnp.float32))
    a = jnp.exp(log_a)
    b_in = jnp.sqrt(-jnp.expm1(2.0 * log_a)) * (i * x).astype(jnp.float32)

    def combine(c1, c2):
        a1, b1 = c1
        a2, b2 = c2
        return a1 * a2, a2 * b1 + b2

    _, h = lax.associative_scan(combine, (a, b_in), axis=1)
    return h.astype(x.dtype)


def token_shift(p, mu):
    prev = jnp.pad(p[:, :-1], ((0, 0), (1, 0), (0, 0)))
    return p + (prev - p) * mu


def rwkv7_time_mix(r, k, v, w_lr, a_lr, g_lr, w0, w2, a0, a2, g2, k_k, k_a, r_k, gn_w, gn_b):
    B, T, _ = r.shape
    H, N = RWKV_HEADS, RWKV_HEAD_DIM
    log_w = -jax.nn.softplus(-(w0 + jnp.tanh(w_lr) @ w2)) - 0.5
    decay = jnp.exp(-jnp.exp(log_w.astype(jnp.float32)))
    a = jax.nn.sigmoid(a0 + a_lr @ a2)
    g = jax.nn.sigmoid(g_lr) @ g2

    def heads(t):
        return t.reshape(B, T, H, N).astype(jnp.float32)

    kk = heads(k * k_k)
    kk = kk / jnp.maximum(jnp.sqrt(jnp.sum(kk * kk, axis=-1, keepdims=True)), 1e-12)
    k = k * (1.0 + (a - 1.0) * k_a)
    rh, kh, vh, ah = heads(r), heads(k), heads(v), heads(a)

    def step(S, inp):
        r_t, w_t, k_t, v_t, kk_t, a_t = inp
        sab = jnp.einsum("bhvi,bhi->bhv", S, -kk_t)
        S = (S * w_t[:, :, None, :] + sab[..., None] * (kk_t * a_t)[:, :, None, :]
             + v_t[..., None] * k_t[:, :, None, :])
        return S, jnp.einsum("bhvi,bhi->bhv", S, r_t)

    xs = tuple(jnp.moveaxis(t, 1, 0) for t in (rh, heads(decay), kh, vh, kk, ah))
    S0 = jnp.zeros((B, H, N, N), jnp.float32)
    _, o = lax.scan(step, S0, xs)
    o = jnp.moveaxis(o, 0, 1)
    mean = jnp.mean(o, axis=-1, keepdims=True)
    var = jnp.mean(jnp.square(o - mean), axis=-1, keepdims=True)
    o = ((o - mean) * lax.rsqrt(var + RWKV_GN_EPS)).reshape(B, T, D_RWKV)
    o = o * gn_w.astype(jnp.float32) + gn_b.astype(jnp.float32)
    bonus = jnp.sum(rh * kh * r_k.astype(jnp.float32), axis=-1, keepdims=True) * vh
    o = o + bonus.reshape(B, T, D_RWKV)
    return (o * g.astype(jnp.float32)).astype(r.dtype)


def peer(x, w_query, q_gain, sub_keys, u_table, v_table):
    B, T, D = x.shape
    n = B * T
    n_pad = -(-n // PEER_BLOCK) * PEER_BLOCK
    xb_all = jnp.pad(x.reshape(n, D), ((0, n_pad - n), (0, 0))).reshape(n_pad // PEER_BLOCK, PEER_BLOCK, D)

    def block(xb):
        q = rmsnorm((xb @ w_query).reshape(PEER_BLOCK, PEER_HEADS, PEER_D_QUERY), q_gain)
        s1 = jnp.einsum("nhd,hkd->nhk", q[..., :PEER_HALF], sub_keys[:, 0])
        s2 = jnp.einsum("nhd,hkd->nhk", q[..., PEER_HALF:], sub_keys[:, 1])
        v1, i1 = lax.top_k(s1, PEER_TOPK)
        v2, i2 = lax.top_k(s2, PEER_TOPK)
        cand = (v1[..., :, None] + v2[..., None, :]).reshape(PEER_BLOCK, PEER_HEADS, PEER_TOPK * PEER_TOPK)
        sc, ci = lax.top_k(cand, PEER_TOPK)
        e1 = jnp.take_along_axis(i1, ci // PEER_TOPK, axis=-1)
        e2 = jnp.take_along_axis(i2, ci % PEER_TOPK, axis=-1)
        expert = e1 * PEER_N_KEYS + e2
        gate = jax.nn.softmax(sc.astype(jnp.float32), axis=-1).astype(xb.dtype)
        u = u_table[expert]
        hid = jax.nn.gelu(jnp.einsum("nhkd,nd->nhk", u, xb), approximate=False)
        return jnp.einsum("nhk,nhkd->nd", gate * hid, v_table[expert])

    y = lax.map(block, xb_all)
    return y.reshape(n_pad, D)[:n].reshape(B, T, D)


def setup_inputs(seed: int = 0) -> dict:
    key = jax.random.key(seed)
    ks = jax.random.split(key, 32)
    f32 = jnp.float32
    L = DEPTH

    def nrm(k, shape, scale):
        return jax.random.normal(k, shape, f32) * scale

    a_init = jax.random.uniform(ks[8], (L, D_LRU), f32, 0.9, 0.999)
    return {
        "x": nrm(ks[0], (BATCH, SEQ, D_MODEL), 1.0),
        "meta_tokens": nrm(ks[1], (N_META, D_MODEL), 1.0),
        "norm1_gain": 1.0 + nrm(ks[2], (L, D_MODEL), 0.01),
        "w_in": nrm(ks[3], (L, D_MODEL, D_IN), D_MODEL ** -0.5),
        "conv_w": nrm(ks[4], (L, CONV_WIDTH, D_LRU), CONV_WIDTH ** -0.5),
        "conv_b": nrm(ks[5], (L, D_LRU), 0.01),
        "lru_gate_a_w": nrm(ks[6], (L, LRU_HEADS, LRU_HEAD_DIM, LRU_HEAD_DIM), LRU_HEAD_DIM ** -0.5),
        "lru_gate_a_b": nrm(ks[7], (L, D_LRU), 0.01),
        "lru_gate_x_w": nrm(ks[9], (L, LRU_HEADS, LRU_HEAD_DIM, LRU_HEAD_DIM), LRU_HEAD_DIM ** -0.5),
        "lru_gate_x_b": nrm(ks[10], (L, D_LRU), 0.01),
        "lru_lambda": jnp.log(a_init) - jnp.log1p(-a_init),
        "lru_out_gain": 1.0 + nrm(ks[11], (L, D_LRU), 0.01),
        "rwkv_shift_mu": jax.random.uniform(ks[12], (L, D_RWKV_IN), f32),
        "rwkv_w0": jax.random.uniform(ks[13], (L, D_RWKV), f32, -6.0, 1.0),
        "rwkv_w2": nrm(ks[14], (L, D_DECAY_LORA, D_RWKV), 0.5 * D_DECAY_LORA ** -0.5),
        "rwkv_a0": nrm(ks[15], (L, D_RWKV), 0.1),
        "rwkv_a2": nrm(ks[16], (L, D_AAA_LORA, D_RWKV), 0.5 * D_AAA_LORA ** -0.5),
        "rwkv_g2": nrm(ks[17], (L, D_GATE_LORA, D_RWKV), D_GATE_LORA ** -0.5),
        "rwkv_k_k": 0.85 + nrm(ks[18], (L, D_RWKV), 0.05),
        "rwkv_k_a": 1.0 + nrm(ks[19], (L, D_RWKV), 0.05),
        "rwkv_r_k": nrm(ks[20], (L, RWKV_HEADS, RWKV_HEAD_DIM), 0.1),
        "rwkv_gn_w": 1.0 + nrm(ks[21], (L, D_RWKV), 0.01),
        "rwkv_gn_b": nrm(ks[22], (L, D_RWKV), 0.01),
        "w_out": nrm(ks[23], (L, D_MIX, D_MODEL), D_MIX ** -0.5),
        "norm2_gain": 1.0 + nrm(ks[24], (L, D_MODEL), 0.01),
        "peer_w_query": nrm(ks[25], (L, D_MODEL, PEER_HEADS * PEER_D_QUERY), D_MODEL ** -0.5),
        "peer_q_gain": 1.0 + nrm(ks[26], (L, PEER_HEADS, PEER_D_QUERY), 0.01),
        "peer_sub_keys": nrm(ks[27], (L, PEER_HEADS, 2, PEER_N_KEYS, PEER_HALF), PEER_HALF ** -0.5),
        "peer_u": nrm(ks[28], (L, PEER_N_EXPERTS, D_MODEL), D_MODEL ** -0.5),
        "peer_v": nrm(ks[29], (L, PEER_N_EXPERTS, D_MODEL), 0.5),
        "final_norm_gain": 1.0 + nrm(ks[30], (D_MODEL,), 0.01),
    }


def reference(x, meta_tokens, norm1_gain, w_in, conv_w, conv_b, lru_gate_a_w, lru_gate_a_b,
              lru_gate_x_w, lru_gate_x_b, lru_lambda, lru_out_gain, rwkv_shift_mu, rwkv_w0,
              rwkv_w2, rwkv_a0, rwkv_a2, rwkv_g2, rwkv_k_k, rwkv_k_a, rwkv_r_k, rwkv_gn_w,
              rwkv_gn_b, w_out, norm2_gain, peer_w_query, peer_q_gain, peer_sub_keys,
              peer_u, peer_v, final_norm_gain):
    B = x.shape[0]
    meta = jnp.broadcast_to(meta_tokens[None].astype(x.dtype), (B, N_META, D_MODEL))
    h = jnp.concatenate([meta, x], axis=1)
    for l in range(DEPTH):
        xn = rmsnorm(h, norm1_gain[l])
        p = xn @ w_in[l]
        x_lru, gate_lru, p_rwkv = p[..., :D_LRU], p[..., D_LRU:2 * D_LRU], p[..., 2 * D_LRU:]
        xc = causal_depthwise_conv(x_lru, conv_w[l], conv_b[l])
        y_lru = rg_lru(xc, lru_gate_a_w[l], lru_gate_a_b[l], lru_gate_x_w[l], lru_gate_x_b[l],
                       lru_lambda[l]) * jax.nn.gelu(gate_lru)
        y_lru = rmsnorm(y_lru, lru_out_gain[l])
        p_rwkv = token_shift(p_rwkv, rwkv_shift_mu[l])
        r, k, v, w_lr, a_lr, g_lr = jnp.split(p_rwkv, RWKV_SPLITS, axis=-1)
        y_rwkv = rwkv7_time_mix(r, k, v, w_lr, a_lr, g_lr, rwkv_w0[l], rwkv_w2[l], rwkv_a0[l],
                                rwkv_a2[l], rwkv_g2[l], rwkv_k_k[l], rwkv_k_a[l], rwkv_r_k[l],
                                rwkv_gn_w[l], rwkv_gn_b[l])
        h = h + jnp.concatenate([y_lru, y_rwkv], axis=-1) @ w_out[l]
        h = h + peer(rmsnorm(h, norm2_gain[l]), peer_w_query[l], peer_q_gain[l],
                     peer_sub_keys[l], peer_u[l], peer_v[l])
    return rmsnorm(h, final_norm_gain)[:, N_META:]
```

```cpp
#include <hip/hip_runtime.h>
#include <stdint.h>
#include <stdio.h>

#ifndef DO_LRU
#define DO_LRU 1
#endif
#ifndef DO_RWKV
#define DO_RWKV 1
#endif
#ifndef DO_PEER
#define DO_PEER 1
#endif

#define NTHR 512
#define T_SEQ 8192
#define NTOK 16384
#define NMETA 16
#define MROWS 16640
#define DM 1024
#define DIN 2816
#define NCHUNK 129
#define LD 72
#define LF 68
#define SLOT (64 * LD)

typedef unsigned short bf16_t;
typedef short bf16x8 __attribute__((ext_vector_type(8)));
typedef float f32x4 __attribute__((ext_vector_type(4)));
typedef float f32x16 __attribute__((ext_vector_type(16)));
typedef unsigned u32x4 __attribute__((ext_vector_type(4)));
typedef unsigned u32x2 __attribute__((ext_vector_type(2)));
typedef __bf16 bf2_t __attribute__((ext_vector_type(2)));

constexpr size_t AL(size_t x) { return (x + 255) & ~(size_t)255; }
constexpr size_t OFF_BAR  = 0;
constexpr size_t OFF_SSQ  = 16384;
constexpr size_t SZ_SUM   = (size_t)NCHUNK * 2 * 512 * 4;
constexpr size_t OFF_SUMA = OFF_SSQ + 65536;
constexpr size_t OFF_SUMH = AL(OFF_SUMA + SZ_SUM);
constexpr size_t OFF_HS   = AL(OFF_SUMH + SZ_SUM);
constexpr size_t OFF_WINT = AL(OFF_HS + SZ_SUM);
constexpr size_t OFF_WOUTT = AL(OFF_WINT + (size_t)DIN * DM * 2);
constexpr size_t OFF_WQT  = AL(OFF_WOUTT + (size_t)DM * DM * 2);
constexpr size_t OFF_W2T  = AL(OFF_WQT + (size_t)2048 * DM * 2);
constexpr size_t OFF_A2T  = AL(OFF_W2T + 512 * 64 * 2);
constexpr size_t OFF_G2T  = AL(OFF_A2T + 512 * 64 * 2);
constexpr size_t OFF_WAT  = AL(OFF_G2T + 512 * 128 * 2);
constexpr size_t OFF_WXT  = AL(OFF_WAT + 8 * 64 * 64 * 2);
constexpr size_t OFF_KEYS = AL(OFF_WXT + 8 * 64 * 64 * 2);
constexpr size_t OFF_UB   = AL(OFF_KEYS + 8 * 2 * 128 * 128 * 2);
constexpr size_t OFF_VB   = AL(OFF_UB + (size_t)16384 * DM * 2);
constexpr size_t OFF_XN   = AL(OFF_VB + (size_t)16384 * DM * 2);
constexpr size_t OFF_SB   = AL(OFF_XN + (size_t)MROWS * DM * 2);
constexpr size_t OFF_P    = AL(OFF_SB + (size_t)2048 * 8192);
constexpr size_t OFF_H1B  = OFF_P;
constexpr size_t OFF_EIDX = AL(OFF_H1B + (size_t)NTOK * DM * 2);
constexpr size_t OFF_GATE = AL(OFF_EIDX + (size_t)NTOK * 128 * 2);
constexpr size_t WS_END   = AL(OFF_P + (size_t)MROWS * DIN * 2);
constexpr size_t UNIT_BYTES = 8192 + 16384;
constexpr int NUNITS = 8 + 2048;
static_assert((size_t)NUNITS * UNIT_BYTES <= (size_t)NTOK * DM * 4, "PQ does not fit in d_out");
static_assert(WS_END <= (size_t)256 * 1024 * 1024, "workspace too large");

constexpr int SMEM_BYTES = 150 * 1024;

struct Params {
    const float *x, *meta, *g1, *w_in, *conv_w, *conv_b, *ga_w, *ga_b, *gx_w, *gx_b, *lam, *lru_gain, *mu, *w0, *w2, *a0, *a2, *g2,
        *k_k, *k_a, *r_k, *gn_w, *gn_b, *w_out, *g2n, *w_q, *q_gain, *keys, *u, *v, *fg;
    float* out;
    char* ws;
};

__device__ __forceinline__ unsigned short f2bf(float f) {
    unsigned u = __float_as_uint(f);
    u += 0x7FFFu + ((u >> 16) & 1u);
    return (unsigned short)(u >> 16);
}
__device__ __forceinline__ unsigned pack2(float lo, float hi) { return (unsigned)f2bf(lo) | ((unsigned)f2bf(hi) << 16); }
__device__ __forceinline__ float bflo(unsigned u) { return __uint_as_float(u << 16); }
__device__ __forceinline__ float bfhi(unsigned u) { return __uint_as_float(u & 0xFFFF0000u); }
__device__ __forceinline__ float bf2f(bf16_t b) { return __uint_as_float((unsigned)b << 16); }
__device__ __forceinline__ float wave_sum(float v) {
#pragma unroll
    for (int o = 32; o > 0; o >>= 1) v += __shfl_xor(v, o);
    return v;
}
__device__ __forceinline__ float sum8(float v) { v += __shfl_xor(v, 1); v += __shfl_xor(v, 2); v += __shfl_xor(v, 4); return v; }
__device__ __forceinline__ float sigmoidf_(float x) { return 1.0f / (1.0f + __expf(-x)); }
__device__ __forceinline__ float gelu_tanh(float x) {
    const float u = 0.7978845608f * (x + 0.044715f * x * x * x);
    const float t = 1.0f - 2.0f / (__expf(2.0f * u) + 1.0f);
    return 0.5f * x * (1.0f + t);
}
__device__ __forceinline__ float gelu_erf(float x) { return 0.5f * x * (1.0f + erff(x * 0.70710678118f)); }
__device__ __forceinline__ void unpack8(u32x4 q, float* f) {
    f[0] = bflo(q[0]); f[1] = bfhi(q[0]); f[2] = bflo(q[1]); f[3] = bfhi(q[1]);
    f[4] = bflo(q[2]); f[5] = bfhi(q[2]); f[6] = bflo(q[3]); f[7] = bfhi(q[3]);
}
__device__ __forceinline__ u32x4 pack8(const float* f) {
    u32x4 q; q[0] = pack2(f[0], f[1]); q[1] = pack2(f[2], f[3]); q[2] = pack2(f[4], f[5]); q[3] = pack2(f[6], f[7]); return q;
}
__device__ __forceinline__ int row_of(int b, int pos) { return pos < NMETA ? NTOK + pos : b * T_SEQ + pos - NMETA; }

#define MFMA32(a, b, c) __builtin_amdgcn_mfma_f32_32x32x16_bf16((a), (b), (c), 0, 0, 0)
#define MFMA16(a, b, c) __builtin_amdgcn_mfma_f32_16x16x32_bf16((a), (b), (c), 0, 0, 0)

template <int KS>
__device__ __forceinline__ f32x16 mm_lds(const bf16_t* A, const bf16_t* Bt, int qm, int qn, int lane, f32x16 acc) {
    const int r = lane & 31, h = lane >> 5;
    const bf16_t* ap = A + (qm * 32 + r) * LD + h * 8;
    const bf16_t* bp = Bt + (qn * 32 + r) * LD + h * 8;
#pragma unroll
    for (int ks = 0; ks < KS; ++ks) {
        bf16x8 a = *(const bf16x8*)(ap + ks * 16), b = *(const bf16x8*)(bp + ks * 16);
        acc = MFMA32(a, b, acc);
    }
    return acc;
}
template <int KS>
__device__ __forceinline__ f32x16 mm_lds_g(const bf16_t* A, const bf16_t* __restrict__ Btg, int ldb, int qm, int qn, int lane, f32x16 acc) {
    const int r = lane & 31, h = lane >> 5;
    const bf16_t* ap = A + (qm * 32 + r) * LD + h * 8;
    const bf16_t* bp = Btg + (size_t)(qn * 32 + r) * ldb + h * 8;
    bf16x8 bfr[KS];
#pragma unroll
    for (int ks = 0; ks < KS; ++ks) bfr[ks] = *(const bf16x8*)(bp + ks * 16);
#pragma unroll
    for (int ks = 0; ks < KS; ++ks) { bf16x8 a = *(const bf16x8*)(ap + ks * 16); acc = MFMA32(a, bfr[ks], acc); }
    return acc;
}
__device__ __forceinline__ void store_N_bf16(bf16_t* dst, const f32x16& c, int qm, int qn, int lane) {
    const int r = lane & 31, h = lane >> 5;
#pragma unroll
    for (int reg = 0; reg < 16; ++reg) dst[(qm * 32 + (reg & 3) + 8 * (reg >> 2) + 4 * h) * LD + qn * 32 + r] = f2bf(c[reg]);
}
__device__ __forceinline__ void store_T_bf16(bf16_t* dst, const f32x16& c, int qm, int qn, int lane) {
    const int r = lane & 31, h = lane >> 5;
#pragma unroll
    for (int g = 0; g < 4; ++g) {
        u32x2 w; w[0] = pack2(c[4 * g], c[4 * g + 1]); w[1] = pack2(c[4 * g + 2], c[4 * g + 3]);
        *(u32x2*)(dst + (qn * 32 + r) * LD + qm * 32 + 8 * g + 4 * h) = w;
    }
}
__device__ __forceinline__ void store_N_f32(float* dst, const f32x16& c, int qm, int qn, int lane) {
    const int r = lane & 31, h = lane >> 5;
#pragma unroll
    for (int reg = 0; reg < 16; ++reg) dst[(qm * 32 + (reg & 3) + 8 * (reg >> 2) + 4 * h) * LF + qn * 32 + r] = c[reg];
}
__device__ __forceinline__ f32x16 zero16() { f32x16 z; for (int i = 0; i < 16; ++i) z[i] = 0.f; return z; }

__device__ __forceinline__ void transpose_tile(const float* __restrict__ src, bf16_t* __restrict__ dst, int K, int N, const float* __restrict__ kscale, int tk, int tn, float* tile) {
    const int tid = threadIdx.x;
#pragma unroll
    for (int i = 0; i < 2; ++i) {
        const int kk = (tid >> 4) + 32 * i, nn = (tid & 15) * 4;
        f32x4 v = *(const f32x4*)(src + (size_t)(tk * 64 + kk) * N + tn * 64 + nn);
        const float s = kscale ? kscale[tk * 64 + kk] : 1.0f;
        tile[kk * 65 + nn] = v[0] * s; tile[kk * 65 + nn + 1] = v[1] * s; tile[kk * 65 + nn + 2] = v[2] * s; tile[kk * 65 + nn + 3] = v[3] * s;
    }
    __syncthreads();
    {
        const int n = tid >> 3, ks = (tid & 7) * 8;
        float f[8];
#pragma unroll
        for (int i = 0; i < 8; ++i) f[i] = tile[(ks + i) * 65 + n];
        *(u32x4*)(dst + (size_t)(tn * 64 + n) * K + tk * 64 + ks) = pack8(f);
    }
    __syncthreads();
}

__device__ __forceinline__ void phase_prep(const Params& p, char* smem) {
    const int tid = threadIdx.x, lane = tid & 63, wave = __builtin_amdgcn_readfirstlane(tid >> 6), G = gridDim.x;
    char* ws = p.ws;
    bf16_t* XN = (bf16_t*)(ws + OFF_XN);
    for (int row = blockIdx.x * 8 + wave; row < MROWS; row += G * 8) {
        u32x2* dst = (u32x2*)(XN + (size_t)row * DM);
        if (row >= NTOK + NMETA) {
#pragma unroll
            for (int i = 0; i < 4; ++i) { u32x2 z; z[0] = 0; z[1] = 0; dst[lane + 64 * i] = z; }
            continue;
        }
        const float* src = row < NTOK ? p.x + (size_t)row * DM : p.meta + (size_t)(row - NTOK) * DM;
        f32x4 v[4]; float ss = 0.f;
#pragma unroll
        for (int i = 0; i < 4; ++i) { v[i] = ((const f32x4*)src)[lane + 64 * i]; ss += v[i][0] * v[i][0] + v[i][1] * v[i][1] + v[i][2] * v[i][2] + v[i][3] * v[i][3]; }
        ss = wave_sum(ss);
        const float rs = rsqrtf(ss * (1.0f / DM) + 1e-6f);
#pragma unroll
        for (int i = 0; i < 4; ++i) {
            f32x4 g = ((const f32x4*)p.g1)[lane + 64 * i];
            u32x2 w; w[0] = pack2(v[i][0] * rs * g[0], v[i][1] * rs * g[1]); w[1] = pack2(v[i][2] * rs * g[2], v[i][3] * rs * g[3]);
            dst[lane + 64 * i] = w;
        }
    }
    {
        float* tile = (float*)smem;
        const int n0 = 16 * 44, n1 = n0 + 16 * 16, n2 = n1 + 16 * 32, n3 = n2 + 8, n4 = n3 + 8, n5 = n4 + 16, n6 = n5 + 8, n7 = n6 + 8;
        for (int t = blockIdx.x; t < n7; t += G) {
            if (t < n0) transpose_tile(p.w_in, (bf16_t*)(ws + OFF_WINT), DM, DIN, nullptr, t / 44, t % 44, tile);
            else if (t < n1) { const int u = t - n0; transpose_tile(p.w_out, (bf16_t*)(ws + OFF_WOUTT), DM, DM, nullptr, u / 16, u % 16, tile); }
            else if (t < n2) { const int u = t - n1; transpose_tile(p.w_q, (bf16_t*)(ws + OFF_WQT), DM, 2048, p.g2n, u / 32, u % 32, tile); }
            else if (t < n3) { const int u = t - n2; transpose_tile(p.w2, (bf16_t*)(ws + OFF_W2T), 64, 512, nullptr, 0, u, tile); }
            else if (t < n4) { const int u = t - n3; transpose_tile(p.a2, (bf16_t*)(ws + OFF_A2T), 64, 512, nullptr, 0, u, tile); }
            else if (t < n5) { const int u = t - n4; transpose_tile(p.g2, (bf16_t*)(ws + OFF_G2T), 128, 512, nullptr, u / 8, u % 8, tile); }
            else if (t < n6) { const int u = t - n5; transpose_tile(p.ga_w + u * 4096, (bf16_t*)(ws + OFF_WAT) + u * 4096, 64, 64, nullptr, 0, 0, tile); }
            else { const int u = t - n6; transpose_tile(p.gx_w + u * 4096, (bf16_t*)(ws + OFF_WXT) + u * 4096, 64, 64, nullptr, 0, 0, tile); }
        }
    }
    {
        const int gt = blockIdx.x * NTHR + tid, gs = G * NTHR;
        bf16_t* KEYS = (bf16_t*)(ws + OFF_KEYS);
        for (int i = gt; i < 8 * 2 * 128 * 128 / 4; i += gs) {
            const int e = i * 4, d = e & 127, sub = (e >> 14) & 1, h = e >> 15;
            f32x4 k = ((const f32x4*)p.keys)[i]; f32x4 g = *(const f32x4*)(p.q_gain + h * 256 + sub * 128 + d);
            u32x2 w; w[0] = pack2(k[0] * g[0], k[1] * g[1]); w[1] = pack2(k[2] * g[2], k[3] * g[3]);
            *(u32x2*)(KEYS + e) = w;
        }
        bf16_t* UB = (bf16_t*)(ws + OFF_UB); bf16_t* VB = (bf16_t*)(ws + OFF_VB);
        for (int i = gt; i < 16384 * DM / 4; i += gs) {
            const int d = (i * 4) & (DM - 1);
            f32x4 u = ((const f32x4*)p.u)[i]; f32x4 g = *(const f32x4*)(p.g2n + d); f32x4 v = ((const f32x4*)p.v)[i];
            u32x2 w; w[0] = pack2(u[0] * g[0], u[1] * g[1]); w[1] = pack2(u[2] * g[2], u[3] * g[3]);
            *(u32x2*)(UB + (size_t)i * 4) = w;
            u32x2 w2; w2[0] = pack2(v[0], v[1]); w2[1] = pack2(v[2], v[3]);
            *(u32x2*)(VB + (size_t)i * 4) = w2;
        }
        float* ssq = (float*)(ws + OFF_SSQ);
        for (int i = gt; i < NTOK; i += gs) ssq[i] = 0.f;
    }
}

constexpr int GA_ROWS = 256, GB_ROWS = 128;
constexpr int GBUF = (GA_ROWS + GB_ROWS) * LD;

struct EpiStoreBf16 {
    bf16_t* C; int ldc;
    __device__ __forceinline__ void operator()(const f32x16 (&acc)[2][2], int mb, int nb, int lane) const {
        const int r = lane & 31, h = lane >> 5;
#pragma unroll
        for (int i = 0; i < 2; ++i)
#pragma unroll
            for (int j = 0; j < 2; ++j)
#pragma unroll
                for (int g = 0; g < 4; ++g) {
                    u32x2 w; w[0] = pack2(acc[i][j][4 * g], acc[i][j][4 * g + 1]); w[1] = pack2(acc[i][j][4 * g + 2], acc[i][j][4 * g + 3]);
                    *(u32x2*)(C + (size_t)(mb + i * 32 + r) * ldc + nb + j * 32 + 8 * g + 4 * h) = w;
                }
    }
};
struct EpiResidual {
    bf16_t* C; const float* X; float* ssq;
    __device__ __forceinline__ void operator()(const f32x16 (&acc)[2][2], int mb, int nb, int lane) const {
        const int r = lane & 31, h = lane >> 5;
#pragma unroll
        for (int i = 0; i < 2; ++i) {
            const int row = mb + i * 32 + r; float ss = 0.f;
#pragma unroll
            for (int j = 0; j < 2; ++j)
#pragma unroll
                for (int g = 0; g < 4; ++g) {
                    const int col = nb + j * 32 + 8 * g + 4 * h;
                    f32x4 xv = *(const f32x4*)(X + (size_t)row * DM + col);
                    const float v0 = acc[i][j][4 * g] + xv[0], v1 = acc[i][j][4 * g + 1] + xv[1], v2 = acc[i][j][4 * g + 2] + xv[2], v3 = acc[i][j][4 * g + 3] + xv[3];
                    ss += v0 * v0 + v1 * v1 + v2 * v2 + v3 * v3;
                    u32x2 w; w[0] = pack2(v0, v1); w[1] = pack2(v2, v3);
                    *(u32x2*)(C + (size_t)row * DM + col) = w;
                }
            ss += __shfl_xor(ss, 32);
            if (h == 0) atomicAdd(ssq + row, ss);
        }
    }
};

template <class Epi>
__device__ __forceinline__ void gemm_phase(const bf16_t* __restrict__ A, const bf16_t* __restrict__ Bt, int M, int N, int K, char* smem, const Epi& epi) {
    const int tid = threadIdx.x, lane = tid & 63, wave = __builtin_amdgcn_readfirstlane(tid >> 6);
    const int wm = wave >> 1, wn = wave & 1, r = lane & 31, h = lane >> 5;
    const int nNt = N / 128, ntiles = (M / 256) * nNt, nk = K / 64;
    const int G = gridDim.x;
    const int bid = (G % 8 == 0) ? (blockIdx.x % 8) * (G / 8) + blockIdx.x / 8 : blockIdx.x;
    bf16_t* lds = (bf16_t*)smem;
    for (int tile = bid; tile < ntiles; tile += G) {
        const int pm = tile / nNt, pn = tile % nNt, m0 = pm * 256, n0 = pn * 128;
        const bf16_t* Ag = A + (size_t)m0 * K; const bf16_t* Bg = Bt + (size_t)n0 * K;
        f32x16 acc[2][2];
#pragma unroll
        for (int i = 0; i < 2; ++i)
#pragma unroll
            for (int j = 0; j < 2; ++j) acc[i][j] = zero16();
        u32x4 ra0[4], rb0[2], ra1[4], rb1[2];
#define G_LOAD(RA, RB, KT) { \
            _Pragma("unroll") for (int i = 0; i < 4; ++i) { const int q = tid + 512 * i; RA[i] = *(const u32x4*)(Ag + (size_t)(q >> 3) * K + (KT) * 64 + (q & 7) * 8); } \
            _Pragma("unroll") for (int i = 0; i < 2; ++i) { const int q = tid + 512 * i; RB[i] = *(const u32x4*)(Bg + (size_t)(q >> 3) * K + (KT) * 64 + (q & 7) * 8); } }
#define G_WRITE(RA, RB, BUF) { bf16_t* b_ = lds + (BUF) * GBUF; \
            _Pragma("unroll") for (int i = 0; i < 4; ++i) { const int q = tid + 512 * i; *(u32x4*)(b_ + (q >> 3) * LD + (q & 7) * 8) = RA[i]; } \
            _Pragma("unroll") for (int i = 0; i < 2; ++i) { const int q = tid + 512 * i; *(u32x4*)(b_ + GA_ROWS * LD + (q >> 3) * LD + (q & 7) * 8) = RB[i]; } }
#define G_COMPUTE(BUF) { const bf16_t* a_ = lds + (BUF) * GBUF + (wm * 64 + r) * LD + h * 8; const bf16_t* b_ = lds + (BUF) * GBUF + (GA_ROWS + wn * 64 + r) * LD + h * 8; \
            _Pragma("unroll") for (int ks = 0; ks < 4; ++ks) { \
                bf16x8 af0 = *(const bf16x8*)(a_ + ks * 16), af1 = *(const bf16x8*)(a_ + 32 * LD + ks * 16); \
                bf16x8 bf0 = *(const bf16x8*)(b_ + ks * 16), bf1 = *(const bf16x8*)(b_ + 32 * LD + ks * 16); \
                acc[0][0] = MFMA32(bf0, af0, acc[0][0]); acc[0][1] = MFMA32(bf1, af0, acc[0][1]); \
                acc[1][0] = MFMA32(bf0, af1, acc[1][0]); acc[1][1] = MFMA32(bf1, af1, acc[1][1]); } }
        G_LOAD(ra0, rb0, 0); G_LOAD(ra1, rb1, 1);
        G_WRITE(ra0, rb0, 0);
        __syncthreads();
        for (int kt = 0; kt < nk; kt += 2) {
            if (kt + 2 < nk) G_LOAD(ra0, rb0, kt + 2);
            G_COMPUTE(0);
            G_WRITE(ra1, rb1, 1);
            __syncthreads();
            if (kt + 3 < nk) G_LOAD(ra1, rb1, kt + 3);
            G_COMPUTE(1);
            if (kt + 2 < nk) G_WRITE(ra0, rb0, 0);
            __syncthreads();
        }
        epi(acc, m0 + wm * 64, n0 + wn * 64, lane);
    }
#undef G_LOAD
#undef G_WRITE
#undef G_COMPUTE
}

__device__ __forceinline__ void lru_unit(const Params& p, char* smem, int mode, int c, int b) {
    int tid_ = threadIdx.x; asm volatile("" : "+v"(tid_));
    const int tid = tid_, lane = tid & 63, wave = __builtin_amdgcn_readfirstlane(tid >> 6);
    char* ws = p.ws;
    const bf16_t* P = (const bf16_t*)(ws + OFF_P);
    bf16_t* Y = (bf16_t*)(ws + OFF_XN);
    const bf16_t* WAT = (const bf16_t*)(ws + OFF_WAT); const bf16_t* WXT = (const bf16_t*)(ws + OFF_WXT);
    float* sumA = (float*)(ws + OFF_SUMA); float* sumH = (float*)(ws + OFF_SUMH); const float* HS = (const float*)(ws + OFF_HS);
    bf16_t* Xc = (bf16_t*)smem;
    float* Z0 = (float*)(smem + 9216);
    float* Z1 = Z0 + 64 * LF;
    float* SegA = Z1 + 64 * LF;
    float* SegH = SegA + 512;
    bf16_t* Yl = (bf16_t*)(SegH + 512);
    const int t = tid >> 3, c8 = tid & 7;
    const int pos0 = c == 0 ? 0 : NMETA + 64 * (c - 1);
    const int pos = pos0 + t;
    const bool valid = (c > 0) || (t < NMETA);
    const int row = row_of(b, valid ? pos : 0);
    const int grp = wave >> 2, qm = (wave >> 1) & 1, qn = wave & 1;
    float ssq = 0.f;
    for (int hd = 0; hd < 8; ++hd) {
        const int ch0 = hd * 64 + c8 * 8;
        float xc[8];
        {
            f32x4 b0 = *(const f32x4*)(p.conv_b + ch0), b1 = *(const f32x4*)(p.conv_b + ch0 + 4);
            xc[0] = b0[0]; xc[1] = b0[1]; xc[2] = b0[2]; xc[3] = b0[3]; xc[4] = b1[0]; xc[5] = b1[1]; xc[6] = b1[2]; xc[7] = b1[3];
#pragma unroll
            for (int d = 0; d < 4; ++d) {
                const int pp = pos - 3 + d;
                if (valid && pp >= 0) {
                    u32x4 q = *(const u32x4*)(P + (size_t)row_of(b, pp) * DIN + ch0);
                    float xv[8]; unpack8(q, xv);
                    f32x4 w0 = *(const f32x4*)(p.conv_w + d * 512 + ch0), w1 = *(const f32x4*)(p.conv_w + d * 512 + ch0 + 4);
                    xc[0] += w0[0] * xv[0]; xc[1] += w0[1] * xv[1]; xc[2] += w0[2] * xv[2]; xc[3] += w0[3] * xv[3];
                    xc[4] += w1[0] * xv[4]; xc[5] += w1[1] * xv[5]; xc[6] += w1[2] * xv[6]; xc[7] += w1[3] * xv[7];
                }
            }
            *(u32x4*)(Xc + t * LD + c8 * 8) = pack8(xc);
        }
        __syncthreads();
        {
            f32x16 acc = zero16();
            acc = mm_lds_g<4>(Xc, (grp == 0 ? WAT : WXT) + hd * 4096, 64, qm, qn, lane, acc);
            store_N_f32(grp == 0 ? Z0 : Z1, acc, qm, qn, lane);
        }
        __syncthreads();
        {
            float za[8], zx[8];
            *(f32x4*)za = *(const f32x4*)(Z0 + t * LF + c8 * 8); *(f32x4*)(za + 4) = *(const f32x4*)(Z0 + t * LF + c8 * 8 + 4);
            *(f32x4*)zx = *(const f32x4*)(Z1 + t * LF + c8 * 8); *(f32x4*)(zx + 4) = *(const f32x4*)(Z1 + t * LF + c8 * 8 + 4);
            float av[8], bv[8];
#pragma unroll
            for (int i = 0; i < 8; ++i) {
                const int ch = ch0 + i;
                const float rg = sigmoidf_(za[i] + p.ga_b[ch]), ig = sigmoidf_(zx[i] + p.gx_b[ch]);
                const float sp = log1pf(__expf(-p.lam[ch]));
                const float la = -8.0f * rg * sp;
                const float a = __expf(la);
                const float bb = sqrtf(fmaxf(-expm1f(2.0f * la), 0.f)) * ig * xc[i];
                av[i] = valid ? a : 1.0f; bv[i] = valid ? bb : 0.f;
            }
            *(f32x4*)(Z0 + t * LF + c8 * 8) = *(f32x4*)av; *(f32x4*)(Z0 + t * LF + c8 * 8 + 4) = *(f32x4*)(av + 4);
            *(f32x4*)(Z1 + t * LF + c8 * 8) = *(f32x4*)bv; *(f32x4*)(Z1 + t * LF + c8 * 8 + 4) = *(f32x4*)(bv + 4);
        }
        __syncthreads();
        const int sch = tid & 63, seg = tid >> 6;
        {
            float Ac = 1.f, hh = 0.f;
#pragma unroll
            for (int k = 0; k < 8; ++k) {
                const int tt = seg * 8 + k;
                const float a = Z0[tt * LF + sch], bb = Z1[tt * LF + sch];
                hh = a * hh + bb; Ac *= a;
                Z0[tt * LF + sch] = Ac; Z1[tt * LF + sch] = hh;
            }
            SegA[seg * 64 + sch] = Ac; SegH[seg * 64 + sch] = hh;
        }
        __syncthreads();
        {
            float hin = mode == 1 ? HS[((size_t)c * 2 + b) * 512 + hd * 64 + sch] : 0.f;
            for (int s2 = 0; s2 < seg; ++s2) hin = SegA[s2 * 64 + sch] * hin + SegH[s2 * 64 + sch];
            if (mode == 0) {
                if (seg == 7) {
                    float At = 1.f;
                    for (int s2 = 0; s2 < 8; ++s2) At *= SegA[s2 * 64 + sch];
                    const float ht = SegA[7 * 64 + sch] * hin + SegH[7 * 64 + sch];
                    sumA[((size_t)c * 2 + b) * 512 + hd * 64 + sch] = At;
                    sumH[((size_t)c * 2 + b) * 512 + hd * 64 + sch] = ht;
                }
            } else {
#pragma unroll
                for (int k = 0; k < 8; ++k) { const int tt = seg * 8 + k; Z1[tt * LF + sch] += Z0[tt * LF + sch] * hin; }
            }
        }
        __syncthreads();
        if (mode == 1) {
            float hv[8];
            *(f32x4*)hv = *(const f32x4*)(Z1 + t * LF + c8 * 8); *(f32x4*)(hv + 4) = *(const f32x4*)(Z1 + t * LF + c8 * 8 + 4);
            u32x4 gq = *(const u32x4*)(P + (size_t)row * DIN + 512 + ch0);
            float gv[8]; unpack8(gq, gv);
            float yv[8];
#pragma unroll
            for (int i = 0; i < 8; ++i) { yv[i] = hv[i] * gelu_tanh(gv[i]); ssq += yv[i] * yv[i]; }
            *(u32x4*)(Yl + t * 512 + ch0) = pack8(yv);
            __syncthreads();
        }
    }
    if (mode == 1) {
        ssq = sum8(ssq);
        const float rs = rsqrtf(ssq * (1.0f / 512.0f) + 1e-6f);
        for (int hd = 0; hd < 8; ++hd) {
            const int ch0 = hd * 64 + c8 * 8;
            u32x4 q = *(const u32x4*)(Yl + t * 512 + ch0);
            float yv[8]; unpack8(q, yv);
            f32x4 g0 = *(const f32x4*)(p.lru_gain + ch0), g1 = *(const f32x4*)(p.lru_gain + ch0 + 4);
            yv[0] *= rs * g0[0]; yv[1] *= rs * g0[1]; yv[2] *= rs * g0[2]; yv[3] *= rs * g0[3];
            yv[4] *= rs * g1[0]; yv[5] *= rs * g1[1]; yv[6] *= rs * g1[2]; yv[7] *= rs * g1[3];
            *(u32x4*)(Y + (size_t)row * DM + ch0) = pack8(yv);
        }
        __syncthreads();
    }
}

__device__ __forceinline__ void rwkv_unit(const Params& p, char* smem, int mode, int c, int b, int hh) {
    int tid_ = threadIdx.x; asm volatile("" : "+v"(tid_));
    const int tid = tid_, lane = tid & 63, wave = __builtin_amdgcn_readfirstlane(tid >> 6);
    char* ws = p.ws;
    const bf16_t* P = (const bf16_t*)(ws + OFF_P);
    bf16_t* Y = (bf16_t*)(ws + OFF_XN);
    bf16_t* S0 = (bf16_t*)smem;
#define SL(i) (S0 + (i) * SLOT)
    float* F0 = (float*)(smem + 12 * SLOT * 2);
    float* F1 = F0 + 64 * LF;
    float* Seg = F1 + 64 * LF;
    float* GC = Seg + 512;
    bf16_t *sLw = SL(0), *sAabb = SL(0), *sLg0 = SL(0);
    bf16_t *sLa = SL(1), *sAak = SL(1), *sLg1 = SL(1);
    bf16_t *sBtT = SL(2), *sArb = SL(2);
    bf16_t *sKtT = SL(3), *sArk = SL(3);
    bf16_t *sAt = SL(4), *sGs = SL(4);
    bf16_t *sAtT = SL(5);
    bf16_t *sBh = SL(6), *sD0T = SL(6), *sW1T = SL(6);
    bf16_t *sKh = SL(7), *sM1T = SL(7), *sW2T = SL(7);
    bf16_t *sRt = SL(8);
    bf16_t *sVT = SL(9);
    bf16_t *sTm = SL(10);
    bf16_t *sY2T = SL(11);
    const int t = tid >> 3, c8 = tid & 7;
    const int pos0 = c == 0 ? 0 : NMETA + 64 * (c - 1);
    const int pos = pos0 + t;
    const bool valid = (c > 0) || (t < NMETA);
    const int row = row_of(b, valid ? pos : 0);
    const int grp = wave >> 2, qm = (wave >> 1) & 1, qn = wave & 1, r = lane & 31, h = lane >> 5;
    const int hc0 = hh * 64 + c8 * 8;
    const int unit = c == 0 ? hh : 8 + ((b * 128 + (c - 1)) * 8 + hh);
    float rv[8], kv[8], vv[8];
    {
        const bool hasprev = valid && pos > 0;
        const bf16_t* pr = P + (size_t)row * DIN;
        const bf16_t* pp = P + (size_t)row_of(b, hasprev ? pos - 1 : 0) * DIN;
        auto ld8 = [&](int col, float* out) {
            float cur[8], prv[8];
            unpack8(*(const u32x4*)(pr + col), cur);
            if (hasprev) unpack8(*(const u32x4*)(pp + col), prv); else { for (int i = 0; i < 8; ++i) prv[i] = 0.f; }
            f32x4 m0 = *(const f32x4*)(p.mu + col - 1024), m1 = *(const f32x4*)(p.mu + col - 1024 + 4);
            float mm[8] = {m0[0], m0[1], m0[2], m0[3], m1[0], m1[1], m1[2], m1[3]};
#pragma unroll
            for (int i = 0; i < 8; ++i) out[i] = valid ? cur[i] + (prv[i] - cur[i]) * mm[i] : 0.f;
        };
        ld8(1024 + hc0, rv); ld8(1536 + hc0, kv); ld8(2048 + hc0, vv);
        float wl[8], al[8];
        ld8(2560 + c8 * 8, wl); ld8(2624 + c8 * 8, al);
#pragma unroll
        for (int i = 0; i < 8; ++i) wl[i] = tanhf(wl[i]);
        *(u32x4*)(sLw + t * LD + c8 * 8) = pack8(wl);
        *(u32x4*)(sLa + t * LD + c8 * 8) = pack8(al);
    }
    __syncthreads();
    {
        f32x16 acc = zero16();
        const bf16_t* Bt = (const bf16_t*)(ws + (grp == 0 ? OFF_W2T : OFF_A2T)) + hh * 64 * 64;
        acc = mm_lds_g<4>(grp == 0 ? sLw : sLa, Bt, 64, qm, qn, lane, acc);
        store_N_f32(grp == 0 ? F0 : F1, acc, qm, qn, lane);
    }
    __syncthreads();
    float lw[8], av[8], kk[8], kt[8];
    float rk = 0.f;
    {
        float zw[8], za[8];
        *(f32x4*)zw = *(const f32x4*)(F0 + t * LF + c8 * 8); *(f32x4*)(zw + 4) = *(const f32x4*)(F0 + t * LF + c8 * 8 + 4);
        *(f32x4*)za = *(const f32x4*)(F1 + t * LF + c8 * 8); *(f32x4*)(za + 4) = *(const f32x4*)(F1 + t * LF + c8 * 8 + 4);
        float n2 = 0.f;
#pragma unroll
        for (int i = 0; i < 8; ++i) {
            const int ch = hc0 + i;
            lw[i] = valid ? -0.6065306597f * sigmoidf_(zw[i] + p.w0[ch]) : 0.f;
            av[i] = valid ? sigmoidf_(za[i] + p.a0[ch]) : 0.f;
            kk[i] = kv[i] * p.k_k[ch]; n2 += kk[i] * kk[i];
            kt[i] = kv[i] * (1.0f + (av[i] - 1.0f) * p.k_a[ch]);
            rk += rv[i] * kt[i] * p.r_k[ch];
        }
        n2 = sum8(n2); rk = sum8(rk);
        const float inv = 1.0f / fmaxf(sqrtf(n2), 1e-12f);
#pragma unroll
        for (int i = 0; i < 8; ++i) kk[i] *= inv;
        *(f32x4*)(F0 + t * LF + c8 * 8) = *(f32x4*)lw; *(f32x4*)(F0 + t * LF + c8 * 8 + 4) = *(f32x4*)(lw + 4);
    }
    __syncthreads();
    {
        const int sch = tid & 63, seg = tid >> 6;
        float s = 0.f;
#pragma unroll
        for (int k = 0; k < 8; ++k) { const int tt = seg * 8 + k; s += F0[tt * LF + sch]; F0[tt * LF + sch] = s; }
        Seg[seg * 64 + sch] = s;
        __syncthreads();
        float pre = 0.f;
        for (int s2 = 0; s2 < seg; ++s2) pre += Seg[s2 * 64 + sch];
#pragma unroll
        for (int k = 0; k < 8; ++k) { const int tt = seg * 8 + k; F0[tt * LF + sch] += pre; }
        if (seg == 7) GC[sch] = s + pre;
    }
    __syncthreads();
    {
        float g[8];
        *(f32x4*)g = *(const f32x4*)(F0 + t * LF + c8 * 8); *(f32x4*)(g + 4) = *(const f32x4*)(F0 + t * LF + c8 * 8 + 4);
        float at[8], bh[8], kh[8], rt[8], bt[8], ktt[8];
#pragma unroll
        for (int i = 0; i < 8; ++i) {
            const float gc = GC[c8 * 8 + i];
            const float em = __expf(-g[i]), ep = __expf(g[i]), epv = __expf(g[i] - lw[i]), ec = __expf(gc - g[i]);
            at[i] = -kk[i] * epv; bh[i] = kk[i] * av[i] * em; kh[i] = kt[i] * em; rt[i] = rv[i] * ep;
            bt[i] = kk[i] * av[i] * ec; ktt[i] = kt[i] * ec;
        }
        *(u32x4*)(sAt + t * LD + c8 * 8) = pack8(at);
        *(u32x4*)(sBh + t * LD + c8 * 8) = pack8(bh);
        *(u32x4*)(sKh + t * LD + c8 * 8) = pack8(kh);
        if (mode == 1) *(u32x4*)(sRt + t * LD + c8 * 8) = pack8(rt);
#pragma unroll
        for (int i = 0; i < 8; ++i) {
            sAtT[(c8 * 8 + i) * LD + t] = f2bf(at[i]);
            sVT[(c8 * 8 + i) * LD + t] = f2bf(vv[i]);
            if (mode == 0) { sBtT[(c8 * 8 + i) * LD + t] = f2bf(bt[i]); sKtT[(c8 * 8 + i) * LD + t] = f2bf(ktt[i]); }
        }
    }
    __syncthreads();
    f32x16 accQ = zero16();
    {
        f32x16 acc = zero16();
        if (grp == 0) {
            acc = mm_lds<4>(sAt, sBh, qm, qn, lane, acc);
#pragma unroll
            for (int reg = 0; reg < 16; ++reg) { const int tt = qm * 32 + (reg & 3) + 8 * (reg >> 2) + 4 * h, ss = qn * 32 + r; if (ss >= tt) acc[reg] = 0.f; }
        } else {
            acc = mm_lds<4>(sAt, sKh, qm, qn, lane, acc);
#pragma unroll
            for (int reg = 0; reg < 16; ++reg) { const int tt = qm * 32 + (reg & 3) + 8 * (reg >> 2) + 4 * h, ss = qn * 32 + r; if (ss >= tt) acc[reg] = 0.f; }
        }
        f32x16 acc2 = zero16();
        if (mode == 1) {
            acc2 = mm_lds<4>(sRt, grp == 0 ? sBh : sKh, qm, qn, lane, acc2);
#pragma unroll
            for (int reg = 0; reg < 16; ++reg) { const int tt = qm * 32 + (reg & 3) + 8 * (reg >> 2) + 4 * h, ss = qn * 32 + r; if (ss > tt) acc2[reg] = 0.f; }
        } else if (grp == 0) {
            accQ = mm_lds<4>(sKtT, sVT, qm, qn, lane, accQ);
        }
        if (grp == 0) { store_N_f32(F0, acc, qm, qn, lane); store_N_bf16(sAabb, acc, qm, qn, lane); if (mode == 1) store_N_bf16(sArb, acc2, qm, qn, lane); }
        else { store_N_bf16(sAak, acc, qm, qn, lane); if (mode == 1) store_N_bf16(sArk, acc2, qm, qn, lane); }
    }
    __syncthreads();
    if (wave == 0) {
        int lane2 = lane; asm volatile("" : "+v"(lane2));
        const int blk = lane2 >> 5, j = lane2 & 31;
        const float* Ab = F0 + (32 * blk) * LF + 32 * blk;
        float xs[32];
#pragma unroll
        for (int tt = 0; tt < 32; ++tt) {
            float s = (tt == j) ? 1.f : 0.f;
#pragma unroll
            for (int s2 = 0; s2 < tt; ++s2) s += Ab[tt * LF + s2] * xs[s2];
            xs[tt] = s;
        }
#pragma unroll
        for (int tt = 0; tt < 32; ++tt) sTm[(32 * blk + tt) * LD + 32 * blk + j] = f2bf(xs[tt]);
        if (blk == 0) {
#pragma unroll
            for (int q = 0; q < 4; ++q) *(u32x4*)(sD0T + j * LD + q * 8) = pack8(xs + q * 8);
        }
    } else if (wave == 1) {
        const int rr = lane >> 1, cc = 32 + (lane & 1) * 16;
        u32x4 z; z[0] = 0; z[1] = 0; z[2] = 0; z[3] = 0;
        *(u32x4*)(sTm + rr * LD + cc) = z; *(u32x4*)(sTm + rr * LD + cc + 8) = z;
    } else if (grp == 1) {
        f32x16 acc = zero16();
        acc = mm_lds<4>(sAak, sVT, qm, qn, lane, acc);
        store_T_bf16(sY2T, acc, qm, qn, lane);
    }
    __syncthreads();
    if (wave == 0) {
        f32x16 acc = zero16();
        acc = mm_lds<2>(sAabb, sD0T, 1, 0, lane, acc);
        store_T_bf16(sM1T, acc, 0, 0, lane);
    }
    __syncthreads();
    if (wave == 0) {
        f32x16 acc = zero16();
        const bf16_t* ap = sTm + (32 + r) * LD + 32 + h * 8;
        const bf16_t* bp = sM1T + r * LD + h * 8;
#pragma unroll
        for (int ks = 0; ks < 2; ++ks) { bf16x8 a = *(const bf16x8*)(ap + ks * 16), bb = *(const bf16x8*)(bp + ks * 16); acc = MFMA32(a, bb, acc); }
        store_N_bf16(sTm, acc, 1, 0, lane);
    }
    __syncthreads();
    {
        f32x16 acc = zero16();
        acc = mm_lds<4>(sTm, grp == 0 ? sAtT : sY2T, qm, qn, lane, acc);
        store_T_bf16(grp == 0 ? sW1T : sW2T, acc, qm, qn, lane);
        if (mode == 1) {
            const bool hasprev = valid && pos > 0;
            const bf16_t* pr = P + (size_t)row * DIN + 2688 + c8 * 16;
            const bf16_t* pp = P + (size_t)row_of(b, hasprev ? pos - 1 : 0) * DIN + 2688 + c8 * 16;
            bf16_t* d = ((c8 < 4) ? sLg0 : sLg1) + t * LD + (c8 & 3) * 16;
#pragma unroll
            for (int hf = 0; hf < 2; ++hf) {
                float cur[8], prv[8], gg[8];
                unpack8(*(const u32x4*)(pr + hf * 8), cur);
                if (hasprev) unpack8(*(const u32x4*)(pp + hf * 8), prv); else { for (int i = 0; i < 8; ++i) prv[i] = 0.f; }
#pragma unroll
                for (int i = 0; i < 8; ++i) gg[i] = valid ? sigmoidf_(cur[i] + (prv[i] - cur[i]) * p.mu[1664 + c8 * 16 + hf * 8 + i]) : 0.5f;
                *(u32x4*)(d + hf * 8) = pack8(gg);
            }
        }
    }
    __syncthreads();
    if (mode == 0) {
        char* PQ = (char*)p.out + (size_t)unit * UNIT_BYTES;
        if (grp == 0) {
            f32x16 acc = mm_lds<4>(sBtT, sW2T, qm, qn, lane, accQ);
            float* QC = (float*)(PQ + 8192);
            const int v = qn * 32 + r;
#pragma unroll
            for (int g = 0; g < 4; ++g) {
                const int k = qm * 32 + 8 * g + 4 * h;
                f32x4 w = {acc[4 * g], acc[4 * g + 1], acc[4 * g + 2], acc[4 * g + 3]};
                *(f32x4*)(QC + (((v >> 4) * 4 + (k >> 4)) * 64 + ((k >> 2) & 3) * 16 + (v & 15)) * 4) = w;
            }
        } else {
            f32x16 acc = zero16();
            acc = mm_lds<4>(sBtT, sW1T, qm, qn, lane, acc);
            bf16_t* PA = (bf16_t*)PQ;
            const int k2 = qn * 32 + r;
#pragma unroll
            for (int reg = 0; reg < 16; ++reg) {
                const int k1 = qm * 32 + (reg & 3) + 8 * (reg >> 2) + 4 * h;
                float vv2 = acc[reg];
                if (k1 == k2) vv2 += __expf(GC[k1]);
                PA[(((k1 >> 4) * 2 + (k2 >> 5)) * 64 + ((k2 >> 2) & 3) * 16 + (k1 & 15)) * 8 + ((k2 >> 4) & 1) * 4 + (k2 & 3)] = f2bf(vv2);
            }
        }
        __syncthreads();
        return;
    }
    f32x16 accH = zero16();
    if (grp == 0) {
        f32x16 acc = zero16();
        acc = mm_lds<4>(sArb, sW1T, qm, qn, lane, acc);
#pragma unroll
        for (int reg = 0; reg < 16; ++reg) { const int tt = qm * 32 + (reg & 3) + 8 * (reg >> 2) + 4 * h, k = qn * 32 + r; acc[reg] += bf2f(sRt[tt * LD + k]); }
        store_N_bf16(sGs, acc, qm, qn, lane);
        f32x16 accg = zero16();
        const bf16_t* G2T = (const bf16_t*)(ws + OFF_G2T) + (size_t)hh * 64 * 128;
        accg = mm_lds_g<4>(sLg0, G2T, 128, qm, qn, lane, accg);
        accg = mm_lds_g<4>(sLg1, G2T + 64, 128, qm, qn, lane, accg);
        store_N_f32(F1, accg, qm, qn, lane);
    } else {
        accH = mm_lds<4>(sArb, sW2T, qm, qn, lane, accH);
        accH = mm_lds<4>(sArk, sVT, qm, qn, lane, accH);
    }
    __syncthreads();
    if (grp == 1) {
        const bf16_t* SB = (const bf16_t*)(ws + OFF_SB) + (size_t)((b * 128 + (c - 1)) * 8 + hh) * 4096;
        accH = mm_lds_g<4>(sGs, SB, 64, qm, qn, lane, accH);
        store_N_f32(F0, accH, qm, qn, lane);
    }
    __syncthreads();
    {
        float o[8], zg[8];
        *(f32x4*)o = *(const f32x4*)(F0 + t * LF + c8 * 8); *(f32x4*)(o + 4) = *(const f32x4*)(F0 + t * LF + c8 * 8 + 4);
        *(f32x4*)zg = *(const f32x4*)(F1 + t * LF + c8 * 8); *(f32x4*)(zg + 4) = *(const f32x4*)(F1 + t * LF + c8 * 8 + 4);
        float s = 0.f;
#pragma unroll
        for (int i = 0; i < 8; ++i) s += o[i];
        const float mean = sum8(s) * (1.0f / 64.0f);
        float q = 0.f;
#pragma unroll
        for (int i = 0; i < 8; ++i) { const float d = o[i] - mean; q += d * d; }
        const float var = sum8(q) * (1.0f / 64.0f);
        const float rs = rsqrtf(var + 64e-5f);
        float yv[8];
#pragma unroll
        for (int i = 0; i < 8; ++i) {
            const int ch = hc0 + i;
            const float on = (o[i] - mean) * rs * p.gn_w[ch] + p.gn_b[ch];
            yv[i] = (on + rk * vv[i]) * zg[i];
        }
        *(u32x4*)(Y + (size_t)row * DM + 512 + hc0) = pack8(yv);
    }
    __syncthreads();
#undef SL
}

__device__ __forceinline__ void rwkv_chain(const Params& p, int chain, int cg, int lane) {
    const int b = chain >> 3, hh = chain & 7;
    const char* PQ = (const char*)p.out;
    bf16_t* SBb = (bf16_t*)(p.ws + OFF_SB);
    f32x4 st[4];
#pragma unroll
    for (int m = 0; m < 4; ++m) st[m] = (f32x4){0.f, 0.f, 0.f, 0.f};
    const int q = lane >> 4, vl = lane & 15;
    for (int c = 0; c < NCHUNK; ++c) {
        const int unit = c == 0 ? hh : 8 + ((b * 128 + (c - 1)) * 8 + hh);
        const char* U = PQ + (size_t)unit * UNIT_BYTES;
        u32x4 pa[4][2]; f32x4 acc[4];
#pragma unroll
        for (int m = 0; m < 4; ++m) {
            pa[m][0] = *(const u32x4*)(U + ((size_t)((m * 2 + 0) * 64 + lane)) * 16);
            pa[m][1] = *(const u32x4*)(U + ((size_t)((m * 2 + 1) * 64 + lane)) * 16);
            acc[m] = *(const f32x4*)(U + 8192 + ((size_t)((cg * 4 + m) * 64 + lane)) * 16);
        }
        u32x4 b0, b1;
        b0[0] = pack2(st[0][0], st[0][1]); b0[1] = pack2(st[0][2], st[0][3]); b0[2] = pack2(st[1][0], st[1][1]); b0[3] = pack2(st[1][2], st[1][3]);
        b1[0] = pack2(st[2][0], st[2][1]); b1[1] = pack2(st[2][2], st[2][3]); b1[2] = pack2(st[3][0], st[3][1]); b1[3] = pack2(st[3][2], st[3][3]);
        if (c > 0) {
            bf16_t* S = SBb + (size_t)((b * 128 + (c - 1)) * 8 + hh) * 4096 + (cg * 16 + vl) * 64 + 4 * q;
            u32x2 w;
            w[0] = b0[0]; w[1] = b0[1]; *(u32x2*)(S + 0) = w;
            w[0] = b0[2]; w[1] = b0[3]; *(u32x2*)(S + 16) = w;
            w[0] = b1[0]; w[1] = b1[1]; *(u32x2*)(S + 32) = w;
            w[0] = b1[2]; w[1] = b1[3]; *(u32x2*)(S + 48) = w;
        }
        const bf16x8 B0 = __builtin_bit_cast(bf16x8, b0), B1 = __builtin_bit_cast(bf16x8, b1);
#pragma unroll
        for (int m = 0; m < 4; ++m) acc[m] = MFMA16(__builtin_bit_cast(bf16x8, pa[m][0]), B0, acc[m]);
#pragma unroll
        for (int m = 0; m < 4; ++m) acc[m] = MFMA16(__builtin_bit_cast(bf16x8, pa[m][1]), B1, acc[m]);
#pragma unroll
        for (int m = 0; m < 4; ++m) st[m] = acc[m];
    }
}
__device__ __forceinline__ void lru_chain(const Params& p, int idx) {
    const int b = idx >> 9, ch = idx & 511;
    const float* sumA = (const float*)(p.ws + OFF_SUMA); const float* sumH = (const float*)(p.ws + OFF_SUMH); float* HS = (float*)(p.ws + OFF_HS);
    float hcur = sumH[ch];
    HS[(size_t)(0 * 2 + b) * 512 + ch] = 0.f;
    for (int c = 1; c < NCHUNK; ++c) {
        HS[((size_t)c * 2 + b) * 512 + ch] = hcur;
        hcur = sumA[((size_t)c * 2 + b) * 512 + ch] * hcur + sumH[((size_t)c * 2 + b) * 512 + ch];
    }
}

#define KLD 136
__device__ __forceinline__ unsigned f2ord(float f) { const unsigned u = __float_as_uint(f); return (u & 0x80000000u) ? ~u : (u | 0x80000000u); }
__device__ __forceinline__ float ord2f(unsigned o) { const unsigned u = (o & 0x80000000u) ? (o & 0x7FFFFFFFu) : ~o; return __uint_as_float(u); }
#define CE(a, b) { const unsigned hi_ = max((a), (b)); (b) = min((a), (b)); (a) = hi_; }
__device__ __forceinline__ void ins16(unsigned (&L)[16], unsigned x) {
#pragma unroll
    for (int s = 0; s < 16; ++s) { const unsigned hi_ = max(L[s], x); x = min(L[s], x); L[s] = hi_; }
}
__device__ __forceinline__ void merge_pair16(unsigned (&L)[16]) {
    unsigned Pp[16];
#pragma unroll
    for (int s = 0; s < 16; ++s) Pp[s] = __shfl_xor(L[s], 32);
#pragma unroll
    for (int s = 0; s < 16; ++s) L[s] = max(L[s], Pp[15 - s]);
#pragma unroll
    for (int d = 8; d > 0; d >>= 1)
#pragma unroll
        for (int i = 0; i < 16; ++i) if ((i & d) == 0) CE(L[i], L[i + d]);
}

__device__ __forceinline__ void peer_topk_unit(const Params& p, char* smem, int tile, int head) {
    int tid_ = threadIdx.x; asm volatile("" : "+v"(tid_));
    const int tid = tid_, lane = tid & 63, wave = __builtin_amdgcn_readfirstlane(tid >> 6), r = lane & 31, h = lane >> 5;
    char* ws = p.ws;
    const bf16_t* KEYS = (const bf16_t*)(ws + OFF_KEYS) + (size_t)head * 2 * 128 * 128;
    const bf16_t* QN = (const bf16_t*)p.out;
    bf16_t* kl = (bf16_t*)smem;
    __syncthreads();
#pragma unroll
    for (int i = 0; i < 8; ++i) { const int q = tid + 512 * i, rowk = q >> 4, c16 = q & 15; *(u32x4*)(kl + rowk * KLD + c16 * 8) = *(const u32x4*)(KEYS + (size_t)rowk * 128 + c16 * 8); }
    __syncthreads();
    const int tok = tile * 256 + wave * 32 + r;
    const bf16_t* qrow = QN + (size_t)tok * 2048 + head * 256;
    float ssq = 0.f;
    unsigned L1[16], L2[16];
#pragma unroll
    for (int sub = 0; sub < 2; ++sub) {
        bf16x8 qf[8];
#pragma unroll
        for (int ks = 0; ks < 8; ++ks) {
            u32x4 qq = *(const u32x4*)(qrow + sub * 128 + ks * 16 + h * 8);
            float f[8]; unpack8(qq, f);
#pragma unroll
            for (int i = 0; i < 8; ++i) ssq += f[i] * f[i];
            qf[ks] = __builtin_bit_cast(bf16x8, qq);
        }
        unsigned (&L)[16] = sub == 0 ? L1 : L2;
#pragma unroll
        for (int s = 0; s < 16; ++s) L[s] = 0u;
#pragma unroll
        for (int mt = 0; mt < 4; ++mt) {
            f32x16 acc = zero16();
            const bf16_t* ap = kl + (sub * 128 + mt * 32 + r) * KLD + h * 8;
#pragma unroll
            for (int ks = 0; ks < 8; ++ks) { bf16x8 a = *(const bf16x8*)(ap + ks * 16); acc = MFMA32(a, qf[ks], acc); }
#pragma unroll
            for (int reg = 0; reg < 16; ++reg) {
                const int key = mt * 32 + (reg & 3) + 8 * (reg >> 2) + 4 * h;
                const unsigned x = (f2ord(acc[reg]) & ~127u) | (unsigned)(127 - key);
                ins16(L, x);
            }
        }
        merge_pair16(L);
    }
    ssq += __shfl_xor(ssq, 32);
    const float rstd2 = rsqrtf(((const float*)(ws + OFF_SSQ))[tok] * (1.0f / DM) + 1e-6f);
    const float scale = rstd2 * rsqrtf(rstd2 * rstd2 * ssq * (1.0f / 256.0f) + 1e-6f);
    float v1[16], v2[16];
#pragma unroll
    for (int s = 0; s < 16; ++s) { v1[s] = ord2f(L1[s] & ~127u); v2[s] = ord2f(L2[s] & ~127u); }
    unsigned F[16];
#pragma unroll
    for (int s = 0; s < 16; ++s) F[s] = 0u;
    {
        int cnt = 0;
        unsigned pend = 0u;
#pragma unroll
        for (int i = 0; i < 16; ++i)
#pragma unroll
            for (int j = 0; j < 16; ++j) {
                if ((i + 1) * (j + 1) > 16) continue;
                const unsigned e = ((127u - (L1[i] & 127u)) << 7) | (127u - (L2[j] & 127u));
                const unsigned x = (f2ord(v1[i] + v2[j]) & ~16383u) | e;
                if ((cnt & 1) == 0) pend = x;
                else { const unsigned mine = h ? x : pend; ins16(F, mine); }
                ++cnt;
            }
    }
    merge_pair16(F);
    float sc[16], mx, sum = 0.f;
#pragma unroll
    for (int s = 0; s < 16; ++s) sc[s] = ord2f(F[s] & ~16383u) * scale;
    mx = sc[0];
#pragma unroll
    for (int s = 0; s < 16; ++s) { sc[s] = __expf(sc[s] - mx); sum += sc[s]; }
    const float inv = 1.0f / sum;
    unsigned short* EI = (unsigned short*)(ws + OFF_EIDX) + ((size_t)tok * 8 + head) * 16;
    float* GT = (float*)(ws + OFF_GATE) + ((size_t)tok * 8 + head) * 16;
    if (h == 0) {
        u32x4 w0, w1;
#pragma unroll
        for (int s = 0; s < 4; ++s) { w0[s] = (F[2 * s] & 16383u) | ((F[2 * s + 1] & 16383u) << 16); w1[s] = (F[8 + 2 * s] & 16383u) | ((F[8 + 2 * s + 1] & 16383u) << 16); }
        *(u32x4*)EI = w0; *(u32x4*)(EI + 8) = w1;
        *(f32x4*)GT = (f32x4){sc[0] * inv, sc[1] * inv, sc[2] * inv, sc[3] * inv};
        *(f32x4*)(GT + 4) = (f32x4){sc[4] * inv, sc[5] * inv, sc[6] * inv, sc[7] * inv};
    } else {
        *(f32x4*)(GT + 8) = (f32x4){sc[8] * inv, sc[9] * inv, sc[10] * inv, sc[11] * inv};
        *(f32x4*)(GT + 12) = (f32x4){sc[12] * inv, sc[13] * inv, sc[14] * inv, sc[15] * inv};
    }
}

__device__ __forceinline__ void peer_token(const Params& p, float* coefl, int tok, int lane, bool with_peer) {
    char* ws = p.ws;
    const bf16_t* H1 = (const bf16_t*)(ws + OFF_H1B) + (size_t)tok * DM;
    u32x4 hx0 = *(const u32x4*)(H1 + lane * 16), hx1 = *(const u32x4*)(H1 + lane * 16 + 8);
    float y[16];
#pragma unroll
    for (int i = 0; i < 16; ++i) y[i] = 0.f;
    if (with_peer) {
        const float rstd2 = rsqrtf(((const float*)(ws + OFF_SSQ))[tok] * (1.0f / DM) + 1e-6f);
        const unsigned short* EI = (const unsigned short*)(ws + OFF_EIDX) + (size_t)tok * 128;
        const float* GT = (const float*)(ws + OFF_GATE) + (size_t)tok * 128;
        const int e0 = EI[lane], e1 = EI[lane + 64];
        const float g0 = GT[lane], g1 = GT[lane + 64];
        const bf16_t* UB = (const bf16_t*)(ws + OFF_UB); const bf16_t* VB = (const bf16_t*)(ws + OFF_VB);
        float hid0 = 0.f, hid1 = 0.f;
#pragma unroll 1
        for (int half = 0; half < 2; ++half) {
            const int ev = half ? e1 : e0;
#pragma unroll 1
            for (int bb = 0; bb < 4; ++bb) {
                float part[16];
#pragma unroll
                for (int k = 0; k < 16; ++k) {
                    const int e = __builtin_amdgcn_readlane(ev, bb * 16 + k);
                    const bf16_t* ur = UB + (size_t)e * DM + lane * 16;
                    u32x4 a0 = *(const u32x4*)ur, a1 = *(const u32x4*)(ur + 8);
                    float s = 0.f;
#pragma unroll
                    for (int i = 0; i < 4; ++i) {
                        const unsigned ua = a0[i], ub = hx0[i], uc = a1[i], ud = hx1[i];
                        s = __builtin_amdgcn_fdot2_f32_bf16(__builtin_bit_cast(bf2_t, ua), __builtin_bit_cast(bf2_t, ub), s, false);
                        s = __builtin_amdgcn_fdot2_f32_bf16(__builtin_bit_cast(bf2_t, uc), __builtin_bit_cast(bf2_t, ud), s, false);
                    }
                    part[k] = s;
                }
#pragma unroll
                for (int k = 0; k < 8; ++k) { const float send = (lane & 32) ? part[k] : part[k + 8]; const float keep = (lane & 32) ? part[k + 8] : part[k]; part[k] = keep + __shfl_xor(send, 32); }
#pragma unroll
                for (int k = 0; k < 4; ++k) { const float send = (lane & 16) ? part[k] : part[k + 4]; const float keep = (lane & 16) ? part[k + 4] : part[k]; part[k] = keep + __shfl_xor(send, 16); }
#pragma unroll
                for (int k = 0; k < 2; ++k) { const float send = (lane & 8) ? part[k] : part[k + 2]; const float keep = (lane & 8) ? part[k + 2] : part[k]; part[k] = keep + __shfl_xor(send, 8); }
                { const float send = (lane & 4) ? part[0] : part[1]; const float keep = (lane & 4) ? part[1] : part[0]; part[0] = keep + __shfl_xor(send, 4); }
                part[0] += __shfl_xor(part[0], 1); part[0] += __shfl_xor(part[0], 2);
                const int vi = ((lane >> 5) & 1) * 8 + ((lane >> 4) & 1) * 4 + ((lane >> 3) & 1) * 2 + ((lane >> 2) & 1);
                if ((lane & 3) == 0) coefl[half * 64 + bb * 16 + vi] = part[0];
            }
        }
        __builtin_amdgcn_s_waitcnt(0xc07f);
        __builtin_amdgcn_wave_barrier();
        hid0 = coefl[lane]; hid1 = coefl[lane + 64];
        __builtin_amdgcn_wave_barrier();
        coefl[lane] = g0 * gelu_erf(hid0 * rstd2);
        coefl[lane + 64] = g1 * gelu_erf(hid1 * rstd2);
        __builtin_amdgcn_s_waitcnt(0xc07f);
        __builtin_amdgcn_wave_barrier();
#pragma unroll 1
        for (int half = 0; half < 2; ++half) {
            const int ev = half ? e1 : e0;
#pragma unroll 1
            for (int bb = 0; bb < 8; ++bb) {
                u32x4 a0[8], a1[8];
#pragma unroll
                for (int k = 0; k < 8; ++k) {
                    const int e = __builtin_amdgcn_readlane(ev, bb * 8 + k);
                    const bf16_t* vr = VB + (size_t)e * DM + lane * 16;
                    a0[k] = *(const u32x4*)vr; a1[k] = *(const u32x4*)(vr + 8);
                }
#pragma unroll
                for (int k = 0; k < 8; ++k) {
                    const float cf = coefl[half * 64 + bb * 8 + k];
#pragma unroll
                    for (int i = 0; i < 4; ++i) {
                        y[2 * i] += cf * bflo(a0[k][i]); y[2 * i + 1] += cf * bfhi(a0[k][i]);
                        y[8 + 2 * i] += cf * bflo(a1[k][i]); y[8 + 2 * i + 1] += cf * bfhi(a1[k][i]);
                    }
                }
            }
        }
    }
    float hv[16];
    unpack8(hx0, hv); unpack8(hx1, hv + 8);
    float ss = 0.f;
#pragma unroll
    for (int i = 0; i < 16; ++i) { hv[i] += y[i]; ss += hv[i] * hv[i]; }
    ss = wave_sum(ss);
    const float rs = rsqrtf(ss * (1.0f / DM) + 1e-6f);
    float* orow = p.out + (size_t)tok * DM + lane * 16;
#pragma unroll
    for (int q4 = 0; q4 < 4; ++q4) {
        f32x4 g = *(const f32x4*)(p.fg + lane * 16 + q4 * 4);
        f32x4 o = {hv[q4 * 4] * rs * g[0], hv[q4 * 4 + 1] * rs * g[1], hv[q4 * 4 + 2] * rs * g[2], hv[q4 * 4 + 3] * rs * g[3]};
        *(f32x4*)(orow + q4 * 4) = o;
    }
}

__device__ __forceinline__ void run_phase(const Params& p, char* smem, const int phase) {
    const int tid = threadIdx.x, lane = tid & 63, wave = __builtin_amdgcn_readfirstlane(tid >> 6), G = gridDim.x;
    char* ws = p.ws;
    switch (phase) {
    case 0: phase_prep(p, smem); break;
    case 1: { EpiStoreBf16 e{(bf16_t*)(ws + OFF_P), DIN}; gemm_phase((const bf16_t*)(ws + OFF_XN), (const bf16_t*)(ws + OFF_WINT), MROWS, DIN, DM, smem, e); } break;
    case 2: {
        for (int u = blockIdx.x; u < NUNITS + 257; u += G) {
            if (u < NUNITS) { const int v = u < 8 ? 0 : u - 8; rwkv_unit(p, smem, 0, u < 8 ? 0 : 1 + ((v >> 3) & 127), v >> 10, u < 8 ? u : (v & 7)); }
            else { const int v = u - NUNITS; const int w = v == 0 ? 0 : v - 1; lru_unit(p, smem, 0, v == 0 ? 0 : 1 + (w & 127), w >> 7); }
        }
    } break;
    case 3: {
        if (blockIdx.x < 8) rwkv_chain(p, blockIdx.x * 2 + (wave >> 2), wave & 3, lane);
        else if (blockIdx.x < 10) lru_chain(p, (blockIdx.x - 8) * NTHR + tid);
    } break;
    case 4: {
        if (!DO_RWKV || !DO_LRU) {
            bf16_t* Yz = (bf16_t*)(ws + OFF_XN);
            for (int i = blockIdx.x * NTHR + tid; i < NTOK * 64; i += G * NTHR) {
                const int row = i >> 6, c = (i & 63) * 8 + (DO_LRU ? 512 : 0);
                u32x4 z; z[0] = 0; z[1] = 0; z[2] = 0; z[3] = 0;
                if (!DO_LRU && !DO_RWKV) { *(u32x4*)(Yz + (size_t)row * DM + (i & 63) * 8) = z; *(u32x4*)(Yz + (size_t)row * DM + 512 + (i & 63) * 8) = z; }
                else *(u32x4*)(Yz + (size_t)row * DM + c) = z;
            }
        }
        for (int u = blockIdx.x; u < 2048 + 256; u += G) {
            if (u < 2048) { if (DO_RWKV) rwkv_unit(p, smem, 1, 1 + ((u >> 3) & 127), u >> 10, u & 7); }
            else if (DO_LRU) { const int v = u - 2048; lru_unit(p, smem, 1, 1 + (v & 127), v >> 7); }
        }
    } break;
    case 5: { EpiResidual e{(bf16_t*)(ws + OFF_H1B), p.x, (float*)(ws + OFF_SSQ)}; gemm_phase((const bf16_t*)(ws + OFF_XN), (const bf16_t*)(ws + OFF_WOUTT), NTOK, DM, DM, smem, e); } break;
    case 6: { EpiStoreBf16 e{(bf16_t*)p.out, 2048}; gemm_phase((const bf16_t*)(ws + OFF_H1B), (const bf16_t*)(ws + OFF_WQT), NTOK, 2048, DM, smem, e); } break;
    case 7: { for (int u = blockIdx.x; u < 64 * 8; u += G) peer_topk_unit(p, smem, u >> 3, u & 7); } break;
    case 8: { float* coefl = (float*)smem + wave * 128; for (int tok = blockIdx.x * 8 + wave; tok < NTOK; tok += G * 8) peer_token(p, coefl, tok, lane, DO_PEER != 0); } break;
    }
}

template <int PH>
__global__ void __launch_bounds__(NTHR) k_phase(Params p) {
    extern __shared__ __attribute__((aligned(16))) char smem[];
    run_phase(p, smem, PH);
}
template <int PH>
static void launch_phase(const Params& p, hipStream_t stream) {
    static bool attr_set = false;
    if (!attr_set) { (void)hipFuncSetAttribute((const void*)k_phase<PH>, hipFuncAttributeMaxDynamicSharedMemorySize, SMEM_BYTES); attr_set = true; }
    k_phase<PH><<<256, NTHR, SMEM_BYTES, stream>>>(p);
}

extern "C" void kernel_launch(void* const* d_in, const int* in_sizes, int n_in, void* d_out, int out_size, void* d_ws, size_t ws_size, hipStream_t stream) {
    Params p{};
    const float** pp = (const float**)&p;
    for (int i = 0; i < 31; ++i) pp[i] = (const float*)d_in[i];
    p.out = (float*)d_out; p.ws = (char*)d_ws;
    launch_phase<0>(p, stream); launch_phase<1>(p, stream); launch_phase<2>(p, stream); launch_phase<3>(p, stream);
    launch_phase<4>(p, stream); launch_phase<5>(p, stream);
    if (DO_PEER) { launch_phase<6>(p, stream); launch_phase<7>(p, stream); }
    launch_phase<8>(p, stream);
}
```

```cpp
#include <hip/hip_runtime.h>
#include <stdint.h>
#include <stdio.h>

#ifndef MULTI_LAUNCH
#define MULTI_LAUNCH 0
#endif
#ifndef DO_LRU
#define DO_LRU 1
#endif
#ifndef DO_RWKV
#define DO_RWKV 1
#endif
#ifndef DO_PEER
#define DO_PEER 1
#endif

#define NTHR 512
#define T_SEQ 8192
#define NTOK 16384
#define NMETA 16
#define MROWS 16640
#define DM 1024
#define DIN 2816
#define NCHUNK 129
#define LD 72
#define LF 68
#define SLOT (64 * LD)

typedef unsigned short bf16_t;
typedef short bf16x8 __attribute__((ext_vector_type(8)));
typedef float f32x4 __attribute__((ext_vector_type(4)));
typedef float f32x16 __attribute__((ext_vector_type(16)));
typedef unsigned u32x4 __attribute__((ext_vector_type(4)));
typedef unsigned u32x2 __attribute__((ext_vector_type(2)));
typedef __bf16 bf2_t __attribute__((ext_vector_type(2)));

constexpr size_t AL(size_t x) { return (x + 255) & ~(size_t)255; }
constexpr size_t OFF_BAR  = 0;
constexpr size_t OFF_SSQ  = 16384;
constexpr size_t SZ_SUM   = (size_t)NCHUNK * 2 * 512 * 4;
constexpr size_t OFF_SUMA = OFF_SSQ + 65536;
constexpr size_t OFF_SUMH = AL(OFF_SUMA + SZ_SUM);
constexpr size_t OFF_HS   = AL(OFF_SUMH + SZ_SUM);
constexpr size_t OFF_WINT = AL(OFF_HS + SZ_SUM);
constexpr size_t OFF_WOUTT = AL(OFF_WINT + (size_t)DIN * DM * 2);
constexpr size_t OFF_WQT  = AL(OFF_WOUTT + (size_t)DM * DM * 2);
constexpr size_t OFF_W2T  = AL(OFF_WQT + (size_t)2048 * DM * 2);
constexpr size_t OFF_A2T  = AL(OFF_W2T + 512 * 64 * 2);
constexpr size_t OFF_G2T  = AL(OFF_A2T + 512 * 64 * 2);
constexpr size_t OFF_WAT  = AL(OFF_G2T + 512 * 128 * 2);
constexpr size_t OFF_WXT  = AL(OFF_WAT + 8 * 64 * 64 * 2);
constexpr size_t OFF_KEYS = AL(OFF_WXT + 8 * 64 * 64 * 2);
constexpr size_t OFF_UB   = AL(OFF_KEYS + 8 * 2 * 128 * 128 * 2);
constexpr size_t OFF_VB   = AL(OFF_UB + (size_t)16384 * DM * 2);
constexpr size_t OFF_XN   = AL(OFF_VB + (size_t)16384 * DM * 2);
constexpr size_t OFF_SB   = AL(OFF_XN + (size_t)MROWS * DM * 2);
constexpr size_t OFF_P    = AL(OFF_SB + (size_t)2048 * 8192);
constexpr size_t OFF_H1B  = OFF_P;
constexpr size_t OFF_EIDX = AL(OFF_H1B + (size_t)NTOK * DM * 2);
constexpr size_t OFF_GATE = AL(OFF_EIDX + (size_t)NTOK * 128 * 2);
constexpr size_t WS_END   = AL(OFF_P + (size_t)MROWS * DIN * 2);
constexpr size_t UNIT_BYTES = 8192 + 16384;
constexpr int NUNITS = 8 + 2048;
static_assert((size_t)NUNITS * UNIT_BYTES <= (size_t)NTOK * DM * 4, "PQ does not fit in d_out");
static_assert(WS_END <= (size_t)256 * 1024 * 1024, "workspace too large");

constexpr int SMEM_BYTES = 150 * 1024;

struct Params {
    const float *x, *meta, *g1, *w_in, *conv_w, *conv_b, *ga_w, *ga_b, *gx_w, *gx_b, *lam, *lru_gain, *mu, *w0, *w2, *a0, *a2, *g2,
        *k_k, *k_a, *r_k, *gn_w, *gn_b, *w_out, *g2n, *w_q, *q_gain, *keys, *u, *v, *fg;
    float* out;
    char* ws;
};

__device__ __forceinline__ unsigned short f2bf(float f) {
    unsigned u = __float_as_uint(f);
    u += 0x7FFFu + ((u >> 16) & 1u);
    return (unsigned short)(u >> 16);
}
__device__ __forceinline__ unsigned pack2(float lo, float hi) { return (unsigned)f2bf(lo) | ((unsigned)f2bf(hi) << 16); }
__device__ __forceinline__ float bflo(unsigned u) { return __uint_as_float(u << 16); }
__device__ __forceinline__ float bfhi(unsigned u) { return __uint_as_float(u & 0xFFFF0000u); }
__device__ __forceinline__ float bf2f(bf16_t b) { return __uint_as_float((unsigned)b << 16); }
__device__ __forceinline__ float wave_sum(float v) {
#pragma unroll
    for (int o = 32; o > 0; o >>= 1) v += __shfl_xor(v, o);
    return v;
}
__device__ __forceinline__ float sum8(float v) { v += __shfl_xor(v, 1); v += __shfl_xor(v, 2); v += __shfl_xor(v, 4); return v; }
__device__ __forceinline__ float sigmoidf_(float x) { return 1.0f / (1.0f + __expf(-x)); }
__device__ __forceinline__ float gelu_tanh(float x) {
    const float u = 0.7978845608f * (x + 0.044715f * x * x * x);
    const float t = 1.0f - 2.0f / (__expf(2.0f * u) + 1.0f);
    return 0.5f * x * (1.0f + t);
}
__device__ __forceinline__ float gelu_erf(float x) { return 0.5f * x * (1.0f + erff(x * 0.70710678118f)); }
__device__ __forceinline__ void unpack8(u32x4 q, float* f) {
    f[0] = bflo(q[0]); f[1] = bfhi(q[0]); f[2] = bflo(q[1]); f[3] = bfhi(q[1]);
    f[4] = bflo(q[2]); f[5] = bfhi(q[2]); f[6] = bflo(q[3]); f[7] = bfhi(q[3]);
}
__device__ __forceinline__ u32x4 pack8(const float* f) {
    u32x4 q; q[0] = pack2(f[0], f[1]); q[1] = pack2(f[2], f[3]); q[2] = pack2(f[4], f[5]); q[3] = pack2(f[6], f[7]); return q;
}
__device__ __forceinline__ int row_of(int b, int pos) { return pos < NMETA ? NTOK + pos : b * T_SEQ + pos - NMETA; }

#define MFMA32(a, b, c) __builtin_amdgcn_mfma_f32_32x32x16_bf16((a), (b), (c), 0, 0, 0)
#define MFMA16(a, b, c) __builtin_amdgcn_mfma_f32_16x16x32_bf16((a), (b), (c), 0, 0, 0)

template <int KS>
__device__ __forceinline__ f32x16 mm_lds(const bf16_t* A, const bf16_t* Bt, int qm, int qn, int lane, f32x16 acc) {
    const int r = lane & 31, h = lane >> 5;
    const bf16_t* ap = A + (qm * 32 + r) * LD + h * 8;
    const bf16_t* bp = Bt + (qn * 32 + r) * LD + h * 8;
#pragma unroll
    for (int ks = 0; ks < KS; ++ks) {
        bf16x8 a = *(const bf16x8*)(ap + ks * 16), b = *(const bf16x8*)(bp + ks * 16);
        acc = MFMA32(a, b, acc);
    }
    return acc;
}
template <int KS>
__device__ __forceinline__ f32x16 mm_lds_g(const bf16_t* A, const bf16_t* __restrict__ Btg, int ldb, int qm, int qn, int lane, f32x16 acc) {
    const int r = lane & 31, h = lane >> 5;
    const bf16_t* ap = A + (qm * 32 + r) * LD + h * 8;
    const bf16_t* bp = Btg + (size_t)(qn * 32 + r) * ldb + h * 8;
    bf16x8 bfr[KS];
#pragma unroll
    for (int ks = 0; ks < KS; ++ks) bfr[ks] = *(const bf16x8*)(bp + ks * 16);
#pragma unroll
    for (int ks = 0; ks < KS; ++ks) { bf16x8 a = *(const bf16x8*)(ap + ks * 16); acc = MFMA32(a, bfr[ks], acc); }
    return acc;
}
__device__ __forceinline__ void store_N_bf16(bf16_t* dst, const f32x16& c, int qm, int qn, int lane) {
    const int r = lane & 31, h = lane >> 5;
#pragma unroll
    for (int reg = 0; reg < 16; ++reg) dst[(qm * 32 + (reg & 3) + 8 * (reg >> 2) + 4 * h) * LD + qn * 32 + r] = f2bf(c[reg]);
}
__device__ __forceinline__ void store_T_bf16(bf16_t* dst, const f32x16& c, int qm, int qn, int lane) {
    const int r = lane & 31, h = lane >> 5;
#pragma unroll
    for (int g = 0; g < 4; ++g) {
        u32x2 w; w[0] = pack2(c[4 * g], c[4 * g + 1]); w[1] = pack2(c[4 * g + 2], c[4 * g + 3]);
        *(u32x2*)(dst + (qn * 32 + r) * LD + qm * 32 + 8 * g + 4 * h) = w;
    }
}
__device__ __forceinline__ void store_N_f32(float* dst, const f32x16& c, int qm, int qn, int lane) {
    const int r = lane & 31, h = lane >> 5;
#pragma unroll
    for (int reg = 0; reg < 16; ++reg) dst[(qm * 32 + (reg & 3) + 8 * (reg >> 2) + 4 * h) * LF + qn * 32 + r] = c[reg];
}
__device__ __forceinline__ f32x16 zero16() { f32x16 z; for (int i = 0; i < 16; ++i) z[i] = 0.f; return z; }

__device__ __forceinline__ void transpose_tile(const float* __restrict__ src, bf16_t* __restrict__ dst, int K, int N, const float* __restrict__ kscale, int tk, int tn, float* tile) {
    const int tid = threadIdx.x;
#pragma unroll
    for (int i = 0; i < 2; ++i) {
        const int kk = (tid >> 4) + 32 * i, nn = (tid & 15) * 4;
        f32x4 v = *(const f32x4*)(src + (size_t)(tk * 64 + kk) * N + tn * 64 + nn);
        const float s = kscale ? kscale[tk * 64 + kk] : 1.0f;
        tile[kk * 65 + nn] = v[0] * s; tile[kk * 65 + nn + 1] = v[1] * s; tile[kk * 65 + nn + 2] = v[2] * s; tile[kk * 65 + nn + 3] = v[3] * s;
    }
    __syncthreads();
    {
        const int n = tid >> 3, ks = (tid & 7) * 8;
        float f[8];
#pragma unroll
        for (int i = 0; i < 8; ++i) f[i] = tile[(ks + i) * 65 + n];
        *(u32x4*)(dst + (size_t)(tn * 64 + n) * K + tk * 64 + ks) = pack8(f);
    }
    __syncthreads();
}

__device__ __forceinline__ void phase_prep(const Params& p, char* smem) {
    const int tid = threadIdx.x, lane = tid & 63, wave = __builtin_amdgcn_readfirstlane(tid >> 6), G = gridDim.x;
    char* ws = p.ws;
    bf16_t* XN = (bf16_t*)(ws + OFF_XN);
    for (int row = blockIdx.x * 8 + wave; row < MROWS; row += G * 8) {
        u32x2* dst = (u32x2*)(XN + (size_t)row * DM);
        if (row >= NTOK + NMETA) {
#pragma unroll
            for (int i = 0; i < 4; ++i) { u32x2 z; z[0] = 0; z[1] = 0; dst[lane + 64 * i] = z; }
            continue;
        }
        const float* src = row < NTOK ? p.x + (size_t)row * DM : p.meta + (size_t)(row - NTOK) * DM;
        f32x4 v[4]; float ss = 0.f;
#pragma unroll
        for (int i = 0; i < 4; ++i) { v[i] = ((const f32x4*)src)[lane + 64 * i]; ss += v[i][0] * v[i][0] + v[i][1] * v[i][1] + v[i][2] * v[i][2] + v[i][3] * v[i][3]; }
        ss = wave_sum(ss);
        const float rs = rsqrtf(ss * (1.0f / DM) + 1e-6f);
#pragma unroll
        for (int i = 0; i < 4; ++i) {
            f32x4 g = ((const f32x4*)p.g1)[lane + 64 * i];
            u32x2 w; w[0] = pack2(v[i][0] * rs * g[0], v[i][1] * rs * g[1]); w[1] = pack2(v[i][2] * rs * g[2], v[i][3] * rs * g[3]);
            dst[lane + 64 * i] = w;
        }
    }
    {
        float* tile = (float*)smem;
        const int n0 = 16 * 44, n1 = n0 + 16 * 16, n2 = n1 + 16 * 32, n3 = n2 + 8, n4 = n3 + 8, n5 = n4 + 16, n6 = n5 + 8, n7 = n6 + 8;
        for (int t = blockIdx.x; t < n7; t += G) {
            if (t < n0) transpose_tile(p.w_in, (bf16_t*)(ws + OFF_WINT), DM, DIN, nullptr, t / 44, t % 44, tile);
            else if (t < n1) { const int u = t - n0; transpose_tile(p.w_out, (bf16_t*)(ws + OFF_WOUTT), DM, DM, nullptr, u / 16, u % 16, tile); }
            else if (t < n2) { const int u = t - n1; transpose_tile(p.w_q, (bf16_t*)(ws + OFF_WQT), DM, 2048, p.g2n, u / 32, u % 32, tile); }
            else if (t < n3) { const int u = t - n2; transpose_tile(p.w2, (bf16_t*)(ws + OFF_W2T), 64, 512, nullptr, 0, u, tile); }
            else if (t < n4) { const int u = t - n3; transpose_tile(p.a2, (bf16_t*)(ws + OFF_A2T), 64, 512, nullptr, 0, u, tile); }
            else if (t < n5) { const int u = t - n4; transpose_tile(p.g2, (bf16_t*)(ws + OFF_G2T), 128, 512, nullptr, u / 8, u % 8, tile); }
            else if (t < n6) { const int u = t - n5; transpose_tile(p.ga_w + u * 4096, (bf16_t*)(ws + OFF_WAT) + u * 4096, 64, 64, nullptr, 0, 0, tile); }
            else { const int u = t - n6; transpose_tile(p.gx_w + u * 4096, (bf16_t*)(ws + OFF_WXT) + u * 4096, 64, 64, nullptr, 0, 0, tile); }
        }
    }
    {
        const int gt = blockIdx.x * NTHR + tid, gs = G * NTHR;
        bf16_t* KEYS = (bf16_t*)(ws + OFF_KEYS);
        for (int i = gt; i < 8 * 2 * 128 * 128 / 4; i += gs) {
            const int e = i * 4, d = e & 127, sub = (e >> 14) & 1, h = e >> 15;
            f32x4 k = ((const f32x4*)p.keys)[i]; f32x4 g = *(const f32x4*)(p.q_gain + h * 256 + sub * 128 + d);
            u32x2 w; w[0] = pack2(k[0] * g[0], k[1] * g[1]); w[1] = pack2(k[2] * g[2], k[3] * g[3]);
            *(u32x2*)(KEYS + e) = w;
        }
        bf16_t* UB = (bf16_t*)(ws + OFF_UB); bf16_t* VB = (bf16_t*)(ws + OFF_VB);
        for (int i = gt; i < 16384 * DM / 4; i += gs) {
            const int d = (i * 4) & (DM - 1);
            f32x4 u = ((const f32x4*)p.u)[i]; f32x4 g = *(const f32x4*)(p.g2n + d); f32x4 v = ((const f32x4*)p.v)[i];
            u32x2 w; w[0] = pack2(u[0] * g[0], u[1] * g[1]); w[1] = pack2(u[2] * g[2], u[3] * g[3]);
            *(u32x2*)(UB + (size_t)i * 4) = w;
            u32x2 w2; w2[0] = pack2(v[0], v[1]); w2[1] = pack2(v[2], v[3]);
            *(u32x2*)(VB + (size_t)i * 4) = w2;
        }
        float* ssq = (float*)(ws + OFF_SSQ);
        for (int i = gt; i < NTOK; i += gs) ssq[i] = 0.f;
    }
}

constexpr int GA_ROWS = 256, GB_ROWS = 128;
constexpr int GBUF = (GA_ROWS + GB_ROWS) * LD;

struct EpiStoreBf16 {
    bf16_t* C; int ldc;
    __device__ __forceinline__ void operator()(const f32x16 (&acc)[2][2], int mb, int nb, int lane) const {
        const int r = lane & 31, h = lane >> 5;
#pragma unroll
        for (int i = 0; i < 2; ++i)
#pragma unroll
            for (int j = 0; j < 2; ++j)
#pragma unroll
                for (int g = 0; g < 4; ++g) {
                    u32x2 w; w[0] = pack2(acc[i][j][4 * g], acc[i][j][4 * g + 1]); w[1] = pack2(acc[i][j][4 * g + 2], acc[i][j][4 * g + 3]);
                    *(u32x2*)(C + (size_t)(mb + i * 32 + r) * ldc + nb + j * 32 + 8 * g + 4 * h) = w;
                }
    }
};
struct EpiResidual {
    bf16_t* C; const float* X; float* ssq;
    __device__ __forceinline__ void operator()(const f32x16 (&acc)[2][2], int mb, int nb, int lane) const {
        const int r = lane & 31, h = lane >> 5;
#pragma unroll
        for (int i = 0; i < 2; ++i) {
            const int row = mb + i * 32 + r; float ss = 0.f;
#pragma unroll
            for (int j = 0; j < 2; ++j)
#pragma unroll
                for (int g = 0; g < 4; ++g) {
                    const int col = nb + j * 32 + 8 * g + 4 * h;
                    f32x4 xv = *(const f32x4*)(X + (size_t)row * DM + col);
                    const float v0 = acc[i][j][4 * g] + xv[0], v1 = acc[i][j][4 * g + 1] + xv[1], v2 = acc[i][j][4 * g + 2] + xv[2], v3 = acc[i][j][4 * g + 3] + xv[3];
                    ss += v0 * v0 + v1 * v1 + v2 * v2 + v3 * v3;
                    u32x2 w; w[0] = pack2(v0, v1); w[1] = pack2(v2, v3);
                    *(u32x2*)(C + (size_t)row * DM + col) = w;
                }
            ss += __shfl_xor(ss, 32);
            if (h == 0) atomicAdd(ssq + row, ss);
        }
    }
};

template <class Epi>
__device__ __forceinline__ void gemm_phase(const bf16_t* __restrict__ A, const bf16_t* __restrict__ Bt, int M, int N, int K, char* smem, const Epi& epi) {
    const int tid = threadIdx.x, lane = tid & 63, wave = __builtin_amdgcn_readfirstlane(tid >> 6);
    const int wm = wave >> 1, wn = wave & 1, r = lane & 31, h = lane >> 5;
    const int nNt = N / 128, ntiles = (M / 256) * nNt, nk = K / 64;
    const int G = gridDim.x;
    const int bid = (G % 8 == 0) ? (blockIdx.x % 8) * (G / 8) + blockIdx.x / 8 : blockIdx.x;
    bf16_t* lds = (bf16_t*)smem;
    for (int tile = bid; tile < ntiles; tile += G) {
        const int pm = tile / nNt, pn = tile % nNt, m0 = pm * 256, n0 = pn * 128;
        const bf16_t* Ag = A + (size_t)m0 * K; const bf16_t* Bg = Bt + (size_t)n0 * K;
        f32x16 acc[2][2];
#pragma unroll
        for (int i = 0; i < 2; ++i)
#pragma unroll
            for (int j = 0; j < 2; ++j) acc[i][j] = zero16();
        u32x4 ra0[4], rb0[2], ra1[4], rb1[2];
#define G_LOAD(RA, RB, KT) { \
            _Pragma("unroll") for (int i = 0; i < 4; ++i) { const int q = tid + 512 * i; RA[i] = *(const u32x4*)(Ag + (size_t)(q >> 3) * K + (KT) * 64 + (q & 7) * 8); } \
            _Pragma("unroll") for (int i = 0; i < 2; ++i) { const int q = tid + 512 * i; RB[i] = *(const u32x4*)(Bg + (size_t)(q >> 3) * K + (KT) * 64 + (q & 7) * 8); } }
#define G_WRITE(RA, RB, BUF) { bf16_t* b_ = lds + (BUF) * GBUF; \
            _Pragma("unroll") for (int i = 0; i < 4; ++i) { const int q = tid + 512 * i; *(u32x4*)(b_ + (q >> 3) * LD + (q & 7) * 8) = RA[i]; } \
            _Pragma("unroll") for (int i = 0; i < 2; ++i) { const int q = tid + 512 * i; *(u32x4*)(b_ + GA_ROWS * LD + (q >> 3) * LD + (q & 7) * 8) = RB[i]; } }
#define G_COMPUTE(BUF) { const bf16_t* a_ = lds + (BUF) * GBUF + (wm * 64 + r) * LD + h * 8; const bf16_t* b_ = lds + (BUF) * GBUF + (GA_ROWS + wn * 64 + r) * LD + h * 8; \
            _Pragma("unroll") for (int ks = 0; ks < 4; ++ks) { \
                bf16x8 af0 = *(const bf16x8*)(a_ + ks * 16), af1 = *(const bf16x8*)(a_ + 32 * LD + ks * 16); \
                bf16x8 bf0 = *(const bf16x8*)(b_ + ks * 16), bf1 = *(const bf16x8*)(b_ + 32 * LD + ks * 16); \
                acc[0][0] = MFMA32(bf0, af0, acc[0][0]); acc[0][1] = MFMA32(bf1, af0, acc[0][1]); \
                acc[1][0] = MFMA32(bf0, af1, acc[1][0]); acc[1][1] = MFMA32(bf1, af1, acc[1][1]); } }
        G_LOAD(ra0, rb0, 0); G_LOAD(ra1, rb1, 1);
        G_WRITE(ra0, rb0, 0);
        __syncthreads();
        for (int kt = 0; kt < nk; kt += 2) {
            if (kt + 2 < nk) G_LOAD(ra0, rb0, kt + 2);
            G_COMPUTE(0);
            G_WRITE(ra1, rb1, 1);
            __syncthreads();
            if (kt + 3 < nk) G_LOAD(ra1, rb1, kt + 3);
            G_COMPUTE(1);
            if (kt + 2 < nk) G_WRITE(ra0, rb0, 0);
            __syncthreads();
        }
        epi(acc, m0 + wm * 64, n0 + wn * 64, lane);
    }
#undef G_LOAD
#undef G_WRITE
#undef G_COMPUTE
}

__device__ __forceinline__ void lru_unit(const Params& p, char* smem, int mode, int c, int b) {
    int tid_ = threadIdx.x; asm volatile("" : "+v"(tid_));
    const int tid = tid_, lane = tid & 63, wave = __builtin_amdgcn_readfirstlane(tid >> 6);
    char* ws = p.ws;
    const bf16_t* P = (const bf16_t*)(ws + OFF_P);
    bf16_t* Y = (bf16_t*)(ws + OFF_XN);
    const bf16_t* WAT = (const bf16_t*)(ws + OFF_WAT); const bf16_t* WXT = (const bf16_t*)(ws + OFF_WXT);
    float* sumA = (float*)(ws + OFF_SUMA); float* sumH = (float*)(ws + OFF_SUMH); const float* HS = (const float*)(ws + OFF_HS);
    bf16_t* Xc = (bf16_t*)smem;
    float* Z0 = (float*)(smem + 9216);
    float* Z1 = Z0 + 64 * LF;
    float* SegA = Z1 + 64 * LF;
    float* SegH = SegA + 512;
    bf16_t* Yl = (bf16_t*)(SegH + 512);
    const int t = tid >> 3, c8 = tid & 7;
    const int pos0 = c == 0 ? 0 : NMETA + 64 * (c - 1);
    const int pos = pos0 + t;
    const bool valid = (c > 0) || (t < NMETA);
    const int row = row_of(b, valid ? pos : 0);
    const int grp = wave >> 2, qm = (wave >> 1) & 1, qn = wave & 1;
    float ssq = 0.f;
    for (int hd = 0; hd < 8; ++hd) {
        const int ch0 = hd * 64 + c8 * 8;
        float xc[8];
        {
            f32x4 b0 = *(const f32x4*)(p.conv_b + ch0), b1 = *(const f32x4*)(p.conv_b + ch0 + 4);
            xc[0] = b0[0]; xc[1] = b0[1]; xc[2] = b0[2]; xc[3] = b0[3]; xc[4] = b1[0]; xc[5] = b1[1]; xc[6] = b1[2]; xc[7] = b1[3];
#pragma unroll
            for (int d = 0; d < 4; ++d) {
                const int pp = pos - 3 + d;
                if (valid && pp >= 0) {
                    u32x4 q = *(const u32x4*)(P + (size_t)row_of(b, pp) * DIN + ch0);
                    float xv[8]; unpack8(q, xv);
                    f32x4 w0 = *(const f32x4*)(p.conv_w + d * 512 + ch0), w1 = *(const f32x4*)(p.conv_w + d * 512 + ch0 + 4);
                    xc[0] += w0[0] * xv[0]; xc[1] += w0[1] * xv[1]; xc[2] += w0[2] * xv[2]; xc[3] += w0[3] * xv[3];
                    xc[4] += w1[0] * xv[4]; xc[5] += w1[1] * xv[5]; xc[6] += w1[2] * xv[6]; xc[7] += w1[3] * xv[7];
                }
            }
            *(u32x4*)(Xc + t * LD + c8 * 8) = pack8(xc);
        }
        __syncthreads();
        {
            f32x16 acc = zero16();
            acc = mm_lds_g<4>(Xc, (grp == 0 ? WAT : WXT) + hd * 4096, 64, qm, qn, lane, acc);
            store_N_f32(grp == 0 ? Z0 : Z1, acc, qm, qn, lane);
        }
        __syncthreads();
        {
            float za[8], zx[8];
            *(f32x4*)za = *(const f32x4*)(Z0 + t * LF + c8 * 8); *(f32x4*)(za + 4) = *(const f32x4*)(Z0 + t * LF + c8 * 8 + 4);
            *(f32x4*)zx = *(const f32x4*)(Z1 + t * LF + c8 * 8); *(f32x4*)(zx + 4) = *(const f32x4*)(Z1 + t * LF + c8 * 8 + 4);
            float av[8], bv[8];
#pragma unroll
            for (int i = 0; i < 8; ++i) {
                const int ch = ch0 + i;
                const float rg = sigmoidf_(za[i] + p.ga_b[ch]), ig = sigmoidf_(zx[i] + p.gx_b[ch]);
                const float sp = log1pf(__expf(-p.lam[ch]));
                const float la = -8.0f * rg * sp;
                const float a = __expf(la);
                const float bb = sqrtf(fmaxf(-expm1f(2.0f * la), 0.f)) * ig * xc[i];
                av[i] = valid ? a : 1.0f; bv[i] = valid ? bb : 0.f;
            }
            *(f32x4*)(Z0 + t * LF + c8 * 8) = *(f32x4*)av; *(f32x4*)(Z0 + t * LF + c8 * 8 + 4) = *(f32x4*)(av + 4);
            *(f32x4*)(Z1 + t * LF + c8 * 8) = *(f32x4*)bv; *(f32x4*)(Z1 + t * LF + c8 * 8 + 4) = *(f32x4*)(bv + 4);
        }
        __syncthreads();
        const int sch = tid & 63, seg = tid >> 6;
        {
            float Ac = 1.f, hh = 0.f;
#pragma unroll
            for (int k = 0; k < 8; ++k) {
                const int tt = seg * 8 + k;
                const float a = Z0[tt * LF + sch], bb = Z1[tt * LF + sch];
                hh = a * hh + bb; Ac *= a;
                Z0[tt * LF + sch] = Ac; Z1[tt * LF + sch] = hh;
            }
            SegA[seg * 64 + sch] = Ac; SegH[seg * 64 + sch] = hh;
        }
        __syncthreads();
        {
            float hin = mode == 1 ? HS[((size_t)c * 2 + b) * 512 + hd * 64 + sch] : 0.f;
            for (int s2 = 0; s2 < seg; ++s2) hin = SegA[s2 * 64 + sch] * hin + SegH[s2 * 64 + sch];
            if (mode == 0) {
                if (seg == 7) {
                    float At = 1.f;
                    for (int s2 = 0; s2 < 8; ++s2) At *= SegA[s2 * 64 + sch];
                    const float ht = SegA[7 * 64 + sch] * hin + SegH[7 * 64 + sch];
                    sumA[((size_t)c * 2 + b) * 512 + hd * 64 + sch] = At;
                    sumH[((size_t)c * 2 + b) * 512 + hd * 64 + sch] = ht;
                }
            } else {
#pragma unroll
                for (int k = 0; k < 8; ++k) { const int tt = seg * 8 + k; Z1[tt * LF + sch] += Z0[tt * LF + sch] * hin; }
            }
        }
        __syncthreads();
        if (mode == 1) {
            float hv[8];
            *(f32x4*)hv = *(const f32x4*)(Z1 + t * LF + c8 * 8); *(f32x4*)(hv + 4) = *(const f32x4*)(Z1 + t * LF + c8 * 8 + 4);
            u32x4 gq = *(const u32x4*)(P + (size_t)row * DIN + 512 + ch0);
            float gv[8]; unpack8(gq, gv);
            float yv[8];
#pragma unroll
            for (int i = 0; i < 8; ++i) { yv[i] = hv[i] * gelu_tanh(gv[i]); ssq += yv[i] * yv[i]; }
            *(u32x4*)(Yl + t * 512 + ch0) = pack8(yv);
            __syncthreads();
        }
    }
    if (mode == 1) {
        ssq = sum8(ssq);
        const float rs = rsqrtf(ssq * (1.0f / 512.0f) + 1e-6f);
        for (int hd = 0; hd < 8; ++hd) {
            const int ch0 = hd * 64 + c8 * 8;
            u32x4 q = *(const u32x4*)(Yl + t * 512 + ch0);
            float yv[8]; unpack8(q, yv);
            f32x4 g0 = *(const f32x4*)(p.lru_gain + ch0), g1 = *(const f32x4*)(p.lru_gain + ch0 + 4);
            yv[0] *= rs * g0[0]; yv[1] *= rs * g0[1]; yv[2] *= rs * g0[2]; yv[3] *= rs * g0[3];
            yv[4] *= rs * g1[0]; yv[5] *= rs * g1[1]; yv[6] *= rs * g1[2]; yv[7] *= rs * g1[3];
            *(u32x4*)(Y + (size_t)row * DM + ch0) = pack8(yv);
        }
        __syncthreads();
    }
}

__device__ __forceinline__ void rwkv_unit(const Params& p, char* smem, int mode, int c, int b, int hh) {
    int tid_ = threadIdx.x; asm volatile("" : "+v"(tid_));
    const int tid = tid_, lane = tid & 63, wave = __builtin_amdgcn_readfirstlane(tid >> 6);
    char* ws = p.ws;
    const bf16_t* P = (const bf16_t*)(ws + OFF_P);
    bf16_t* Y = (bf16_t*)(ws + OFF_XN);
    bf16_t* S0 = (bf16_t*)smem;
#define SL(i) (S0 + (i) * SLOT)
    float* F0 = (float*)(smem + 12 * SLOT * 2);
    float* F1 = F0 + 64 * LF;
    float* Seg = F1 + 64 * LF;
    float* GC = Seg + 512;
    bf16_t *sLw = SL(0), *sAabb = SL(0), *sLg0 = SL(0);
    bf16_t *sLa = SL(1), *sAak = SL(1), *sLg1 = SL(1);
    bf16_t *sBtT = SL(2), *sArb = SL(2);
    bf16_t *sKtT = SL(3), *sArk = SL(3);
    bf16_t *sAt = SL(4), *sGs = SL(4);
    bf16_t *sAtT = SL(5);
    bf16_t *sBh = SL(6), *sD0T = SL(6), *sW1T = SL(6);
    bf16_t *sKh = SL(7), *sM1T = SL(7), *sW2T = SL(7);
    bf16_t *sRt = SL(8);
    bf16_t *sVT = SL(9);
    bf16_t *sTm = SL(10);
    bf16_t *sY2T = SL(11);
    const int t = tid >> 3, c8 = tid & 7;
    const int pos0 = c == 0 ? 0 : NMETA + 64 * (c - 1);
    const int pos = pos0 + t;
    const bool valid = (c > 0) || (t < NMETA);
    const int row = row_of(b, valid ? pos : 0);
    const int grp = wave >> 2, qm = (wave >> 1) & 1, qn = wave & 1, r = lane & 31, h = lane >> 5;
    const int hc0 = hh * 64 + c8 * 8;
    const int unit = c == 0 ? hh : 8 + ((b * 128 + (c - 1)) * 8 + hh);
    float rv[8], kv[8], vv[8];
    {
        const bool hasprev = valid && pos > 0;
        const bf16_t* pr = P + (size_t)row * DIN;
        const bf16_t* pp = P + (size_t)row_of(b, hasprev ? pos - 1 : 0) * DIN;
        auto ld8 = [&](int col, float* out) {
            float cur[8], prv[8];
            unpack8(*(const u32x4*)(pr + col), cur);
            if (hasprev) unpack8(*(const u32x4*)(pp + col), prv); else { for (int i = 0; i < 8; ++i) prv[i] = 0.f; }
            f32x4 m0 = *(const f32x4*)(p.mu + col - 1024), m1 = *(const f32x4*)(p.mu + col - 1024 + 4);
            float mm[8] = {m0[0], m0[1], m0[2], m0[3], m1[0], m1[1], m1[2], m1[3]};
#pragma unroll
            for (int i = 0; i < 8; ++i) out[i] = valid ? cur[i] + (prv[i] - cur[i]) * mm[i] : 0.f;
        };
        ld8(1024 + hc0, rv); ld8(1536 + hc0, kv); ld8(2048 + hc0, vv);
        float wl[8], al[8];
        ld8(2560 + c8 * 8, wl); ld8(2624 + c8 * 8, al);
#pragma unroll
        for (int i = 0; i < 8; ++i) wl[i] = tanhf(wl[i]);
        *(u32x4*)(sLw + t * LD + c8 * 8) = pack8(wl);
        *(u32x4*)(sLa + t * LD + c8 * 8) = pack8(al);
    }
    __syncthreads();
    {
        f32x16 acc = zero16();
        const bf16_t* Bt = (const bf16_t*)(ws + (grp == 0 ? OFF_W2T : OFF_A2T)) + hh * 64 * 64;
        acc = mm_lds_g<4>(grp == 0 ? sLw : sLa, Bt, 64, qm, qn, lane, acc);
        store_N_f32(grp == 0 ? F0 : F1, acc, qm, qn, lane);
    }
    __syncthreads();
    float lw[8], av[8], kk[8], kt[8];
    float rk = 0.f;
    {
        float zw[8], za[8];
        *(f32x4*)zw = *(const f32x4*)(F0 + t * LF + c8 * 8); *(f32x4*)(zw + 4) = *(const f32x4*)(F0 + t * LF + c8 * 8 + 4);
        *(f32x4*)za = *(const f32x4*)(F1 + t * LF + c8 * 8); *(f32x4*)(za + 4) = *(const f32x4*)(F1 + t * LF + c8 * 8 + 4);
        float n2 = 0.f;
#pragma unroll
        for (int i = 0; i < 8; ++i) {
            const int ch = hc0 + i;
            lw[i] = valid ? -0.6065306597f * sigmoidf_(zw[i] + p.w0[ch]) : 0.f;
            av[i] = valid ? sigmoidf_(za[i] + p.a0[ch]) : 0.f;
            kk[i] = kv[i] * p.k_k[ch]; n2 += kk[i] * kk[i];
            kt[i] = kv[i] * (1.0f + (av[i] - 1.0f) * p.k_a[ch]);
            rk += rv[i] * kt[i] * p.r_k[ch];
        }
        n2 = sum8(n2); rk = sum8(rk);
        const float inv = 1.0f / fmaxf(sqrtf(n2), 1e-12f);
#pragma unroll
        for (int i = 0; i < 8; ++i) kk[i] *= inv;
        *(f32x4*)(F0 + t * LF + c8 * 8) = *(f32x4*)lw; *(f32x4*)(F0 + t * LF + c8 * 8 + 4) = *(f32x4*)(lw + 4);
    }
    __syncthreads();
    {
        const int sch = tid & 63, seg = tid >> 6;
        float s = 0.f;
#pragma unroll
        for (int k = 0; k < 8; ++k) { const int tt = seg * 8 + k; s += F0[tt * LF + sch]; F0[tt * LF + sch] = s; }
        Seg[seg * 64 + sch] = s;
        __syncthreads();
        float pre = 0.f;
        for (int s2 = 0; s2 < seg; ++s2) pre += Seg[s2 * 64 + sch];
#pragma unroll
        for (int k = 0; k < 8; ++k) { const int tt = seg * 8 + k; F0[tt * LF + sch] += pre; }
        if (seg == 7) GC[sch] = s + pre;
    }
    __syncthreads();
    {
        float g[8];
        *(f32x4*)g = *(const f32x4*)(F0 + t * LF + c8 * 8); *(f32x4*)(g + 4) = *(const f32x4*)(F0 + t * LF + c8 * 8 + 4);
        float at[8], bh[8], kh[8], rt[8], bt[8], ktt[8];
#pragma unroll
        for (int i = 0; i < 8; ++i) {
            const float gc = GC[c8 * 8 + i];
            const float em = __expf(-g[i]), ep = __expf(g[i]), epv = __expf(g[i] - lw[i]), ec = __expf(gc - g[i]);
            at[i] = -kk[i] * epv; bh[i] = kk[i] * av[i] * em; kh[i] = kt[i] * em; rt[i] = rv[i] * ep;
            bt[i] = kk[i] * av[i] * ec; ktt[i] = kt[i] * ec;
        }
        *(u32x4*)(sAt + t * LD + c8 * 8) = pack8(at);
        *(u32x4*)(sBh + t * LD + c8 * 8) = pack8(bh);
        *(u32x4*)(sKh + t * LD + c8 * 8) = pack8(kh);
        if (mode == 1) *(u32x4*)(sRt + t * LD + c8 * 8) = pack8(rt);
#pragma unroll
        for (int i = 0; i < 8; ++i) {
            sAtT[(c8 * 8 + i) * LD + t] = f2bf(at[i]);
            sVT[(c8 * 8 + i) * LD + t] = f2bf(vv[i]);
            if (mode == 0) { sBtT[(c8 * 8 + i) * LD + t] = f2bf(bt[i]); sKtT[(c8 * 8 + i) * LD + t] = f2bf(ktt[i]); }
        }
    }
    __syncthreads();
    f32x16 accQ = zero16();
    {
        f32x16 acc = zero16();
        if (grp == 0) {
            acc = mm_lds<4>(sAt, sBh, qm, qn, lane, acc);
#pragma unroll
            for (int reg = 0; reg < 16; ++reg) { const int tt = qm * 32 + (reg & 3) + 8 * (reg >> 2) + 4 * h, ss = qn * 32 + r; if (ss >= tt) acc[reg] = 0.f; }
        } else {
            acc = mm_lds<4>(sAt, sKh, qm, qn, lane, acc);
#pragma unroll
            for (int reg = 0; reg < 16; ++reg) { const int tt = qm * 32 + (reg & 3) + 8 * (reg >> 2) + 4 * h, ss = qn * 32 + r; if (ss >= tt) acc[reg] = 0.f; }
        }
        f32x16 acc2 = zero16();
        if (mode == 1) {
            acc2 = mm_lds<4>(sRt, grp == 0 ? sBh : sKh, qm, qn, lane, acc2);
#pragma unroll
            for (int reg = 0; reg < 16; ++reg) { const int tt = qm * 32 + (reg & 3) + 8 * (reg >> 2) + 4 * h, ss = qn * 32 + r; if (ss > tt) acc2[reg] = 0.f; }
        } else if (grp == 0) {
            accQ = mm_lds<4>(sKtT, sVT, qm, qn, lane, accQ);
        }
        if (grp == 0) { store_N_f32(F0, acc, qm, qn, lane); store_N_bf16(sAabb, acc, qm, qn, lane); if (mode == 1) store_N_bf16(sArb, acc2, qm, qn, lane); }
        else { store_N_bf16(sAak, acc, qm, qn, lane); if (mode == 1) store_N_bf16(sArk, acc2, qm, qn, lane); }
    }
    __syncthreads();
    if (wave == 0) {
        int lane2 = lane; asm volatile("" : "+v"(lane2));
        const int blk = lane2 >> 5, j = lane2 & 31;
        const float* Ab = F0 + (32 * blk) * LF + 32 * blk;
        float xs[32];
#pragma unroll
        for (int tt = 0; tt < 32; ++tt) {
            float s = (tt == j) ? 1.f : 0.f;
#pragma unroll
            for (int s2 = 0; s2 < tt; ++s2) s += Ab[tt * LF + s2] * xs[s2];
            xs[tt] = s;
        }
#pragma unroll
        for (int tt = 0; tt < 32; ++tt) sTm[(32 * blk + tt) * LD + 32 * blk + j] = f2bf(xs[tt]);
        if (blk == 0) {
#pragma unroll
            for (int q = 0; q < 4; ++q) *(u32x4*)(sD0T + j * LD + q * 8) = pack8(xs + q * 8);
        }
    } else if (wave == 1) {
        const int rr = lane >> 1, cc = 32 + (lane & 1) * 16;
        u32x4 z; z[0] = 0; z[1] = 0; z[2] = 0; z[3] = 0;
        *(u32x4*)(sTm + rr * LD + cc) = z; *(u32x4*)(sTm + rr * LD + cc + 8) = z;
    } else if (grp == 1) {
        f32x16 acc = zero16();
        acc = mm_lds<4>(sAak, sVT, qm, qn, lane, acc);
        store_T_bf16(sY2T, acc, qm, qn, lane);
    }
    __syncthreads();
    if (wave == 0) {
        f32x16 acc = zero16();
        acc = mm_lds<2>(sAabb, sD0T, 1, 0, lane, acc);
        store_T_bf16(sM1T, acc, 0, 0, lane);
    }
    __syncthreads();
    if (wave == 0) {
        f32x16 acc = zero16();
        const bf16_t* ap = sTm + (32 + r) * LD + 32 + h * 8;
        const bf16_t* bp = sM1T + r * LD + h * 8;
#pragma unroll
        for (int ks = 0; ks < 2; ++ks) { bf16x8 a = *(const bf16x8*)(ap + ks * 16), bb = *(const bf16x8*)(bp + ks * 16); acc = MFMA32(a, bb, acc); }
        store_N_bf16(sTm, acc, 1, 0, lane);
    }
    __syncthreads();
    {
        f32x16 acc = zero16();
        acc = mm_lds<4>(sTm, grp == 0 ? sAtT : sY2T, qm, qn, lane, acc);
        store_T_bf16(grp == 0 ? sW1T : sW2T, acc, qm, qn, lane);
        if (mode == 1) {
            const bool hasprev = valid && pos > 0;
            const bf16_t* pr = P + (size_t)row * DIN + 2688 + c8 * 16;
            const bf16_t* pp = P + (size_t)row_of(b, hasprev ? pos - 1 : 0) * DIN + 2688 + c8 * 16;
            bf16_t* d = ((c8 < 4) ? sLg0 : sLg1) + t * LD + (c8 & 3) * 16;
#pragma unroll
            for (int hf = 0; hf < 2; ++hf) {
                float cur[8], prv[8], gg[8];
                unpack8(*(const u32x4*)(pr + hf * 8), cur);
                if (hasprev) unpack8(*(const u32x4*)(pp + hf * 8), prv); else { for (int i = 0; i < 8; ++i) prv[i] = 0.f; }
#pragma unroll
                for (int i = 0; i < 8; ++i) gg[i] = valid ? sigmoidf_(cur[i] + (prv[i] - cur[i]) * p.mu[1664 + c8 * 16 + hf * 8 + i]) : 0.5f;
                *(u32x4*)(d + hf * 8) = pack8(gg);
            }
        }
    }
    __syncthreads();
    if (mode == 0) {
        char* PQ = (char*)p.out + (size_t)unit * UNIT_BYTES;
        if (grp == 0) {
            f32x16 acc = mm_lds<4>(sBtT, sW2T, qm, qn, lane, accQ);
            float* QC = (float*)(PQ + 8192);
            const int v = qn * 32 + r;
#pragma unroll
            for (int g = 0; g < 4; ++g) {
                const int k = qm * 32 + 8 * g + 4 * h;
                f32x4 w = {acc[4 * g], acc[4 * g + 1], acc[4 * g + 2], acc[4 * g + 3]};
                *(f32x4*)(QC + (((v >> 4) * 4 + (k >> 4)) * 64 + ((k >> 2) & 3) * 16 + (v & 15)) * 4) = w;
            }
        } else {
            f32x16 acc = zero16();
            acc = mm_lds<4>(sBtT, sW1T, qm, qn, lane, acc);
            bf16_t* PA = (bf16_t*)PQ;
            const int k2 = qn * 32 + r;
#pragma unroll
            for (int reg = 0; reg < 16; ++reg) {
                const int k1 = qm * 32 + (reg & 3) + 8 * (reg >> 2) + 4 * h;
                float vv2 = acc[reg];
                if (k1 == k2) vv2 += __expf(GC[k1]);
                PA[(((k1 >> 4) * 2 + (k2 >> 5)) * 64 + ((k2 >> 2) & 3) * 16 + (k1 & 15)) * 8 + ((k2 >> 4) & 1) * 4 + (k2 & 3)] = f2bf(vv2);
            }
        }
        __syncthreads();
        return;
    }
    f32x16 accH = zero16();
    if (grp == 0) {
        f32x16 acc = zero16();
        acc = mm_lds<4>(sArb, sW1T, qm, qn, lane, acc);
#pragma unroll
        for (int reg = 0; reg < 16; ++reg) { const int tt = qm * 32 + (reg & 3) + 8 * (reg >> 2) + 4 * h, k = qn * 32 + r; acc[reg] += bf2f(sRt[tt * LD + k]); }
        store_N_bf16(sGs, acc, qm, qn, lane);
        f32x16 accg = zero16();
        const bf16_t* G2T = (const bf16_t*)(ws + OFF_G2T) + (size_t)hh * 64 * 128;
        accg = mm_lds_g<4>(sLg0, G2T, 128, qm, qn, lane, accg);
        accg = mm_lds_g<4>(sLg1, G2T + 64, 128, qm, qn, lane, accg);
        store_N_f32(F1, accg, qm, qn, lane);
    } else {
        accH = mm_lds<4>(sArb, sW2T, qm, qn, lane, accH);
        accH = mm_lds<4>(sArk, sVT, qm, qn, lane, accH);
    }
    __syncthreads();
    if (grp == 1) {
        const bf16_t* SB = (const bf16_t*)(ws + OFF_SB) + (size_t)((b * 128 + (c - 1)) * 8 + hh) * 4096;
        accH = mm_lds_g<4>(sGs, SB, 64, qm, qn, lane, accH);
        store_N_f32(F0, accH, qm, qn, lane);
    }
    __syncthreads();
    {
        float o[8], zg[8];
        *(f32x4*)o = *(const f32x4*)(F0 + t * LF + c8 * 8); *(f32x4*)(o + 4) = *(const f32x4*)(F0 + t * LF + c8 * 8 + 4);
        *(f32x4*)zg = *(const f32x4*)(F1 + t * LF + c8 * 8); *(f32x4*)(zg + 4) = *(const f32x4*)(F1 + t * LF + c8 * 8 + 4);
        float s = 0.f;
#pragma unroll
        for (int i = 0; i < 8; ++i) s += o[i];
        const float mean = sum8(s) * (1.0f / 64.0f);
        float q = 0.f;
#pragma unroll
        for (int i = 0; i < 8; ++i) { const float d = o[i] - mean; q += d * d; }
        const float var = sum8(q) * (1.0f / 64.0f);
        const float rs = rsqrtf(var + 64e-5f);
        float yv[8];
#pragma unroll
        for (int i = 0; i < 8; ++i) {
            const int ch = hc0 + i;
            const float on = (o[i] - mean) * rs * p.gn_w[ch] + p.gn_b[ch];
            yv[i] = (on + rk * vv[i]) * zg[i];
        }
        *(u32x4*)(Y + (size_t)row * DM + 512 + hc0) = pack8(yv);
    }
    __syncthreads();
#undef SL
}

__device__ __forceinline__ void rwkv_chain(const Params& p, int chain, int cg, int lane) {
    const int b = chain >> 3, hh = chain & 7;
    const char* PQ = (const char*)p.out;
    bf16_t* SBb = (bf16_t*)(p.ws + OFF_SB);
    f32x4 st[4];
#pragma unroll
    for (int m = 0; m < 4; ++m) st[m] = (f32x4){0.f, 0.f, 0.f, 0.f};
    const int q = lane >> 4, vl = lane & 15;
    for (int c = 0; c < NCHUNK; ++c) {
        const int unit = c == 0 ? hh : 8 + ((b * 128 + (c - 1)) * 8 + hh);
        const char* U = PQ + (size_t)unit * UNIT_BYTES;
        u32x4 pa[4][2]; f32x4 acc[4];
#pragma unroll
        for (int m = 0; m < 4; ++m) {
            pa[m][0] = *(const u32x4*)(U + ((size_t)((m * 2 + 0) * 64 + lane)) * 16);
            pa[m][1] = *(const u32x4*)(U + ((size_t)((m * 2 + 1) * 64 + lane)) * 16);
            acc[m] = *(const f32x4*)(U + 8192 + ((size_t)((cg * 4 + m) * 64 + lane)) * 16);
        }
        u32x4 b0, b1;
        b0[0] = pack2(st[0][0], st[0][1]); b0[1] = pack2(st[0][2], st[0][3]); b0[2] = pack2(st[1][0], st[1][1]); b0[3] = pack2(st[1][2], st[1][3]);
        b1[0] = pack2(st[2][0], st[2][1]); b1[1] = pack2(st[2][2], st[2][3]); b1[2] = pack2(st[3][0], st[3][1]); b1[3] = pack2(st[3][2], st[3][3]);
        if (c > 0) {
            bf16_t* S = SBb + (size_t)((b * 128 + (c - 1)) * 8 + hh) * 4096 + (cg * 16 + vl) * 64 + 4 * q;
            u32x2 w;
            w[0] = b0[0]; w[1] = b0[1]; *(u32x2*)(S + 0) = w;
            w[0] = b0[2]; w[1] = b0[3]; *(u32x2*)(S + 16) = w;
            w[0] = b1[0]; w[1] = b1[1]; *(u32x2*)(S + 32) = w;
            w[0] = b1[2]; w[1] = b1[3]; *(u32x2*)(S + 48) = w;
        }
        const bf16x8 B0 = __builtin_bit_cast(bf16x8, b0), B1 = __builtin_bit_cast(bf16x8, b1);
#pragma unroll
        for (int m = 0; m < 4; ++m) acc[m] = MFMA16(__builtin_bit_cast(bf16x8, pa[m][0]), B0, acc[m]);
#pragma unroll
        for (int m = 0; m < 4; ++m) acc[m] = MFMA16(__builtin_bit_cast(bf16x8, pa[m][1]), B1, acc[m]);
#pragma unroll
        for (int m = 0; m < 4; ++m) st[m] = acc[m];
    }
}
__device__ __forceinline__ void lru_chain(const Params& p, int idx) {
    const int b = idx >> 9, ch = idx & 511;
    const float* sumA = (const float*)(p.ws + OFF_SUMA); const float* sumH = (const float*)(p.ws + OFF_SUMH); float* HS = (float*)(p.ws + OFF_HS);
    float hcur = sumH[ch];
    HS[(size_t)(0 * 2 + b) * 512 + ch] = 0.f;
    for (int c = 1; c < NCHUNK; ++c) {
        HS[((size_t)c * 2 + b) * 512 + ch] = hcur;
        hcur = sumA[((size_t)c * 2 + b) * 512 + ch] * hcur + sumH[((size_t)c * 2 + b) * 512 + ch];
    }
}

#define KLD 136
__device__ __forceinline__ unsigned f2ord(float f) { const unsigned u = __float_as_uint(f); return (u & 0x80000000u) ? ~u : (u | 0x80000000u); }
__device__ __forceinline__ float ord2f(unsigned o) { const unsigned u = (o & 0x80000000u) ? (o & 0x7FFFFFFFu) : ~o; return __uint_as_float(u); }
#define CE(a, b) { const unsigned hi_ = max((a), (b)); (b) = min((a), (b)); (a) = hi_; }
__device__ __forceinline__ void ins16(unsigned (&L)[16], unsigned x) {
#pragma unroll
    for (int s = 0; s < 16; ++s) { const unsigned hi_ = max(L[s], x); x = min(L[s], x); L[s] = hi_; }
}
__device__ __forceinline__ void merge_pair16(unsigned (&L)[16]) {
    unsigned Pp[16];
#pragma unroll
    for (int s = 0; s < 16; ++s) Pp[s] = __shfl_xor(L[s], 32);
#pragma unroll
    for (int s = 0; s < 16; ++s) L[s] = max(L[s], Pp[15 - s]);
#pragma unroll
    for (int d = 8; d > 0; d >>= 1)
#pragma unroll
        for (int i = 0; i < 16; ++i) if ((i & d) == 0) CE(L[i], L[i + d]);
}

__device__ __forceinline__ void peer_topk_unit(const Params& p, char* smem, int tile, int head) {
    int tid_ = threadIdx.x; asm volatile("" : "+v"(tid_));
    const int tid = tid_, lane = tid & 63, wave = __builtin_amdgcn_readfirstlane(tid >> 6), r = lane & 31, h = lane >> 5;
    char* ws = p.ws;
    const bf16_t* KEYS = (const bf16_t*)(ws + OFF_KEYS) + (size_t)head * 2 * 128 * 128;
    const bf16_t* QN = (const bf16_t*)p.out;
    bf16_t* kl = (bf16_t*)smem;
    __syncthreads();
#pragma unroll
    for (int i = 0; i < 8; ++i) { const int q = tid + 512 * i, rowk = q >> 4, c16 = q & 15; *(u32x4*)(kl + rowk * KLD + c16 * 8) = *(const u32x4*)(KEYS + (size_t)rowk * 128 + c16 * 8); }
    __syncthreads();
    const int tok = tile * 256 + wave * 32 + r;
    const bf16_t* qrow = QN + (size_t)tok * 2048 + head * 256;
    float ssq = 0.f;
    unsigned L1[16], L2[16];
#pragma unroll
    for (int sub = 0; sub < 2; ++sub) {
        bf16x8 qf[8];
#pragma unroll
        for (int ks = 0; ks < 8; ++ks) {
            u32x4 qq = *(const u32x4*)(qrow + sub * 128 + ks * 16 + h * 8);
            float f[8]; unpack8(qq, f);
#pragma unroll
            for (int i = 0; i < 8; ++i) ssq += f[i] * f[i];
            qf[ks] = __builtin_bit_cast(bf16x8, qq);
        }
        unsigned (&L)[16] = sub == 0 ? L1 : L2;
#pragma unroll
        for (int s = 0; s < 16; ++s) L[s] = 0u;
#pragma unroll
        for (int mt = 0; mt < 4; ++mt) {
            f32x16 acc = zero16();
            const bf16_t* ap = kl + (sub * 128 + mt * 32 + r) * KLD + h * 8;
#pragma unroll
            for (int ks = 0; ks < 8; ++ks) { bf16x8 a = *(const bf16x8*)(ap + ks * 16); acc = MFMA32(a, qf[ks], acc); }
#pragma unroll
            for (int reg = 0; reg < 16; ++reg) {
                const int key = mt * 32 + (reg & 3) + 8 * (reg >> 2) + 4 * h;
                const unsigned x = (f2ord(acc[reg]) & ~127u) | (unsigned)(127 - key);
                ins16(L, x);
            }
        }
        merge_pair16(L);
    }
    ssq += __shfl_xor(ssq, 32);
    const float rstd2 = rsqrtf(((const float*)(ws + OFF_SSQ))[tok] * (1.0f / DM) + 1e-6f);
    const float scale = rstd2 * rsqrtf(rstd2 * rstd2 * ssq * (1.0f / 256.0f) + 1e-6f);
    float v1[16], v2[16];
#pragma unroll
    for (int s = 0; s < 16; ++s) { v1[s] = ord2f(L1[s] & ~127u); v2[s] = ord2f(L2[s] & ~127u); }
    unsigned F[16];
#pragma unroll
    for (int s = 0; s < 16; ++s) F[s] = 0u;
    {
        int cnt = 0;
        unsigned pend = 0u;
#pragma unroll
        for (int i = 0; i < 16; ++i)
#pragma unroll
            for (int j = 0; j < 16; ++j) {
                if ((i + 1) * (j + 1) > 16) continue;
                const unsigned e = ((127u - (L1[i] & 127u)) << 7) | (127u - (L2[j] & 127u));
                const unsigned x = (f2ord(v1[i] + v2[j]) & ~16383u) | e;
                if ((cnt & 1) == 0) pend = x;
                else { const unsigned mine = h ? x : pend; ins16(F, mine); }
                ++cnt;
            }
    }
    merge_pair16(F);
    float sc[16], mx, sum = 0.f;
#pragma unroll
    for (int s = 0; s < 16; ++s) sc[s] = ord2f(F[s] & ~16383u) * scale;
    mx = sc[0];
#pragma unroll
    for (int s = 0; s < 16; ++s) { sc[s] = __expf(sc[s] - mx); sum += sc[s]; }
    const float inv = 1.0f / sum;
    unsigned short* EI = (unsigned short*)(ws + OFF_EIDX) + ((size_t)tok * 8 + head) * 16;
    float* GT = (float*)(ws + OFF_GATE) + ((size_t)tok * 8 + head) * 16;
    if (h == 0) {
        u32x4 w0, w1;
#pragma unroll
        for (int s = 0; s < 4; ++s) { w0[s] = (F[2 * s] & 16383u) | ((F[2 * s + 1] & 16383u) << 16); w1[s] = (F[8 + 2 * s] & 16383u) | ((F[8 + 2 * s + 1] & 16383u) << 16); }
        *(u32x4*)EI = w0; *(u32x4*)(EI + 8) = w1;
        *(f32x4*)GT = (f32x4){sc[0] * inv, sc[1] * inv, sc[2] * inv, sc[3] * inv};
        *(f32x4*)(GT + 4) = (f32x4){sc[4] * inv, sc[5] * inv, sc[6] * inv, sc[7] * inv};
    } else {
        *(f32x4*)(GT + 8) = (f32x4){sc[8] * inv, sc[9] * inv, sc[10] * inv, sc[11] * inv};
        *(f32x4*)(GT + 12) = (f32x4){sc[12] * inv, sc[13] * inv, sc[14] * inv, sc[15] * inv};
    }
}

__device__ __forceinline__ void peer_token(const Params& p, float* coefl, int tok, int lane, bool with_peer) {
    char* ws = p.ws;
    const bf16_t* H1 = (const bf16_t*)(ws + OFF_H1B) + (size_t)tok * DM;
    u32x4 hx0 = *(const u32x4*)(H1 + lane * 16), hx1 = *(const u32x4*)(H1 + lane * 16 + 8);
    float y[16];
#pragma unroll
    for (int i = 0; i < 16; ++i) y[i] = 0.f;
    if (with_peer) {
        const float rstd2 = rsqrtf(((const float*)(ws + OFF_SSQ))[tok] * (1.0f / DM) + 1e-6f);
        const unsigned short* EI = (const unsigned short*)(ws + OFF_EIDX) + (size_t)tok * 128;
        const float* GT = (const float*)(ws + OFF_GATE) + (size_t)tok * 128;
        const int e0 = EI[lane], e1 = EI[lane + 64];
        const float g0 = GT[lane], g1 = GT[lane + 64];
        const bf16_t* UB = (const bf16_t*)(ws + OFF_UB); const bf16_t* VB = (const bf16_t*)(ws + OFF_VB);
        float hid0 = 0.f, hid1 = 0.f;
#pragma unroll 1
        for (int half = 0; half < 2; ++half) {
            const int ev = half ? e1 : e0;
#pragma unroll 1
            for (int bb = 0; bb < 4; ++bb) {
                float part[16];
#pragma unroll
                for (int k = 0; k < 16; ++k) {
                    const int e = __builtin_amdgcn_readlane(ev, bb * 16 + k);
                    const bf16_t* ur = UB + (size_t)e * DM + lane * 16;
                    u32x4 a0 = *(const u32x4*)ur, a1 = *(const u32x4*)(ur + 8);
                    float s = 0.f;
#pragma unroll
                    for (int i = 0; i < 4; ++i) {
                        const unsigned ua = a0[i], ub = hx0[i], uc = a1[i], ud = hx1[i];
                        s = __builtin_amdgcn_fdot2_f32_bf16(__builtin_bit_cast(bf2_t, ua), __builtin_bit_cast(bf2_t, ub), s, false);
                        s = __builtin_amdgcn_fdot2_f32_bf16(__builtin_bit_cast(bf2_t, uc), __builtin_bit_cast(bf2_t, ud), s, false);
                    }
                    part[k] = s;
                }
#pragma unroll
                for (int k = 0; k < 8; ++k) { const float send = (lane & 32) ? part[k] : part[k + 8]; const float keep = (lane & 32) ? part[k + 8] : part[k]; part[k] = keep + __shfl_xor(send, 32); }
#pragma unroll
                for (int k = 0; k < 4; ++k) { const float send = (lane & 16) ? part[k] : part[k + 4]; const float keep = (lane & 16) ? part[k + 4] : part[k]; part[k] = keep + __shfl_xor(send, 16); }
#pragma unroll
                for (int k = 0; k < 2; ++k) { const float send = (lane & 8) ? part[k] : part[k + 2]; const float keep = (lane & 8) ? part[k + 2] : part[k]; part[k] = keep + __shfl_xor(send, 8); }
                { const float send = (lane & 4) ? part[0] : part[1]; const float keep = (lane & 4) ? part[1] : part[0]; part[0] = keep + __shfl_xor(send, 4); }
                part[0] += __shfl_xor(part[0], 1); part[0] += __shfl_xor(part[0], 2);
                const int vi = ((lane >> 5) & 1) * 8 + ((lane >> 4) & 1) * 4 + ((lane >> 3) & 1) * 2 + ((lane >> 2) & 1);
                if ((lane & 3) == 0) coefl[half * 64 + bb * 16 + vi] = part[0];
            }
        }
        __builtin_amdgcn_s_waitcnt(0xc07f);
        __builtin_amdgcn_wave_barrier();
        hid0 = coefl[lane]; hid1 = coefl[lane + 64];
        __builtin_amdgcn_wave_barrier();
        coefl[lane] = g0 * gelu_erf(hid0 * rstd2);
        coefl[lane + 64] = g1 * gelu_erf(hid1 * rstd2);
        __builtin_amdgcn_s_waitcnt(0xc07f);
        __builtin_amdgcn_wave_barrier();
#pragma unroll 1
        for (int half = 0; half < 2; ++half) {
            const int ev = half ? e1 : e0;
#pragma unroll 1
            for (int bb = 0; bb < 8; ++bb) {
                u32x4 a0[8], a1[8];
#pragma unroll
                for (int k = 0; k < 8; ++k) {
                    const int e = __builtin_amdgcn_readlane(ev, bb * 8 + k);
                    const bf16_t* vr = VB + (size_t)e * DM + lane * 16;
                    a0[k] = *(const u32x4*)vr; a1[k] = *(const u32x4*)(vr + 8);
                }
#pragma unroll
                for (int k = 0; k < 8; ++k) {
                    const float cf = coefl[half * 64 + bb * 8 + k];
#pragma unroll
                    for (int i = 0; i < 4; ++i) {
                        y[2 * i] += cf * bflo(a0[k][i]); y[2 * i + 1] += cf * bfhi(a0[k][i]);
                        y[8 + 2 * i] += cf * bflo(a1[k][i]); y[8 + 2 * i + 1] += cf * bfhi(a1[k][i]);
                    }
                }
            }
        }
    }
    float hv[16];
    unpack8(hx0, hv); unpack8(hx1, hv + 8);
    float ss = 0.f;
#pragma unroll
    for (int i = 0; i < 16; ++i) { hv[i] += y[i]; ss += hv[i] * hv[i]; }
    ss = wave_sum(ss);
    const float rs = rsqrtf(ss * (1.0f / DM) + 1e-6f);
    float* orow = p.out + (size_t)tok * DM + lane * 16;
#pragma unroll
    for (int q4 = 0; q4 < 4; ++q4) {
        f32x4 g = *(const f32x4*)(p.fg + lane * 16 + q4 * 4);
        f32x4 o = {hv[q4 * 4] * rs * g[0], hv[q4 * 4 + 1] * rs * g[1], hv[q4 * 4 + 2] * rs * g[2], hv[q4 * 4 + 3] * rs * g[3]};
        *(f32x4*)(orow + q4 * 4) = o;
    }
}


#define XB_TMO      128
#define XB_XCNT(j)  (256  + 64 * (j))
#define XB_XSUB(j)  (1280 + 64 * (j))
#define XB_XGEN(j)  (2304 + 64 * (j))
#define XB_TOP      3328
#define XB_TOPGEN   3392
#define XCD_BAR_WORDS 3456
#define XB_SPIN_CAP (1u << 21)
#define LAS __attribute__((address_space(3)))
__device__ __forceinline__ unsigned xb_ld(unsigned* p)              { return __hip_atomic_load(p, __ATOMIC_RELAXED, __HIP_MEMORY_SCOPE_AGENT); }
__device__ __forceinline__ unsigned xb_add(unsigned* p, unsigned v) { return __hip_atomic_fetch_add(p, v, __ATOMIC_RELAXED, __HIP_MEMORY_SCOPE_AGENT); }
__device__ __forceinline__ unsigned xb_xcc_id() { return (unsigned)__builtin_amdgcn_s_getreg((3 << 11) | 20) & 0xFu; }
#define XB_SPIN(cond, bar) do { unsigned _sp = 0; while (cond) { __builtin_amdgcn_s_sleep(1); \
    if ((++_sp & 255u) == 0u) { if (xb_ld(&(bar)[XB_TMO])) break; if (_sp > XB_SPIN_CAP) { atomicAdd(&(bar)[XB_TMO], 1u); break; } } } } while (0)
struct XcdBarrier { unsigned* bar; unsigned x; volatile LAS unsigned* st; };
__device__ __forceinline__ XcdBarrier xcd_barrier_post(unsigned* bar, volatile LAS unsigned* st) {
    XcdBarrier b; b.bar = bar; b.x = xb_xcc_id(); b.st = st;
    if (threadIdx.x == 0) (void)xb_add(&bar[XB_XCNT(b.x)], 1u);
    return b;
}
__device__ __forceinline__ void xcd_barrier_complete(unsigned* bar, unsigned x, unsigned& nloc, unsigned& nx) {
    const unsigned G = gridDim.x * gridDim.y * gridDim.z;
    unsigned sum, cnt, mine, sp = 0u;
    for (;;) {
        sum = 0u; cnt = 0u; mine = 0u;
#pragma unroll
        for (unsigned j = 0; j < 16; ++j) { const unsigned c = xb_ld(&bar[XB_XCNT(j)]); sum += c; cnt += (c > 0u) ? 1u : 0u; mine = (j == x) ? c : mine; }
        if (sum == G) break;
        __builtin_amdgcn_s_sleep(1);
        if ((++sp & 255u) == 0u) { if (xb_ld(&bar[XB_TMO])) break; if (sp > XB_SPIN_CAP) { atomicAdd(&bar[XB_TMO], 1u); break; } }
    }
    nloc = mine > 0u ? mine : 1u; nx = cnt > 0u ? cnt : 1u;
}
__device__ __forceinline__ void xcd_barrier(const XcdBarrier& b) {
    asm volatile("s_waitcnt vmcnt(0)" ::: "memory");
    __syncthreads();
    if (threadIdx.x == 0) {
        unsigned* bar = b.bar;
        __builtin_amdgcn_s_waitcnt(0);
        unsigned nloc = b.st[0], nx = b.st[1];
        if (nloc == 0u) { xcd_barrier_complete(bar, b.x, nloc, nx); b.st[0] = nloc; b.st[1] = nx; }
        const unsigned old = xb_add(&bar[XB_XSUB(b.x)], 1u);
        const unsigned gen = old / nloc;
        if (old + 1u == (gen + 1u) * nloc) {
            __builtin_amdgcn_fence(__ATOMIC_RELEASE, "agent");
            asm volatile("s_waitcnt vmcnt(0)" ::: "memory");
            const unsigned og = xb_add(&bar[XB_TOP], 1u);
            const unsigned tg = og / nx;
            if (og + 1u == (tg + 1u) * nx) xb_add(&bar[XB_TOPGEN], 1u);
            else XB_SPIN(xb_ld(&bar[XB_TOPGEN]) == tg, bar);
            __builtin_amdgcn_fence(__ATOMIC_ACQUIRE, "agent");
            xb_add(&bar[XB_XGEN(b.x)], 1u);
            asm volatile("s_waitcnt vmcnt(0)" ::: "memory");
        } else {
            XB_SPIN(xb_ld(&bar[XB_XGEN(b.x)]) == gen, bar);
            __builtin_amdgcn_fence(__ATOMIC_ACQUIRE, "agent");
            asm volatile("s_waitcnt vmcnt(0)" ::: "memory");
        }
    }
    __syncthreads();
}

__device__ __forceinline__ void run_phase(const Params& p, char* smem, const int phase) {
    const int tid = threadIdx.x, lane = tid & 63, wave = __builtin_amdgcn_readfirstlane(tid >> 6), G = gridDim.x;
    char* ws = p.ws;
    switch (phase) {
    case 0: phase_prep(p, smem); break;
    case 1: { EpiStoreBf16 e{(bf16_t*)(ws + OFF_P), DIN}; gemm_phase((const bf16_t*)(ws + OFF_XN), (const bf16_t*)(ws + OFF_WINT), MROWS, DIN, DM, smem, e); } break;
    case 2: {
        for (int u = blockIdx.x; u < NUNITS + 257; u += G) {
            if (u < NUNITS) { const int v = u < 8 ? 0 : u - 8; rwkv_unit(p, smem, 0, u < 8 ? 0 : 1 + ((v >> 3) & 127), v >> 10, u < 8 ? u : (v & 7)); }
            else { const int v = u - NUNITS; const int w = v == 0 ? 0 : v - 1; lru_unit(p, smem, 0, v == 0 ? 0 : 1 + (w & 127), w >> 7); }
        }
    } break;
    case 3: {
        if (blockIdx.x < 8) rwkv_chain(p, blockIdx.x * 2 + (wave >> 2), wave & 3, lane);
        else if (blockIdx.x < 10) lru_chain(p, (blockIdx.x - 8) * NTHR + tid);
    } break;
    case 4: {
        if (!DO_RWKV || !DO_LRU) {
            bf16_t* Yz = (bf16_t*)(ws + OFF_XN);
            for (int i = blockIdx.x * NTHR + tid; i < NTOK * 64; i += G * NTHR) {
                const int row = i >> 6, c = (i & 63) * 8 + (DO_LRU ? 512 : 0);
                u32x4 z; z[0] = 0; z[1] = 0; z[2] = 0; z[3] = 0;
                if (!DO_LRU && !DO_RWKV) { *(u32x4*)(Yz + (size_t)row * DM + (i & 63) * 8) = z; *(u32x4*)(Yz + (size_t)row * DM + 512 + (i & 63) * 8) = z; }
                else *(u32x4*)(Yz + (size_t)row * DM + c) = z;
            }
        }
        for (int u = blockIdx.x; u < 2048 + 256; u += G) {
            if (u < 2048) { if (DO_RWKV) rwkv_unit(p, smem, 1, 1 + ((u >> 3) & 127), u >> 10, u & 7); }
            else if (DO_LRU) { const int v = u - 2048; lru_unit(p, smem, 1, 1 + (v & 127), v >> 7); }
        }
    } break;
    case 5: { EpiResidual e{(bf16_t*)(ws + OFF_H1B), p.x, (float*)(ws + OFF_SSQ)}; gemm_phase((const bf16_t*)(ws + OFF_XN), (const bf16_t*)(ws + OFF_WOUTT), NTOK, DM, DM, smem, e); } break;
    case 6: { EpiStoreBf16 e{(bf16_t*)p.out, 2048}; gemm_phase((const bf16_t*)(ws + OFF_H1B), (const bf16_t*)(ws + OFF_WQT), NTOK, 2048, DM, smem, e); } break;
    case 7: { for (int u = blockIdx.x; u < 64 * 8; u += G) peer_topk_unit(p, smem, u >> 3, u & 7); } break;
    case 8: { float* coefl = (float*)smem + wave * 128; for (int tok = blockIdx.x * 8 + wave; tok < NTOK; tok += G * 8) peer_token(p, coefl, tok, lane, DO_PEER != 0); } break;
    }
}

template <int PH>
__global__ void __launch_bounds__(NTHR) k_phase(Params p) {
    extern __shared__ __attribute__((aligned(16))) char smem[];
    run_phase(p, smem, PH);
}
template <int PH>
static void launch_phase(const Params& p, hipStream_t stream) {
    static bool attr_set = false;
    if (!attr_set) { (void)hipFuncSetAttribute((const void*)k_phase<PH>, hipFuncAttributeMaxDynamicSharedMemorySize, SMEM_BYTES); attr_set = true; }
    k_phase<PH><<<256, NTHR, SMEM_BYTES, stream>>>(p);
}


__global__ void __launch_bounds__(NTHR) k_mega(Params p) {
    extern __shared__ __attribute__((aligned(16))) char smem[];
    volatile LAS unsigned* st = (volatile LAS unsigned*)(smem + SMEM_BYTES - 16);
    if (threadIdx.x == 0) { st[0] = 0u; st[1] = 0u; st[2] = 0u; st[3] = 0u; }
    __syncthreads();
    XcdBarrier bar = xcd_barrier_post((unsigned*)(p.ws + OFF_BAR), st);
    run_phase(p, smem, 0); xcd_barrier(bar);
    run_phase(p, smem, 1); xcd_barrier(bar);
    run_phase(p, smem, 2); xcd_barrier(bar);
    run_phase(p, smem, 3); xcd_barrier(bar);
    run_phase(p, smem, 4); xcd_barrier(bar);
    run_phase(p, smem, 5); xcd_barrier(bar);
    run_phase(p, smem, 6); xcd_barrier(bar);
    run_phase(p, smem, 7); xcd_barrier(bar);
    run_phase(p, smem, 8);
}

extern "C" void kernel_launch(void* const* d_in, const int* in_sizes, int n_in, void* d_out, int out_size, void* d_ws, size_t ws_size, hipStream_t stream) {
    Params p{};
    const float** pp = (const float**)&p;
    for (int i = 0; i < 31; ++i) pp[i] = (const float*)d_in[i];
    p.out = (float*)d_out; p.ws = (char*)d_ws;
#if MULTI_LAUNCH
    launch_phase<0>(p, stream); launch_phase<1>(p, stream); launch_phase<2>(p, stream); launch_phase<3>(p, stream);
    launch_phase<4>(p, stream); launch_phase<5>(p, stream);
    if (DO_PEER) { launch_phase<6>(p, stream); launch_phase<7>(p, stream); }
    launch_phase<8>(p, stream);
#else
    static bool attr_set = false;
    if (!attr_set) { (void)hipFuncSetAttribute((const void*)k_mega, hipFuncAttributeMaxDynamicSharedMemorySize, SMEM_BYTES); attr_set = true; }
    (void)hipMemsetAsync(p.ws + OFF_BAR, 0, XCD_BAR_WORDS * 4, stream);
    void* args[] = {&p};
    hipError_t e = hipLaunchCooperativeKernel((const void*)k_mega, dim3(256), dim3(NTHR), args, SMEM_BYTES, stream);
    if (e != hipSuccess) fprintf(stderr, "cooperative launch failed: %s\n", hipGetErrorString(e));
#endif
}
```

```cpp
#include <hip/hip_runtime.h>
#include <stdint.h>
#include <stdio.h>

#ifndef REP0
#define REP0 1
#endif
#ifndef REP1
#define REP1 1
#endif
#ifndef REP2
#define REP2 1
#endif
#ifndef REP3
#define REP3 1
#endif
#ifndef REP4
#define REP4 1
#endif
#ifndef REP6
#define REP6 1
#endif
#ifndef REP7
#define REP7 1
#endif
#ifndef REP8
#define REP8 1
#endif
#ifndef MULTI_LAUNCH
#define MULTI_LAUNCH 0
#endif
#ifndef DO_LRU
#define DO_LRU 1
#endif
#ifndef DO_RWKV
#define DO_RWKV 1
#endif
#ifndef DO_PEER
#define DO_PEER 1
#endif

#define NTHR 512
#define T_SEQ 8192
#define NTOK 16384
#define NMETA 16
#define MROWS 16640
#define DM 1024
#define DIN 2816
#define NCHUNK 129
#define LD 72
#define LF 68
#define SLOT (64 * LD)

typedef unsigned short bf16_t;
typedef short bf16x8 __attribute__((ext_vector_type(8)));
typedef float f32x4 __attribute__((ext_vector_type(4)));
typedef float f32x16 __attribute__((ext_vector_type(16)));
typedef unsigned u32x4 __attribute__((ext_vector_type(4)));
typedef unsigned u32x2 __attribute__((ext_vector_type(2)));
typedef __bf16 bf2_t __attribute__((ext_vector_type(2)));
typedef float f32x2 __attribute__((ext_vector_type(2)));

constexpr size_t AL(size_t x) { return (x + 255) & ~(size_t)255; }
constexpr size_t OFF_BAR  = 0;
constexpr size_t OFF_SSQ  = 16384;
constexpr size_t SZ_SUM   = (size_t)NCHUNK * 2 * 512 * 4;
constexpr size_t OFF_SUMA = OFF_SSQ + 65536;
constexpr size_t OFF_SUMH = AL(OFF_SUMA + SZ_SUM);
constexpr size_t OFF_HS   = AL(OFF_SUMH + SZ_SUM);
constexpr size_t OFF_WINT = AL(OFF_HS + SZ_SUM);
constexpr size_t OFF_WOUTT = AL(OFF_WINT + (size_t)DIN * DM * 2);
constexpr size_t OFF_WQT  = AL(OFF_WOUTT + (size_t)DM * DM * 2);
constexpr size_t OFF_W2T  = AL(OFF_WQT + (size_t)2048 * DM * 2);
constexpr size_t OFF_A2T  = AL(OFF_W2T + 512 * 64 * 2);
constexpr size_t OFF_G2T  = AL(OFF_A2T + 512 * 64 * 2);
constexpr size_t OFF_WAT  = AL(OFF_G2T + 512 * 128 * 2);
constexpr size_t OFF_WXT  = AL(OFF_WAT + 8 * 64 * 64 * 2);
constexpr size_t OFF_KEYS = AL(OFF_WXT + 8 * 64 * 64 * 2);
constexpr size_t OFF_UB   = AL(OFF_KEYS + 8 * 2 * 128 * 128 * 2);
constexpr size_t OFF_VB   = AL(OFF_UB + (size_t)16384 * DM);
constexpr size_t OFF_XN   = AL(OFF_VB + (size_t)16384 * DM);
constexpr size_t OFF_SB   = AL(OFF_XN + (size_t)MROWS * DM * 2);
constexpr size_t OFF_P    = AL(OFF_SB + (size_t)2048 * 8192);
constexpr size_t OFF_H1B  = OFF_P;
constexpr size_t OFF_EIDX = AL(OFF_H1B + (size_t)NTOK * DM * 2);
constexpr size_t OFF_GATE = AL(OFF_EIDX + (size_t)NTOK * 128 * 2);
constexpr size_t WS_END   = AL(OFF_P + (size_t)MROWS * DIN * 2);
constexpr size_t UNIT_BYTES = 8192 + 16384;
constexpr int NUNITS = 8 + 2048;
static_assert((size_t)NUNITS * UNIT_BYTES <= (size_t)NTOK * DM * 4, "PQ does not fit in d_out");
static_assert(WS_END <= (size_t)256 * 1024 * 1024, "workspace too large");

constexpr int SMEM_BYTES = 150 * 1024;

struct Params {
    const float *x, *meta, *g1, *w_in, *conv_w, *conv_b, *ga_w, *ga_b, *gx_w, *gx_b, *lam, *lru_gain, *mu, *w0, *w2, *a0, *a2, *g2,
        *k_k, *k_a, *r_k, *gn_w, *gn_b, *w_out, *g2n, *w_q, *q_gain, *keys, *u, *v, *fg;
    float* out;
    char* ws;
};

__device__ __forceinline__ unsigned short f2bf(float f) { __bf16 b = (__bf16)f; return __builtin_bit_cast(unsigned short, b); }
__device__ __forceinline__ unsigned pack2(float lo, float hi) { bf2_t v; v[0] = (__bf16)lo; v[1] = (__bf16)hi; return __builtin_bit_cast(unsigned, v); }
__device__ __forceinline__ float bflo(unsigned u) { return __uint_as_float(u << 16); }
__device__ __forceinline__ float bfhi(unsigned u) { return __uint_as_float(u & 0xFFFF0000u); }
__device__ __forceinline__ float bf2f(bf16_t b) { return __uint_as_float((unsigned)b << 16); }
__device__ __forceinline__ float wave_sum(float v) {
#pragma unroll
    for (int o = 32; o > 0; o >>= 1) v += __shfl_xor(v, o);
    return v;
}
__device__ __forceinline__ float sum8(float v) { v += __shfl_xor(v, 1); v += __shfl_xor(v, 2); v += __shfl_xor(v, 4); return v; }
__device__ __forceinline__ float sigmoidf_(float x) { return 1.0f / (1.0f + __expf(-x)); }
__device__ __forceinline__ float gelu_tanh(float x) {
    const float u = 0.7978845608f * (x + 0.044715f * x * x * x);
    const float t = 1.0f - 2.0f / (__expf(2.0f * u) + 1.0f);
    return 0.5f * x * (1.0f + t);
}
__device__ __forceinline__ float gelu_erf(float x) { return 0.5f * x * (1.0f + erff(x * 0.70710678118f)); }
__device__ __forceinline__ void unpack8(u32x4 q, float* f) {
    f[0] = bflo(q[0]); f[1] = bfhi(q[0]); f[2] = bflo(q[1]); f[3] = bfhi(q[1]);
    f[4] = bflo(q[2]); f[5] = bfhi(q[2]); f[6] = bflo(q[3]); f[7] = bfhi(q[3]);
}
__device__ __forceinline__ u32x4 pack8(const float* f) {
    u32x4 q; q[0] = pack2(f[0], f[1]); q[1] = pack2(f[2], f[3]); q[2] = pack2(f[4], f[5]); q[3] = pack2(f[6], f[7]); return q;
}
__device__ __forceinline__ int row_of(int b, int pos) { return pos < NMETA ? NTOK + pos : b * T_SEQ + pos - NMETA; }

#define MFMA32(a, b, c) __builtin_amdgcn_mfma_f32_32x32x16_bf16((a), (b), (c), 0, 0, 0)
#define MFMA16(a, b, c) __builtin_amdgcn_mfma_f32_16x16x32_bf16((a), (b), (c), 0, 0, 0)

template <int KS>
__device__ __forceinline__ f32x16 mm_lds(const bf16_t* A, const bf16_t* Bt, int qm, int qn, int lane, f32x16 acc) {
    const int r = lane & 31, h = lane >> 5;
    const bf16_t* ap = A + (qm * 32 + r) * LD + h * 8;
    const bf16_t* bp = Bt + (qn * 32 + r) * LD + h * 8;
#pragma unroll
    for (int ks = 0; ks < KS; ++ks) {
        bf16x8 a = *(const bf16x8*)(ap + ks * 16), b = *(const bf16x8*)(bp + ks * 16);
        acc = MFMA32(a, b, acc);
    }
    return acc;
}
template <int KS>
__device__ __forceinline__ f32x16 mm_lds_g(const bf16_t* A, const bf16_t* __restrict__ Btg, int ldb, int qm, int qn, int lane, f32x16 acc) {
    const int r = lane & 31, h = lane >> 5;
    const bf16_t* ap = A + (qm * 32 + r) * LD + h * 8;
    const bf16_t* bp = Btg + (size_t)(qn * 32 + r) * ldb + h * 8;
    bf16x8 bfr[KS];
#pragma unroll
    for (int ks = 0; ks < KS; ++ks) bfr[ks] = *(const bf16x8*)(bp + ks * 16);
#pragma unroll
    for (int ks = 0; ks < KS; ++ks) { bf16x8 a = *(const bf16x8*)(ap + ks * 16); acc = MFMA32(a, bfr[ks], acc); }
    return acc;
}
__device__ __forceinline__ void store_N_bf16(bf16_t* dst, const f32x16& c, int qm, int qn, int lane) {
    const int r = lane & 31, h = lane >> 5;
#pragma unroll
    for (int reg = 0; reg < 16; ++reg) dst[(qm * 32 + (reg & 3) + 8 * (reg >> 2) + 4 * h) * LD + qn * 32 + r] = f2bf(c[reg]);
}
__device__ __forceinline__ void store_T_bf16(bf16_t* dst, const f32x16& c, int qm, int qn, int lane) {
    const int r = lane & 31, h = lane >> 5;
#pragma unroll
    for (int g = 0; g < 4; ++g) {
        u32x2 w; w[0] = pack2(c[4 * g], c[4 * g + 1]); w[1] = pack2(c[4 * g + 2], c[4 * g + 3]);
        *(u32x2*)(dst + (qn * 32 + r) * LD + qm * 32 + 8 * g + 4 * h) = w;
    }
}
__device__ __forceinline__ void store_N_f32(float* dst, const f32x16& c, int qm, int qn, int lane) {
    const int r = lane & 31, h = lane >> 5;
#pragma unroll
    for (int reg = 0; reg < 16; ++reg) dst[(qm * 32 + (reg & 3) + 8 * (reg >> 2) + 4 * h) * LF + qn * 32 + r] = c[reg];
}
__device__ __forceinline__ f32x16 zero16() { f32x16 z; for (int i = 0; i < 16; ++i) z[i] = 0.f; return z; }

__device__ __forceinline__ void transpose_tile(const float* __restrict__ src, bf16_t* __restrict__ dst, int K, int N, const float* __restrict__ kscale, int tk, int tn, float* tile) {
    const int tid = threadIdx.x;
#pragma unroll
    for (int i = 0; i < 2; ++i) {
        const int kk = (tid >> 4) + 32 * i, nn = (tid & 15) * 4;
        f32x4 v = *(const f32x4*)(src + (size_t)(tk * 64 + kk) * N + tn * 64 + nn);
        const float s = kscale ? kscale[tk * 64 + kk] : 1.0f;
        tile[kk * 65 + nn] = v[0] * s; tile[kk * 65 + nn + 1] = v[1] * s; tile[kk * 65 + nn + 2] = v[2] * s; tile[kk * 65 + nn + 3] = v[3] * s;
    }
    __syncthreads();
    {
        const int n = tid >> 3, ks = (tid & 7) * 8;
        float f[8];
#pragma unroll
        for (int i = 0; i < 8; ++i) f[i] = tile[(ks + i) * 65 + n];
        *(u32x4*)(dst + (size_t)(tn * 64 + n) * K + tk * 64 + ks) = pack8(f);
    }
    __syncthreads();
}

__device__ __forceinline__ void phase_prep(const Params& p, char* smem) {
    const int tid = threadIdx.x, lane = tid & 63, wave = __builtin_amdgcn_readfirstlane(tid >> 6), G = gridDim.x;
    char* ws = p.ws;
    bf16_t* XN = (bf16_t*)(ws + OFF_XN);
    for (int row = blockIdx.x * 8 + wave; row < MROWS; row += G * 8) {
        u32x2* dst = (u32x2*)(XN + (size_t)row * DM);
        if (row >= NTOK + NMETA) {
#pragma unroll
            for (int i = 0; i < 4; ++i) { u32x2 z; z[0] = 0; z[1] = 0; dst[lane + 64 * i] = z; }
            continue;
        }
        const float* src = row < NTOK ? p.x + (size_t)row * DM : p.meta + (size_t)(row - NTOK) * DM;
        f32x4 v[4]; float ss = 0.f;
#pragma unroll
        for (int i = 0; i < 4; ++i) { v[i] = ((const f32x4*)src)[lane + 64 * i]; ss += v[i][0] * v[i][0] + v[i][1] * v[i][1] + v[i][2] * v[i][2] + v[i][3] * v[i][3]; }
        ss = wave_sum(ss);
        const float rs = rsqrtf(ss * (1.0f / DM) + 1e-6f);
#pragma unroll
        for (int i = 0; i < 4; ++i) {
            f32x4 g = ((const f32x4*)p.g1)[lane + 64 * i];
            u32x2 w; w[0] = pack2(v[i][0] * rs * g[0], v[i][1] * rs * g[1]); w[1] = pack2(v[i][2] * rs * g[2], v[i][3] * rs * g[3]);
            dst[lane + 64 * i] = w;
        }
    }
    {
        float* tile = (float*)smem;
        const int n0 = 16 * 44, n1 = n0 + 16 * 16, n2 = n1 + 16 * 32, n3 = n2 + 8, n4 = n3 + 8, n5 = n4 + 16, n6 = n5 + 8, n7 = n6 + 8;
        for (int t = blockIdx.x; t < n7; t += G) {
            if (t < n0) transpose_tile(p.w_in, (bf16_t*)(ws + OFF_WINT), DM, DIN, nullptr, t / 44, t % 44, tile);
            else if (t < n1) { const int u = t - n0; transpose_tile(p.w_out, (bf16_t*)(ws + OFF_WOUTT), DM, DM, nullptr, u / 16, u % 16, tile); }
            else if (t < n2) { const int u = t - n1; transpose_tile(p.w_q, (bf16_t*)(ws + OFF_WQT), DM, 2048, p.g2n, u / 32, u % 32, tile); }
            else if (t < n3) { const int u = t - n2; transpose_tile(p.w2, (bf16_t*)(ws + OFF_W2T), 64, 512, nullptr, 0, u, tile); }
            else if (t < n4) { const int u = t - n3; transpose_tile(p.a2, (bf16_t*)(ws + OFF_A2T), 64, 512, nullptr, 0, u, tile); }
            else if (t < n5) { const int u = t - n4; transpose_tile(p.g2, (bf16_t*)(ws + OFF_G2T), 128, 512, nullptr, u / 8, u % 8, tile); }
            else if (t < n6) { const int u = t - n5; transpose_tile(p.ga_w + u * 4096, (bf16_t*)(ws + OFF_WAT) + u * 4096, 64, 64, nullptr, 0, 0, tile); }
            else { const int u = t - n6; transpose_tile(p.gx_w + u * 4096, (bf16_t*)(ws + OFF_WXT) + u * 4096, 64, 64, nullptr, 0, 0, tile); }
        }
    }
    {
        const int gt = blockIdx.x * NTHR + tid, gs = G * NTHR;
        bf16_t* KEYS = (bf16_t*)(ws + OFF_KEYS);
        for (int i = gt; i < 8 * 2 * 128 * 128 / 4; i += gs) {
            const int e = i * 4, d = e & 127, sub = (e >> 14) & 1, h = e >> 15;
            f32x4 k = ((const f32x4*)p.keys)[i]; f32x4 g = *(const f32x4*)(p.q_gain + h * 256 + sub * 128 + d);
            u32x2 w; w[0] = pack2(k[0] * g[0], k[1] * g[1]); w[1] = pack2(k[2] * g[2], k[3] * g[3]);
            *(u32x2*)(KEYS + e) = w;
        }
        unsigned* UB = (unsigned*)(ws + OFF_UB); unsigned* VB = (unsigned*)(ws + OFF_VB);
        for (int i = gt; i < 16384 * DM / 4; i += gs) {
            const int d = (i * 4) & (DM - 1);
            f32x4 u = ((const f32x4*)p.u)[i]; f32x4 g = *(const f32x4*)(p.g2n + d); f32x4 v = ((const f32x4*)p.v)[i];
            int r = __builtin_amdgcn_cvt_pk_fp8_f32(u[0] * g[0] * 256.f, u[1] * g[1] * 256.f, 0, false);
            r = __builtin_amdgcn_cvt_pk_fp8_f32(u[2] * g[2] * 256.f, u[3] * g[3] * 256.f, r, true);
            UB[i] = (unsigned)r;
            int r2 = __builtin_amdgcn_cvt_pk_fp8_f32(v[0] * 16.f, v[1] * 16.f, 0, false);
            r2 = __builtin_amdgcn_cvt_pk_fp8_f32(v[2] * 16.f, v[3] * 16.f, r2, true);
            VB[i] = (unsigned)r2;
        }
        float* ssq = (float*)(ws + OFF_SSQ);
        for (int i = gt; i < NTOK; i += gs) ssq[i] = 0.f;
    }
}

constexpr int GA_ROWS = 256, GB_ROWS = 128;
constexpr int GBUF = (GA_ROWS + GB_ROWS) * LD;

struct EpiStoreBf16 {
    bf16_t* C; int ldc;
    __device__ __forceinline__ void operator()(const f32x16 (&acc)[2][2], int mb, int nb, int lane) const {
        const int r = lane & 31, h = lane >> 5;
#pragma unroll
        for (int i = 0; i < 2; ++i)
#pragma unroll
            for (int j = 0; j < 2; ++j)
#pragma unroll
                for (int g = 0; g < 4; ++g) {
                    u32x2 w; w[0] = pack2(acc[i][j][4 * g], acc[i][j][4 * g + 1]); w[1] = pack2(acc[i][j][4 * g + 2], acc[i][j][4 * g + 3]);
                    *(u32x2*)(C + (size_t)(mb + i * 32 + r) * ldc + nb + j * 32 + 8 * g + 4 * h) = w;
                }
    }
};
struct EpiResidual {
    bf16_t* C; const float* X; float* ssq;
    __device__ __forceinline__ void operator()(const f32x16 (&acc)[2][2], int mb, int nb, int lane) const {
        const int r = lane & 31, h = lane >> 5;
#pragma unroll
        for (int i = 0; i < 2; ++i) {
            const int row = mb + i * 32 + r; float ss = 0.f;
#pragma unroll
            for (int j = 0; j < 2; ++j)
#pragma unroll
                for (int g = 0; g < 4; ++g) {
                    const int col = nb + j * 32 + 8 * g + 4 * h;
                    f32x4 xv = *(const f32x4*)(X + (size_t)row * DM + col);
                    const float v0 = acc[i][j][4 * g] + xv[0], v1 = acc[i][j][4 * g + 1] + xv[1], v2 = acc[i][j][4 * g + 2] + xv[2], v3 = acc[i][j][4 * g + 3] + xv[3];
                    ss += v0 * v0 + v1 * v1 + v2 * v2 + v3 * v3;
                    u32x2 w; w[0] = pack2(v0, v1); w[1] = pack2(v2, v3);
                    *(u32x2*)(C + (size_t)row * DM + col) = w;
                }
            ss += __shfl_xor(ss, 32);
            if (h == 0) atomicAdd(ssq + row, ss);
        }
    }
};

template <class Epi>
__device__ __forceinline__ void gemm_phase(const bf16_t* __restrict__ A, const bf16_t* __restrict__ Bt, int M, int N, int K, char* smem, const Epi& epi) {
    const int tid = threadIdx.x, lane = tid & 63, wave = __builtin_amdgcn_readfirstlane(tid >> 6);
    const int wm = wave >> 1, wn = wave & 1, r = lane & 31, h = lane >> 5;
    const int nNt = N / 128, ntiles = (M / 256) * nNt, nk = K / 64;
    const int G = gridDim.x;
    const int bid = (G % 8 == 0) ? (blockIdx.x % 8) * (G / 8) + blockIdx.x / 8 : blockIdx.x;
    bf16_t* lds = (bf16_t*)smem;
    for (int tile = bid; tile < ntiles; tile += G) {
        const int pm = tile / nNt, pn = tile % nNt, m0 = pm * 256, n0 = pn * 128;
        const bf16_t* Ag = A + (size_t)m0 * K; const bf16_t* Bg = Bt + (size_t)n0 * K;
        f32x16 acc[2][2];
#pragma unroll
        for (int i = 0; i < 2; ++i)
#pragma unroll
            for (int j = 0; j < 2; ++j) acc[i][j] = zero16();
        u32x4 ra0[4], rb0[2], ra1[4], rb1[2];
#define G_LOAD(RA, RB, KT) { \
            _Pragma("unroll") for (int i = 0; i < 4; ++i) { const int q = tid + 512 * i; RA[i] = *(const u32x4*)(Ag + (size_t)(q >> 3) * K + (KT) * 64 + (q & 7) * 8); } \
            _Pragma("unroll") for (int i = 0; i < 2; ++i) { const int q = tid + 512 * i; RB[i] = *(const u32x4*)(Bg + (size_t)(q >> 3) * K + (KT) * 64 + (q & 7) * 8); } }
#define G_WRITE(RA, RB, BUF) { bf16_t* b_ = lds + (BUF) * GBUF; \
            _Pragma("unroll") for (int i = 0; i < 4; ++i) { const int q = tid + 512 * i; *(u32x4*)(b_ + (q >> 3) * LD + (q & 7) * 8) = RA[i]; } \
            _Pragma("unroll") for (int i = 0; i < 2; ++i) { const int q = tid + 512 * i; *(u32x4*)(b_ + GA_ROWS * LD + (q >> 3) * LD + (q & 7) * 8) = RB[i]; } }
#define G_COMPUTE(BUF) { const bf16_t* a_ = lds + (BUF) * GBUF + (wm * 64 + r) * LD + h * 8; const bf16_t* b_ = lds + (BUF) * GBUF + (GA_ROWS + wn * 64 + r) * LD + h * 8; \
            _Pragma("unroll") for (int ks = 0; ks < 4; ++ks) { \
                bf16x8 af0 = *(const bf16x8*)(a_ + ks * 16), af1 = *(const bf16x8*)(a_ + 32 * LD + ks * 16); \
                bf16x8 bf0 = *(const bf16x8*)(b_ + ks * 16), bf1 = *(const bf16x8*)(b_ + 32 * LD + ks * 16); \
                acc[0][0] = MFMA32(bf0, af0, acc[0][0]); acc[0][1] = MFMA32(bf1, af0, acc[0][1]); \
                acc[1][0] = MFMA32(bf0, af1, acc[1][0]); acc[1][1] = MFMA32(bf1, af1, acc[1][1]); } }
        G_LOAD(ra0, rb0, 0); G_LOAD(ra1, rb1, 1);
        G_WRITE(ra0, rb0, 0);
        __syncthreads();
        for (int kt = 0; kt < nk; kt += 2) {
            if (kt + 2 < nk) G_LOAD(ra0, rb0, kt + 2);
            G_COMPUTE(0);
            G_WRITE(ra1, rb1, 1);
            __syncthreads();
            if (kt + 3 < nk) G_LOAD(ra1, rb1, kt + 3);
            G_COMPUTE(1);
            if (kt + 2 < nk) G_WRITE(ra0, rb0, 0);
            __syncthreads();
        }
        epi(acc, m0 + wm * 64, n0 + wn * 64, lane);
    }
#undef G_LOAD
#undef G_WRITE
#undef G_COMPUTE
}

__device__ __forceinline__ void lru_unit(const Params& p, char* smem, int mode, int c, int b) {
    int tid_ = threadIdx.x; asm volatile("" : "+v"(tid_));
    const int tid = tid_, lane = tid & 63, wave = __builtin_amdgcn_readfirstlane(tid >> 6);
    char* ws = p.ws;
    const bf16_t* P = (const bf16_t*)(ws + OFF_P);
    bf16_t* Y = (bf16_t*)(ws + OFF_XN);
    const bf16_t* WAT = (const bf16_t*)(ws + OFF_WAT); const bf16_t* WXT = (const bf16_t*)(ws + OFF_WXT);
    float* sumA = (float*)(ws + OFF_SUMA); float* sumH = (float*)(ws + OFF_SUMH); const float* HS = (const float*)(ws + OFF_HS);
    bf16_t* Xc = (bf16_t*)smem;
    float* Z0 = (float*)(smem + 9216);
    float* Z1 = Z0 + 64 * LF;
    float* SegA = Z1 + 64 * LF;
    float* SegH = SegA + 512;
    bf16_t* Yl = (bf16_t*)(SegH + 512);
    const int t = tid >> 3, c8 = tid & 7;
    const int pos0 = c == 0 ? 0 : NMETA + 64 * (c - 1);
    const int pos = pos0 + t;
    const bool valid = (c > 0) || (t < NMETA);
    const int row = row_of(b, valid ? pos : 0);
    const int grp = wave >> 2, qm = (wave >> 1) & 1, qn = wave & 1;
    float ssq = 0.f;
    for (int hd = 0; hd < 8; ++hd) {
        const int ch0 = hd * 64 + c8 * 8;
        float xc[8];
        {
            f32x4 b0 = *(const f32x4*)(p.conv_b + ch0), b1 = *(const f32x4*)(p.conv_b + ch0 + 4);
            xc[0] = b0[0]; xc[1] = b0[1]; xc[2] = b0[2]; xc[3] = b0[3]; xc[4] = b1[0]; xc[5] = b1[1]; xc[6] = b1[2]; xc[7] = b1[3];
#pragma unroll
            for (int d = 0; d < 4; ++d) {
                const int pp = pos - 3 + d;
                if (valid && pp >= 0) {
                    u32x4 q = *(const u32x4*)(P + (size_t)row_of(b, pp) * DIN + ch0);
                    float xv[8]; unpack8(q, xv);
                    f32x4 w0 = *(const f32x4*)(p.conv_w + d * 512 + ch0), w1 = *(const f32x4*)(p.conv_w + d * 512 + ch0 + 4);
                    xc[0] += w0[0] * xv[0]; xc[1] += w0[1] * xv[1]; xc[2] += w0[2] * xv[2]; xc[3] += w0[3] * xv[3];
                    xc[4] += w1[0] * xv[4]; xc[5] += w1[1] * xv[5]; xc[6] += w1[2] * xv[6]; xc[7] += w1[3] * xv[7];
                }
            }
            *(u32x4*)(Xc + t * LD + c8 * 8) = pack8(xc);
        }
        __syncthreads();
        {
            f32x16 acc = zero16();
            acc = mm_lds_g<4>(Xc, (grp == 0 ? WAT : WXT) + hd * 4096, 64, qm, qn, lane, acc);
            store_N_f32(grp == 0 ? Z0 : Z1, acc, qm, qn, lane);
        }
        __syncthreads();
        {
            float za[8], zx[8];
            *(f32x4*)za = *(const f32x4*)(Z0 + t * LF + c8 * 8); *(f32x4*)(za + 4) = *(const f32x4*)(Z0 + t * LF + c8 * 8 + 4);
            *(f32x4*)zx = *(const f32x4*)(Z1 + t * LF + c8 * 8); *(f32x4*)(zx + 4) = *(const f32x4*)(Z1 + t * LF + c8 * 8 + 4);
            float av[8], bv[8];
#pragma unroll
            for (int i = 0; i < 8; ++i) {
                const int ch = ch0 + i;
                const float rg = sigmoidf_(za[i] + p.ga_b[ch]), ig = sigmoidf_(zx[i] + p.gx_b[ch]);
                const float sp = log1pf(__expf(-p.lam[ch]));
                const float la = -8.0f * rg * sp;
                const float a = __expf(la);
                const float bb = sqrtf(fmaxf(-expm1f(2.0f * la), 0.f)) * ig * xc[i];
                av[i] = valid ? a : 1.0f; bv[i] = valid ? bb : 0.f;
            }
            *(f32x4*)(Z0 + t * LF + c8 * 8) = *(f32x4*)av; *(f32x4*)(Z0 + t * LF + c8 * 8 + 4) = *(f32x4*)(av + 4);
            *(f32x4*)(Z1 + t * LF + c8 * 8) = *(f32x4*)bv; *(f32x4*)(Z1 + t * LF + c8 * 8 + 4) = *(f32x4*)(bv + 4);
        }
        __syncthreads();
        const int sch = tid & 63, seg = tid >> 6;
        {
            float Ac = 1.f, hh = 0.f;
#pragma unroll
            for (int k = 0; k < 8; ++k) {
                const int tt = seg * 8 + k;
                const float a = Z0[tt * LF + sch], bb = Z1[tt * LF + sch];
                hh = a * hh + bb; Ac *= a;
                Z0[tt * LF + sch] = Ac; Z1[tt * LF + sch] = hh;
            }
            SegA[seg * 64 + sch] = Ac; SegH[seg * 64 + sch] = hh;
        }
        __syncthreads();
        {
            float hin = mode == 1 ? HS[((size_t)c * 2 + b) * 512 + hd * 64 + sch] : 0.f;
            for (int s2 = 0; s2 < seg; ++s2) hin = SegA[s2 * 64 + sch] * hin + SegH[s2 * 64 + sch];
            if (mode == 0) {
                if (seg == 7) {
                    float At = 1.f;
                    for (int s2 = 0; s2 < 8; ++s2) At *= SegA[s2 * 64 + sch];
                    const float ht = SegA[7 * 64 + sch] * hin + SegH[7 * 64 + sch];
                    sumA[((size_t)c * 2 + b) * 512 + hd * 64 + sch] = At;
                    sumH[((size_t)c * 2 + b) * 512 + hd * 64 + sch] = ht;
                }
            } else {
#pragma unroll
                for (int k = 0; k < 8; ++k) { const int tt = seg * 8 + k; Z1[tt * LF + sch] += Z0[tt * LF + sch] * hin; }
            }
        }
        __syncthreads();
        if (mode == 1) {
            float hv[8];
            *(f32x4*)hv = *(const f32x4*)(Z1 + t * LF + c8 * 8); *(f32x4*)(hv + 4) = *(const f32x4*)(Z1 + t * LF + c8 * 8 + 4);
            u32x4 gq = *(const u32x4*)(P + (size_t)row * DIN + 512 + ch0);
            float gv[8]; unpack8(gq, gv);
            float yv[8];
#pragma unroll
            for (int i = 0; i < 8; ++i) { yv[i] = hv[i] * gelu_tanh(gv[i]); ssq += yv[i] * yv[i]; }
            *(u32x4*)(Yl + t * 512 + ch0) = pack8(yv);
            __syncthreads();
        }
    }
    if (mode == 1) {
        ssq = sum8(ssq);
        const float rs = rsqrtf(ssq * (1.0f / 512.0f) + 1e-6f);
        for (int hd = 0; hd < 8; ++hd) {
            const int ch0 = hd * 64 + c8 * 8;
            u32x4 q = *(const u32x4*)(Yl + t * 512 + ch0);
            float yv[8]; unpack8(q, yv);
            f32x4 g0 = *(const f32x4*)(p.lru_gain + ch0), g1 = *(const f32x4*)(p.lru_gain + ch0 + 4);
            yv[0] *= rs * g0[0]; yv[1] *= rs * g0[1]; yv[2] *= rs * g0[2]; yv[3] *= rs * g0[3];
            yv[4] *= rs * g1[0]; yv[5] *= rs * g1[1]; yv[6] *= rs * g1[2]; yv[7] *= rs * g1[3];
            *(u32x4*)(Y + (size_t)row * DM + ch0) = pack8(yv);
        }
        __syncthreads();
    }
}

__device__ __forceinline__ void rwkv_unit(const Params& p, char* smem, int mode, int c, int b, int hh) {
    int tid_ = threadIdx.x; asm volatile("" : "+v"(tid_));
    const int tid = tid_, lane = tid & 63, wave = __builtin_amdgcn_readfirstlane(tid >> 6);
    char* ws = p.ws;
    const bf16_t* P = (const bf16_t*)(ws + OFF_P);
    bf16_t* Y = (bf16_t*)(ws + OFF_XN);
    bf16_t* S0 = (bf16_t*)smem;
#define SL(i) (S0 + (i) * SLOT)
    float* F0 = (float*)(smem + 12 * SLOT * 2);
    float* F1 = F0 + 64 * LF;
    float* Seg = F1 + 64 * LF;
    float* GC = Seg + 512;
    bf16_t *sLw = SL(0), *sAabb = SL(0), *sLg0 = SL(0);
    bf16_t *sLa = SL(1), *sAak = SL(1), *sLg1 = SL(1);
    bf16_t *sBtT = SL(2), *sArb = SL(2);
    bf16_t *sKtT = SL(3), *sArk = SL(3);
    bf16_t *sAt = SL(4), *sGs = SL(4);
    bf16_t *sAtT = SL(5);
    bf16_t *sBh = SL(6), *sD0T = SL(6), *sW1T = SL(6);
    bf16_t *sKh = SL(7), *sM1T = SL(7), *sW2T = SL(7);
    bf16_t *sRt = SL(8);
    bf16_t *sVT = SL(9);
    bf16_t *sTm = SL(10);
    bf16_t *sY2T = SL(11);
    const int t = tid >> 3, c8 = tid & 7;
    const int pos0 = c == 0 ? 0 : NMETA + 64 * (c - 1);
    const int pos = pos0 + t;
    const bool valid = (c > 0) || (t < NMETA);
    const int row = row_of(b, valid ? pos : 0);
    const int grp = wave >> 2, qm = (wave >> 1) & 1, qn = wave & 1, r = lane & 31, h = lane >> 5;
    const int hc0 = hh * 64 + c8 * 8;
    const int unit = c == 0 ? hh : 8 + ((b * 128 + (c - 1)) * 8 + hh);
    float rv[8], kv[8], vv[8];
    {
        const bool hasprev = valid && pos > 0;
        const bf16_t* pr = P + (size_t)row * DIN;
        const bf16_t* pp = P + (size_t)row_of(b, hasprev ? pos - 1 : 0) * DIN;
        auto ld8 = [&](int col, float* out) {
            float cur[8], prv[8];
            unpack8(*(const u32x4*)(pr + col), cur);
            if (hasprev) unpack8(*(const u32x4*)(pp + col), prv); else { for (int i = 0; i < 8; ++i) prv[i] = 0.f; }
            f32x4 m0 = *(const f32x4*)(p.mu + col - 1024), m1 = *(const f32x4*)(p.mu + col - 1024 + 4);
            float mm[8] = {m0[0], m0[1], m0[2], m0[3], m1[0], m1[1], m1[2], m1[3]};
#pragma unroll
            for (int i = 0; i < 8; ++i) out[i] = valid ? cur[i] + (prv[i] - cur[i]) * mm[i] : 0.f;
        };
        ld8(1024 + hc0, rv); ld8(1536 + hc0, kv); ld8(2048 + hc0, vv);
        float wl[8], al[8];
        ld8(2560 + c8 * 8, wl); ld8(2624 + c8 * 8, al);
#pragma unroll
        for (int i = 0; i < 8; ++i) wl[i] = tanhf(wl[i]);
        *(u32x4*)(sLw + t * LD + c8 * 8) = pack8(wl);
        *(u32x4*)(sLa + t * LD + c8 * 8) = pack8(al);
    }
    __syncthreads();
    {
        f32x16 acc = zero16();
        const bf16_t* Bt = (const bf16_t*)(ws + (grp == 0 ? OFF_W2T : OFF_A2T)) + hh * 64 * 64;
        acc = mm_lds_g<4>(grp == 0 ? sLw : sLa, Bt, 64, qm, qn, lane, acc);
        store_N_f32(grp == 0 ? F0 : F1, acc, qm, qn, lane);
    }
    __syncthreads();
    float lw[8], av[8], kk[8], kt[8];
    float rk = 0.f;
    {
        float zw[8], za[8];
        *(f32x4*)zw = *(const f32x4*)(F0 + t * LF + c8 * 8); *(f32x4*)(zw + 4) = *(const f32x4*)(F0 + t * LF + c8 * 8 + 4);
        *(f32x4*)za = *(const f32x4*)(F1 + t * LF + c8 * 8); *(f32x4*)(za + 4) = *(const f32x4*)(F1 + t * LF + c8 * 8 + 4);
        float n2 = 0.f;
#pragma unroll
        for (int i = 0; i < 8; ++i) {
            const int ch = hc0 + i;
            lw[i] = valid ? -0.6065306597f * sigmoidf_(zw[i] + p.w0[ch]) : 0.f;
            av[i] = valid ? sigmoidf_(za[i] + p.a0[ch]) : 0.f;
            kk[i] = kv[i] * p.k_k[ch]; n2 += kk[i] * kk[i];
            kt[i] = kv[i] * (1.0f + (av[i] - 1.0f) * p.k_a[ch]);
            rk += rv[i] * kt[i] * p.r_k[ch];
        }
        n2 = sum8(n2); rk = sum8(rk);
        const float inv = 1.0f / fmaxf(sqrtf(n2), 1e-12f);
#pragma unroll
        for (int i = 0; i < 8; ++i) kk[i] *= inv;
        *(f32x4*)(F0 + t * LF + c8 * 8) = *(f32x4*)lw; *(f32x4*)(F0 + t * LF + c8 * 8 + 4) = *(f32x4*)(lw + 4);
    }
    __syncthreads();
    {
        const int sch = tid & 63, seg = tid >> 6;
        float s = 0.f;
#pragma unroll
        for (int k = 0; k < 8; ++k) { const int tt = seg * 8 + k; s += F0[tt * LF + sch]; F0[tt * LF + sch] = s; }
        Seg[seg * 64 + sch] = s;
        __syncthreads();
        float pre = 0.f;
        for (int s2 = 0; s2 < seg; ++s2) pre += Seg[s2 * 64 + sch];
#pragma unroll
        for (int k = 0; k < 8; ++k) { const int tt = seg * 8 + k; F0[tt * LF + sch] += pre; }
        if (seg == 7) GC[sch] = s + pre;
    }
    __syncthreads();
    {
        float g[8];
        *(f32x4*)g = *(const f32x4*)(F0 + t * LF + c8 * 8); *(f32x4*)(g + 4) = *(const f32x4*)(F0 + t * LF + c8 * 8 + 4);
        float at[8], bh[8], kh[8], rt[8], bt[8], ktt[8];
#pragma unroll
        for (int i = 0; i < 8; ++i) {
            const float gc = GC[c8 * 8 + i];
            const float em = __expf(-g[i]), ep = __expf(g[i]), epv = __expf(g[i] - lw[i]), ec = __expf(gc - g[i]);
            at[i] = -kk[i] * epv; bh[i] = kk[i] * av[i] * em; kh[i] = kt[i] * em; rt[i] = rv[i] * ep;
            bt[i] = kk[i] * av[i] * ec; ktt[i] = kt[i] * ec;
        }
        *(u32x4*)(sAt + t * LD + c8 * 8) = pack8(at);
        *(u32x4*)(sBh + t * LD + c8 * 8) = pack8(bh);
        *(u32x4*)(sKh + t * LD + c8 * 8) = pack8(kh);
        if (mode == 1) *(u32x4*)(sRt + t * LD + c8 * 8) = pack8(rt);
#pragma unroll
        for (int i = 0; i < 8; ++i) {
            sAtT[(c8 * 8 + i) * LD + t] = f2bf(at[i]);
            sVT[(c8 * 8 + i) * LD + t] = f2bf(vv[i]);
            if (mode == 0) { sBtT[(c8 * 8 + i) * LD + t] = f2bf(bt[i]); sKtT[(c8 * 8 + i) * LD + t] = f2bf(ktt[i]); }
        }
    }
    __syncthreads();
    f32x16 accQ = zero16();
    {
        f32x16 acc = zero16();
        if (grp == 0) {
            acc = mm_lds<4>(sAt, sBh, qm, qn, lane, acc);
#pragma unroll
            for (int reg = 0; reg < 16; ++reg) { const int tt = qm * 32 + (reg & 3) + 8 * (reg >> 2) + 4 * h, ss = qn * 32 + r; if (ss >= tt) acc[reg] = 0.f; }
        } else {
            acc = mm_lds<4>(sAt, sKh, qm, qn, lane, acc);
#pragma unroll
            for (int reg = 0; reg < 16; ++reg) { const int tt = qm * 32 + (reg & 3) + 8 * (reg >> 2) + 4 * h, ss = qn * 32 + r; if (ss >= tt) acc[reg] = 0.f; }
        }
        f32x16 acc2 = zero16();
        if (mode == 1) {
            acc2 = mm_lds<4>(sRt, grp == 0 ? sBh : sKh, qm, qn, lane, acc2);
#pragma unroll
            for (int reg = 0; reg < 16; ++reg) { const int tt = qm * 32 + (reg & 3) + 8 * (reg >> 2) + 4 * h, ss = qn * 32 + r; if (ss > tt) acc2[reg] = 0.f; }
        } else if (grp == 0) {
            accQ = mm_lds<4>(sKtT, sVT, qm, qn, lane, accQ);
        }
        if (grp == 0) { store_N_f32(F0, acc, qm, qn, lane); store_N_bf16(sAabb, acc, qm, qn, lane); if (mode == 1) store_N_bf16(sArb, acc2, qm, qn, lane); }
        else { store_N_bf16(sAak, acc, qm, qn, lane); if (mode == 1) store_N_bf16(sArk, acc2, qm, qn, lane); }
    }
    __syncthreads();
    if (wave == 0) {
        int lane2 = lane; asm volatile("" : "+v"(lane2));
        const int blk = lane2 >> 5, j = lane2 & 31;
        const float* Ab = F0 + (32 * blk) * LF + 32 * blk;
        float xs[32];
#pragma unroll
        for (int tt = 0; tt < 32; ++tt) {
            float s = (tt == j) ? 1.f : 0.f;
#pragma unroll
            for (int s2 = 0; s2 < tt; ++s2) s += Ab[tt * LF + s2] * xs[s2];
            xs[tt] = s;
        }
#pragma unroll
        for (int tt = 0; tt < 32; ++tt) sTm[(32 * blk + tt) * LD + 32 * blk + j] = f2bf(xs[tt]);
        if (blk == 0) {
#pragma unroll
            for (int q = 0; q < 4; ++q) *(u32x4*)(sD0T + j * LD + q * 8) = pack8(xs + q * 8);
        }
    } else if (wave == 1) {
        const int rr = lane >> 1, cc = 32 + (lane & 1) * 16;
        u32x4 z; z[0] = 0; z[1] = 0; z[2] = 0; z[3] = 0;
        *(u32x4*)(sTm + rr * LD + cc) = z; *(u32x4*)(sTm + rr * LD + cc + 8) = z;
    } else if (grp == 1) {
        f32x16 acc = zero16();
        acc = mm_lds<4>(sAak, sVT, qm, qn, lane, acc);
        store_T_bf16(sY2T, acc, qm, qn, lane);
    }
    __syncthreads();
    if (wave == 0) {
        f32x16 acc = zero16();
        acc = mm_lds<2>(sAabb, sD0T, 1, 0, lane, acc);
        store_T_bf16(sM1T, acc, 0, 0, lane);
    }
    __syncthreads();
    if (wave == 0) {
        f32x16 acc = zero16();
        const bf16_t* ap = sTm + (32 + r) * LD + 32 + h * 8;
        const bf16_t* bp = sM1T + r * LD + h * 8;
#pragma unroll
        for (int ks = 0; ks < 2; ++ks) { bf16x8 a = *(const bf16x8*)(ap + ks * 16), bb = *(const bf16x8*)(bp + ks * 16); acc = MFMA32(a, bb, acc); }
        store_N_bf16(sTm, acc, 1, 0, lane);
    }
    __syncthreads();
    {
        f32x16 acc = zero16();
        acc = mm_lds<4>(sTm, grp == 0 ? sAtT : sY2T, qm, qn, lane, acc);
        store_T_bf16(grp == 0 ? sW1T : sW2T, acc, qm, qn, lane);
        if (mode == 1) {
            const bool hasprev = valid && pos > 0;
            const bf16_t* pr = P + (size_t)row * DIN + 2688 + c8 * 16;
            const bf16_t* pp = P + (size_t)row_of(b, hasprev ? pos - 1 : 0) * DIN + 2688 + c8 * 16;
            bf16_t* d = ((c8 < 4) ? sLg0 : sLg1) + t * LD + (c8 & 3) * 16;
#pragma unroll
            for (int hf = 0; hf < 2; ++hf) {
                float cur[8], prv[8], gg[8];
                unpack8(*(const u32x4*)(pr + hf * 8), cur);
                if (hasprev) unpack8(*(const u32x4*)(pp + hf * 8), prv); else { for (int i = 0; i < 8; ++i) prv[i] = 0.f; }
#pragma unroll
                for (int i = 0; i < 8; ++i) gg[i] = valid ? sigmoidf_(cur[i] + (prv[i] - cur[i]) * p.mu[1664 + c8 * 16 + hf * 8 + i]) : 0.5f;
                *(u32x4*)(d + hf * 8) = pack8(gg);
            }
        }
    }
    __syncthreads();
    if (mode == 0) {
        char* PQ = (char*)p.out + (size_t)unit * UNIT_BYTES;
        if (grp == 0) {
            f32x16 acc = mm_lds<4>(sBtT, sW2T, qm, qn, lane, accQ);
            float* QC = (float*)(PQ + 8192);
            const int v = qn * 32 + r;
#pragma unroll
            for (int g = 0; g < 4; ++g) {
                const int k = qm * 32 + 8 * g + 4 * h;
                f32x4 w = {acc[4 * g], acc[4 * g + 1], acc[4 * g + 2], acc[4 * g + 3]};
                *(f32x4*)(QC + (((v >> 4) * 4 + (k >> 4)) * 64 + ((k >> 2) & 3) * 16 + (v & 15)) * 4) = w;
            }
        } else {
            f32x16 acc = zero16();
            acc = mm_lds<4>(sBtT, sW1T, qm, qn, lane, acc);
            bf16_t* PA = (bf16_t*)PQ;
            const int k2 = qn * 32 + r;
#pragma unroll
            for (int reg = 0; reg < 16; ++reg) {
                const int k1 = qm * 32 + (reg & 3) + 8 * (reg >> 2) + 4 * h;
                float vv2 = acc[reg];
                if (k1 == k2) vv2 += __expf(GC[k1]);
                PA[(((k1 >> 4) * 2 + (k2 >> 5)) * 64 + ((k2 >> 2) & 3) * 16 + (k1 & 15)) * 8 + ((k2 >> 4) & 1) * 4 + (k2 & 3)] = f2bf(vv2);
            }
        }
        __syncthreads();
        return;
    }
    f32x16 accH = zero16();
    if (grp == 0) {
        f32x16 acc = zero16();
        acc = mm_lds<4>(sArb, sW1T, qm, qn, lane, acc);
#pragma unroll
        for (int reg = 0; reg < 16; ++reg) { const int tt = qm * 32 + (reg & 3) + 8 * (reg >> 2) + 4 * h, k = qn * 32 + r; acc[reg] += bf2f(sRt[tt * LD + k]); }
        store_N_bf16(sGs, acc, qm, qn, lane);
        f32x16 accg = zero16();
        const bf16_t* G2T = (const bf16_t*)(ws + OFF_G2T) + (size_t)hh * 64 * 128;
        accg = mm_lds_g<4>(sLg0, G2T, 128, qm, qn, lane, accg);
        accg = mm_lds_g<4>(sLg1, G2T + 64, 128, qm, qn, lane, accg);
        store_N_f32(F1, accg, qm, qn, lane);
    } else {
        accH = mm_lds<4>(sArb, sW2T, qm, qn, lane, accH);
        accH = mm_lds<4>(sArk, sVT, qm, qn, lane, accH);
    }
    __syncthreads();
    if (grp == 1) {
        const bf16_t* SB = (const bf16_t*)(ws + OFF_SB) + (size_t)((b * 128 + (c - 1)) * 8 + hh) * 4096;
        accH = mm_lds_g<4>(sGs, SB, 64, qm, qn, lane, accH);
        store_N_f32(F0, accH, qm, qn, lane);
    }
    __syncthreads();
    {
        float o[8], zg[8];
        *(f32x4*)o = *(const f32x4*)(F0 + t * LF + c8 * 8); *(f32x4*)(o + 4) = *(const f32x4*)(F0 + t * LF + c8 * 8 + 4);
        *(f32x4*)zg = *(const f32x4*)(F1 + t * LF + c8 * 8); *(f32x4*)(zg + 4) = *(const f32x4*)(F1 + t * LF + c8 * 8 + 4);
        float s = 0.f;
#pragma unroll
        for (int i = 0; i < 8; ++i) s += o[i];
        const float mean = sum8(s) * (1.0f / 64.0f);
        float q = 0.f;
#pragma unroll
        for (int i = 0; i < 8; ++i) { const float d = o[i] - mean; q += d * d; }
        const float var = sum8(q) * (1.0f / 64.0f);
        const float rs = rsqrtf(var + 64e-5f);
        float yv[8];
#pragma unroll
        for (int i = 0; i < 8; ++i) {
            const int ch = hc0 + i;
            const float on = (o[i] - mean) * rs * p.gn_w[ch] + p.gn_b[ch];
            yv[i] = (on + rk * vv[i]) * zg[i];
        }
        *(u32x4*)(Y + (size_t)row * DM + 512 + hc0) = pack8(yv);
    }
    __syncthreads();
#undef SL
}

struct ChainOp { u32x4 pa[4][2]; f32x4 q[4]; };
__device__ __forceinline__ void chain_load(ChainOp& o, const char* PQ, int b, int hh, int cg, int lane, int c) {
    const int unit = c == 0 ? hh : 8 + ((b * 128 + (c - 1)) * 8 + hh);
    const char* U = PQ + (size_t)unit * UNIT_BYTES;
#pragma unroll
    for (int m = 0; m < 4; ++m) {
        o.pa[m][0] = *(const u32x4*)(U + ((size_t)((m * 2 + 0) * 64 + lane)) * 16);
        o.pa[m][1] = *(const u32x4*)(U + ((size_t)((m * 2 + 1) * 64 + lane)) * 16);
        o.q[m] = *(const f32x4*)(U + 8192 + ((size_t)((cg * 4 + m) * 64 + lane)) * 16);
    }
}
__device__ __forceinline__ void chain_step(const ChainOp& o, f32x4 (&st)[4], bf16_t* SBb, int b, int hh, int cg, int lane, int c) {
    const int q = lane >> 4, vl = lane & 15;
    u32x4 b0, b1;
    b0[0] = pack2(st[0][0], st[0][1]); b0[1] = pack2(st[0][2], st[0][3]); b0[2] = pack2(st[1][0], st[1][1]); b0[3] = pack2(st[1][2], st[1][3]);
    b1[0] = pack2(st[2][0], st[2][1]); b1[1] = pack2(st[2][2], st[2][3]); b1[2] = pack2(st[3][0], st[3][1]); b1[3] = pack2(st[3][2], st[3][3]);
    if (c > 0) {
        bf16_t* S = SBb + (size_t)((b * 128 + (c - 1)) * 8 + hh) * 4096 + (cg * 16 + vl) * 64 + 4 * q;
        u32x2 w;
        w[0] = b0[0]; w[1] = b0[1]; *(u32x2*)(S + 0) = w;
        w[0] = b0[2]; w[1] = b0[3]; *(u32x2*)(S + 16) = w;
        w[0] = b1[0]; w[1] = b1[1]; *(u32x2*)(S + 32) = w;
        w[0] = b1[2]; w[1] = b1[3]; *(u32x2*)(S + 48) = w;
    }
    const bf16x8 B0 = __builtin_bit_cast(bf16x8, b0), B1 = __builtin_bit_cast(bf16x8, b1);
    f32x4 acc[4];
#pragma unroll
    for (int m = 0; m < 4; ++m) acc[m] = MFMA16(__builtin_bit_cast(bf16x8, o.pa[m][0]), B0, o.q[m]);
#pragma unroll
    for (int m = 0; m < 4; ++m) acc[m] = MFMA16(__builtin_bit_cast(bf16x8, o.pa[m][1]), B1, acc[m]);
#pragma unroll
    for (int m = 0; m < 4; ++m) st[m] = acc[m];
}
__device__ __forceinline__ void rwkv_chain(const Params& p, int chain, int cg, int lane) {
    const int b = chain >> 3, hh = chain & 7;
    const char* PQ = (const char*)p.out;
    bf16_t* SBb = (bf16_t*)(p.ws + OFF_SB);
    f32x4 st[4];
#pragma unroll
    for (int m = 0; m < 4; ++m) st[m] = (f32x4){0.f, 0.f, 0.f, 0.f};
    ChainOp oA, oB, oC, oD;
    chain_load(oA, PQ, b, hh, cg, lane, 0); chain_load(oB, PQ, b, hh, cg, lane, 1);
    chain_load(oC, PQ, b, hh, cg, lane, 2); chain_load(oD, PQ, b, hh, cg, lane, 3);
#pragma unroll 1
    for (int c = 0; c < 128; c += 4) {
        chain_step(oA, st, SBb, b, hh, cg, lane, c);     chain_load(oA, PQ, b, hh, cg, lane, c + 4);
        chain_step(oB, st, SBb, b, hh, cg, lane, c + 1); if (c + 5 < NCHUNK) chain_load(oB, PQ, b, hh, cg, lane, c + 5);
        chain_step(oC, st, SBb, b, hh, cg, lane, c + 2); if (c + 6 < NCHUNK) chain_load(oC, PQ, b, hh, cg, lane, c + 6);
        chain_step(oD, st, SBb, b, hh, cg, lane, c + 3); if (c + 7 < NCHUNK) chain_load(oD, PQ, b, hh, cg, lane, c + 7);
    }
    chain_step(oA, st, SBb, b, hh, cg, lane, 128);
}
__device__ __forceinline__ void lru_chain(const Params& p, int idx) {
    const int b = idx >> 9, ch = idx & 511;
    const float* __restrict__ sumA = (const float*)(p.ws + OFF_SUMA); const float* __restrict__ sumH = (const float*)(p.ws + OFF_SUMH);
    float* __restrict__ HS = (float*)(p.ws + OFF_HS);
    float hcur = sumH[ch];
    HS[(size_t)(0 * 2 + b) * 512 + ch] = 0.f;
#pragma unroll 1
    for (int c0 = 1; c0 < NCHUNK; c0 += 16) {
        float av[16], hv[16];
#pragma unroll
        for (int k = 0; k < 16; ++k) { av[k] = sumA[((size_t)(c0 + k) * 2 + b) * 512 + ch]; hv[k] = sumH[((size_t)(c0 + k) * 2 + b) * 512 + ch]; }
#pragma unroll
        for (int k = 0; k < 16; ++k) { HS[((size_t)(c0 + k) * 2 + b) * 512 + ch] = hcur; hcur = av[k] * hcur + hv[k]; }
    }
}

#define KLD 136
__device__ __forceinline__ unsigned f2ord(float f) { const unsigned u = __float_as_uint(f); return (u & 0x80000000u) ? ~u : (u | 0x80000000u); }
__device__ __forceinline__ float ord2f(unsigned o) { const unsigned u = (o & 0x80000000u) ? (o & 0x7FFFFFFFu) : ~o; return __uint_as_float(u); }
#define CE(a, b) { const unsigned hi_ = max((a), (b)); (b) = min((a), (b)); (a) = hi_; }
__device__ __forceinline__ void ins16(unsigned (&L)[16], unsigned x) {
#pragma unroll
    for (int s = 0; s < 16; ++s) { const unsigned hi_ = max(L[s], x); x = min(L[s], x); L[s] = hi_; }
}
__device__ __forceinline__ void merge_pair16(unsigned (&L)[16]) {
    unsigned Pp[16];
#pragma unroll
    for (int s = 0; s < 16; ++s) Pp[s] = __shfl_xor(L[s], 32);
#pragma unroll
    for (int s = 0; s < 16; ++s) L[s] = max(L[s], Pp[15 - s]);
#pragma unroll
    for (int d = 8; d > 0; d >>= 1)
#pragma unroll
        for (int i = 0; i < 16; ++i) if ((i & d) == 0) CE(L[i], L[i + d]);
}

__device__ __forceinline__ void peer_topk_unit(const Params& p, char* smem, int tile, int head) {
    int tid_ = threadIdx.x; asm volatile("" : "+v"(tid_));
    const int tid = tid_, lane = tid & 63, wave = __builtin_amdgcn_readfirstlane(tid >> 6), r = lane & 31, h = lane >> 5;
    char* ws = p.ws;
    const bf16_t* KEYS = (const bf16_t*)(ws + OFF_KEYS) + (size_t)head * 2 * 128 * 128;
    const bf16_t* QN = (const bf16_t*)p.out;
    bf16_t* kl = (bf16_t*)smem;
    __syncthreads();
#pragma unroll
    for (int i = 0; i < 8; ++i) { const int q = tid + 512 * i, rowk = q >> 4, c16 = q & 15; *(u32x4*)(kl + rowk * KLD + c16 * 8) = *(const u32x4*)(KEYS + (size_t)rowk * 128 + c16 * 8); }
    __syncthreads();
    const int tok = tile * 256 + wave * 32 + r;
    const bf16_t* qrow = QN + (size_t)tok * 2048 + head * 256;
    float ssq = 0.f;
    unsigned L1[16], L2[16];
#pragma unroll
    for (int sub = 0; sub < 2; ++sub) {
        bf16x8 qf[8];
#pragma unroll
        for (int ks = 0; ks < 8; ++ks) {
            u32x4 qq = *(const u32x4*)(qrow + sub * 128 + ks * 16 + h * 8);
            float f[8]; unpack8(qq, f);
#pragma unroll
            for (int i = 0; i < 8; ++i) ssq += f[i] * f[i];
            qf[ks] = __builtin_bit_cast(bf16x8, qq);
        }
        unsigned (&L)[16] = sub == 0 ? L1 : L2;
#pragma unroll
        for (int s = 0; s < 16; ++s) L[s] = 0u;
#pragma unroll
        for (int mt = 0; mt < 4; ++mt) {
            f32x16 acc = zero16();
            const bf16_t* ap = kl + (sub * 128 + mt * 32 + r) * KLD + h * 8;
#pragma unroll
            for (int ks = 0; ks < 8; ++ks) { bf16x8 a = *(const bf16x8*)(ap + ks * 16); acc = MFMA32(a, qf[ks], acc); }
#pragma unroll
            for (int reg = 0; reg < 16; ++reg) {
                const int key = mt * 32 + (reg & 3) + 8 * (reg >> 2) + 4 * h;
                const unsigned x = (f2ord(acc[reg]) & ~127u) | (unsigned)(127 - key);
                ins16(L, x);
            }
        }
        merge_pair16(L);
    }
    ssq += __shfl_xor(ssq, 32);
    const float rstd2 = rsqrtf(((const float*)(ws + OFF_SSQ))[tok] * (1.0f / DM) + 1e-6f);
    const float scale = rstd2 * rsqrtf(rstd2 * rstd2 * ssq * (1.0f / 256.0f) + 1e-6f);
    float v1[16], v2[16];
#pragma unroll
    for (int s = 0; s < 16; ++s) { v1[s] = ord2f(L1[s] & ~127u); v2[s] = ord2f(L2[s] & ~127u); }
    unsigned F[16];
#pragma unroll
    for (int s = 0; s < 16; ++s) F[s] = 0u;
    {
        int cnt = 0;
        unsigned pend = 0u;
#pragma unroll
        for (int i = 0; i < 16; ++i)
#pragma unroll
            for (int j = 0; j < 16; ++j) {
                if ((i + 1) * (j + 1) > 16) continue;
                const unsigned e = ((127u - (L1[i] & 127u)) << 7) | (127u - (L2[j] & 127u));
                const unsigned x = (f2ord(v1[i] + v2[j]) & ~16383u) | e;
                if ((cnt & 1) == 0) pend = x;
                else { const unsigned mine = h ? x : pend; ins16(F, mine); }
                ++cnt;
            }
    }
    merge_pair16(F);
    float sc[16], mx, sum = 0.f;
#pragma unroll
    for (int s = 0; s < 16; ++s) sc[s] = ord2f(F[s] & ~16383u) * scale;
    mx = sc[0];
#pragma unroll
    for (int s = 0; s < 16; ++s) { sc[s] = __expf(sc[s] - mx); sum += sc[s]; }
    const float inv = 1.0f / sum;
    unsigned short* EI = (unsigned short*)(ws + OFF_EIDX) + ((size_t)tok * 8 + head) * 16;
    float* GT = (float*)(ws + OFF_GATE) + ((size_t)tok * 8 + head) * 16;
    if (h == 0) {
        u32x4 w0, w1;
#pragma unroll
        for (int s = 0; s < 4; ++s) { w0[s] = (F[2 * s] & 16383u) | ((F[2 * s + 1] & 16383u) << 16); w1[s] = (F[8 + 2 * s] & 16383u) | ((F[8 + 2 * s + 1] & 16383u) << 16); }
        *(u32x4*)EI = w0; *(u32x4*)(EI + 8) = w1;
        *(f32x4*)GT = (f32x4){sc[0] * inv, sc[1] * inv, sc[2] * inv, sc[3] * inv};
        *(f32x4*)(GT + 4) = (f32x4){sc[4] * inv, sc[5] * inv, sc[6] * inv, sc[7] * inv};
    } else {
        *(f32x4*)(GT + 8) = (f32x4){sc[8] * inv, sc[9] * inv, sc[10] * inv, sc[11] * inv};
        *(f32x4*)(GT + 12) = (f32x4){sc[12] * inv, sc[13] * inv, sc[14] * inv, sc[15] * inv};
    }
}

__device__ __forceinline__ void peer_token(const Params& p, float* coefl, int tok, int lane, bool with_peer) {
    char* ws = p.ws;
    const bf16_t* H1 = (const bf16_t*)(ws + OFF_H1B) + (size_t)tok * DM;
    u32x4 hx0 = *(const u32x4*)(H1 + lane * 16), hx1 = *(const u32x4*)(H1 + lane * 16 + 8);
    float y[16];
#pragma unroll
    for (int i = 0; i < 16; ++i) y[i] = 0.f;
    if (with_peer) {
        const float rstd2 = rsqrtf(((const float*)(ws + OFF_SSQ))[tok] * (1.0f / DM) + 1e-6f);
        const unsigned short* EI = (const unsigned short*)(ws + OFF_EIDX) + (size_t)tok * 128;
        const float* GT = (const float*)(ws + OFF_GATE) + (size_t)tok * 128;
        const int e0 = EI[lane], e1 = EI[lane + 64];
        const float g0 = GT[lane], g1 = GT[lane + 64];
        const unsigned char* UB = (const unsigned char*)(ws + OFF_UB); const unsigned char* VB = (const unsigned char*)(ws + OFF_VB);
        float xf[16];
        unpack8(hx0, xf); unpack8(hx1, xf + 8);
        float hid0 = 0.f, hid1 = 0.f;
#pragma unroll 1
        for (int half = 0; half < 2; ++half) {
            const int ev = half ? e1 : e0;
#pragma unroll 1
            for (int bb = 0; bb < 4; ++bb) {
                u32x4 ua[16];
#pragma unroll
                for (int k = 0; k < 16; ++k) {
                    const int e = __builtin_amdgcn_readlane(ev, bb * 16 + k);
                    ua[k] = *(const u32x4*)(UB + (size_t)e * DM + lane * 16);
                }
                float part[16];
#pragma unroll
                for (int k = 0; k < 16; ++k) {
                    float s = 0.f;
#pragma unroll
                    for (int i = 0; i < 4; ++i) {
                        const int w = (int)ua[k][i];
                        const f32x2 lo = __builtin_amdgcn_cvt_pk_f32_fp8(w, false), hi = __builtin_amdgcn_cvt_pk_f32_fp8(w, true);
                        s += lo[0] * xf[4 * i] + lo[1] * xf[4 * i + 1] + hi[0] * xf[4 * i + 2] + hi[1] * xf[4 * i + 3];
                    }
                    part[k] = s;
                }
#pragma unroll
                for (int k = 0; k < 8; ++k) { const float send = (lane & 32) ? part[k] : part[k + 8]; const float keep = (lane & 32) ? part[k + 8] : part[k]; part[k] = keep + __shfl_xor(send, 32); }
#pragma unroll
                for (int k = 0; k < 4; ++k) { const float send = (lane & 16) ? part[k] : part[k + 4]; const float keep = (lane & 16) ? part[k + 4] : part[k]; part[k] = keep + __shfl_xor(send, 16); }
#pragma unroll
                for (int k = 0; k < 2; ++k) { const float send = (lane & 8) ? part[k] : part[k + 2]; const float keep = (lane & 8) ? part[k + 2] : part[k]; part[k] = keep + __shfl_xor(send, 8); }
                { const float send = (lane & 4) ? part[0] : part[1]; const float keep = (lane & 4) ? part[1] : part[0]; part[0] = keep + __shfl_xor(send, 4); }
                part[0] += __shfl_xor(part[0], 1); part[0] += __shfl_xor(part[0], 2);
                const int vi = ((lane >> 5) & 1) * 8 + ((lane >> 4) & 1) * 4 + ((lane >> 3) & 1) * 2 + ((lane >> 2) & 1);
                if ((lane & 3) == 0) coefl[half * 64 + bb * 16 + vi] = part[0];
            }
        }
        __builtin_amdgcn_s_waitcnt(0xc07f);
        __builtin_amdgcn_wave_barrier();
        hid0 = coefl[lane]; hid1 = coefl[lane + 64];
        __builtin_amdgcn_wave_barrier();
        coefl[lane] = g0 * gelu_erf(hid0 * rstd2 * (1.0f / 256.0f)) * (1.0f / 16.0f);
        coefl[lane + 64] = g1 * gelu_erf(hid1 * rstd2 * (1.0f / 256.0f)) * (1.0f / 16.0f);
        __builtin_amdgcn_s_waitcnt(0xc07f);
        __builtin_amdgcn_wave_barrier();
#pragma unroll 1
        for (int half = 0; half < 2; ++half) {
            const int ev = half ? e1 : e0;
#pragma unroll 1
            for (int bb = 0; bb < 4; ++bb) {
                u32x4 va[16];
#pragma unroll
                for (int k = 0; k < 16; ++k) {
                    const int e = __builtin_amdgcn_readlane(ev, bb * 16 + k);
                    va[k] = *(const u32x4*)(VB + (size_t)e * DM + lane * 16);
                }
#pragma unroll
                for (int k = 0; k < 16; ++k) {
                    const float cf = coefl[half * 64 + bb * 16 + k];
#pragma unroll
                    for (int i = 0; i < 4; ++i) {
                        const int w = (int)va[k][i];
                        const f32x2 lo = __builtin_amdgcn_cvt_pk_f32_fp8(w, false), hi = __builtin_amdgcn_cvt_pk_f32_fp8(w, true);
                        y[4 * i] += cf * lo[0]; y[4 * i + 1] += cf * lo[1]; y[4 * i + 2] += cf * hi[0]; y[4 * i + 3] += cf * hi[1];
                    }
                }
            }
        }
    }
    float hv[16];
    unpack8(hx0, hv); unpack8(hx1, hv + 8);
    float ss = 0.f;
#pragma unroll
    for (int i = 0; i < 16; ++i) { hv[i] += y[i]; ss += hv[i] * hv[i]; }
    ss = wave_sum(ss);
    const float rs = rsqrtf(ss * (1.0f / DM) + 1e-6f);
    float* orow = p.out + (size_t)tok * DM + lane * 16;
#pragma unroll
    for (int q4 = 0; q4 < 4; ++q4) {
        f32x4 g = *(const f32x4*)(p.fg + lane * 16 + q4 * 4);
        f32x4 o = {hv[q4 * 4] * rs * g[0], hv[q4 * 4 + 1] * rs * g[1], hv[q4 * 4 + 2] * rs * g[2], hv[q4 * 4 + 3] * rs * g[3]};
        *(f32x4*)(orow + q4 * 4) = o;
    }
}


#define XB_TMO      128
#define XB_XCNT(j)  (256  + 64 * (j))
#define XB_XSUB(j)  (1280 + 64 * (j))
#define XB_XGEN(j)  (2304 + 64 * (j))
#define XB_TOP      3328
#define XB_TOPGEN   3392
#define XCD_BAR_WORDS 3456
#define XB_SPIN_CAP (1u << 21)
#define LAS __attribute__((address_space(3)))
__device__ __forceinline__ unsigned xb_ld(unsigned* p)              { return __hip_atomic_load(p, __ATOMIC_RELAXED, __HIP_MEMORY_SCOPE_AGENT); }
__device__ __forceinline__ unsigned xb_add(unsigned* p, unsigned v) { return __hip_atomic_fetch_add(p, v, __ATOMIC_RELAXED, __HIP_MEMORY_SCOPE_AGENT); }
__device__ __forceinline__ unsigned xb_xcc_id() { return (unsigned)__builtin_amdgcn_s_getreg((3 << 11) | 20) & 0xFu; }
#define XB_SPIN(cond, bar) do { unsigned _sp = 0; while (cond) { __builtin_amdgcn_s_sleep(1); \
    if ((++_sp & 255u) == 0u) { if (xb_ld(&(bar)[XB_TMO])) break; if (_sp > XB_SPIN_CAP) { atomicAdd(&(bar)[XB_TMO], 1u); break; } } } } while (0)
struct XcdBarrier { unsigned* bar; unsigned x; volatile LAS unsigned* st; };
__device__ __forceinline__ XcdBarrier xcd_barrier_post(unsigned* bar, volatile LAS unsigned* st) {
    XcdBarrier b; b.bar = bar; b.x = xb_xcc_id(); b.st = st;
    if (threadIdx.x == 0) (void)xb_add(&bar[XB_XCNT(b.x)], 1u);
    return b;
}
__device__ __forceinline__ void xcd_barrier_complete(unsigned* bar, unsigned x, unsigned& nloc, unsigned& nx) {
    const unsigned G = gridDim.x * gridDim.y * gridDim.z;
    unsigned sum, cnt, mine, sp = 0u;
    for (;;) {
        sum = 0u; cnt = 0u; mine = 0u;
#pragma unroll
        for (unsigned j = 0; j < 16; ++j) { const unsigned c = xb_ld(&bar[XB_XCNT(j)]); sum += c; cnt += (c > 0u) ? 1u : 0u; mine = (j == x) ? c : mine; }
        if (sum == G) break;
        __builtin_amdgcn_s_sleep(1);
        if ((++sp & 255u) == 0u) { if (xb_ld(&bar[XB_TMO])) break; if (sp > XB_SPIN_CAP) { atomicAdd(&bar[XB_TMO], 1u); break; } }
    }
    nloc = mine > 0u ? mine : 1u; nx = cnt > 0u ? cnt : 1u;
}
__device__ __forceinline__ void xcd_barrier(const XcdBarrier& b) {
    asm volatile("s_waitcnt vmcnt(0)" ::: "memory");
    __syncthreads();
    if (threadIdx.x == 0) {
        unsigned* bar = b.bar;
        __builtin_amdgcn_s_waitcnt(0);
        unsigned nloc = b.st[0], nx = b.st[1];
        if (nloc == 0u) { xcd_barrier_complete(bar, b.x, nloc, nx); b.st[0] = nloc; b.st[1] = nx; }
        const unsigned old = xb_add(&bar[XB_XSUB(b.x)], 1u);
        const unsigned gen = old / nloc;
        if (old + 1u == (gen + 1u) * nloc) {
            __builtin_amdgcn_fence(__ATOMIC_RELEASE, "agent");
            asm volatile("s_waitcnt vmcnt(0)" ::: "memory");
            const unsigned og = xb_add(&bar[XB_TOP], 1u);
            const unsigned tg = og / nx;
            if (og + 1u == (tg + 1u) * nx) xb_add(&bar[XB_TOPGEN], 1u);
            else XB_SPIN(xb_ld(&bar[XB_TOPGEN]) == tg, bar);
            __builtin_amdgcn_fence(__ATOMIC_ACQUIRE, "agent");
            xb_add(&bar[XB_XGEN(b.x)], 1u);
            asm volatile("s_waitcnt vmcnt(0)" ::: "memory");
        } else {
            XB_SPIN(xb_ld(&bar[XB_XGEN(b.x)]) == gen, bar);
            __builtin_amdgcn_fence(__ATOMIC_ACQUIRE, "agent");
            asm volatile("s_waitcnt vmcnt(0)" ::: "memory");
        }
    }
    __syncthreads();
}

__device__ __forceinline__ void run_phase(const Params& p, char* smem, const int phase) {
    const int tid = threadIdx.x, lane = tid & 63, wave = __builtin_amdgcn_readfirstlane(tid >> 6), G = gridDim.x;
    char* ws = p.ws;
    switch (phase) {
    case 0: phase_prep(p, smem); break;
    case 1: { EpiStoreBf16 e{(bf16_t*)(ws + OFF_P), DIN}; gemm_phase((const bf16_t*)(ws + OFF_XN), (const bf16_t*)(ws + OFF_WINT), MROWS, DIN, DM, smem, e); } break;
    case 2: {
        for (int u = blockIdx.x; u < NUNITS + 257; u += G) {
            if (u < NUNITS) { const int v = u < 8 ? 0 : u - 8; rwkv_unit(p, smem, 0, u < 8 ? 0 : 1 + ((v >> 3) & 127), v >> 10, u < 8 ? u : (v & 7)); }
            else { const int v = u - NUNITS; const int w = v == 0 ? 0 : v - 1; lru_unit(p, smem, 0, v == 0 ? 0 : 1 + (w & 127), w >> 7); }
        }
    } break;
    case 3: {
        if (blockIdx.x < 8) rwkv_chain(p, blockIdx.x * 2 + (wave >> 2), wave & 3, lane);
        else if (blockIdx.x < 10) lru_chain(p, (blockIdx.x - 8) * NTHR + tid);
    } break;
    case 4: {
        if (!DO_RWKV || !DO_LRU) {
            bf16_t* Yz = (bf16_t*)(ws + OFF_XN);
            for (int i = blockIdx.x * NTHR + tid; i < NTOK * 64; i += G * NTHR) {
                const int row = i >> 6, c = (i & 63) * 8 + (DO_LRU ? 512 : 0);
                u32x4 z; z[0] = 0; z[1] = 0; z[2] = 0; z[3] = 0;
                if (!DO_LRU && !DO_RWKV) { *(u32x4*)(Yz + (size_t)row * DM + (i & 63) * 8) = z; *(u32x4*)(Yz + (size_t)row * DM + 512 + (i & 63) * 8) = z; }
                else *(u32x4*)(Yz + (size_t)row * DM + c) = z;
            }
        }
        for (int u = blockIdx.x; u < 2048 + 256; u += G) {
            if (u < 2048) { if (DO_RWKV) rwkv_unit(p, smem, 1, 1 + ((u >> 3) & 127), u >> 10, u & 7); }
            else if (DO_LRU) { const int v = u - 2048; lru_unit(p, smem, 1, 1 + (v & 127), v >> 7); }
        }
    } break;
    case 5: { EpiResidual e{(bf16_t*)(ws + OFF_H1B), p.x, (float*)(ws + OFF_SSQ)}; gemm_phase((const bf16_t*)(ws + OFF_XN), (const bf16_t*)(ws + OFF_WOUTT), NTOK, DM, DM, smem, e); } break;
    case 6: { EpiStoreBf16 e{(bf16_t*)p.out, 2048}; gemm_phase((const bf16_t*)(ws + OFF_H1B), (const bf16_t*)(ws + OFF_WQT), NTOK, 2048, DM, smem, e); } break;
    case 7: { for (int u = blockIdx.x; u < 64 * 8; u += G) peer_topk_unit(p, smem, u >> 3, u & 7); } break;
    case 8: { float* coefl = (float*)smem + wave * 128; for (int tok = blockIdx.x * 8 + wave; tok < NTOK; tok += G * 8) peer_token(p, coefl, tok, lane, DO_PEER != 0); } break;
    }
}

template <int PH>
__global__ void __launch_bounds__(NTHR) k_phase(Params p) {
    extern __shared__ __attribute__((aligned(16))) char smem[];
    run_phase(p, smem, PH);
}
template <int PH>
static void launch_phase(const Params& p, hipStream_t stream) {
    static bool attr_set = false;
    if (!attr_set) { (void)hipFuncSetAttribute((const void*)k_phase<PH>, hipFuncAttributeMaxDynamicSharedMemorySize, SMEM_BYTES); attr_set = true; }
    k_phase<PH><<<256, NTHR, SMEM_BYTES, stream>>>(p);
}


__global__ void __launch_bounds__(NTHR) k_mega(Params p) {
    extern __shared__ __attribute__((aligned(16))) char smem[];
    volatile LAS unsigned* st = (volatile LAS unsigned*)(smem + SMEM_BYTES - 16);
    if (threadIdx.x == 0) { st[0] = 0u; st[1] = 0u; st[2] = 0u; st[3] = 0u; }
    __syncthreads();
    XcdBarrier bar = xcd_barrier_post((unsigned*)(p.ws + OFF_BAR), st);
#define RUNP(ph, n) if ((n) == 1) { if (ph > 0) xcd_barrier(bar); run_phase(p, smem, ph); } else { _Pragma("unroll 1") for (int it = 0; it < (n); ++it) { xcd_barrier(bar); run_phase(p, smem, ph); } }
    RUNP(0, REP0) RUNP(1, REP1) RUNP(2, REP2) RUNP(3, REP3) RUNP(4, REP4) RUNP(5, 1) RUNP(6, REP6) RUNP(7, REP7) RUNP(8, REP8)
}

extern "C" void kernel_launch(void* const* d_in, const int* in_sizes, int n_in, void* d_out, int out_size, void* d_ws, size_t ws_size, hipStream_t stream) {
    Params p{};
    const float** pp = (const float**)&p;
    for (int i = 0; i < 31; ++i) pp[i] = (const float*)d_in[i];
    p.out = (float*)d_out; p.ws = (char*)d_ws;
#if MULTI_LAUNCH
    launch_phase<0>(p, stream); launch_phase<1>(p, stream); launch_phase<2>(p, stream); launch_phase<3>(p, stream);
    launch_phase<4>(p, stream); launch_phase<5>(p, stream);
    if (DO_PEER) { launch_phase<6>(p, stream); launch_phase<7>(p, stream); }
    launch_phase<8>(p, stream);
#else
    static bool attr_set = false;
    if (!attr_set) { (void)hipFuncSetAttribute((const void*)k_mega, hipFuncAttributeMaxDynamicSharedMemorySize, SMEM_BYTES); attr_set = true; }
    (void)hipMemsetAsync(p.ws + OFF_BAR, 0, XCD_BAR_WORDS * 4, stream);
    void* args[] = {&p};
    hipError_t e = hipLaunchCooperativeKernel((const void*)k_mega, dim3(256), dim3(NTHR), args, SMEM_BYTES, stream);
    if (e != hipSuccess) fprintf(stderr, "cooperative launch failed: %s\n", hipGetErrorString(e));
#endif
}
```

```cpp
#include <hip/hip_runtime.h>
#include <stdint.h>
#include <stdio.h>

#ifndef REP0
#define REP0 1
#endif
#ifndef REP1
#define REP1 1
#endif
#ifndef REP2
#define REP2 1
#endif
#ifndef REP3
#define REP3 1
#endif
#ifndef REP4
#define REP4 1
#endif
#ifndef REP6
#define REP6 1
#endif
#ifndef REP7
#define REP7 1
#endif
#ifndef REP8
#define REP8 1
#endif
#ifndef TSSTAGE
#define TSSTAGE -1
#endif
#ifndef TSROLE
#define TSROLE -1
#endif
#ifndef GEMMFN
#define GEMMFN gemm_phase
#endif
#ifndef CHV
#define CHV 0
#endif
#ifndef CHAINX
#define CHAINX 1
#endif
#ifndef TBLX
#define TBLX 1
#endif
#ifndef MULTI_LAUNCH
#define MULTI_LAUNCH 0
#endif
#ifndef DO_LRU
#define DO_LRU 1
#endif
#ifndef DO_RWKV
#define DO_RWKV 1
#endif
#ifndef DO_PEER
#define DO_PEER 1
#endif

#define NTHR 512
#define T_SEQ 8192
#define NTOK 16384
#define NMETA 16
#define MROWS 16640
#define DM 1024
#define DIN 2816
#define NCHUNK 129
#define LD 72
#define LF 68
#define SLOT (64 * LD)

typedef unsigned short bf16_t;
typedef short bf16x8 __attribute__((ext_vector_type(8)));
typedef float f32x4 __attribute__((ext_vector_type(4)));
typedef float f32x16 __attribute__((ext_vector_type(16)));
typedef unsigned u32x4 __attribute__((ext_vector_type(4)));
typedef unsigned u32x2 __attribute__((ext_vector_type(2)));
typedef __bf16 bf2_t __attribute__((ext_vector_type(2)));
typedef float f32x2 __attribute__((ext_vector_type(2)));

constexpr size_t AL(size_t x) { return (x + 255) & ~(size_t)255; }
constexpr size_t OFF_BAR  = 0;
constexpr size_t OFF_SSQ  = 16384;
constexpr size_t SZ_SUM   = (size_t)NCHUNK * 2 * 512 * 4;
constexpr size_t OFF_SUMA = OFF_SSQ + 65536;
constexpr size_t OFF_SUMH = AL(OFF_SUMA + SZ_SUM);
constexpr size_t OFF_HS   = AL(OFF_SUMH + SZ_SUM);
constexpr size_t OFF_SP   = AL(OFF_HS + SZ_SUM);
constexpr size_t OFF_MPQ  = AL(OFF_SP + 2048);
constexpr size_t OFF_WINT = AL(OFF_MPQ + 8 * 16384);
constexpr size_t OFF_WOUTT = AL(OFF_WINT + (size_t)DIN * DM * 2);
constexpr size_t OFF_WQT  = AL(OFF_WOUTT + (size_t)DM * DM * 2);
constexpr size_t OFF_W2T  = AL(OFF_WQT + (size_t)2048 * DM * 2);
constexpr size_t OFF_A2T  = AL(OFF_W2T + 512 * 64 * 2);
constexpr size_t OFF_G2T  = AL(OFF_A2T + 512 * 64 * 2);
constexpr size_t OFF_WAT  = AL(OFF_G2T + 512 * 128 * 2);
constexpr size_t OFF_WXT  = AL(OFF_WAT + 8 * 64 * 64 * 2);
constexpr size_t OFF_KEYS = AL(OFF_WXT + 8 * 64 * 64 * 2);
constexpr size_t OFF_UB   = AL(OFF_KEYS + 8 * 2 * 128 * 128 * 2);
constexpr size_t OFF_VB   = AL(OFF_UB + (size_t)16384 * DM / 2);
constexpr size_t OFF_SU   = AL(OFF_VB + (size_t)16384 * DM / 2);
constexpr size_t OFF_SV   = AL(OFF_SU + 16384 * 4);
constexpr size_t OFF_XN   = AL(OFF_SV + 16384 * 4);
constexpr size_t OFF_SB   = AL(OFF_XN + (size_t)MROWS * DM * 2);
constexpr size_t OFF_P    = AL(OFF_SB + (size_t)2048 * 8192);
constexpr size_t OFF_H1B  = OFF_P;
constexpr size_t OFF_EIDX = AL(OFF_H1B + (size_t)NTOK * DM * 2);
constexpr size_t OFF_GATE = AL(OFF_EIDX + (size_t)NTOK * 128 * 2);
constexpr size_t OFF_E1   = AL(OFF_P + (size_t)MROWS * DIN * 2);
constexpr size_t OFF_E2   = AL(OFF_E1 + (size_t)NTOK * 512 * 2);
constexpr size_t OFF_AC   = AL(OFF_E2 + (size_t)NTOK * 512 * 2);
constexpr size_t OFF_HL   = AL(OFF_AC + (size_t)NTOK * 512 * 2);
constexpr size_t WS_END   = AL(OFF_HL + (size_t)NTOK * 512 * 2);
constexpr size_t UNIT_BYTES = 32768;
constexpr int NUNITS = 8 + 2048;
static_assert((size_t)2048 * UNIT_BYTES <= (size_t)NTOK * DM * 4, "unit data does not fit in d_out");
static_assert(WS_END <= (size_t)256 * 1024 * 1024, "workspace too large");

constexpr int SMEM_BYTES = 160 * 1024;
constexpr int PRM_RWKV = 148736;
constexpr int PRM_LRU = 65536;

struct Params {
    const float *x, *meta, *g1, *w_in, *conv_w, *conv_b, *ga_w, *ga_b, *gx_w, *gx_b, *lam, *lru_gain, *mu, *w0, *w2, *a0, *a2, *g2,
        *k_k, *k_a, *r_k, *gn_w, *gn_b, *w_out, *g2n, *w_q, *q_gain, *keys, *u, *v, *fg;
    float* out;
    char* ws;
};

__device__ __forceinline__ unsigned short f2bf(float f) { __bf16 b = (__bf16)f; return __builtin_bit_cast(unsigned short, b); }
__device__ __forceinline__ unsigned pack2(float lo, float hi) { bf2_t v; v[0] = (__bf16)lo; v[1] = (__bf16)hi; return __builtin_bit_cast(unsigned, v); }
__device__ __forceinline__ float bflo(unsigned u) { return __uint_as_float(u << 16); }
__device__ __forceinline__ float bfhi(unsigned u) { return __uint_as_float(u & 0xFFFF0000u); }
__device__ __forceinline__ float bf2f(bf16_t b) { return __uint_as_float((unsigned)b << 16); }
__device__ __forceinline__ float wave_sum(float v) {
#pragma unroll
    for (int o = 32; o > 0; o >>= 1) v += __shfl_xor(v, o);
    return v;
}
__device__ __forceinline__ float sum8(float v) { v += __shfl_xor(v, 1); v += __shfl_xor(v, 2); v += __shfl_xor(v, 4); return v; }
__device__ __forceinline__ float sigmoidf_(float x) { return 1.0f / (1.0f + __expf(-x)); }
__device__ __forceinline__ float gelu_tanh(float x) {
    const float u = 0.7978845608f * (x + 0.044715f * x * x * x);
    const float t = 1.0f - 2.0f / (__expf(2.0f * u) + 1.0f);
    return 0.5f * x * (1.0f + t);
}
__device__ __forceinline__ float gelu_erf(float x) { return 0.5f * x * (1.0f + erff(x * 0.70710678118f)); }
__device__ __forceinline__ void unpack8(u32x4 q, float* f) {
    f[0] = bflo(q[0]); f[1] = bfhi(q[0]); f[2] = bflo(q[1]); f[3] = bfhi(q[1]);
    f[4] = bflo(q[2]); f[5] = bfhi(q[2]); f[6] = bflo(q[3]); f[7] = bfhi(q[3]);
}
__device__ __forceinline__ u32x4 pack8(const float* f) {
    u32x4 q; q[0] = pack2(f[0], f[1]); q[1] = pack2(f[2], f[3]); q[2] = pack2(f[4], f[5]); q[3] = pack2(f[6], f[7]); return q;
}
__device__ __forceinline__ int row_of(int b, int pos) { return pos < NMETA ? NTOK + pos : b * T_SEQ + pos - NMETA; }

#define MFMA32(a, b, c) __builtin_amdgcn_mfma_f32_32x32x16_bf16((a), (b), (c), 0, 0, 0)
#define MFMA16(a, b, c) __builtin_amdgcn_mfma_f32_16x16x32_bf16((a), (b), (c), 0, 0, 0)

template <int KS>
__device__ __forceinline__ f32x16 mm_lds(const bf16_t* A, const bf16_t* Bt, int qm, int qn, int lane, f32x16 acc) {
    const int r = lane & 31, h = lane >> 5;
    const bf16_t* ap = A + (qm * 32 + r) * LD + h * 8;
    const bf16_t* bp = Bt + (qn * 32 + r) * LD + h * 8;
#pragma unroll
    for (int ks = 0; ks < KS; ++ks) {
        bf16x8 a = *(const bf16x8*)(ap + ks * 16), b = *(const bf16x8*)(bp + ks * 16);
        acc = MFMA32(a, b, acc);
    }
    return acc;
}
template <int KS>
__device__ __forceinline__ f32x16 mm_lds_s(const bf16_t* A, const bf16_t* Bt, int qm, int qn, int lane, f32x16 acc, bool swzA, bool swzB) {
    const int r = lane & 31, h = lane >> 5;
    const int ra = qm * 32 + r, rb = qn * 32 + r;
    const int xa = swzA ? ((ra >> 3) & 7) : 0, xb = swzB ? ((rb >> 3) & 7) : 0;
    const bf16_t* ap = A + ra * LD;
    const bf16_t* bp = Bt + rb * LD;
#pragma unroll
    for (int ks = 0; ks < KS; ++ks) {
        bf16x8 a = *(const bf16x8*)(ap + (((ks * 2 + h) ^ xa) * 8)), b = *(const bf16x8*)(bp + (((ks * 2 + h) ^ xb) * 8));
        acc = MFMA32(a, b, acc);
    }
    return acc;
}
template <int KS>
__device__ __forceinline__ f32x16 mm_lds_g(const bf16_t* A, const bf16_t* __restrict__ Btg, int ldb, int qm, int qn, int lane, f32x16 acc) {
    const int r = lane & 31, h = lane >> 5;
    const bf16_t* ap = A + (qm * 32 + r) * LD + h * 8;
    const bf16_t* bp = Btg + (size_t)(qn * 32 + r) * ldb + h * 8;
    bf16x8 bfr[KS];
#pragma unroll
    for (int ks = 0; ks < KS; ++ks) bfr[ks] = *(const bf16x8*)(bp + ks * 16);
#pragma unroll
    for (int ks = 0; ks < KS; ++ks) { bf16x8 a = *(const bf16x8*)(ap + ks * 16); acc = MFMA32(a, bfr[ks], acc); }
    return acc;
}
__device__ __forceinline__ void store_N_bf16(bf16_t* dst, const f32x16& c, int qm, int qn, int lane) {
    const int r = lane & 31, h = lane >> 5;
#pragma unroll
    for (int reg = 0; reg < 16; ++reg) dst[(qm * 32 + (reg & 3) + 8 * (reg >> 2) + 4 * h) * LD + qn * 32 + r] = f2bf(c[reg]);
}
__device__ __forceinline__ void store_T_bf16(bf16_t* dst, const f32x16& c, int qm, int qn, int lane) {
    const int r = lane & 31, h = lane >> 5;
#pragma unroll
    for (int g = 0; g < 4; ++g) {
        u32x2 w; w[0] = pack2(c[4 * g], c[4 * g + 1]); w[1] = pack2(c[4 * g + 2], c[4 * g + 3]);
        *(u32x2*)(dst + (qn * 32 + r) * LD + qm * 32 + 8 * g + 4 * h) = w;
    }
}
__device__ __forceinline__ void store_N_f32(float* dst, const f32x16& c, int qm, int qn, int lane) {
    const int r = lane & 31, h = lane >> 5;
#pragma unroll
    for (int reg = 0; reg < 16; ++reg) dst[(qm * 32 + (reg & 3) + 8 * (reg >> 2) + 4 * h) * LF + qn * 32 + r] = c[reg];
}
__device__ __forceinline__ f32x16 zero16() { f32x16 z; for (int i = 0; i < 16; ++i) z[i] = 0.f; return z; }

__device__ __forceinline__ void transpose_tile(const float* __restrict__ src, bf16_t* __restrict__ dst, int K, int N, const float* __restrict__ kscale, int tk, int tn, float* tile) {
    const int tid = threadIdx.x;
#pragma unroll
    for (int i = 0; i < 2; ++i) {
        const int kk = (tid >> 4) + 32 * i, nn = (tid & 15) * 4;
        f32x4 v = *(const f32x4*)(src + (size_t)(tk * 64 + kk) * N + tn * 64 + nn);
        const float s = kscale ? kscale[tk * 64 + kk] : 1.0f;
        tile[kk * 65 + nn] = v[0] * s; tile[kk * 65 + nn + 1] = v[1] * s; tile[kk * 65 + nn + 2] = v[2] * s; tile[kk * 65 + nn + 3] = v[3] * s;
    }
    __syncthreads();
    {
        const int n = tid >> 3, ks = (tid & 7) * 8;
        float f[8];
#pragma unroll
        for (int i = 0; i < 8; ++i) f[i] = tile[(ks + i) * 65 + n];
        *(u32x4*)(dst + (size_t)(tn * 64 + n) * K + tk * 64 + ks) = pack8(f);
    }
    __syncthreads();
}

__device__ __forceinline__ void phase_prep(const Params& p, char* smem) {
    const int tid = threadIdx.x, lane = tid & 63, wave = __builtin_amdgcn_readfirstlane(tid >> 6), G = gridDim.x;
    char* ws = p.ws;
    bf16_t* XN = (bf16_t*)(ws + OFF_XN);
    for (int row = blockIdx.x * 8 + wave; row < MROWS; row += G * 8) {
        u32x2* dst = (u32x2*)(XN + (size_t)row * DM);
        if (row >= NTOK + NMETA) {
#pragma unroll
            for (int i = 0; i < 4; ++i) { u32x2 z; z[0] = 0; z[1] = 0; dst[lane + 64 * i] = z; }
            continue;
        }
        const float* src = row < NTOK ? p.x + (size_t)row * DM : p.meta + (size_t)(row - NTOK) * DM;
        f32x4 v[4]; float ss = 0.f;
#pragma unroll
        for (int i = 0; i < 4; ++i) { v[i] = ((const f32x4*)src)[lane + 64 * i]; ss += v[i][0] * v[i][0] + v[i][1] * v[i][1] + v[i][2] * v[i][2] + v[i][3] * v[i][3]; }
        ss = wave_sum(ss);
        const float rs = rsqrtf(ss * (1.0f / DM) + 1e-6f);
#pragma unroll
        for (int i = 0; i < 4; ++i) {
            f32x4 g = ((const f32x4*)p.g1)[lane + 64 * i];
            u32x2 w; w[0] = pack2(v[i][0] * rs * g[0], v[i][1] * rs * g[1]); w[1] = pack2(v[i][2] * rs * g[2], v[i][3] * rs * g[3]);
            dst[lane + 64 * i] = w;
        }
    }
    {
        float* tile = (float*)smem;
        const int n0 = 16 * 44, n1 = n0 + 16 * 16, n2 = n1 + 16 * 32, n3 = n2 + 8, n4 = n3 + 8, n5 = n4 + 16, n6 = n5 + 8, n7 = n6 + 8;
        for (int t = blockIdx.x; t < n7; t += G) {
            if (t < n0) transpose_tile(p.w_in, (bf16_t*)(ws + OFF_WINT), DM, DIN, nullptr, t / 44, t % 44, tile);
            else if (t < n1) { const int u = t - n0; transpose_tile(p.w_out, (bf16_t*)(ws + OFF_WOUTT), DM, DM, nullptr, u / 16, u % 16, tile); }
            else if (t < n2) { const int u = t - n1; transpose_tile(p.w_q, (bf16_t*)(ws + OFF_WQT), DM, 2048, p.g2n, u / 32, u % 32, tile); }
            else if (t < n3) { const int u = t - n2; transpose_tile(p.w2, (bf16_t*)(ws + OFF_W2T), 64, 512, nullptr, 0, u, tile); }
            else if (t < n4) { const int u = t - n3; transpose_tile(p.a2, (bf16_t*)(ws + OFF_A2T), 64, 512, nullptr, 0, u, tile); }
            else if (t < n5) { const int u = t - n4; transpose_tile(p.g2, (bf16_t*)(ws + OFF_G2T), 128, 512, nullptr, u / 8, u % 8, tile); }
            else if (t < n6) { const int u = t - n5; transpose_tile(p.ga_w + u * 4096, (bf16_t*)(ws + OFF_WAT) + u * 4096, 64, 64, nullptr, 0, 0, tile); }
            else { const int u = t - n6; transpose_tile(p.gx_w + u * 4096, (bf16_t*)(ws + OFF_WXT) + u * 4096, 64, 64, nullptr, 0, 0, tile); }
        }
    }
    {
        const int gt = blockIdx.x * NTHR + tid, gs = G * NTHR;
        bf16_t* KEYS = (bf16_t*)(ws + OFF_KEYS);
        for (int i = gt; i < 8 * 2 * 128 * 128 / 4; i += gs) {
            const int e = i * 4, d = e & 127, sub = (e >> 14) & 1, h = e >> 15;
            f32x4 k = ((const f32x4*)p.keys)[i]; f32x4 g = *(const f32x4*)(p.q_gain + h * 256 + sub * 128 + d);
            u32x2 w; w[0] = pack2(k[0] * g[0], k[1] * g[1]); w[1] = pack2(k[2] * g[2], k[3] * g[3]);
            *(u32x2*)(KEYS + e) = w;
        }
        float* ssq = (float*)(ws + OFF_SSQ);
        for (int i = gt; i < NTOK; i += gs) ssq[i] = 0.f;
        float* SPt = (float*)(ws + OFF_SP);
        for (int i = gt; i < 512; i += gs) SPt[i] = log1pf(__expf(-p.lam[i]));
    }
}


__device__ __forceinline__ void convert_tables(const Params& p, int first) {
    char* ws = p.ws;
    const int lane = threadIdx.x & 63, wave = threadIdx.x >> 6;
    const int gw = (blockIdx.x - first) * 8 + wave, nw = (gridDim.x - first) * 8;
    float g[16];
#pragma unroll
    for (int q = 0; q < 4; ++q) *(f32x4*)(g + 4 * q) = *(const f32x4*)(p.g2n + lane * 16 + 4 * q);
#pragma unroll 1
    for (int r0 = gw; r0 < 32768; r0 += nw * 2) {
        f32x4 xv[2][4];
#pragma unroll
        for (int k = 0; k < 2; ++k) {
            const int rr = min(r0 + k * nw, 32767);
            const float* src = (rr < 16384 ? p.u : p.v) + (size_t)(rr & 16383) * DM + lane * 16;
#pragma unroll
            for (int q = 0; q < 4; ++q) xv[k][q] = *(const f32x4*)(src + 4 * q);
        }
        int keep = r0; asm volatile("" : "+v"(keep) :: "memory");
#pragma unroll
        for (int k = 0; k < 2; ++k) {
            const int rr = keep + k * nw;
            if (rr < 32768) {
                const bool isu = rr < 16384;
                float x[16]; float amax = 0.f;
#pragma unroll
                for (int i = 0; i < 16; ++i) { x[i] = xv[k][i >> 2][i & 3] * (isu ? g[i] : 1.0f); amax = fmaxf(amax, fabsf(x[i])); }
#pragma unroll
                for (int o = 32; o > 0; o >>= 1) amax = fmaxf(amax, __shfl_xor(amax, o));
                const float sc = fmaxf(amax, 1e-30f) * (1.0f / 6.0f), inv = 1.0f / sc;
                unsigned w0 = 0, w1 = 0;
                w0 = __builtin_amdgcn_cvt_scalef32_pk_fp4_f32(w0, x[0] * inv, x[1] * inv, 1.0f, 0);
                w0 = __builtin_amdgcn_cvt_scalef32_pk_fp4_f32(w0, x[2] * inv, x[3] * inv, 1.0f, 1);
                w0 = __builtin_amdgcn_cvt_scalef32_pk_fp4_f32(w0, x[4] * inv, x[5] * inv, 1.0f, 2);
                w0 = __builtin_amdgcn_cvt_scalef32_pk_fp4_f32(w0, x[6] * inv, x[7] * inv, 1.0f, 3);
                w1 = __builtin_amdgcn_cvt_scalef32_pk_fp4_f32(w1, x[8] * inv, x[9] * inv, 1.0f, 0);
                w1 = __builtin_amdgcn_cvt_scalef32_pk_fp4_f32(w1, x[10] * inv, x[11] * inv, 1.0f, 1);
                w1 = __builtin_amdgcn_cvt_scalef32_pk_fp4_f32(w1, x[12] * inv, x[13] * inv, 1.0f, 2);
                w1 = __builtin_amdgcn_cvt_scalef32_pk_fp4_f32(w1, x[14] * inv, x[15] * inv, 1.0f, 3);
                u32x2 w; w[0] = w0; w[1] = w1;
                *(u32x2*)(ws + (isu ? OFF_UB : OFF_VB) + (size_t)(rr & 16383) * (DM / 2) + lane * 8) = w;
                if (lane == 0) ((float*)(ws + (isu ? OFF_SU : OFF_SV)))[rr & 16383] = sc;
            }
        }
    }
}

constexpr int GA_ROWS = 256, GB_ROWS = 128;
constexpr int GBUF = (GA_ROWS + GB_ROWS) * LD;

struct EpiStoreBf16 {
    bf16_t* C; int ldc;
    __device__ __forceinline__ void operator()(const f32x16 (&acc)[2][2], int mb, int nb, int lane) const {
        const int r = lane & 31, h = lane >> 5;
#pragma unroll
        for (int i = 0; i < 2; ++i)
#pragma unroll
            for (int j = 0; j < 2; ++j)
#pragma unroll
                for (int g = 0; g < 4; ++g) {
                    u32x2 w; w[0] = pack2(acc[i][j][4 * g], acc[i][j][4 * g + 1]); w[1] = pack2(acc[i][j][4 * g + 2], acc[i][j][4 * g + 3]);
                    *(u32x2*)(C + (size_t)(mb + i * 32 + r) * ldc + nb + j * 32 + 8 * g + 4 * h) = w;
                }
    }
};
struct EpiResidual {
    bf16_t* C; const float* X; float* ssq;
    __device__ __forceinline__ void operator()(const f32x16 (&acc)[2][2], int mb, int nb, int lane) const {
        const int r = lane & 31, h = lane >> 5;
#pragma unroll
        for (int i = 0; i < 2; ++i) {
            const int row = mb + i * 32 + r; float ss = 0.f;
#pragma unroll
            for (int j = 0; j < 2; ++j)
#pragma unroll
                for (int g = 0; g < 4; ++g) {
                    const int col = nb + j * 32 + 8 * g + 4 * h;
                    f32x4 xv = *(const f32x4*)(X + (size_t)row * DM + col);
                    const float v0 = acc[i][j][4 * g] + xv[0], v1 = acc[i][j][4 * g + 1] + xv[1], v2 = acc[i][j][4 * g + 2] + xv[2], v3 = acc[i][j][4 * g + 3] + xv[3];
                    ss += v0 * v0 + v1 * v1 + v2 * v2 + v3 * v3;
                    u32x2 w; w[0] = pack2(v0, v1); w[1] = pack2(v2, v3);
                    *(u32x2*)(C + (size_t)row * DM + col) = w;
                }
            ss += __shfl_xor(ss, 32);
            if (h == 0) atomicAdd(ssq + row, ss);
        }
    }
};

template <class Epi>
__device__ __forceinline__ void gemm_phase(const bf16_t* __restrict__ A, const bf16_t* __restrict__ Bt, int M, int N, int K, char* smem, const Epi& epi) {
    const int tid = threadIdx.x, lane = tid & 63, wave = __builtin_amdgcn_readfirstlane(tid >> 6);
    const int wm = wave >> 1, wn = wave & 1, r = lane & 31, h = lane >> 5;
    const int nNt = N / 128, ntiles = (M / 256) * nNt, nk = K / 64;
    const int G = gridDim.x;
    const int bid = (G % 8 == 0) ? (blockIdx.x % 8) * (G / 8) + blockIdx.x / 8 : blockIdx.x;
    bf16_t* lds = (bf16_t*)smem;
    for (int tile = bid; tile < ntiles; tile += G) {
        const int pm = tile / nNt, pn = tile % nNt, m0 = pm * 256, n0 = pn * 128;
        const bf16_t* Ag = A + (size_t)m0 * K; const bf16_t* Bg = Bt + (size_t)n0 * K;
        f32x16 acc[2][2];
#pragma unroll
        for (int i = 0; i < 2; ++i)
#pragma unroll
            for (int j = 0; j < 2; ++j) acc[i][j] = zero16();
        u32x4 ra0[4], rb0[2], ra1[4], rb1[2];
#define G_LOAD(RA, RB, KT) { \
            _Pragma("unroll") for (int i = 0; i < 4; ++i) { const int q = tid + 512 * i; RA[i] = *(const u32x4*)(Ag + (size_t)(q >> 3) * K + (KT) * 64 + (q & 7) * 8); } \
            _Pragma("unroll") for (int i = 0; i < 2; ++i) { const int q = tid + 512 * i; RB[i] = *(const u32x4*)(Bg + (size_t)(q >> 3) * K + (KT) * 64 + (q & 7) * 8); } }
#define G_WRITE(RA, RB, BUF) { bf16_t* b_ = lds + (BUF) * GBUF; \
            _Pragma("unroll") for (int i = 0; i < 4; ++i) { const int q = tid + 512 * i; *(u32x4*)(b_ + (q >> 3) * LD + (q & 7) * 8) = RA[i]; } \
            _Pragma("unroll") for (int i = 0; i < 2; ++i) { const int q = tid + 512 * i; *(u32x4*)(b_ + GA_ROWS * LD + (q >> 3) * LD + (q & 7) * 8) = RB[i]; } }
#define G_COMPUTE(BUF) { const bf16_t* a_ = lds + (BUF) * GBUF + (wm * 64 + r) * LD + h * 8; const bf16_t* b_ = lds + (BUF) * GBUF + (GA_ROWS + wn * 64 + r) * LD + h * 8; \
            _Pragma("unroll") for (int ks = 0; ks < 4; ++ks) { \
                bf16x8 af0 = *(const bf16x8*)(a_ + ks * 16), af1 = *(const bf16x8*)(a_ + 32 * LD + ks * 16); \
                bf16x8 bf0 = *(const bf16x8*)(b_ + ks * 16), bf1 = *(const bf16x8*)(b_ + 32 * LD + ks * 16); \
                acc[0][0] = MFMA32(bf0, af0, acc[0][0]); acc[0][1] = MFMA32(bf1, af0, acc[0][1]); \
                acc[1][0] = MFMA32(bf0, af1, acc[1][0]); acc[1][1] = MFMA32(bf1, af1, acc[1][1]); } }
        G_LOAD(ra0, rb0, 0); G_LOAD(ra1, rb1, 1);
        G_WRITE(ra0, rb0, 0);
        __syncthreads();
        for (int kt = 0; kt < nk; kt += 2) {
            if (kt + 2 < nk) G_LOAD(ra0, rb0, kt + 2);
            G_COMPUTE(0);
            G_WRITE(ra1, rb1, 1);
            __syncthreads();
            if (kt + 3 < nk) G_LOAD(ra1, rb1, kt + 3);
            G_COMPUTE(1);
            if (kt + 2 < nk) G_WRITE(ra0, rb0, 0);
            __syncthreads();
        }
        epi(acc, m0 + wm * 64, n0 + wn * 64, lane);
    }
#undef G_LOAD
#undef G_WRITE
#undef G_COMPUTE
}

constexpr int GBUF2 = 512 * LD;
template <class Epi>
__device__ __forceinline__ void gemm_phase256(const bf16_t* __restrict__ A, const bf16_t* __restrict__ Bt, int M, int N, int K, char* smem, const Epi& epi) {
    int tid_ = threadIdx.x; asm volatile("" : "+v"(tid_));
    const int tid = tid_, lane = tid & 63, wave = __builtin_amdgcn_readfirstlane(tid >> 6);
    const int wm = wave >> 2, wn = wave & 3, r = lane & 31, h = lane >> 5;
    const int nNt = N / 256, ntiles = (M / 256) * nNt, nk = K / 64;
    const int G = gridDim.x;
    const int bid = (G % 8 == 0) ? (blockIdx.x % 8) * (G / 8) + blockIdx.x / 8 : blockIdx.x;
    bf16_t* lds = (bf16_t*)smem;
    for (int tile = bid; tile < ntiles; tile += G) {
        const int pm = tile / nNt, pn = tile % nNt, m0 = pm * 256, n0 = pn * 256;
        const bf16_t* Ag = A + (size_t)m0 * K; const bf16_t* Bg = Bt + (size_t)n0 * K;
        f32x16 acc[4][2];
#pragma unroll
        for (int i = 0; i < 4; ++i)
#pragma unroll
            for (int j = 0; j < 2; ++j) acc[i][j] = zero16();
        u32x4 ra0[4], rb0[4];
#define G_LOAD(RA, RB, KT) { \
            _Pragma("unroll") for (int i = 0; i < 4; ++i) { const int q = tid + 512 * i; RA[i] = *(const u32x4*)(Ag + (size_t)(q >> 3) * K + (KT) * 64 + (q & 7) * 8); \
                                                                                      RB[i] = *(const u32x4*)(Bg + (size_t)(q >> 3) * K + (KT) * 64 + (q & 7) * 8); } }
#define G_WRITE(RA, RB, BUF) { bf16_t* b_ = lds + (BUF) * GBUF2; \
            _Pragma("unroll") for (int i = 0; i < 4; ++i) { const int q = tid + 512 * i; *(u32x4*)(b_ + (q >> 3) * LD + (q & 7) * 8) = RA[i]; \
                                                                                      *(u32x4*)(b_ + 256 * LD + (q >> 3) * LD + (q & 7) * 8) = RB[i]; } }
#define G_COMPUTE(BUF) { const bf16_t* a_ = lds + (BUF) * GBUF2 + (wm * 128 + r) * LD + h * 8; const bf16_t* b_ = lds + (BUF) * GBUF2 + (256 + wn * 64 + r) * LD + h * 8; \
            _Pragma("unroll") for (int ks = 0; ks < 4; ++ks) { \
                bf16x8 bf0 = *(const bf16x8*)(b_ + ks * 16), bf1 = *(const bf16x8*)(b_ + 32 * LD + ks * 16); \
                _Pragma("unroll") for (int i = 0; i < 4; ++i) { bf16x8 af = *(const bf16x8*)(a_ + i * 32 * LD + ks * 16); \
                    acc[i][0] = MFMA32(bf0, af, acc[i][0]); acc[i][1] = MFMA32(bf1, af, acc[i][1]); } } }
        G_LOAD(ra0, rb0, 0);
        G_WRITE(ra0, rb0, 0);
        __syncthreads();
        G_LOAD(ra0, rb0, 1);
#pragma unroll 1
        for (int kt = 0; kt < nk; kt += 2) {
            G_COMPUTE(0);
            G_WRITE(ra0, rb0, 1);
            __syncthreads();
            if (kt + 2 < nk) G_LOAD(ra0, rb0, kt + 2);
            G_COMPUTE(1);
            if (kt + 2 < nk) G_WRITE(ra0, rb0, 0);
            __syncthreads();
            if (kt + 3 < nk) G_LOAD(ra0, rb0, kt + 3);
        }
        epi(*(const f32x16 (*)[2][2])(&acc[0]), m0 + wm * 128, n0 + wn * 64, lane);
        epi(*(const f32x16 (*)[2][2])(&acc[2]), m0 + wm * 128 + 64, n0 + wn * 64, lane);
    }
#undef G_LOAD
#undef G_WRITE
#undef G_COMPUTE
}

namespace pg8 {
#define PG8_LAS __attribute__((address_space(3)))
constexpr int BM = 256, BK = 64, HALF = 128, HTB = HALF * BK * 2  , STAGE_BYTES = 8 * HTB, NXCD = 8, WGM = 8;
__host__ __device__ __forceinline__ int lds_byte(int r, int c) { const int st = (r >> 4) * 2 + (c >> 5), rr = r & 15, cc = c & 31, ob = rr * 64 + cc * 2; return st * 1024 + (ob ^ (((ob >> 9) & 1) << 5)); }
__host__ __device__ __forceinline__ void stage_rc(int b, int& R, int& C) { const int st = b / 1024, sb = b % 1024, swz = sb ^ (((sb >> 9) & 1) << 5); R = (st >> 1) * 16 + swz / 64; C = (st & 1) * 32 + (swz % 64) / 2; }
__host__ __device__ __forceinline__ int perm32(int rho) { const int n = rho >> 4, i = rho & 15; return 8 * (i >> 2) + 4 * n + (i & 3); }
struct Unit { int pm, pn; };
struct Gemm { const bf16_t* A; const bf16_t* Bt; int M, N, K; };
struct StaticOrder {
    int nM, nN, nwg, G, c;
    __host__ __device__ void init(int M, int N, int G_, int c_) { nM = M / BM; nN = N / BM; nwg = nM * nN; G = G_; c = c_; }
    __host__ __device__ bool next(int i, Unit& u) const {
        const long L = (long)i * G + c; if (L >= nwg) return false;
        int wgid = (int)L; { const int q = nwg / NXCD, r = nwg % NXCD, xcd = wgid % NXCD, off = wgid / NXCD; wgid = (xcd < r ? xcd * (q + 1) : r * (q + 1) + (xcd - r) * q) + off; }
        const int nig = WGM * nN, gid = wgid / nig, fm = gid * WGM, gsz = (nM - fm) < WGM ? (nM - fm) : WGM;
        u.pm = fm + ((wgid % nig) % gsz); u.pn = (wgid % nig) / gsz; return true;
    }
    __device__ __forceinline__ void a_ready(const Unit&) const {}
    __device__ __forceinline__ void done(const Unit&) const {}
};
struct EpiBf16 {
    static constexpr bool PERM = true, AFTER_DRAIN = false;
    bf16_t* C; int ldc;
    __device__ __forceinline__ void operator()(const f32x4 (&acc)[2][2][4][2], const Unit& u, int wr, int wc, int fr, int fq) const {
#pragma unroll
        for (int ai = 0; ai < 2; ++ai)
#pragma unroll
            for (int m = 0; m < 4; ++m) {
                bf16_t* rowp = C + (size_t)(u.pm * BM + ai * HALF + wr * 64 + m * 16 + fr) * ldc + u.pn * BM + wc * 32 + 8 * fq;
#pragma unroll
                for (int bj = 0; bj < 2; ++bj) {
                    const f32x4 v0 = acc[ai][bj][m][0], v1 = acc[ai][bj][m][1];
                    u32x4 w; w[0] = pack2(v0[0], v0[1]); w[1] = pack2(v0[2], v0[3]); w[2] = pack2(v1[0], v1[1]); w[3] = pack2(v1[2], v1[3]);
                    *(u32x4*)(rowp + bj * HALF) = w;
                }
                asm volatile("" ::: "memory");
            }
    }
};
struct EpiRes {
    static constexpr bool PERM = true, AFTER_DRAIN = false;
    bf16_t* C; const float* X; float* ssq;
    __device__ __forceinline__ void operator()(const f32x4 (&acc)[2][2][4][2], const Unit& u, int wr, int wc, int fr, int fq) const {
#pragma unroll
        for (int ai = 0; ai < 2; ++ai)
#pragma unroll
            for (int m = 0; m < 4; ++m) {
                const int row = u.pm * BM + ai * HALF + wr * 64 + m * 16 + fr;
                float ss = 0.f;
#pragma unroll
                for (int bj = 0; bj < 2; ++bj) {
                    const int col = u.pn * BM + bj * HALF + wc * 32 + 8 * fq;
                    const f32x4 x0 = *(const f32x4*)(X + (size_t)row * DM + col), x1 = *(const f32x4*)(X + (size_t)row * DM + col + 4);
                    const f32x4 v0 = acc[ai][bj][m][0] + x0, v1 = acc[ai][bj][m][1] + x1;
                    ss += v0[0] * v0[0] + v0[1] * v0[1] + v0[2] * v0[2] + v0[3] * v0[3] + v1[0] * v1[0] + v1[1] * v1[1] + v1[2] * v1[2] + v1[3] * v1[3];
                    u32x4 w; w[0] = pack2(v0[0], v0[1]); w[1] = pack2(v0[2], v0[3]); w[2] = pack2(v1[0], v1[1]); w[3] = pack2(v1[2], v1[3]);
                    *(u32x4*)(C + (size_t)row * DM + col) = w;
                }
                ss += __shfl_xor(ss, 16); ss += __shfl_xor(ss, 32);
                if (fq == 0) atomicAdd(ssq + row, ss);
                asm volatile("" ::: "memory");
            }
    }
};
template <class Epi, class Sched, bool ALIGN_EPI = false, bool SP2 = false>
__device__ __forceinline__ void gemm_phase(PG8_LAS unsigned char* lds, const Gemm g, const Sched& S, const Epi& E) {
    const int tid = threadIdx.x, wid = __builtin_amdgcn_readfirstlane(tid >> 6), lane = tid & 63, wr = wid >> 2, wc = wid & 3, fr = lane & 15, fq = lane >> 4;
    const int K = g.K, nt = K / BK;
    unsigned voffA[2], voffB[2];
#pragma unroll
    for (int i = 0; i < 2; ++i) { int R, C; stage_rc(tid * 16 + i * 8192, R, C); const int Rb = Epi::PERM ? ((R & ~31) + perm32(R & 31)) : R;
        voffA[i] = (unsigned)(R * K + C) * 2u; voffB[i] = (unsigned)(Rb * K + C) * 2u; }
    const size_t kstep = (size_t)(BK * 2);
    const size_t hstep = (size_t)HALF * K * 2;
    const size_t tstep = 2 * hstep;
    const unsigned ldsw = (unsigned)wid * 1024u;
    const int aoff = lds_byte(wr * 64 + fr, fq * 8), boff = lds_byte(wc * 32 + fr, fq * 8);
#define PG8_SA(b, h) (((b) * 2 + (h)) * HTB)
#define PG8_SB(b, h) ((4 + (b) * 2 + (h)) * HTB)
#define PG8_STAGE(bufoff, gbase, voff) do { _Pragma("unroll") for (int _i = 0; _i < 2; ++_i) \
        __builtin_amdgcn_global_load_lds((const unsigned*)((const char*)(gbase) + (voff)[_i]), (PG8_LAS unsigned*)(lds + (bufoff) + ldsw + _i * 8192), 16, 0, 0); } while (0)
#define PG8_LDA(dst, b, h) do { _Pragma("unroll") for (int m = 0; m < 4; ++m) _Pragma("unroll") for (int k = 0; k < 2; ++k) dst[m][k] = *(const PG8_LAS bf16x8*)(lds + PG8_SA(b, h) + aoff + m * 2048 + k * 1024); } while (0)
#define PG8_LDB(dst, b, h) do { _Pragma("unroll") for (int n = 0; n < 2; ++n) _Pragma("unroll") for (int k = 0; k < 2; ++k) dst[n][k] = *(const PG8_LAS bf16x8*)(lds + PG8_SB(b, h) + boff + n * 2048 + k * 1024); } while (0)
#define PG8_MMA(ai, bj, At, Bt) do { __builtin_amdgcn_s_setprio(1); _Pragma("unroll") for (int m = 0; m < 4; ++m) _Pragma("unroll") for (int n = 0; n < 2; ++n) _Pragma("unroll") for (int k = 0; k < 2; ++k) \
        acc[ai][bj][m][n] = __builtin_amdgcn_mfma_f32_16x16x32_bf16(Bt[n][k], At[m][k], acc[ai][bj][m][n], 0, 0, 0); __builtin_amdgcn_s_setprio(0); } while (0)
#define PG8_WAIT_V(n) asm volatile("s_waitcnt vmcnt(" #n ")" ::: "memory")
#define PG8_WAIT_L(n) asm volatile("s_waitcnt lgkmcnt(" #n ")" ::: "memory")
#define PG8_BAR __builtin_amdgcn_s_barrier()
#define PG8_SCHED __builtin_amdgcn_sched_barrier(0)
    Unit cur, nxt; int ui = 0;
    if (!S.next(0, cur)) return;
    f32x4 acc[2][2][4][2];
#pragma unroll
    for (int a = 0; a < 2; ++a)
#pragma unroll
        for (int b = 0; b < 2; ++b)
#pragma unroll
            for (int m = 0; m < 4; ++m)
#pragma unroll
                for (int n = 0; n < 2; ++n) acc[a][b][m][n] = (f32x4){0.f, 0.f, 0.f, 0.f};
    bf16x8 At[4][2], B0[2][2], B1[2][2];
    const char* cA = (const char*)g.A + (size_t)cur.pm * tstep; const char* cB = (const char*)g.Bt + (size_t)cur.pn * tstep;
    S.a_ready(cur);
    if constexpr (SP2) {
        PG8_STAGE(PG8_SB(0, 0), cB, voffB); PG8_STAGE(PG8_SB(0, 1), cB + hstep, voffB); PG8_STAGE(PG8_SA(0, 0), cA, voffA); PG8_STAGE(PG8_SA(0, 1), cA + hstep, voffA);
        if (wr == 1) PG8_BAR;
        PG8_WAIT_V(2); PG8_BAR;
        PG8_STAGE(PG8_SB(1, 0), cB + kstep, voffB); PG8_STAGE(PG8_SA(1, 0), cA + kstep, voffA); PG8_STAGE(PG8_SB(1, 1), cB + hstep + kstep, voffB);
        PG8_WAIT_V(6); PG8_BAR;
    } else {
        PG8_STAGE(PG8_SB(0, 0), cB, voffB); PG8_STAGE(PG8_SA(0, 0), cA, voffA); PG8_STAGE(PG8_SB(0, 1), cB + hstep, voffB); PG8_STAGE(PG8_SA(0, 1), cA + hstep, voffA);
        if (wr == 1) PG8_BAR;
        PG8_WAIT_V(4); PG8_BAR;
        PG8_STAGE(PG8_SB(1, 0), cB + kstep, voffB); PG8_STAGE(PG8_SA(1, 0), cA + kstep, voffA); PG8_STAGE(PG8_SB(1, 1), cB + hstep + kstep, voffB);
        PG8_WAIT_V(6); PG8_BAR;
    }
    for (;;) {
        const bool has_next = S.next(ui + 1, nxt);
        const char* nA = has_next ? (const char*)g.A + (size_t)nxt.pm * tstep : cA; const char* nB = has_next ? (const char*)g.Bt + (size_t)nxt.pn * tstep : cB;
        for (int t = 0; t < nt; t += 2) {
            const bool last = (t == nt - 2);
            const char* a1 = cA + (size_t)(t + 1) * kstep;
            const char* a2 = last ? nA : cA + (size_t)(t + 2) * kstep; const char* b2 = last ? nB : cB + (size_t)(t + 2) * kstep;
            const char* a3 = a2 + kstep; const char* b3 = b2 + kstep;
            if (last && has_next) S.a_ready(nxt);
            if constexpr (SP2) {
            PG8_LDB(B0, 0, 0); PG8_LDB(B1, 0, 1); PG8_SCHED; PG8_LDA(At, 0, 0); PG8_STAGE(PG8_SA(1, 1), a1 + hstep, voffA);
            PG8_WAIT_V(8); PG8_WAIT_L(0); PG8_BAR; PG8_MMA(0, 0, At, B0); PG8_MMA(0, 1, At, B1); PG8_BAR; PG8_SCHED;
            PG8_LDA(At, 0, 1); PG8_STAGE(PG8_SB(0, 0), b2, voffB); PG8_STAGE(PG8_SB(0, 1), b2 + hstep, voffB); PG8_STAGE(PG8_SA(0, 0), a2, voffA);
            PG8_WAIT_V(8); PG8_WAIT_L(0); PG8_BAR; PG8_MMA(1, 0, At, B0); PG8_MMA(1, 1, At, B1); PG8_BAR; PG8_SCHED;
            PG8_LDB(B0, 1, 0); PG8_LDB(B1, 1, 1); PG8_SCHED; PG8_LDA(At, 1, 0); PG8_STAGE(PG8_SA(0, 1), a2 + hstep, voffA);
            PG8_WAIT_V(8); PG8_WAIT_L(0); PG8_BAR; PG8_MMA(0, 0, At, B0); PG8_MMA(0, 1, At, B1); PG8_BAR; PG8_SCHED;
            PG8_LDA(At, 1, 1); PG8_STAGE(PG8_SB(1, 0), b3, voffB); PG8_STAGE(PG8_SB(1, 1), b3 + hstep, voffB); PG8_STAGE(PG8_SA(1, 0), a3, voffA);
            PG8_WAIT_V(8); PG8_WAIT_L(0); PG8_BAR; PG8_MMA(1, 0, At, B0); PG8_MMA(1, 1, At, B1); PG8_BAR; PG8_SCHED;
            } else {
            PG8_LDB(B0, 0, 0); PG8_SCHED; PG8_LDA(At, 0, 0); PG8_STAGE(PG8_SA(1, 1), a1 + hstep, voffA);
            PG8_WAIT_L(8); PG8_BAR; PG8_WAIT_L(0); PG8_MMA(0, 0, At, B0); PG8_BAR; PG8_SCHED;
            PG8_LDB(B1, 0, 1); PG8_STAGE(PG8_SB(0, 0), b2, voffB);
            PG8_BAR; PG8_WAIT_L(0); PG8_MMA(0, 1, At, B1); PG8_BAR;
            PG8_LDA(At, 0, 1); PG8_STAGE(PG8_SA(0, 0), a2, voffA);
            PG8_BAR; PG8_WAIT_L(0); PG8_MMA(1, 0, At, B0); PG8_BAR; PG8_SCHED;
            PG8_STAGE(PG8_SB(0, 1), b2 + hstep, voffB);
            PG8_WAIT_V(6); PG8_BAR; PG8_MMA(1, 1, At, B1); PG8_BAR;
            PG8_LDB(B0, 1, 0); PG8_SCHED; PG8_LDA(At, 1, 0); PG8_STAGE(PG8_SA(0, 1), a2 + hstep, voffA);
            PG8_WAIT_L(8); PG8_BAR; PG8_WAIT_L(0); PG8_MMA(0, 0, At, B0); PG8_BAR; PG8_SCHED;
            PG8_LDB(B1, 1, 1); PG8_STAGE(PG8_SB(1, 0), b3, voffB);
            PG8_BAR; PG8_WAIT_L(0); PG8_MMA(0, 1, At, B1); PG8_BAR;
            PG8_LDA(At, 1, 1); PG8_STAGE(PG8_SA(1, 0), a3, voffA);
            PG8_BAR; PG8_WAIT_L(0); PG8_MMA(1, 0, At, B0); PG8_BAR; PG8_SCHED;
            PG8_STAGE(PG8_SB(1, 1), b3 + hstep, voffB);
            PG8_WAIT_V(6); PG8_BAR; PG8_MMA(1, 1, At, B1); PG8_BAR;
            }
        }
        if constexpr (ALIGN_EPI) { if (wr == 0) PG8_BAR; }
        if constexpr (!Epi::AFTER_DRAIN) { E(acc, cur, wr, wc, fr, fq); S.done(cur); }
        if (!has_next) break;
#pragma unroll
        for (int a = 0; a < 2; ++a)
#pragma unroll
            for (int b = 0; b < 2; ++b)
#pragma unroll
                for (int m = 0; m < 4; ++m)
#pragma unroll
                    for (int n = 0; n < 2; ++n) acc[a][b][m][n] = (f32x4){0.f, 0.f, 0.f, 0.f};
        cur = nxt; cA = nA; cB = nB; ++ui;
        if constexpr (ALIGN_EPI) { if (wr == 1) PG8_BAR; }
    }
    PG8_WAIT_V(0);
    if constexpr (!ALIGN_EPI) { if (wr == 0) PG8_BAR; }
    PG8_BAR;
    if constexpr (Epi::AFTER_DRAIN) { E.fused(acc, cur, wr, wc, fr, fq, lds, wid, lane); S.done(cur); }
#undef PG8_SA
#undef PG8_SB
#undef PG8_STAGE
#undef PG8_LDA
#undef PG8_LDB
#undef PG8_MMA
#undef PG8_WAIT_V
#undef PG8_WAIT_L
#undef PG8_BAR
#undef PG8_SCHED
}
}

__device__ __forceinline__ void lru_unit(const Params& p, char* smem, int c, int b) {
    int tid_ = threadIdx.x; asm volatile("" : "+v"(tid_));
    const int tid = tid_, lane = tid & 63, wave = __builtin_amdgcn_readfirstlane(tid >> 6);
    char* ws = p.ws;
    const bf16_t* P = (const bf16_t*)(ws + OFF_P);
    const bf16_t* WAT = (const bf16_t*)(ws + OFF_WAT); const bf16_t* WXT = (const bf16_t*)(ws + OFF_WXT);
    float* sumA = (float*)(ws + OFF_SUMA); float* sumH = (float*)(ws + OFF_SUMH);
    const float* lp = (const float*)(smem + PRM_LRU);
    bf16_t* AC = (bf16_t*)(ws + OFF_AC); bf16_t* HL = (bf16_t*)(ws + OFF_HL);
    bf16_t* Xc = (bf16_t*)smem;
    float* Z0 = (float*)(smem + 9216);
    float* Z1 = Z0 + 64 * LF;
    float* SegA = Z1 + 64 * LF;
    float* SegH = SegA + 512;
    const int t = tid >> 3, c8 = tid & 7;
    const int pos0 = c == 0 ? 0 : NMETA + 64 * (c - 1);
    const int pos = pos0 + t;
    const bool valid = (c > 0) || (t < NMETA);
    const int row = row_of(b, valid ? pos : 0);
    const int grp = wave >> 2, qm = (wave >> 1) & 1, qn = wave & 1;
    const int r = lane & 31, hh2 = lane >> 5;
    u32x4 nx[4]; bf16x8 nb[4];
    auto fetch = [&](int hd) {
        const int ch0 = hd * 64 + c8 * 8;
#pragma unroll
        for (int d = 0; d < 4; ++d) {
            const int pp = pos - 3 + d;
            u32x4 z; z[0] = 0; z[1] = 0; z[2] = 0; z[3] = 0;
            nx[d] = (valid && pp >= 0) ? *(const u32x4*)(P + (size_t)row_of(b, pp) * DIN + ch0) : z;
        }
        const bf16_t* bp = (grp == 0 ? WAT : WXT) + hd * 4096 + (size_t)(qn * 32 + r) * 64 + hh2 * 8;
#pragma unroll
        for (int ks = 0; ks < 4; ++ks) nb[ks] = *(const bf16x8*)(bp + ks * 16);
    };
    fetch(0);
#pragma unroll 1
    for (int hd = 0; hd < 8; ++hd) {
        const int ch0 = hd * 64 + c8 * 8;
        float xc[8];
        u32x4 cx[4]; bf16x8 cb[4];
#pragma unroll
        for (int d = 0; d < 4; ++d) { cx[d] = nx[d]; cb[d] = nb[d]; }
        if (hd < 7) fetch(hd + 1);
        {
            f32x4 b0 = *(const f32x4*)(lp + 1536 + ch0), b1 = *(const f32x4*)(lp + 1536 + ch0 + 4);
            xc[0] = b0[0]; xc[1] = b0[1]; xc[2] = b0[2]; xc[3] = b0[3]; xc[4] = b1[0]; xc[5] = b1[1]; xc[6] = b1[2]; xc[7] = b1[3];
#pragma unroll
            for (int d = 0; d < 4; ++d) {
                float xv[8]; unpack8(cx[d], xv);
                f32x4 w0 = *(const f32x4*)(lp + 2048 + d * 512 + ch0), w1 = *(const f32x4*)(lp + 2048 + d * 512 + ch0 + 4);
                xc[0] += w0[0] * xv[0]; xc[1] += w0[1] * xv[1]; xc[2] += w0[2] * xv[2]; xc[3] += w0[3] * xv[3];
                xc[4] += w1[0] * xv[4]; xc[5] += w1[1] * xv[5]; xc[6] += w1[2] * xv[6]; xc[7] += w1[3] * xv[7];
            }
            *(u32x4*)(Xc + t * LD + c8 * 8) = pack8(xc);
        }
        __syncthreads();
        {
            f32x16 acc = zero16();
            const bf16_t* ap = Xc + (qm * 32 + r) * LD + hh2 * 8;
#pragma unroll
            for (int ks = 0; ks < 4; ++ks) { bf16x8 av_ = *(const bf16x8*)(ap + ks * 16); acc = MFMA32(av_, cb[ks], acc); }
            store_N_f32(grp == 0 ? Z0 : Z1, acc, qm, qn, lane);
        }
        __syncthreads();
        {
            float za[8], zx[8];
            *(f32x4*)za = *(const f32x4*)(Z0 + t * LF + c8 * 8); *(f32x4*)(za + 4) = *(const f32x4*)(Z0 + t * LF + c8 * 8 + 4);
            *(f32x4*)zx = *(const f32x4*)(Z1 + t * LF + c8 * 8); *(f32x4*)(zx + 4) = *(const f32x4*)(Z1 + t * LF + c8 * 8 + 4);
            float av[8], bv[8];
#pragma unroll
            for (int i = 0; i < 8; ++i) {
                const int ch = ch0 + i;
                const float rg = sigmoidf_(za[i] + lp[ch]), ig = sigmoidf_(zx[i] + lp[512 + ch]);
                const float a = __expf(-8.0f * rg * lp[1024 + ch]);
                const float bb = sqrtf(fmaxf(1.0f - a * a, 0.f)) * ig * xc[i];
                av[i] = valid ? a : 1.0f; bv[i] = valid ? bb : 0.f;
            }
            *(f32x4*)(Z0 + t * LF + c8 * 8) = *(f32x4*)av; *(f32x4*)(Z0 + t * LF + c8 * 8 + 4) = *(f32x4*)(av + 4);
            *(f32x4*)(Z1 + t * LF + c8 * 8) = *(f32x4*)bv; *(f32x4*)(Z1 + t * LF + c8 * 8 + 4) = *(f32x4*)(bv + 4);
        }
        __syncthreads();
        const int sch = tid & 63, seg = tid >> 6;
        {
            float Ac = 1.f, hh = 0.f;
#pragma unroll
            for (int k = 0; k < 8; ++k) {
                const int tt = seg * 8 + k;
                const float a = Z0[tt * LF + sch], bb = Z1[tt * LF + sch];
                hh = a * hh + bb; Ac *= a;
                Z0[tt * LF + sch] = Ac; Z1[tt * LF + sch] = hh;
            }
            SegA[seg * 64 + sch] = Ac; SegH[seg * 64 + sch] = hh;
        }
        __syncthreads();
        {
            float hin = 0.f, Ain = 1.f;
            for (int s2 = 0; s2 < seg; ++s2) { hin = SegA[s2 * 64 + sch] * hin + SegH[s2 * 64 + sch]; Ain *= SegA[s2 * 64 + sch]; }
#pragma unroll
            for (int k = 0; k < 8; ++k) {
                const int tt = seg * 8 + k;
                const float a = Z0[tt * LF + sch];
                Z1[tt * LF + sch] += a * hin; Z0[tt * LF + sch] = a * Ain;
            }
            if (seg == 7) {
                sumA[((size_t)c * 2 + b) * 512 + hd * 64 + sch] = Z0[63 * LF + sch];
                sumH[((size_t)c * 2 + b) * 512 + hd * 64 + sch] = Z1[63 * LF + sch];
            }
        }
        __syncthreads();
        if (c > 0) {
            float a8[8], h8[8];
            *(f32x4*)a8 = *(const f32x4*)(Z0 + t * LF + c8 * 8); *(f32x4*)(a8 + 4) = *(const f32x4*)(Z0 + t * LF + c8 * 8 + 4);
            *(f32x4*)h8 = *(const f32x4*)(Z1 + t * LF + c8 * 8); *(f32x4*)(h8 + 4) = *(const f32x4*)(Z1 + t * LF + c8 * 8 + 4);
            *(u32x4*)(AC + (size_t)row * 512 + ch0) = pack8(a8);
            *(u32x4*)(HL + (size_t)row * 512 + ch0) = pack8(h8);
        }
        __syncthreads();
    }
}
__device__ __forceinline__ void lru_out(const Params& p, char* smem, int c, int b) {
    int tid_ = threadIdx.x; asm volatile("" : "+v"(tid_));
    const int tid = tid_;
    char* ws = p.ws;
    const bf16_t* P = (const bf16_t*)(ws + OFF_P);
    const bf16_t* AC = (const bf16_t*)(ws + OFF_AC); const bf16_t* HL = (const bf16_t*)(ws + OFF_HL);
    float* HS = (float*)smem;
    bf16_t* Y = (bf16_t*)(ws + OFF_XN);
    {
        const float* sumA = (const float*)(ws + OFF_SUMA); const float* sumH = (const float*)(ws + OFF_SUMH);
        float hcur = sumH[tid];
#pragma unroll 1
        for (int c0 = 1; c0 < c; c0 += 32) {
            float av[32], hv[32];
#pragma unroll
            for (int k = 0; k < 32; ++k) { const int cc = min(c0 + k, NCHUNK - 1); av[k] = sumA[((size_t)cc * 2 + b) * 512 + tid]; hv[k] = sumH[((size_t)cc * 2 + b) * 512 + tid]; }
            asm volatile("" : "+v"(hcur) :: "memory");
#pragma unroll
            for (int k = 0; k < 32; ++k) { if (c0 + k < c) hcur = av[k] * hcur + hv[k]; }
        }
        __syncthreads();
        HS[tid] = hcur;
        __syncthreads();
    }
    const int t = tid >> 3, c8 = tid & 7;
    const int row = b * T_SEQ + 64 * (c - 1) + t;
    u32x4 yp[8];
    float ssq = 0.f;
#pragma unroll
    for (int hd = 0; hd < 8; ++hd) {
        const int ch0 = hd * 64 + c8 * 8;
        float a8[8], h8[8], g8[8], yv[8];
        unpack8(*(const u32x4*)(AC + (size_t)row * 512 + ch0), a8);
        unpack8(*(const u32x4*)(HL + (size_t)row * 512 + ch0), h8);
        unpack8(*(const u32x4*)(P + (size_t)row * DIN + 512 + ch0), g8);
        f32x4 s0 = *(const f32x4*)(HS + ch0), s1 = *(const f32x4*)(HS + ch0 + 4);
        const float hs[8] = {s0[0], s0[1], s0[2], s0[3], s1[0], s1[1], s1[2], s1[3]};
#pragma unroll
        for (int i = 0; i < 8; ++i) { yv[i] = (h8[i] + a8[i] * hs[i]) * gelu_tanh(g8[i]); ssq += yv[i] * yv[i]; }
        yp[hd] = pack8(yv);
    }
    ssq = sum8(ssq);
    const float rs = rsqrtf(ssq * (1.0f / 512.0f) + 1e-6f);
#pragma unroll
    for (int hd = 0; hd < 8; ++hd) {
        const int ch0 = hd * 64 + c8 * 8;
        float yv[8]; unpack8(yp[hd], yv);
        f32x4 g0 = *(const f32x4*)(p.lru_gain + ch0), g1 = *(const f32x4*)(p.lru_gain + ch0 + 4);
        yv[0] *= rs * g0[0]; yv[1] *= rs * g0[1]; yv[2] *= rs * g0[2]; yv[3] *= rs * g0[3];
        yv[4] *= rs * g1[0]; yv[5] *= rs * g1[1]; yv[6] *= rs * g1[2]; yv[7] *= rs * g1[3];
        *(u32x4*)(Y + (size_t)row * DM + ch0) = pack8(yv);
    }
    __syncthreads();
}

__device__ __forceinline__ float tanh_fast(float x) { return 1.0f - 2.0f / (__expf(2.0f * x) + 1.0f); }
struct S0Pre { u32x4 cur[5], prv[5]; };
__device__ __forceinline__ void s0_fetch(const Params& p, int c, int b, int hh, int tid, S0Pre& o) {
    const bf16_t* P = (const bf16_t*)(p.ws + OFF_P);
    const int t = tid >> 3, c8 = tid & 7;
    const int pos = (c == 0 ? 0 : NMETA + 64 * (c - 1)) + t;
    const bool valid = (c > 0) || (t < NMETA);
    const bool hasprev = valid && pos > 0;
    const bf16_t* pr = P + (size_t)row_of(b, valid ? pos : 0) * DIN;
    const bf16_t* pp = P + (size_t)row_of(b, hasprev ? pos - 1 : 0) * DIN;
    const int hc0 = hh * 64 + c8 * 8;
    const int cols[5] = {1024 + hc0, 1536 + hc0, 2048 + hc0, 2560 + c8 * 8, 2624 + c8 * 8};
#pragma unroll
    for (int i = 0; i < 5; ++i) { o.cur[i] = *(const u32x4*)(pr + cols[i]); o.prv[i] = *(const u32x4*)(pp + cols[i]); }
}
__device__ __forceinline__ void rwkv_unit(const Params& p, char* smem, int c, int b, int hh, unsigned long long& tacc, S0Pre& pre, bool has_next, int nc, int nb_, int nh) {
#define TT(k) if (TSSTAGE >= 0) { if ((k) == TSSTAGE) tacc -= __builtin_amdgcn_s_memrealtime(); if ((k) == TSSTAGE + 1) tacc += __builtin_amdgcn_s_memrealtime(); }
    TT(0)
    int tid_ = threadIdx.x; asm volatile("" : "+v"(tid_));
    const int tid = tid_, lane = tid & 63, wave = __builtin_amdgcn_readfirstlane(tid >> 6);
    char* ws = p.ws;
    const bf16_t* P = (const bf16_t*)(ws + OFF_P);
    bf16_t* S0 = (bf16_t*)smem;
#define SL(i) (S0 + (i) * SLOT)
    float* F0 = (float*)(smem + 14 * SLOT * 2);
    float* Seg = F0 + 64 * LF;
    float* GC = Seg + 512;
    float* FZa = (float*)SL(2);
    float* FZg = (float*)SL(4);
    const float* prm = (const float*)(smem + PRM_RWKV);
    bf16_t *sLw = SL(0), *sAabb = SL(0), *sLg0 = SL(0);
    bf16_t *sLa = SL(1), *sAak = SL(1), *sLg1 = SL(1);
    bf16_t *sBtT = SL(2), *sKtT = SL(3);
    bf16_t *sAt = SL(4), *sAtT = SL(5);
    bf16_t *sBh = SL(6), *sD0T = SL(6), *sW1T = SL(6);
    bf16_t *sKh = SL(7), *sM1T = SL(7), *sW2T = SL(7);
    bf16_t *sRt = SL(8), *sVT = SL(9), *sTm = SL(10), *sY2T = SL(11), *sArb = SL(12), *sArk = SL(13);
    const int t = tid >> 3, c8 = tid & 7;
    const int pos0 = c == 0 ? 0 : NMETA + 64 * (c - 1);
    const int pos = pos0 + t;
    const bool valid = (c > 0) || (t < NMETA);
    const int row = row_of(b, valid ? pos : 0);
    const int grp = wave >> 2, qm = (wave >> 1) & 1, qn = wave & 1, r = lane & 31, h = lane >> 5;
    const int hc0 = hh * 64 + c8 * 8;
    const int uidx = (b * 128 + (c - 1)) * 8 + hh;
    char* UD = c == 0 ? (ws + OFF_MPQ + (size_t)hh * 16384) : ((char*)p.out + (size_t)uidx * UNIT_BYTES);
    s0_fetch(p, c, b, hh, tid, pre);
    float rv[8], kv[8], vv[8];
    bf16x8 lorab[4];
    {
        const bf16_t* Bt = (const bf16_t*)(ws + (grp == 0 ? OFF_W2T : OFF_A2T)) + hh * 64 * 64 + (size_t)(qn * 32 + r) * 64 + h * 8;
#pragma unroll
        for (int ks = 0; ks < 4; ++ks) lorab[ks] = *(const bf16x8*)(Bt + ks * 16);
    }
    {
        const bool hasprev = valid && pos > 0;
        const int hcq = hc0, cols[5] = {1024 + hcq, 1536 + hcq, 2048 + hcq, 2560 + c8 * 8, 2624 + c8 * 8};
        auto sh8 = [&](int i, float* out) {
            float cur[8], prv[8];
            unpack8(pre.cur[i], cur); unpack8(pre.prv[i], prv);
            f32x4 m0 = *(const f32x4*)(p.mu + cols[i] - 1024), m1 = *(const f32x4*)(p.mu + cols[i] - 1024 + 4);
            float mm[8] = {m0[0], m0[1], m0[2], m0[3], m1[0], m1[1], m1[2], m1[3]};
#pragma unroll
            for (int k = 0; k < 8; ++k) out[k] = valid ? cur[k] + ((hasprev ? prv[k] : 0.f) - cur[k]) * mm[k] : 0.f;
        };
        sh8(0, rv); sh8(1, kv); sh8(2, vv);
        float wl[8], al[8];
        sh8(3, wl); sh8(4, al);
#pragma unroll
        for (int i = 0; i < 8; ++i) wl[i] = tanh_fast(wl[i]);
        *(u32x4*)(sLw + t * LD + c8 * 8) = pack8(wl);
        *(u32x4*)(sLa + t * LD + c8 * 8) = pack8(al);
    }
    __syncthreads();
    TT(1)
    {
        f32x16 acc = zero16();
        const bf16_t* ap = (grp == 0 ? sLw : sLa) + (qm * 32 + r) * LD + h * 8;
#pragma unroll
        for (int ks = 0; ks < 4; ++ks) { bf16x8 a_ = *(const bf16x8*)(ap + ks * 16); acc = MFMA32(a_, lorab[ks], acc); }
        store_N_f32(grp == 0 ? F0 : FZa, acc, qm, qn, lane);
    }
    __syncthreads();
    TT(2)
    float lw[8], av[8], kk[8], kt[8];
    float rk = 0.f;
    {
        float zw[8], za[8];
        *(f32x4*)zw = *(const f32x4*)(F0 + t * LF + c8 * 8); *(f32x4*)(zw + 4) = *(const f32x4*)(F0 + t * LF + c8 * 8 + 4);
        *(f32x4*)za = *(const f32x4*)(FZa + t * LF + c8 * 8); *(f32x4*)(za + 4) = *(const f32x4*)(FZa + t * LF + c8 * 8 + 4);
        float n2 = 0.f;
#pragma unroll
        for (int i = 0; i < 8; ++i) {
            const int ch = hc0 + i;
            lw[i] = valid ? -0.6065306597f * sigmoidf_(zw[i] + prm[ch]) : 0.f;
            av[i] = valid ? sigmoidf_(za[i] + prm[512 + ch]) : 0.f;
            kk[i] = kv[i] * prm[1024 + ch]; n2 += kk[i] * kk[i];
            kt[i] = kv[i] * (1.0f + (av[i] - 1.0f) * prm[1536 + ch]);
            rk += rv[i] * kt[i] * prm[2048 + ch];
        }
        n2 = sum8(n2); rk = sum8(rk);
        const float inv = 1.0f / fmaxf(sqrtf(n2), 1e-12f);
#pragma unroll
        for (int i = 0; i < 8; ++i) kk[i] *= inv;
        *(f32x4*)(F0 + t * LF + c8 * 8) = *(f32x4*)lw; *(f32x4*)(F0 + t * LF + c8 * 8 + 4) = *(f32x4*)(lw + 4);
    }
    __syncthreads();
    TT(3)
    {
        const int sch = tid & 63, seg = tid >> 6;
        float sacc = 0.f;
#pragma unroll
        for (int k = 0; k < 8; ++k) { const int tt = seg * 8 + k; sacc += F0[tt * LF + sch]; F0[tt * LF + sch] = sacc; }
        Seg[seg * 64 + sch] = sacc;
        __syncthreads();
        float pre = 0.f;
        for (int s2 = 0; s2 < seg; ++s2) pre += Seg[s2 * 64 + sch];
#pragma unroll
        for (int k = 0; k < 8; ++k) { const int tt = seg * 8 + k; F0[tt * LF + sch] += pre; }
        if (seg == 7) GC[sch] = sacc + pre;
    }
    __syncthreads();
    TT(4)
    {
        float g[8];
        *(f32x4*)g = *(const f32x4*)(F0 + t * LF + c8 * 8); *(f32x4*)(g + 4) = *(const f32x4*)(F0 + t * LF + c8 * 8 + 4);
        float at[8], bh[8], kh[8], rt[8], bt[8], ktt[8];
#pragma unroll
        for (int i = 0; i < 8; ++i) {
            const float gc = GC[c8 * 8 + i];
            const float em = __expf(-g[i]), ep = __expf(g[i]), epv = __expf(g[i] - lw[i]), ec = __expf(gc - g[i]);
            at[i] = -kk[i] * epv; bh[i] = kk[i] * av[i] * em; kh[i] = kt[i] * em; rt[i] = rv[i] * ep;
            bt[i] = kk[i] * av[i] * ec; ktt[i] = kt[i] * ec;
        }
        *(u32x4*)(sAt + t * LD + c8 * 8) = pack8(at);
        *(u32x4*)(sBh + t * LD + c8 * 8) = pack8(bh);
        *(u32x4*)(sKh + t * LD + c8 * 8) = pack8(kh);
        *(u32x4*)(sRt + t * LD + c8 * 8) = pack8(rt);
#pragma unroll
        for (int i = 0; i < 8; ++i) {
            const int tsw = (((t >> 3) ^ c8) << 3) | (t & 7);
            sAtT[(c8 * 8 + i) * LD + tsw] = f2bf(at[i]);
            sVT[(c8 * 8 + i) * LD + tsw] = f2bf(vv[i]);
            sBtT[(c8 * 8 + i) * LD + tsw] = f2bf(bt[i]);
            sKtT[(c8 * 8 + i) * LD + tsw] = f2bf(ktt[i]);
        }
    }
    __syncthreads();
    TT(5)
    f32x16 accQ = zero16();
    {
        f32x16 acc = zero16(), acc2 = zero16();
        acc = mm_lds<4>(sAt, grp == 0 ? sBh : sKh, qm, qn, lane, acc);
        acc2 = mm_lds<4>(sRt, grp == 0 ? sBh : sKh, qm, qn, lane, acc2);
#pragma unroll
        for (int reg = 0; reg < 16; ++reg) {
            const int tt = qm * 32 + (reg & 3) + 8 * (reg >> 2) + 4 * h, ss = qn * 32 + r;
            if (ss >= tt) acc[reg] = 0.f;
            if (ss > tt) acc2[reg] = 0.f;
        }
        if (grp == 0) accQ = mm_lds_s<4>(sKtT, sVT, qm, qn, lane, accQ, true, true);
        if (grp == 0) { store_N_f32(F0, acc, qm, qn, lane); store_N_bf16(sAabb, acc, qm, qn, lane); store_N_bf16(sArb, acc2, qm, qn, lane); }
        else { store_N_bf16(sAak, acc, qm, qn, lane); store_N_bf16(sArk, acc2, qm, qn, lane); }
    }
    __syncthreads();
    TT(6)
    if (wave == 0) {
        int lane2 = lane; asm volatile("" : "+v"(lane2));
        const int blk = lane2 >> 5, j = lane2 & 31;
        const float* Ab = F0 + (32 * blk) * LF + 32 * blk;
        float xs[32];
#pragma unroll
        for (int tt = 0; tt < 32; ++tt) {
            float sacc = (tt == j) ? 1.f : 0.f;
#pragma unroll
            for (int s2 = 0; s2 < tt; ++s2) sacc += Ab[tt * LF + s2] * xs[s2];
            xs[tt] = sacc;
        }
#pragma unroll
        for (int tt = 0; tt < 32; ++tt) sTm[(32 * blk + tt) * LD + 32 * blk + j] = f2bf(xs[tt]);
        if (blk == 0) {
#pragma unroll
            for (int q = 0; q < 4; ++q) *(u32x4*)(sD0T + j * LD + q * 8) = pack8(xs + q * 8);
        }
    } else if (wave == 1) {
        const int rr = lane >> 1, cc = 32 + (lane & 1) * 16;
        u32x4 z; z[0] = 0; z[1] = 0; z[2] = 0; z[3] = 0;
        *(u32x4*)(sTm + rr * LD + cc) = z; *(u32x4*)(sTm + rr * LD + cc + 8) = z;
    } else if (grp == 1) {
        f32x16 acc = zero16();
        acc = mm_lds_s<4>(sAak, sVT, qm, qn, lane, acc, false, true);
        store_T_bf16(sY2T, acc, qm, qn, lane);
    }
    __syncthreads();
    TT(7)
    if (wave == 0) {
        f32x16 acc = zero16();
        acc = mm_lds<2>(sAabb, sD0T, 1, 0, lane, acc);
        store_T_bf16(sM1T, acc, 0, 0, lane);
    }
    __syncthreads();
    TT(8)
    if (wave == 0) {
        f32x16 acc = zero16();
        const bf16_t* ap = sTm + (32 + r) * LD + 32 + h * 8;
        const bf16_t* bp = sM1T + r * LD + h * 8;
#pragma unroll
        for (int ks = 0; ks < 2; ++ks) { bf16x8 a = *(const bf16x8*)(ap + ks * 16), bb = *(const bf16x8*)(bp + ks * 16); acc = MFMA32(a, bb, acc); }
        store_N_bf16(sTm, acc, 1, 0, lane);
    }
    __syncthreads();
    TT(9)
    {
        u32x4 glc[2], glp[2];
        if (c > 0) {
            const bf16_t* pr = P + (size_t)row * DIN + 2688 + c8 * 16;
            const bf16_t* pp = P + (size_t)row_of(b, pos - 1) * DIN + 2688 + c8 * 16;
            glc[0] = *(const u32x4*)pr; glc[1] = *(const u32x4*)(pr + 8); glp[0] = *(const u32x4*)pp; glp[1] = *(const u32x4*)(pp + 8);
        }
        f32x16 acc = zero16();
        acc = mm_lds_s<4>(sTm, grp == 0 ? sAtT : sY2T, qm, qn, lane, acc, false, grp == 0);
        store_T_bf16(grp == 0 ? sW1T : sW2T, acc, qm, qn, lane);
        if (c > 0) {
            bf16_t* d = ((c8 < 4) ? sLg0 : sLg1) + t * LD + (c8 & 3) * 16;
#pragma unroll
            for (int hf = 0; hf < 2; ++hf) {
                float cur[8], prv[8], gg[8];
                unpack8(glc[hf], cur); unpack8(glp[hf], prv);
#pragma unroll
                for (int i = 0; i < 8; ++i) gg[i] = sigmoidf_(cur[i] + (prv[i] - cur[i]) * p.mu[1664 + c8 * 16 + hf * 8 + i]);
                *(u32x4*)(d + hf * 8) = pack8(gg);
            }
        }
    }
    __syncthreads();
    TT(10)
    if (grp == 0) {
        f32x16 acc = mm_lds_s<4>(sBtT, sW2T, qm, qn, lane, accQ, true, false);
        bf16_t* QC = (bf16_t*)(UD + 8192);
        const int v = qn * 32 + r;
#pragma unroll
        for (int g = 0; g < 4; ++g) {
            const int k = qm * 32 + 8 * g + 4 * h;
            u32x2 w; w[0] = pack2(acc[4 * g], acc[4 * g + 1]); w[1] = pack2(acc[4 * g + 2], acc[4 * g + 3]);
            *(u32x2*)(QC + (((v >> 4) * 2 + (k >> 5)) * 64 + ((k >> 2) & 3) * 16 + (v & 15)) * 8 + ((k >> 4) & 1) * 4) = w;
        }
        if (c > 0) {
            f32x16 ag = zero16();
            ag = mm_lds<4>(sArb, sW1T, qm, qn, lane, ag);
            bf16_t* Gg = (bf16_t*)(UD + 16384);
#pragma unroll
            for (int reg = 0; reg < 16; ++reg) {
                const int tt = qm * 32 + (reg & 3) + 8 * (reg >> 2) + 4 * h, k = qn * 32 + r;
                Gg[tt * 64 + (k >> 5) * 32 + ((k >> 2) & 3) * 8 + ((k >> 4) & 1) * 4 + (k & 3)] = f2bf(ag[reg] + bf2f(sRt[tt * LD + k]));
            }
            f32x16 accg = zero16();
            const bf16_t* G2T = (const bf16_t*)(ws + OFF_G2T) + (size_t)hh * 64 * 128;
            accg = mm_lds_g<4>(sLg0, G2T, 128, qm, qn, lane, accg);
            accg = mm_lds_g<4>(sLg1, G2T + 64, 128, qm, qn, lane, accg);
            store_N_f32(FZg, accg, qm, qn, lane);
        }
    } else {
        f32x16 acc = zero16();
        acc = mm_lds_s<4>(sBtT, sW1T, qm, qn, lane, acc, true, false);
        bf16_t* PA = (bf16_t*)UD;
        const int k2 = qn * 32 + r;
#pragma unroll
        for (int reg = 0; reg < 16; ++reg) {
            const int k1 = qm * 32 + (reg & 3) + 8 * (reg >> 2) + 4 * h;
            float vv2 = acc[reg];
            if (k1 == k2) vv2 += __expf(GC[k1]);
            PA[(((k1 >> 4) * 2 + (k2 >> 5)) * 64 + ((k2 >> 2) & 3) * 16 + (k1 & 15)) * 8 + ((k2 >> 4) & 1) * 4 + (k2 & 3)] = f2bf(vv2);
        }
        if (c > 0) {
            f32x16 ah = zero16();
            ah = mm_lds<4>(sArb, sW2T, qm, qn, lane, ah);
            ah = mm_lds_s<4>(sArk, sVT, qm, qn, lane, ah, false, true);
            bf16_t* HC = (bf16_t*)(UD + 24576) + ((qm * 2 + qn) * 64 + lane) * 16;
            float hf[16];
#pragma unroll
            for (int reg = 0; reg < 16; ++reg) hf[reg] = ah[reg];
            *(u32x4*)HC = pack8(hf); *(u32x4*)(HC + 8) = pack8(hf + 8);
        }
    }
    __syncthreads();
    TT(11)
    if (c > 0) {
        float zg[8], e1[8], e2[8];
        *(f32x4*)zg = *(const f32x4*)(FZg + t * LF + c8 * 8); *(f32x4*)(zg + 4) = *(const f32x4*)(FZg + t * LF + c8 * 8 + 4);
#pragma unroll
        for (int i = 0; i < 8; ++i) { const int ch = hc0 + i; e1[i] = zg[i] * prm[2560 + ch]; e2[i] = zg[i] * (prm[3072 + ch] + rk * vv[i]); }
        *(u32x4*)((bf16_t*)(ws + OFF_E1) + (size_t)row * 512 + hc0) = pack8(e1);
        *(u32x4*)((bf16_t*)(ws + OFF_E2) + (size_t)row * 512 + hc0) = pack8(e2);
    }
    __syncthreads();
    TT(12)
#undef SL
}

__device__ __forceinline__ void rwkv_out_pair(const Params& p, char* smem, int pair) {
    int tid_ = threadIdx.x; asm volatile("" : "+v"(tid_));
    const int tid = tid_, lane = tid & 63, wave = __builtin_amdgcn_readfirstlane(tid >> 6);
    char* ws = p.ws;
    const int su = wave >> 2, qm = (wave >> 1) & 1, qn = wave & 1, r = lane & 31, h = lane >> 5;
    float* Ob = (float*)smem;
    {
        const int uidx = pair * 2 + su;
        const char* UD = (const char*)p.out + (size_t)uidx * UNIT_BYTES;
        const bf16_t* Gg = (const bf16_t*)(UD + 16384) + (qm * 32 + r) * 64 + h * 8;
        const bf16_t* SB = (const bf16_t*)(ws + OFF_SB) + (size_t)uidx * 4096 + (qn * 32 + r) * 64 + h * 8;
        const bf16_t* HC = (const bf16_t*)(UD + 24576) + ((qm * 2 + qn) * 64 + lane) * 16;
        bf16x8 gf[4], sf[4];
#pragma unroll
        for (int ks = 0; ks < 4; ++ks) { gf[ks] = *(const bf16x8*)(Gg + ks * 16); sf[ks] = *(const bf16x8*)(SB + ks * 16); }
        float hf[16];
        unpack8(*(const u32x4*)HC, hf); unpack8(*(const u32x4*)(HC + 8), hf + 8);
        f32x16 acc;
#pragma unroll
        for (int i = 0; i < 16; ++i) acc[i] = hf[i];
#pragma unroll
        for (int ks = 0; ks < 4; ++ks) acc = MFMA32(gf[ks], sf[ks], acc);
        store_N_f32(Ob + su * 64 * LF, acc, qm, qn, lane);
    }
    __syncthreads();
    {
        const int su2 = tid >> 8, t = (tid >> 2) & 63, c16 = tid & 3;
        const int uidx = pair * 2 + su2;
        const int hh = uidx & 7, cm1 = (uidx >> 3) & 127, b = uidx >> 10;
        const int row = b * T_SEQ + 64 * cm1 + t;
        const float* orow = Ob + su2 * 64 * LF + t * LF + c16 * 16;
        float o[16];
#pragma unroll
        for (int q = 0; q < 4; ++q) *(f32x4*)(o + 4 * q) = *(const f32x4*)(orow + 4 * q);
        float sacc = 0.f;
#pragma unroll
        for (int i = 0; i < 16; ++i) sacc += o[i];
        sacc += __shfl_xor(sacc, 1); sacc += __shfl_xor(sacc, 2);
        const float mean = sacc * (1.0f / 64.0f);
        float q2 = 0.f;
#pragma unroll
        for (int i = 0; i < 16; ++i) { const float d = o[i] - mean; q2 += d * d; }
        q2 += __shfl_xor(q2, 1); q2 += __shfl_xor(q2, 2);
        const float rs = rsqrtf(q2 * (1.0f / 64.0f) + 64e-5f);
        const bf16_t* e1p = (const bf16_t*)(ws + OFF_E1) + (size_t)row * 512 + hh * 64 + c16 * 16;
        const bf16_t* e2p = (const bf16_t*)(ws + OFF_E2) + (size_t)row * 512 + hh * 64 + c16 * 16;
        bf16_t* yp = (bf16_t*)(ws + OFF_XN) + (size_t)row * DM + 512 + hh * 64 + c16 * 16;
#pragma unroll
        for (int hf2 = 0; hf2 < 2; ++hf2) {
            float e1[8], e2[8], yv[8];
            unpack8(*(const u32x4*)(e1p + hf2 * 8), e1); unpack8(*(const u32x4*)(e2p + hf2 * 8), e2);
#pragma unroll
            for (int i = 0; i < 8; ++i) yv[i] = (o[hf2 * 8 + i] - mean) * rs * e1[i] + e2[i];
            *(u32x4*)(yp + hf2 * 8) = pack8(yv);
        }
    }
    __syncthreads();
}

struct ChainOp { u32x4 pa[4][2]; u32x4 q[2]; };
template <int MODE>
__device__ __forceinline__ void chain_load(ChainOp& o, const Params& p, int b, int hh, int cg, int lane, int c_) {
    const int c = (MODE & 4) ? 9 : c_;
    const char* U = c == 0 ? (const char*)(p.ws + OFF_MPQ + (size_t)hh * 16384) : ((const char*)p.out + (size_t)((b * 128 + (c - 1)) * 8 + hh) * UNIT_BYTES);
#pragma unroll
    for (int m = 0; m < 4; ++m) {
        o.pa[m][0] = *(const u32x4*)(U + ((size_t)((m * 2 + 0) * 64 + lane)) * 16);
        o.pa[m][1] = *(const u32x4*)(U + ((size_t)((m * 2 + 1) * 64 + lane)) * 16);
    }
    o.q[0] = *(const u32x4*)(U + 8192 + ((size_t)((cg * 2 + 0) * 64 + lane)) * 16);
    o.q[1] = *(const u32x4*)(U + 8192 + ((size_t)((cg * 2 + 1) * 64 + lane)) * 16);
}
template <int MODE>
__device__ __forceinline__ void chain_step(const ChainOp& o, f32x4 (&st)[4], bf16_t* SBb, int cg, int lane, int c) {
    const int q = lane >> 4, vl = lane & 15;
    u32x4 b0, b1;
    b0[0] = pack2(st[0][0], st[0][1]); b0[1] = pack2(st[0][2], st[0][3]); b0[2] = pack2(st[1][0], st[1][1]); b0[3] = pack2(st[1][2], st[1][3]);
    b1[0] = pack2(st[2][0], st[2][1]); b1[1] = pack2(st[2][2], st[2][3]); b1[2] = pack2(st[3][0], st[3][1]); b1[3] = pack2(st[3][2], st[3][3]);
    if (!(MODE & 2)) {
        bf16_t* S = SBb + (size_t)(max(c - 1, 0) * 8) * 4096 + (cg * 16 + vl) * 64 + 8 * q;
        *(u32x4*)S = b0; *(u32x4*)(S + 32) = b1;
    }
    const bf16x8 B0 = __builtin_bit_cast(bf16x8, b0), B1 = __builtin_bit_cast(bf16x8, b1);
    f32x4 acc[4];
#pragma unroll
    for (int m = 0; m < 4; ++m) {
        const unsigned q0 = o.q[m >> 1][(m & 1) * 2], q1 = o.q[m >> 1][(m & 1) * 2 + 1];
        f32x4 qi = {bflo(q0), bfhi(q0), bflo(q1), bfhi(q1)};
        acc[m] = MFMA16(__builtin_bit_cast(bf16x8, o.pa[m][0]), B0, qi);
    }
#pragma unroll
    for (int m = 0; m < 4; ++m) acc[m] = MFMA16(__builtin_bit_cast(bf16x8, o.pa[m][1]), B1, acc[m]);
#pragma unroll
    for (int m = 0; m < 4; ++m) st[m] = acc[m];
}
template <int MODE>
__device__ __forceinline__ void rwkv_chain_wg(const Params& p, char* smem, int chain) {
    const int tid = threadIdx.x, lane = tid & 63, wave = __builtin_amdgcn_readfirstlane(tid >> 6);
    const int b = chain >> 3, hh = chain & 7;
    int* prog = (int*)smem;
#define LDS_LD(ptr) __hip_atomic_load((ptr), __ATOMIC_RELAXED, __HIP_MEMORY_SCOPE_WORKGROUP)
#define LDS_ST(ptr, v) __hip_atomic_store((ptr), (v), __ATOMIC_RELAXED, __HIP_MEMORY_SCOPE_WORKGROUP)
    if (tid == 0) *prog = -1;
    __syncthreads();
    if (wave < 4) {
        const int cg = wave;
        bf16_t* SBb = (bf16_t*)(p.ws + ((MODE & 1) ? OFF_XN : OFF_SB)) + (size_t)(b * 128 * 8 + hh) * 4096;
        f32x4 st[4];
#pragma unroll
        for (int m = 0; m < 4; ++m) st[m] = (f32x4){0.f, 0.f, 0.f, 0.f};
        ChainOp oA, oB, oC, oD;
        chain_load<MODE>(oA, p, b, hh, cg, lane, 0); chain_load<MODE>(oB, p, b, hh, cg, lane, 1);
        chain_load<MODE>(oC, p, b, hh, cg, lane, 2); chain_load<MODE>(oD, p, b, hh, cg, lane, 3);
#pragma unroll 1
        for (int c = 0; c < 128; c += 4) {
            chain_step<MODE>(oA, st, SBb, cg, lane, c);     chain_load<MODE>(oA, p, b, hh, cg, lane, c + 4);
            chain_step<MODE>(oB, st, SBb, cg, lane, c + 1); chain_load<MODE>(oB, p, b, hh, cg, lane, min(c + 5, NCHUNK - 1));
            chain_step<MODE>(oC, st, SBb, cg, lane, c + 2); chain_load<MODE>(oC, p, b, hh, cg, lane, min(c + 6, NCHUNK - 1));
            chain_step<MODE>(oD, st, SBb, cg, lane, c + 3); chain_load<MODE>(oD, p, b, hh, cg, lane, min(c + 7, NCHUNK - 1));
            if (wave == 0 && lane == 0) LDS_ST(prog, c + 3);
        }
        chain_step<MODE>(oA, st, SBb, cg, lane, 128);
        if (MODE & 2) { asm volatile("" :: "v"(st[0][0]), "v"(st[1][0]), "v"(st[2][0]), "v"(st[3][0])); }
    } else if (!(MODE & 8)) {
        const int w = wave - 4;
#pragma unroll 1
        for (int c0 = 4; c0 < NCHUNK; c0 += 8) {
            int spins = 0;
            while (c0 > LDS_LD(prog) + 40 && spins < (1 << 20)) { __builtin_amdgcn_s_sleep(2); ++spins; }
            unsigned acc = 0;
            u32x4 v[32];
#pragma unroll
            for (int k = 0; k < 8; ++k) {
                const int cp = min(c0 + k, NCHUNK - 1);
                const char* U = (const char*)p.out + (size_t)((b * 128 + (cp - 1)) * 8 + hh) * UNIT_BYTES + w * 4096;
#pragma unroll
                for (int i = 0; i < 4; ++i) v[k * 4 + i] = *(const u32x4*)(U + i * 1024 + lane * 16);
            }
#pragma unroll
            for (int k = 0; k < 32; ++k) acc ^= v[k][0];
            asm volatile("" :: "v"(acc));
        }
    }
}
__device__ __forceinline__ void lru_chain(const Params& p, int idx) {
    const int b = idx >> 9, ch = idx & 511;
    const float* __restrict__ sumA = (const float*)(p.ws + OFF_SUMA); const float* __restrict__ sumH = (const float*)(p.ws + OFF_SUMH);
    float* __restrict__ HS = (float*)(p.ws + OFF_HS);
    float hcur = sumH[ch];
    HS[(size_t)(0 * 2 + b) * 512 + ch] = 0.f;
#pragma unroll 1
    for (int c0 = 1; c0 < NCHUNK; c0 += 32) {
        float av[32], hv[32];
#pragma unroll
        for (int k = 0; k < 32; ++k) { av[k] = sumA[((size_t)(c0 + k) * 2 + b) * 512 + ch]; hv[k] = sumH[((size_t)(c0 + k) * 2 + b) * 512 + ch]; }
        asm volatile("" : "+v"(hcur) :: "memory");
#pragma unroll
        for (int k = 0; k < 32; ++k) { HS[((size_t)(c0 + k) * 2 + b) * 512 + ch] = hcur; hcur = av[k] * hcur + hv[k]; }
        asm volatile("" ::: "memory");
    }
}

#define KLD 136
__device__ __forceinline__ unsigned f2ord(float f) { const unsigned u = __float_as_uint(f); return (u & 0x80000000u) ? ~u : (u | 0x80000000u); }
__device__ __forceinline__ float ord2f(unsigned o) { const unsigned u = (o & 0x80000000u) ? (o & 0x7FFFFFFFu) : ~o; return __uint_as_float(u); }
#define CE(a, b) { const unsigned hi_ = max((a), (b)); (b) = min((a), (b)); (a) = hi_; }
__device__ __forceinline__ void ins16(unsigned (&L)[16], unsigned x) {
#pragma unroll
    for (int s = 0; s < 16; ++s) { const unsigned hi_ = max(L[s], x); x = min(L[s], x); L[s] = hi_; }
}
__device__ __forceinline__ void merge_pair16(unsigned (&L)[16]) {
    unsigned Pp[16];
#pragma unroll
    for (int s = 0; s < 16; ++s) Pp[s] = __shfl_xor(L[s], 32);
#pragma unroll
    for (int s = 0; s < 16; ++s) L[s] = max(L[s], Pp[15 - s]);
#pragma unroll
    for (int d = 8; d > 0; d >>= 1)
#pragma unroll
        for (int i = 0; i < 16; ++i) if ((i & d) == 0) CE(L[i], L[i + d]);
}

__device__ __forceinline__ void sort16_desc(unsigned (&T)[16]) {
#pragma unroll
    for (int k = 2; k <= 16; k <<= 1)
#pragma unroll
        for (int j = k >> 1; j > 0; j >>= 1)
#pragma unroll
            for (int i = 0; i < 16; ++i) {
                const int l = i ^ j;
                if (l > i) {
                    const unsigned hi_ = max(T[i], T[l]), lo_ = min(T[i], T[l]);
                    if ((i & k) == 0) { T[i] = hi_; T[l] = lo_; } else { T[i] = lo_; T[l] = hi_; }
                }
            }
}
__device__ __forceinline__ void merge16_desc(unsigned (&L)[16], const unsigned (&T)[16]) {
#pragma unroll
    for (int s = 0; s < 16; ++s) L[s] = max(L[s], T[15 - s]);
#pragma unroll
    for (int d = 8; d > 0; d >>= 1)
#pragma unroll
        for (int i = 0; i < 16; ++i) if ((i & d) == 0) CE(L[i], L[i + d]);
}
__device__ __forceinline__ void peer_topk_unit(const Params& p, char* smem, int tile, int head) {
    int tid_ = threadIdx.x; asm volatile("" : "+v"(tid_));
    const int tid = tid_, lane = tid & 63, wave = __builtin_amdgcn_readfirstlane(tid >> 6), r = lane & 31, h = lane >> 5;
    char* ws = p.ws;
    const bf16_t* KEYS = (const bf16_t*)(ws + OFF_KEYS) + (size_t)head * 2 * 128 * 128;
    const bf16_t* QN = (const bf16_t*)p.out;
    bf16_t* kl = (bf16_t*)smem;
    __syncthreads();
#pragma unroll
    for (int i = 0; i < 8; ++i) { const int q = tid + 512 * i, rowk = q >> 4, c16 = q & 15; *(u32x4*)(kl + rowk * KLD + c16 * 8) = *(const u32x4*)(KEYS + (size_t)rowk * 128 + c16 * 8); }
    __syncthreads();
    const int tok = tile * 256 + wave * 32 + r;
    const bf16_t* qrow = QN + (size_t)tok * 2048 + head * 256;
    float ssq = 0.f;
    unsigned L1[16], L2[16];
#pragma unroll
    for (int sub = 0; sub < 2; ++sub) {
        bf16x8 qf[8];
#pragma unroll
        for (int ks = 0; ks < 8; ++ks) {
            u32x4 qq = *(const u32x4*)(qrow + sub * 128 + ks * 16 + h * 8);
            float f[8]; unpack8(qq, f);
#pragma unroll
            for (int i = 0; i < 8; ++i) ssq += f[i] * f[i];
            qf[ks] = __builtin_bit_cast(bf16x8, qq);
        }
        unsigned (&L)[16] = sub == 0 ? L1 : L2;
#pragma unroll
        for (int s = 0; s < 16; ++s) L[s] = 0u;
#pragma unroll
        for (int mt = 0; mt < 4; ++mt) {
            f32x16 acc = zero16();
            const bf16_t* ap = kl + (sub * 128 + mt * 32 + r) * KLD + h * 8;
#pragma unroll
            for (int ks = 0; ks < 8; ++ks) { bf16x8 a = *(const bf16x8*)(ap + ks * 16); acc = MFMA32(a, qf[ks], acc); }
            unsigned T[16];
#pragma unroll
            for (int reg = 0; reg < 16; ++reg) {
                const int key = mt * 32 + (reg & 3) + 8 * (reg >> 2) + 4 * h;
                T[reg] = (f2ord(acc[reg]) & ~127u) | (unsigned)(127 - key);
            }
            sort16_desc(T);
            if (mt == 0) {
#pragma unroll
                for (int s2 = 0; s2 < 16; ++s2) L[s2] = T[s2];
            } else merge16_desc(L, T);
        }
        merge_pair16(L);
    }
    ssq += __shfl_xor(ssq, 32);
    const float rstd2 = rsqrtf(((const float*)(ws + OFF_SSQ))[tok] * (1.0f / DM) + 1e-6f);
    const float scale = rstd2 * rsqrtf(rstd2 * rstd2 * ssq * (1.0f / 256.0f) + 1e-6f);
    float v1[16], v2[16];
#pragma unroll
    for (int s = 0; s < 16; ++s) { v1[s] = ord2f(L1[s] & ~127u); v2[s] = ord2f(L2[s] & ~127u); }
    unsigned F[16];
#pragma unroll
    for (int s = 0; s < 16; ++s) F[s] = 0u;
    {
        int cnt = 0;
        unsigned pend = 0u;
#pragma unroll
        for (int i = 0; i < 16; ++i)
#pragma unroll
            for (int j = 0; j < 16; ++j) {
                if ((i + 1) * (j + 1) > 16) continue;
                const unsigned e = ((127u - (L1[i] & 127u)) << 7) | (127u - (L2[j] & 127u));
                const unsigned x = (f2ord(v1[i] + v2[j]) & ~16383u) | e;
                if ((cnt & 1) == 0) pend = x;
                else { const unsigned mine = h ? x : pend; ins16(F, mine); }
                ++cnt;
            }
    }
    merge_pair16(F);
    float sc[16], mx, sum = 0.f;
#pragma unroll
    for (int s = 0; s < 16; ++s) sc[s] = ord2f(F[s] & ~16383u) * scale;
    mx = sc[0];
#pragma unroll
    for (int s = 0; s < 16; ++s) { sc[s] = __expf(sc[s] - mx); sum += sc[s]; }
    const float inv = 1.0f / sum;
    unsigned short* EI = (unsigned short*)(ws + OFF_EIDX) + ((size_t)tok * 8 + head) * 16;
    float* GT = (float*)(ws + OFF_GATE) + ((size_t)tok * 8 + head) * 16;
    if (h == 0) {
        u32x4 w0, w1;
#pragma unroll
        for (int s = 0; s < 4; ++s) { w0[s] = (F[2 * s] & 16383u) | ((F[2 * s + 1] & 16383u) << 16); w1[s] = (F[8 + 2 * s] & 16383u) | ((F[8 + 2 * s + 1] & 16383u) << 16); }
        *(u32x4*)EI = w0; *(u32x4*)(EI + 8) = w1;
        *(f32x4*)GT = (f32x4){sc[0] * inv, sc[1] * inv, sc[2] * inv, sc[3] * inv};
        *(f32x4*)(GT + 4) = (f32x4){sc[4] * inv, sc[5] * inv, sc[6] * inv, sc[7] * inv};
    } else {
        *(f32x4*)(GT + 8) = (f32x4){sc[8] * inv, sc[9] * inv, sc[10] * inv, sc[11] * inv};
        *(f32x4*)(GT + 12) = (f32x4){sc[12] * inv, sc[13] * inv, sc[14] * inv, sc[15] * inv};
    }
}

__device__ __forceinline__ void peer_token(const Params& p, float* coefl, int tok, int lane, bool with_peer) {
    char* ws = p.ws;
    const bf16_t* H1 = (const bf16_t*)(ws + OFF_H1B) + (size_t)tok * DM;
    u32x4 hx0 = *(const u32x4*)(H1 + lane * 16), hx1 = *(const u32x4*)(H1 + lane * 16 + 8);
    float y[16];
#pragma unroll
    for (int i = 0; i < 16; ++i) y[i] = 0.f;
    if (with_peer) {
        const float rstd2 = rsqrtf(((const float*)(ws + OFF_SSQ))[tok] * (1.0f / DM) + 1e-6f);
        const unsigned short* EI = (const unsigned short*)(ws + OFF_EIDX) + (size_t)tok * 128;
        const float* GT = (const float*)(ws + OFF_GATE) + (size_t)tok * 128;
        const int e0 = EI[lane], e1 = EI[lane + 64];
        const float g0 = GT[lane], g1 = GT[lane + 64];
        const unsigned char* UB = (const unsigned char*)(ws + OFF_UB); const unsigned char* VB = (const unsigned char*)(ws + OFF_VB);
        const float su0 = ((const float*)(ws + OFF_SU))[e0], su1 = ((const float*)(ws + OFF_SU))[e1];
        const float sv0 = ((const float*)(ws + OFF_SV))[e0], sv1 = ((const float*)(ws + OFF_SV))[e1];
        float xf[16];
        unpack8(hx0, xf); unpack8(hx1, xf + 8);
        f32x2 xf2[8];
#pragma unroll
        for (int i = 0; i < 8; ++i) { xf2[i][0] = xf[2 * i]; xf2[i][1] = xf[2 * i + 1]; }
        float hid0 = 0.f, hid1 = 0.f;
#pragma unroll 1
        for (int half = 0; half < 2; ++half) {
            const int ev = half ? e1 : e0;
#pragma unroll 1
            for (int bb = 0; bb < 4; ++bb) {
                u32x2 ua[16];
#pragma unroll
                for (int k = 0; k < 16; ++k) {
                    const int e = __builtin_amdgcn_readlane(ev, bb * 16 + k);
                    ua[k] = *(const u32x2*)(UB + (size_t)e * (DM / 2) + lane * 8);
                }
                float part[16];
#pragma unroll
                for (int k = 0; k < 16; ++k) {
                    f32x2 s2 = {0.f, 0.f};
#pragma unroll
                    for (int i = 0; i < 2; ++i) {
                        const unsigned w = ua[k][i];
                        s2 = __builtin_elementwise_fma(__builtin_amdgcn_cvt_scalef32_pk_f32_fp4(w, 1.0f, 0), xf2[4 * i], s2);
                        s2 = __builtin_elementwise_fma(__builtin_amdgcn_cvt_scalef32_pk_f32_fp4(w, 1.0f, 1), xf2[4 * i + 1], s2);
                        s2 = __builtin_elementwise_fma(__builtin_amdgcn_cvt_scalef32_pk_f32_fp4(w, 1.0f, 2), xf2[4 * i + 2], s2);
                        s2 = __builtin_elementwise_fma(__builtin_amdgcn_cvt_scalef32_pk_f32_fp4(w, 1.0f, 3), xf2[4 * i + 3], s2);
                    }
                    part[k] = s2[0] + s2[1];
                }
#pragma unroll
                for (int k = 0; k < 8; ++k) { const float send = (lane & 32) ? part[k] : part[k + 8]; const float keep = (lane & 32) ? part[k + 8] : part[k]; part[k] = keep + __shfl_xor(send, 32); }
#pragma unroll
                for (int k = 0; k < 4; ++k) { const float send = (lane & 16) ? part[k] : part[k + 4]; const float keep = (lane & 16) ? part[k + 4] : part[k]; part[k] = keep + __shfl_xor(send, 16); }
#pragma unroll
                for (int k = 0; k < 2; ++k) { const float send = (lane & 8) ? part[k] : part[k + 2]; const float keep = (lane & 8) ? part[k + 2] : part[k]; part[k] = keep + __shfl_xor(send, 8); }
                { const float send = (lane & 4) ? part[0] : part[1]; const float keep = (lane & 4) ? part[1] : part[0]; part[0] = keep + __shfl_xor(send, 4); }
                part[0] += __shfl_xor(part[0], 1); part[0] += __shfl_xor(part[0], 2);
                const int vi = ((lane >> 5) & 1) * 8 + ((lane >> 4) & 1) * 4 + ((lane >> 3) & 1) * 2 + ((lane >> 2) & 1);
                if ((lane & 3) == 0) coefl[half * 64 + bb * 16 + vi] = part[0];
            }
        }
        __builtin_amdgcn_s_waitcnt(0xc07f);
        __builtin_amdgcn_wave_barrier();
        hid0 = coefl[lane]; hid1 = coefl[lane + 64];
        __builtin_amdgcn_wave_barrier();
        coefl[lane] = g0 * gelu_erf(hid0 * rstd2 * su0) * sv0;
        coefl[lane + 64] = g1 * gelu_erf(hid1 * rstd2 * su1) * sv1;
        __builtin_amdgcn_s_waitcnt(0xc07f);
        __builtin_amdgcn_wave_barrier();
#pragma unroll 1
        for (int half = 0; half < 2; ++half) {
            const int ev = half ? e1 : e0;
#pragma unroll 1
            for (int bb = 0; bb < 4; ++bb) {
                u32x2 va[16];
#pragma unroll
                for (int k = 0; k < 16; ++k) {
                    const int e = __builtin_amdgcn_readlane(ev, bb * 16 + k);
                    va[k] = *(const u32x2*)(VB + (size_t)e * (DM / 2) + lane * 8);
                }
#pragma unroll
                for (int k = 0; k < 16; ++k) {
                    const float cf = coefl[half * 64 + bb * 16 + k];
#pragma unroll
                    for (int i = 0; i < 2; ++i) {
                        const unsigned w = va[k][i];
                        const f32x2 a0 = __builtin_amdgcn_cvt_scalef32_pk_f32_fp4(w, 1.0f, 0), a1 = __builtin_amdgcn_cvt_scalef32_pk_f32_fp4(w, 1.0f, 1);
                        const f32x2 a2 = __builtin_amdgcn_cvt_scalef32_pk_f32_fp4(w, 1.0f, 2), a3 = __builtin_amdgcn_cvt_scalef32_pk_f32_fp4(w, 1.0f, 3);
                        y[8 * i] += cf * a0[0]; y[8 * i + 1] += cf * a0[1]; y[8 * i + 2] += cf * a1[0]; y[8 * i + 3] += cf * a1[1];
                        y[8 * i + 4] += cf * a2[0]; y[8 * i + 5] += cf * a2[1]; y[8 * i + 6] += cf * a3[0]; y[8 * i + 7] += cf * a3[1];
                    }
                }
            }
        }
    }
    float hv[16];
    unpack8(hx0, hv); unpack8(hx1, hv + 8);
    float ss = 0.f;
#pragma unroll
    for (int i = 0; i < 16; ++i) { hv[i] += y[i]; ss += hv[i] * hv[i]; }
    ss = wave_sum(ss);
    const float rs = rsqrtf(ss * (1.0f / DM) + 1e-6f);
    float* orow = p.out + (size_t)tok * DM + lane * 16;
#pragma unroll
    for (int q4 = 0; q4 < 4; ++q4) {
        f32x4 g = *(const f32x4*)(p.fg + lane * 16 + q4 * 4);
        f32x4 o = {hv[q4 * 4] * rs * g[0], hv[q4 * 4 + 1] * rs * g[1], hv[q4 * 4 + 2] * rs * g[2], hv[q4 * 4 + 3] * rs * g[3]};
        *(f32x4*)(orow + q4 * 4) = o;
    }
}


#define XB_TMO      128
#define XB_XCNT(j)  (256  + 64 * (j))
#define XB_XSUB(j)  (1280 + 64 * (j))
#define XB_XGEN(j)  (2304 + 64 * (j))
#define XB_TOP      3328
#define XB_TOPGEN   3392
#define XCD_BAR_WORDS 3456
#define XB_SPIN_CAP (1u << 21)
#define LAS __attribute__((address_space(3)))
__device__ __forceinline__ unsigned xb_ld(unsigned* p)              { return __hip_atomic_load(p, __ATOMIC_RELAXED, __HIP_MEMORY_SCOPE_AGENT); }
__device__ __forceinline__ unsigned xb_add(unsigned* p, unsigned v) { return __hip_atomic_fetch_add(p, v, __ATOMIC_RELAXED, __HIP_MEMORY_SCOPE_AGENT); }
__device__ __forceinline__ unsigned xb_xcc_id() { return (unsigned)__builtin_amdgcn_s_getreg((3 << 11) | 20) & 0xFu; }
#define XB_SPIN(cond, bar) do { unsigned _sp = 0; while (cond) { __builtin_amdgcn_s_sleep(1); \
    if ((++_sp & 255u) == 0u) { if (xb_ld(&(bar)[XB_TMO])) break; if (_sp > XB_SPIN_CAP) { atomicAdd(&(bar)[XB_TMO], 1u); break; } } } } while (0)
struct XcdBarrier { unsigned* bar; unsigned x; volatile LAS unsigned* st; };
__device__ __forceinline__ XcdBarrier xcd_barrier_post(unsigned* bar, volatile LAS unsigned* st) {
    XcdBarrier b; b.bar = bar; b.x = xb_xcc_id(); b.st = st;
    if (threadIdx.x == 0) (void)xb_add(&bar[XB_XCNT(b.x)], 1u);
    return b;
}
__device__ __forceinline__ void xcd_barrier_complete(unsigned* bar, unsigned x, unsigned& nloc, unsigned& nx) {
    const unsigned G = gridDim.x * gridDim.y * gridDim.z;
    unsigned sum, cnt, mine, sp = 0u;
    for (;;) {
        sum = 0u; cnt = 0u; mine = 0u;
#pragma unroll
        for (unsigned j = 0; j < 16; ++j) { const unsigned c = xb_ld(&bar[XB_XCNT(j)]); sum += c; cnt += (c > 0u) ? 1u : 0u; mine = (j == x) ? c : mine; }
        if (sum == G) break;
        __builtin_amdgcn_s_sleep(1);
        if ((++sp & 255u) == 0u) { if (xb_ld(&bar[XB_TMO])) break; if (sp > XB_SPIN_CAP) { atomicAdd(&bar[XB_TMO], 1u); break; } }
    }
    nloc = mine > 0u ? mine : 1u; nx = cnt > 0u ? cnt : 1u;
}
__device__ __forceinline__ void xcd_barrier(const XcdBarrier& b) {
    asm volatile("s_waitcnt vmcnt(0)" ::: "memory");
    __syncthreads();
    if (threadIdx.x == 0) {
        unsigned* bar = b.bar;
        __builtin_amdgcn_s_waitcnt(0);
        unsigned nloc = b.st[0], nx = b.st[1];
        if (nloc == 0u) { xcd_barrier_complete(bar, b.x, nloc, nx); b.st[0] = nloc; b.st[1] = nx; }
        const unsigned old = xb_add(&bar[XB_XSUB(b.x)], 1u);
        const unsigned gen = old / nloc;
        if (old + 1u == (gen + 1u) * nloc) {
            __builtin_amdgcn_fence(__ATOMIC_RELEASE, "agent");
            asm volatile("s_waitcnt vmcnt(0)" ::: "memory");
            const unsigned og = xb_add(&bar[XB_TOP], 1u);
            const unsigned tg = og / nx;
            if (og + 1u == (tg + 1u) * nx) xb_add(&bar[XB_TOPGEN], 1u);
            else XB_SPIN(xb_ld(&bar[XB_TOPGEN]) == tg, bar);
            __builtin_amdgcn_fence(__ATOMIC_ACQUIRE, "agent");
            xb_add(&bar[XB_XGEN(b.x)], 1u);
            asm volatile("s_waitcnt vmcnt(0)" ::: "memory");
        } else {
            XB_SPIN(xb_ld(&bar[XB_XGEN(b.x)]) == gen, bar);
            __builtin_amdgcn_fence(__ATOMIC_ACQUIRE, "agent");
            asm volatile("s_waitcnt vmcnt(0)" ::: "memory");
        }
    }
    __syncthreads();
}

__device__ __forceinline__ void run_phase(const Params& p, char* smem, const int phase) {
    int tidl_ = threadIdx.x; asm volatile("" : "+v"(tidl_));
    const int tid = tidl_, lane = tid & 63, wave = __builtin_amdgcn_readfirstlane(tid >> 6), G = gridDim.x;
    char* ws = p.ws;
    switch (phase) {
    case 0: phase_prep(p, smem); break;
    case 1: { pg8::EpiBf16 e{(bf16_t*)(ws + OFF_P), DIN}; pg8::Gemm g{(const bf16_t*)(ws + OFF_XN), (const bf16_t*)(ws + OFF_WINT), MROWS, DIN, DM}; pg8::StaticOrder so; so.init(MROWS, DIN, G, blockIdx.x);
              pg8::gemm_phase<pg8::EpiBf16, pg8::StaticOrder, true, true>((PG8_LAS unsigned char*)smem, g, so, e); } break;
    case 2: {
        unsigned long long tacc2 = 0;
        {
            float* prm = (float*)(smem + PRM_RWKV);
            prm[tid] = p.w0[tid]; prm[512 + tid] = p.a0[tid]; prm[1024 + tid] = p.k_k[tid]; prm[1536 + tid] = p.k_a[tid];
            prm[2048 + tid] = p.r_k[tid]; prm[2560 + tid] = p.gn_w[tid]; prm[3072 + tid] = p.gn_b[tid];
            __syncthreads();
        }
        S0Pre pre;
        if ((int)blockIdx.x < NUNITS) { const int u = blockIdx.x, v = u < 8 ? 0 : u - 8; s0_fetch(p, u < 8 ? 0 : 1 + ((v >> 3) & 127), v >> 10, u < 8 ? u : (v & 7), tid, pre); }
        for (int u = blockIdx.x; u < NUNITS; u += G) {
            const int v = u < 8 ? 0 : u - 8, un = u + G, vn = un - 8;
            rwkv_unit(p, smem, u < 8 ? 0 : 1 + ((v >> 3) & 127), v >> 10, u < 8 ? u : (v & 7), tacc2, pre, un < NUNITS, 1 + ((vn >> 3) & 127), vn >> 10, vn & 7);
        }
#if TSSTAGE >= 0
        if (blockIdx.x == 0 && tid == 0) __hip_atomic_store((unsigned long long*)(ws + OFF_BAR + 14336), tacc2, __ATOMIC_RELAXED, __HIP_MEMORY_SCOPE_AGENT);
#endif
    } break;
    case 3: {
        if (blockIdx.x < 16) { rwkv_chain_wg<8>(p, smem, blockIdx.x); __syncthreads(); }
        else {
            float* lp = (float*)(smem + PRM_LRU);
            lp[tid] = p.ga_b[tid]; lp[512 + tid] = p.gx_b[tid]; lp[1024 + tid] = ((const float*)(ws + OFF_SP))[tid]; lp[1536 + tid] = p.conv_b[tid];
            lp[2048 + tid] = p.conv_w[tid]; lp[2560 + tid] = p.conv_w[512 + tid]; lp[3072 + tid] = p.conv_w[1024 + tid]; lp[3584 + tid] = p.conv_w[1536 + tid];
            __syncthreads();
            for (int v = blockIdx.x - 16; v < 257; v += G - 16) { const int w = v == 0 ? 0 : v - 1; lru_unit(p, smem, v == 0 ? 0 : 1 + (w & 127), w >> 7); }
            if (blockIdx.x >= 33) convert_tables(p, 33);
        }
    } break;
    case 4: {
        for (int u = blockIdx.x; u < 1024 + 256; u += G) {
            if (u < 1024) rwkv_out_pair(p, smem, u);
            else { const int v = u - 1024; lru_out(p, smem, 1 + (v & 127), v >> 7); }
        }
    } break;
    case 5: { pg8::EpiRes e{(bf16_t*)(ws + OFF_H1B), p.x, (float*)(ws + OFF_SSQ)}; pg8::Gemm g{(const bf16_t*)(ws + OFF_XN), (const bf16_t*)(ws + OFF_WOUTT), NTOK, DM, DM}; pg8::StaticOrder so; so.init(NTOK, DM, G, blockIdx.x);
              pg8::gemm_phase<pg8::EpiRes, pg8::StaticOrder, false, true>((PG8_LAS unsigned char*)smem, g, so, e); } break;
    case 6: { pg8::EpiBf16 e{(bf16_t*)p.out, 2048}; pg8::Gemm g{(const bf16_t*)(ws + OFF_H1B), (const bf16_t*)(ws + OFF_WQT), NTOK, 2048, DM}; pg8::StaticOrder so; so.init(NTOK, 2048, G, blockIdx.x);
              pg8::gemm_phase<pg8::EpiBf16, pg8::StaticOrder, true, true>((PG8_LAS unsigned char*)smem, g, so, e); } break;
    case 7: { for (int u = blockIdx.x; u < 64 * 8; u += G) peer_topk_unit(p, smem, u >> 3, u & 7); } break;
    case 8: { float* coefl = (float*)smem + wave * 128; for (int tok = blockIdx.x * 8 + wave; tok < NTOK; tok += G * 8) peer_token(p, coefl, tok, lane, DO_PEER != 0); } break;
    }
}

template <int PH>
__global__ void __launch_bounds__(NTHR) k_phase(Params p) {
    extern __shared__ __attribute__((aligned(16))) char smem[];
    run_phase(p, smem, PH);
}
template <int PH>
static void launch_phase(const Params& p, hipStream_t stream) {
    static bool attr_set = false;
    if (!attr_set) { (void)hipFuncSetAttribute((const void*)k_phase<PH>, hipFuncAttributeMaxDynamicSharedMemorySize, SMEM_BYTES); attr_set = true; }
    k_phase<PH><<<256, NTHR, SMEM_BYTES, stream>>>(p);
}


__global__ void __launch_bounds__(NTHR) k_mega(Params p) {
    extern __shared__ __attribute__((aligned(16))) char smem[];
    volatile LAS unsigned* st = (volatile LAS unsigned*)(smem + SMEM_BYTES - 16);
    if (threadIdx.x == 0) { st[0] = 0u; st[1] = 0u; st[2] = 0u; st[3] = 0u; }
    __syncthreads();
    XcdBarrier bar = xcd_barrier_post((unsigned*)(p.ws + OFF_BAR), st);
#ifndef TSPH
#define TSPH -1
#endif
    unsigned long long ts[10];
#define RUNP(ph, n) if ((n) == 1) { if (ph > 0) xcd_barrier(bar); if (TSPH >= 0) ts[ph] = __builtin_amdgcn_s_memrealtime(); run_phase(p, smem, ph); } else { _Pragma("unroll 1") for (int it = 0; it < (n); ++it) { xcd_barrier(bar); run_phase(p, smem, ph); } }
    RUNP(0, REP0) RUNP(1, REP1) RUNP(2, REP2) RUNP(3, REP3) RUNP(4, REP4) RUNP(5, 1) RUNP(6, REP6) RUNP(7, REP7) RUNP(8, REP8)
    if (TSPH >= 0) {
        xcd_barrier(bar);
        ts[9] = __builtin_amdgcn_s_memrealtime();
        if (blockIdx.x == 0) {
#if TSROLE >= 0 || TSSTAGE >= 0
            const unsigned long long d = __hip_atomic_load((unsigned long long*)(p.ws + OFF_BAR + 14336), __ATOMIC_RELAXED, __HIP_MEMORY_SCOPE_AGENT) * 4ull, t0 = __builtin_amdgcn_s_memrealtime();
#else
            const unsigned long long d = (ts[TSPH + 1] - ts[TSPH]) * 4ull, t0 = __builtin_amdgcn_s_memrealtime();
#endif
            while (__builtin_amdgcn_s_memrealtime() - t0 < d) __builtin_amdgcn_s_sleep(8);
        }
    }
}

extern "C" void kernel_launch(void* const* d_in, const int* in_sizes, int n_in, void* d_out, int out_size, void* d_ws, size_t ws_size, hipStream_t stream) {
    Params p{};
    const float** pp = (const float**)&p;
    for (int i = 0; i < 31; ++i) pp[i] = (const float*)d_in[i];
    p.out = (float*)d_out; p.ws = (char*)d_ws;
#if MULTI_LAUNCH
    launch_phase<0>(p, stream); launch_phase<1>(p, stream); launch_phase<2>(p, stream); launch_phase<3>(p, stream);
    launch_phase<4>(p, stream); launch_phase<5>(p, stream);
    if (DO_PEER) { launch_phase<6>(p, stream); launch_phase<7>(p, stream); }
    launch_phase<8>(p, stream);
#else
    static bool attr_set = false;
    if (!attr_set) { (void)hipFuncSetAttribute((const void*)k_mega, hipFuncAttributeMaxDynamicSharedMemorySize, SMEM_BYTES); attr_set = true; }
    (void)hipMemsetAsync(p.ws + OFF_BAR, 0, XCD_BAR_WORDS * 4, stream);
    void* args[] = {&p};
    hipError_t e = hipLaunchCooperativeKernel((const void*)k_mega, dim3(256), dim3(NTHR), args, SMEM_BYTES, stream);
    if (e != hipSuccess) fprintf(stderr, "cooperative launch failed: %s\n", hipGetErrorString(e));
#endif
}
```

```cpp
#include <hip/hip_runtime.h>
#include <stdint.h>
#include <stdio.h>

#ifndef REP0
#define REP0 1
#endif
#ifndef REP1
#define REP1 1
#endif
#ifndef REP2
#define REP2 1
#endif
#ifndef REP3
#define REP3 1
#endif
#ifndef REP4
#define REP4 1
#endif
#ifndef REP6
#define REP6 1
#endif
#ifndef REP7
#define REP7 1
#endif
#ifndef REP8
#define REP8 1
#endif
#ifndef TSSTAGE
#define TSSTAGE -1
#endif
#ifndef TSROLE
#define TSROLE -1
#endif
#ifndef GEMMFN
#define GEMMFN gemm_phase
#endif
#ifndef CHV
#define CHV 0
#endif
#ifndef CHAINX
#define CHAINX 1
#endif
#ifndef TBLX
#define TBLX 1
#endif
#ifndef MULTI_LAUNCH
#define MULTI_LAUNCH 0
#endif
#ifndef DO_LRU
#define DO_LRU 1
#endif
#ifndef DO_RWKV
#define DO_RWKV 1
#endif
#ifndef DO_PEER
#define DO_PEER 1
#endif

#define NTHR 512
#define T_SEQ 8192
#define NTOK 16384
#define NMETA 16
#define MROWS 16640
#define DM 1024
#define DIN 2816
#define NCHUNK 129
#define LD 72
#define LF 68
#define SLOT (64 * LD)

typedef unsigned short bf16_t;
typedef short bf16x8 __attribute__((ext_vector_type(8)));
typedef float f32x4 __attribute__((ext_vector_type(4)));
typedef float f32x16 __attribute__((ext_vector_type(16)));
typedef unsigned u32x4 __attribute__((ext_vector_type(4)));
typedef unsigned u32x2 __attribute__((ext_vector_type(2)));
typedef __bf16 bf2_t __attribute__((ext_vector_type(2)));
typedef float f32x2 __attribute__((ext_vector_type(2)));

constexpr size_t AL(size_t x) { return (x + 255) & ~(size_t)255; }
constexpr size_t OFF_BAR  = 0;
constexpr size_t OFF_SSQ  = 16384;
constexpr size_t SZ_SUM   = (size_t)NCHUNK * 2 * 512 * 4;
constexpr size_t OFF_SUMA = OFF_SSQ + 65536;
constexpr size_t OFF_SUMH = AL(OFF_SUMA + SZ_SUM);
constexpr size_t OFF_HS   = AL(OFF_SUMH + SZ_SUM);
constexpr size_t OFF_SP   = AL(OFF_HS + SZ_SUM);
constexpr size_t OFF_MPQ  = AL(OFF_SP + 2048);
constexpr size_t OFF_WINT = AL(OFF_MPQ + 8 * 16384);
constexpr size_t OFF_WOUTT = AL(OFF_WINT + (size_t)DIN * DM * 2);
constexpr size_t OFF_WQT  = AL(OFF_WOUTT + (size_t)DM * DM * 2);
constexpr size_t OFF_W2T  = AL(OFF_WQT + (size_t)2048 * DM * 2);
constexpr size_t OFF_A2T  = AL(OFF_W2T + 512 * 64 * 2);
constexpr size_t OFF_G2T  = AL(OFF_A2T + 512 * 64 * 2);
constexpr size_t OFF_WAT  = AL(OFF_G2T + 512 * 128 * 2);
constexpr size_t OFF_WXT  = AL(OFF_WAT + 8 * 64 * 64 * 2);
constexpr size_t OFF_KEYS = AL(OFF_WXT + 8 * 64 * 64 * 2);
constexpr size_t OFF_UB   = AL(OFF_KEYS + 8 * 2 * 128 * 128 * 2);
constexpr size_t OFF_VB   = AL(OFF_UB + (size_t)16384 * DM / 2);
constexpr size_t OFF_SU   = AL(OFF_VB + (size_t)16384 * DM / 2);
constexpr size_t OFF_SV   = AL(OFF_SU + 16384 * 4);
constexpr size_t OFF_XN   = AL(OFF_SV + 16384 * 4);
constexpr size_t OFF_SB   = AL(OFF_XN + (size_t)MROWS * DM * 2);
constexpr size_t OFF_P    = AL(OFF_SB + (size_t)2048 * 8192);
constexpr size_t OFF_H1B  = OFF_P;
constexpr size_t OFF_EIDX = AL(OFF_H1B + (size_t)NTOK * DM * 2);
constexpr size_t OFF_GATE = AL(OFF_EIDX + (size_t)NTOK * 128 * 2);
constexpr size_t OFF_E1   = AL(OFF_P + (size_t)MROWS * DIN * 2);
constexpr size_t OFF_E2   = AL(OFF_E1 + (size_t)NTOK * 512 * 2);
constexpr size_t OFF_AC   = AL(OFF_E2 + (size_t)NTOK * 512 * 2);
constexpr size_t OFF_HL   = AL(OFF_AC + (size_t)NTOK * 512 * 2);
constexpr size_t WS_END   = AL(OFF_HL + (size_t)NTOK * 512 * 2);
constexpr size_t UNIT_BYTES = 32768;
constexpr int NUNITS = 8 + 2048;
static_assert((size_t)2048 * UNIT_BYTES <= (size_t)NTOK * DM * 4, "unit data does not fit in d_out");
static_assert(WS_END <= (size_t)256 * 1024 * 1024, "workspace too large");

constexpr int SMEM_BYTES = 160 * 1024;
constexpr int PRM_RWKV = 148736;
constexpr int PRM_LRU = 65536;

struct Params {
    const float *x, *meta, *g1, *w_in, *conv_w, *conv_b, *ga_w, *ga_b, *gx_w, *gx_b, *lam, *lru_gain, *mu, *w0, *w2, *a0, *a2, *g2,
        *k_k, *k_a, *r_k, *gn_w, *gn_b, *w_out, *g2n, *w_q, *q_gain, *keys, *u, *v, *fg;
    float* out;
    char* ws;
};

__device__ __forceinline__ unsigned short f2bf(float f) { __bf16 b = (__bf16)f; return __builtin_bit_cast(unsigned short, b); }
__device__ __forceinline__ unsigned pack2(float lo, float hi) { bf2_t v; v[0] = (__bf16)lo; v[1] = (__bf16)hi; return __builtin_bit_cast(unsigned, v); }
__device__ __forceinline__ float bflo(unsigned u) { return __uint_as_float(u << 16); }
__device__ __forceinline__ float bfhi(unsigned u) { return __uint_as_float(u & 0xFFFF0000u); }
__device__ __forceinline__ float bf2f(bf16_t b) { return __uint_as_float((unsigned)b << 16); }
__device__ __forceinline__ float wave_sum(float v) {
#pragma unroll
    for (int o = 32; o > 0; o >>= 1) v += __shfl_xor(v, o);
    return v;
}
__device__ __forceinline__ float sum8(float v) { v += __shfl_xor(v, 1); v += __shfl_xor(v, 2); v += __shfl_xor(v, 4); return v; }
__device__ __forceinline__ float sigmoidf_(float x) { return 1.0f / (1.0f + __expf(-x)); }
__device__ __forceinline__ float gelu_tanh(float x) {
    const float u = 0.7978845608f * (x + 0.044715f * x * x * x);
    const float t = 1.0f - 2.0f / (__expf(2.0f * u) + 1.0f);
    return 0.5f * x * (1.0f + t);
}
__device__ __forceinline__ float gelu_erf(float x) { return 0.5f * x * (1.0f + erff(x * 0.70710678118f)); }
__device__ __forceinline__ void unpack8(u32x4 q, float* f) {
    f[0] = bflo(q[0]); f[1] = bfhi(q[0]); f[2] = bflo(q[1]); f[3] = bfhi(q[1]);
    f[4] = bflo(q[2]); f[5] = bfhi(q[2]); f[6] = bflo(q[3]); f[7] = bfhi(q[3]);
}
__device__ __forceinline__ u32x4 pack8(const float* f) {
    u32x4 q; q[0] = pack2(f[0], f[1]); q[1] = pack2(f[2], f[3]); q[2] = pack2(f[4], f[5]); q[3] = pack2(f[6], f[7]); return q;
}
__device__ __forceinline__ int row_of(int b, int pos) { return pos < NMETA ? NTOK + pos : b * T_SEQ + pos - NMETA; }

#define MFMA32(a, b, c) __builtin_amdgcn_mfma_f32_32x32x16_bf16((a), (b), (c), 0, 0, 0)
#define MFMA16(a, b, c) __builtin_amdgcn_mfma_f32_16x16x32_bf16((a), (b), (c), 0, 0, 0)

template <int KS>
__device__ __forceinline__ f32x16 mm_lds(const bf16_t* A, const bf16_t* Bt, int qm, int qn, int lane, f32x16 acc) {
    const int r = lane & 31, h = lane >> 5;
    const bf16_t* ap = A + (qm * 32 + r) * LD + h * 8;
    const bf16_t* bp = Bt + (qn * 32 + r) * LD + h * 8;
#pragma unroll
    for (int ks = 0; ks < KS; ++ks) {
        bf16x8 a = *(const bf16x8*)(ap + ks * 16), b = *(const bf16x8*)(bp + ks * 16);
        acc = MFMA32(a, b, acc);
    }
    return acc;
}
template <int KS>
__device__ __forceinline__ f32x16 mm_lds_s(const bf16_t* A, const bf16_t* Bt, int qm, int qn, int lane, f32x16 acc, bool swzA, bool swzB) {
    const int r = lane & 31, h = lane >> 5;
    const int ra = qm * 32 + r, rb = qn * 32 + r;
    const int xa = swzA ? ((ra >> 3) & 7) : 0, xb = swzB ? ((rb >> 3) & 7) : 0;
    const bf16_t* ap = A + ra * LD;
    const bf16_t* bp = Bt + rb * LD;
#pragma unroll
    for (int ks = 0; ks < KS; ++ks) {
        bf16x8 a = *(const bf16x8*)(ap + (((ks * 2 + h) ^ xa) * 8)), b = *(const bf16x8*)(bp + (((ks * 2 + h) ^ xb) * 8));
        acc = MFMA32(a, b, acc);
    }
    return acc;
}
template <int KS>
__device__ __forceinline__ f32x16 mm_lds_g(const bf16_t* A, const bf16_t* __restrict__ Btg, int ldb, int qm, int qn, int lane, f32x16 acc) {
    const int r = lane & 31, h = lane >> 5;
    const bf16_t* ap = A + (qm * 32 + r) * LD + h * 8;
    const bf16_t* bp = Btg + (size_t)(qn * 32 + r) * ldb + h * 8;
    bf16x8 bfr[KS];
#pragma unroll
    for (int ks = 0; ks < KS; ++ks) bfr[ks] = *(const bf16x8*)(bp + ks * 16);
#pragma unroll
    for (int ks = 0; ks < KS; ++ks) { bf16x8 a = *(const bf16x8*)(ap + ks * 16); acc = MFMA32(a, bfr[ks], acc); }
    return acc;
}
__device__ __forceinline__ void store_N_bf16(bf16_t* dst, const f32x16& c, int qm, int qn, int lane) {
    const int r = lane & 31, h = lane >> 5;
#pragma unroll
    for (int reg = 0; reg < 16; ++reg) dst[(qm * 32 + (reg & 3) + 8 * (reg >> 2) + 4 * h) * LD + qn * 32 + r] = f2bf(c[reg]);
}
__device__ __forceinline__ void store_T_bf16(bf16_t* dst, const f32x16& c, int qm, int qn, int lane) {
    const int r = lane & 31, h = lane >> 5;
#pragma unroll
    for (int g = 0; g < 4; ++g) {
        u32x2 w; w[0] = pack2(c[4 * g], c[4 * g + 1]); w[1] = pack2(c[4 * g + 2], c[4 * g + 3]);
        *(u32x2*)(dst + (qn * 32 + r) * LD + qm * 32 + 8 * g + 4 * h) = w;
    }
}
__device__ __forceinline__ void store_N_f32(float* dst, const f32x16& c, int qm, int qn, int lane) {
    const int r = lane & 31, h = lane >> 5;
#pragma unroll
    for (int reg = 0; reg < 16; ++reg) dst[(qm * 32 + (reg & 3) + 8 * (reg >> 2) + 4 * h) * LF + qn * 32 + r] = c[reg];
}
__device__ __forceinline__ f32x16 zero16() { f32x16 z; for (int i = 0; i < 16; ++i) z[i] = 0.f; return z; }

__device__ __forceinline__ void transpose_tile(const float* __restrict__ src, bf16_t* __restrict__ dst, int K, int N, const float* __restrict__ kscale, int tk, int tn, float* tile) {
    const int tid = threadIdx.x;
#pragma unroll
    for (int i = 0; i < 2; ++i) {
        const int kk = (tid >> 4) + 32 * i, nn = (tid & 15) * 4;
        f32x4 v = *(const f32x4*)(src + (size_t)(tk * 64 + kk) * N + tn * 64 + nn);
        const float s = kscale ? kscale[tk * 64 + kk] : 1.0f;
        tile[kk * 65 + nn] = v[0] * s; tile[kk * 65 + nn + 1] = v[1] * s; tile[kk * 65 + nn + 2] = v[2] * s; tile[kk * 65 + nn + 3] = v[3] * s;
    }
    __syncthreads();
    {
        const int n = tid >> 3, ks = (tid & 7) * 8;
        float f[8];
#pragma unroll
        for (int i = 0; i < 8; ++i) f[i] = tile[(ks + i) * 65 + n];
        *(u32x4*)(dst + (size_t)(tn * 64 + n) * K + tk * 64 + ks) = pack8(f);
    }
    __syncthreads();
}

__device__ __forceinline__ void phase_prep(const Params& p, char* smem) {
    const int tid = threadIdx.x, lane = tid & 63, wave = __builtin_amdgcn_readfirstlane(tid >> 6), G = gridDim.x;
    char* ws = p.ws;
    bf16_t* XN = (bf16_t*)(ws + OFF_XN);
    for (int row = blockIdx.x * 8 + wave; row < MROWS; row += G * 8) {
        u32x2* dst = (u32x2*)(XN + (size_t)row * DM);
        if (row >= NTOK + NMETA) {
#pragma unroll
            for (int i = 0; i < 4; ++i) { u32x2 z; z[0] = 0; z[1] = 0; dst[lane + 64 * i] = z; }
            continue;
        }
        const float* src = row < NTOK ? p.x + (size_t)row * DM : p.meta + (size_t)(row - NTOK) * DM;
        f32x4 v[4]; float ss = 0.f;
#pragma unroll
        for (int i = 0; i < 4; ++i) { v[i] = ((const f32x4*)src)[lane + 64 * i]; ss += v[i][0] * v[i][0] + v[i][1] * v[i][1] + v[i][2] * v[i][2] + v[i][3] * v[i][3]; }
        ss = wave_sum(ss);
        const float rs = rsqrtf(ss * (1.0f / DM) + 1e-6f);
#pragma unroll
        for (int i = 0; i < 4; ++i) {
            f32x4 g = ((const f32x4*)p.g1)[lane + 64 * i];
            u32x2 w; w[0] = pack2(v[i][0] * rs * g[0], v[i][1] * rs * g[1]); w[1] = pack2(v[i][2] * rs * g[2], v[i][3] * rs * g[3]);
            dst[lane + 64 * i] = w;
        }
    }
    {
        float* tile = (float*)smem;
        const int n0 = 16 * 44, n1 = n0 + 16 * 16, n2 = n1 + 16 * 32, n3 = n2 + 8, n4 = n3 + 8, n5 = n4 + 16, n6 = n5 + 8, n7 = n6 + 8;
        for (int t = blockIdx.x; t < n7; t += G) {
            if (t < n0) transpose_tile(p.w_in, (bf16_t*)(ws + OFF_WINT), DM, DIN, nullptr, t / 44, t % 44, tile);
            else if (t < n1) { const int u = t - n0; transpose_tile(p.w_out, (bf16_t*)(ws + OFF_WOUTT), DM, DM, nullptr, u / 16, u % 16, tile); }
            else if (t < n2) { const int u = t - n1; transpose_tile(p.w_q, (bf16_t*)(ws + OFF_WQT), DM, 2048, p.g2n, u / 32, u % 32, tile); }
            else if (t < n3) { const int u = t - n2; transpose_tile(p.w2, (bf16_t*)(ws + OFF_W2T), 64, 512, nullptr, 0, u, tile); }
            else if (t < n4) { const int u = t - n3; transpose_tile(p.a2, (bf16_t*)(ws + OFF_A2T), 64, 512, nullptr, 0, u, tile); }
            else if (t < n5) { const int u = t - n4; transpose_tile(p.g2, (bf16_t*)(ws + OFF_G2T), 128, 512, nullptr, u / 8, u % 8, tile); }
            else if (t < n6) { const int u = t - n5; transpose_tile(p.ga_w + u * 4096, (bf16_t*)(ws + OFF_WAT) + u * 4096, 64, 64, nullptr, 0, 0, tile); }
            else { const int u = t - n6; transpose_tile(p.gx_w + u * 4096, (bf16_t*)(ws + OFF_WXT) + u * 4096, 64, 64, nullptr, 0, 0, tile); }
        }
    }
    {
        const int gt = blockIdx.x * NTHR + tid, gs = G * NTHR;
        bf16_t* KEYS = (bf16_t*)(ws + OFF_KEYS);
        for (int i = gt; i < 8 * 2 * 128 * 128 / 4; i += gs) {
            const int e = i * 4, d = e & 127, sub = (e >> 14) & 1, h = e >> 15;
            f32x4 k = ((const f32x4*)p.keys)[i]; f32x4 g = *(const f32x4*)(p.q_gain + h * 256 + sub * 128 + d);
            u32x2 w; w[0] = pack2(k[0] * g[0], k[1] * g[1]); w[1] = pack2(k[2] * g[2], k[3] * g[3]);
            *(u32x2*)(KEYS + e) = w;
        }
        float* ssq = (float*)(ws + OFF_SSQ);
        for (int i = gt; i < NTOK; i += gs) ssq[i] = 0.f;
        float* SPt = (float*)(ws + OFF_SP);
        for (int i = gt; i < 512; i += gs) SPt[i] = log1pf(__expf(-p.lam[i]));
    }
}


__device__ __forceinline__ void convert_tables(const Params& p, int first) {
    char* ws = p.ws;
    const int lane = threadIdx.x & 63, wave = threadIdx.x >> 6;
    const int gw = (blockIdx.x - first) * 8 + wave, nw = (gridDim.x - first) * 8;
    float g[16];
#pragma unroll
    for (int q = 0; q < 4; ++q) *(f32x4*)(g + 4 * q) = *(const f32x4*)(p.g2n + lane * 16 + 4 * q);
#pragma unroll 1
    for (int r0 = gw; r0 < 32768; r0 += nw * 2) {
        f32x4 xv[2][4];
#pragma unroll
        for (int k = 0; k < 2; ++k) {
            const int rr = min(r0 + k * nw, 32767);
            const float* src = (rr < 16384 ? p.u : p.v) + (size_t)(rr & 16383) * DM + lane * 16;
#pragma unroll
            for (int q = 0; q < 4; ++q) xv[k][q] = *(const f32x4*)(src + 4 * q);
        }
        int keep = r0; asm volatile("" : "+v"(keep) :: "memory");
#pragma unroll
        for (int k = 0; k < 2; ++k) {
            const int rr = keep + k * nw;
            if (rr < 32768) {
                const bool isu = rr < 16384;
                float x[16]; float amax = 0.f;
#pragma unroll
                for (int i = 0; i < 16; ++i) { x[i] = xv[k][i >> 2][i & 3] * (isu ? g[i] : 1.0f); amax = fmaxf(amax, fabsf(x[i])); }
#pragma unroll
                for (int o = 32; o > 0; o >>= 1) amax = fmaxf(amax, __shfl_xor(amax, o));
                const float sc = fmaxf(amax, 1e-30f) * (1.0f / 6.0f), inv = 1.0f / sc;
                unsigned w0 = 0, w1 = 0;
                w0 = __builtin_amdgcn_cvt_scalef32_pk_fp4_f32(w0, x[0] * inv, x[1] * inv, 1.0f, 0);
                w0 = __builtin_amdgcn_cvt_scalef32_pk_fp4_f32(w0, x[2] * inv, x[3] * inv, 1.0f, 1);
                w0 = __builtin_amdgcn_cvt_scalef32_pk_fp4_f32(w0, x[4] * inv, x[5] * inv, 1.0f, 2);
                w0 = __builtin_amdgcn_cvt_scalef32_pk_fp4_f32(w0, x[6] * inv, x[7] * inv, 1.0f, 3);
                w1 = __builtin_amdgcn_cvt_scalef32_pk_fp4_f32(w1, x[8] * inv, x[9] * inv, 1.0f, 0);
                w1 = __builtin_amdgcn_cvt_scalef32_pk_fp4_f32(w1, x[10] * inv, x[11] * inv, 1.0f, 1);
                w1 = __builtin_amdgcn_cvt_scalef32_pk_fp4_f32(w1, x[12] * inv, x[13] * inv, 1.0f, 2);
                w1 = __builtin_amdgcn_cvt_scalef32_pk_fp4_f32(w1, x[14] * inv, x[15] * inv, 1.0f, 3);
                u32x2 w; w[0] = w0; w[1] = w1;
                *(u32x2*)(ws + (isu ? OFF_UB : OFF_VB) + (size_t)(rr & 16383) * (DM / 2) + lane * 8) = w;
                if (lane == 0) ((float*)(ws + (isu ? OFF_SU : OFF_SV)))[rr & 16383] = sc;
            }
        }
    }
}

constexpr int GA_ROWS = 256, GB_ROWS = 128;
constexpr int GBUF = (GA_ROWS + GB_ROWS) * LD;

struct EpiStoreBf16 {
    bf16_t* C; int ldc;
    __device__ __forceinline__ void operator()(const f32x16 (&acc)[2][2], int mb, int nb, int lane) const {
        const int r = lane & 31, h = lane >> 5;
#pragma unroll
        for (int i = 0; i < 2; ++i)
#pragma unroll
            for (int j = 0; j < 2; ++j)
#pragma unroll
                for (int g = 0; g < 4; ++g) {
                    u32x2 w; w[0] = pack2(acc[i][j][4 * g], acc[i][j][4 * g + 1]); w[1] = pack2(acc[i][j][4 * g + 2], acc[i][j][4 * g + 3]);
                    *(u32x2*)(C + (size_t)(mb + i * 32 + r) * ldc + nb + j * 32 + 8 * g + 4 * h) = w;
                }
    }
};
struct EpiResidual {
    bf16_t* C; const float* X; float* ssq;
    __device__ __forceinline__ void operator()(const f32x16 (&acc)[2][2], int mb, int nb, int lane) const {
        const int r = lane & 31, h = lane >> 5;
#pragma unroll
        for (int i = 0; i < 2; ++i) {
            const int row = mb + i * 32 + r; float ss = 0.f;
#pragma unroll
            for (int j = 0; j < 2; ++j)
#pragma unroll
                for (int g = 0; g < 4; ++g) {
                    const int col = nb + j * 32 + 8 * g + 4 * h;
                    f32x4 xv = *(const f32x4*)(X + (size_t)row * DM + col);
                    const float v0 = acc[i][j][4 * g] + xv[0], v1 = acc[i][j][4 * g + 1] + xv[1], v2 = acc[i][j][4 * g + 2] + xv[2], v3 = acc[i][j][4 * g + 3] + xv[3];
                    ss += v0 * v0 + v1 * v1 + v2 * v2 + v3 * v3;
                    u32x2 w; w[0] = pack2(v0, v1); w[1] = pack2(v2, v3);
                    *(u32x2*)(C + (size_t)row * DM + col) = w;
                }
            ss += __shfl_xor(ss, 32);
            if (h == 0) atomicAdd(ssq + row, ss);
        }
    }
};

template <class Epi>
__device__ __forceinline__ void gemm_phase(const bf16_t* __restrict__ A, const bf16_t* __restrict__ Bt, int M, int N, int K, char* smem, const Epi& epi) {
    const int tid = threadIdx.x, lane = tid & 63, wave = __builtin_amdgcn_readfirstlane(tid >> 6);
    const int wm = wave >> 1, wn = wave & 1, r = lane & 31, h = lane >> 5;
    const int nNt = N / 128, ntiles = (M / 256) * nNt, nk = K / 64;
    const int G = gridDim.x;
    const int bid = (G % 8 == 0) ? (blockIdx.x % 8) * (G / 8) + blockIdx.x / 8 : blockIdx.x;
    bf16_t* lds = (bf16_t*)smem;
    for (int tile = bid; tile < ntiles; tile += G) {
        const int pm = tile / nNt, pn = tile % nNt, m0 = pm * 256, n0 = pn * 128;
        const bf16_t* Ag = A + (size_t)m0 * K; const bf16_t* Bg = Bt + (size_t)n0 * K;
        f32x16 acc[2][2];
#pragma unroll
        for (int i = 0; i < 2; ++i)
#pragma unroll
            for (int j = 0; j < 2; ++j) acc[i][j] = zero16();
        u32x4 ra0[4], rb0[2], ra1[4], rb1[2];
#define G_LOAD(RA, RB, KT) { \
            _Pragma("unroll") for (int i = 0; i < 4; ++i) { const int q = tid + 512 * i; RA[i] = *(const u32x4*)(Ag + (size_t)(q >> 3) * K + (KT) * 64 + (q & 7) * 8); } \
            _Pragma("unroll") for (int i = 0; i < 2; ++i) { const int q = tid + 512 * i; RB[i] = *(const u32x4*)(Bg + (size_t)(q >> 3) * K + (KT) * 64 + (q & 7) * 8); } }
#define G_WRITE(RA, RB, BUF) { bf16_t* b_ = lds + (BUF) * GBUF; \
            _Pragma("unroll") for (int i = 0; i < 4; ++i) { const int q = tid + 512 * i; *(u32x4*)(b_ + (q >> 3) * LD + (q & 7) * 8) = RA[i]; } \
            _Pragma("unroll") for (int i = 0; i < 2; ++i) { const int q = tid + 512 * i; *(u32x4*)(b_ + GA_ROWS * LD + (q >> 3) * LD + (q & 7) * 8) = RB[i]; } }
#define G_COMPUTE(BUF) { const bf16_t* a_ = lds + (BUF) * GBUF + (wm * 64 + r) * LD + h * 8; const bf16_t* b_ = lds + (BUF) * GBUF + (GA_ROWS + wn * 64 + r) * LD + h * 8; \
            _Pragma("unroll") for (int ks = 0; ks < 4; ++ks) { \
                bf16x8 af0 = *(const bf16x8*)(a_ + ks * 16), af1 = *(const bf16x8*)(a_ + 32 * LD + ks * 16); \
                bf16x8 bf0 = *(const bf16x8*)(b_ + ks * 16), bf1 = *(const bf16x8*)(b_ + 32 * LD + ks * 16); \
                acc[0][0] = MFMA32(bf0, af0, acc[0][0]); acc[0][1] = MFMA32(bf1, af0, acc[0][1]); \
                acc[1][0] = MFMA32(bf0, af1, acc[1][0]); acc[1][1] = MFMA32(bf1, af1, acc[1][1]); } }
        G_LOAD(ra0, rb0, 0); G_LOAD(ra1, rb1, 1);
        G_WRITE(ra0, rb0, 0);
        __syncthreads();
        for (int kt = 0; kt < nk; kt += 2) {
            if (kt + 2 < nk) G_LOAD(ra0, rb0, kt + 2);
            G_COMPUTE(0);
            G_WRITE(ra1, rb1, 1);
            __syncthreads();
            if (kt + 3 < nk) G_LOAD(ra1, rb1, kt + 3);
            G_COMPUTE(1);
            if (kt + 2 < nk) G_WRITE(ra0, rb0, 0);
            __syncthreads();
        }
        epi(acc, m0 + wm * 64, n0 + wn * 64, lane);
    }
#undef G_LOAD
#undef G_WRITE
#undef G_COMPUTE
}

constexpr int GBUF2 = 512 * LD;
template <class Epi>
__device__ __forceinline__ void gemm_phase256(const bf16_t* __restrict__ A, const bf16_t* __restrict__ Bt, int M, int N, int K, char* smem, const Epi& epi) {
    int tid_ = threadIdx.x; asm volatile("" : "+v"(tid_));
    const int tid = tid_, lane = tid & 63, wave = __builtin_amdgcn_readfirstlane(tid >> 6);
    const int wm = wave >> 2, wn = wave & 3, r = lane & 31, h = lane >> 5;
    const int nNt = N / 256, ntiles = (M / 256) * nNt, nk = K / 64;
    const int G = gridDim.x;
    const int bid = (G % 8 == 0) ? (blockIdx.x % 8) * (G / 8) + blockIdx.x / 8 : blockIdx.x;
    bf16_t* lds = (bf16_t*)smem;
    for (int tile = bid; tile < ntiles; tile += G) {
        const int pm = tile / nNt, pn = tile % nNt, m0 = pm * 256, n0 = pn * 256;
        const bf16_t* Ag = A + (size_t)m0 * K; const bf16_t* Bg = Bt + (size_t)n0 * K;
        f32x16 acc[4][2];
#pragma unroll
        for (int i = 0; i < 4; ++i)
#pragma unroll
            for (int j = 0; j < 2; ++j) acc[i][j] = zero16();
        u32x4 ra0[4], rb0[4];
#define G_LOAD(RA, RB, KT) { \
            _Pragma("unroll") for (int i = 0; i < 4; ++i) { const int q = tid + 512 * i; RA[i] = *(const u32x4*)(Ag + (size_t)(q >> 3) * K + (KT) * 64 + (q & 7) * 8); \
                                                                                      RB[i] = *(const u32x4*)(Bg + (size_t)(q >> 3) * K + (KT) * 64 + (q & 7) * 8); } }
#define G_WRITE(RA, RB, BUF) { bf16_t* b_ = lds + (BUF) * GBUF2; \
            _Pragma("unroll") for (int i = 0; i < 4; ++i) { const int q = tid + 512 * i; *(u32x4*)(b_ + (q >> 3) * LD + (q & 7) * 8) = RA[i]; \
                                                                                      *(u32x4*)(b_ + 256 * LD + (q >> 3) * LD + (q & 7) * 8) = RB[i]; } }
#define G_COMPUTE(BUF) { const bf16_t* a_ = lds + (BUF) * GBUF2 + (wm * 128 + r) * LD + h * 8; const bf16_t* b_ = lds + (BUF) * GBUF2 + (256 + wn * 64 + r) * LD + h * 8; \
            _Pragma("unroll") for (int ks = 0; ks < 4; ++ks) { \
                bf16x8 bf0 = *(const bf16x8*)(b_ + ks * 16), bf1 = *(const bf16x8*)(b_ + 32 * LD + ks * 16); \
                _Pragma("unroll") for (int i = 0; i < 4; ++i) { bf16x8 af = *(const bf16x8*)(a_ + i * 32 * LD + ks * 16); \
                    acc[i][0] = MFMA32(bf0, af, acc[i][0]); acc[i][1] = MFMA32(bf1, af, acc[i][1]); } } }
        G_LOAD(ra0, rb0, 0);
        G_WRITE(ra0, rb0, 0);
        __syncthreads();
        G_LOAD(ra0, rb0, 1);
#pragma unroll 1
        for (int kt = 0; kt < nk; kt += 2) {
            G_COMPUTE(0);
            G_WRITE(ra0, rb0, 1);
            __syncthreads();
            if (kt + 2 < nk) G_LOAD(ra0, rb0, kt + 2);
            G_COMPUTE(1);
            if (kt + 2 < nk) G_WRITE(ra0, rb0, 0);
            __syncthreads();
            if (kt + 3 < nk) G_LOAD(ra0, rb0, kt + 3);
        }
        epi(*(const f32x16 (*)[2][2])(&acc[0]), m0 + wm * 128, n0 + wn * 64, lane);
        epi(*(const f32x16 (*)[2][2])(&acc[2]), m0 + wm * 128 + 64, n0 + wn * 64, lane);
    }
#undef G_LOAD
#undef G_WRITE
#undef G_COMPUTE
}

namespace pg8 {
#define PG8_LAS __attribute__((address_space(3)))
constexpr int BM = 256, BK = 64, HALF = 128, HTB = HALF * BK * 2  , STAGE_BYTES = 8 * HTB, NXCD = 8, WGM = 8;
__host__ __device__ __forceinline__ int lds_byte(int r, int c) { const int st = (r >> 4) * 2 + (c >> 5), rr = r & 15, cc = c & 31, ob = rr * 64 + cc * 2; return st * 1024 + (ob ^ (((ob >> 9) & 1) << 5)); }
__host__ __device__ __forceinline__ void stage_rc(int b, int& R, int& C) { const int st = b / 1024, sb = b % 1024, swz = sb ^ (((sb >> 9) & 1) << 5); R = (st >> 1) * 16 + swz / 64; C = (st & 1) * 32 + (swz % 64) / 2; }
__host__ __device__ __forceinline__ int perm32(int rho) { const int n = rho >> 4, i = rho & 15; return 8 * (i >> 2) + 4 * n + (i & 3); }
struct Unit { int pm, pn; };
struct Gemm { const bf16_t* A; const bf16_t* Bt; int M, N, K; };
struct StaticOrder {
    int nM, nN, nwg, G, c;
    __host__ __device__ void init(int M, int N, int G_, int c_) { nM = M / BM; nN = N / BM; nwg = nM * nN; G = G_; c = c_; }
    __host__ __device__ bool next(int i, Unit& u) const {
        const long L = (long)i * G + c; if (L >= nwg) return false;
        int wgid = (int)L; { const int q = nwg / NXCD, r = nwg % NXCD, xcd = wgid % NXCD, off = wgid / NXCD; wgid = (xcd < r ? xcd * (q + 1) : r * (q + 1) + (xcd - r) * q) + off; }
        const int nig = WGM * nN, gid = wgid / nig, fm = gid * WGM, gsz = (nM - fm) < WGM ? (nM - fm) : WGM;
        u.pm = fm + ((wgid % nig) % gsz); u.pn = (wgid % nig) / gsz; return true;
    }
    __device__ __forceinline__ void a_ready(const Unit&) const {}
    __device__ __forceinline__ void done(const Unit&) const {}
};
struct EpiBf16 {
    static constexpr bool PERM = true, AFTER_DRAIN = false;
    bf16_t* C; int ldc;
    __device__ __forceinline__ void operator()(const f32x4 (&acc)[2][2][4][2], const Unit& u, int wr, int wc, int fr, int fq) const {
#pragma unroll
        for (int ai = 0; ai < 2; ++ai)
#pragma unroll
            for (int m = 0; m < 4; ++m) {
                bf16_t* rowp = C + (size_t)(u.pm * BM + ai * HALF + wr * 64 + m * 16 + fr) * ldc + u.pn * BM + wc * 32 + 8 * fq;
#pragma unroll
                for (int bj = 0; bj < 2; ++bj) {
                    const f32x4 v0 = acc[ai][bj][m][0], v1 = acc[ai][bj][m][1];
                    u32x4 w; w[0] = pack2(v0[0], v0[1]); w[1] = pack2(v0[2], v0[3]); w[2] = pack2(v1[0], v1[1]); w[3] = pack2(v1[2], v1[3]);
                    *(u32x4*)(rowp + bj * HALF) = w;
                }
                asm volatile("" ::: "memory");
            }
    }
};
struct EpiRes {
    static constexpr bool PERM = true, AFTER_DRAIN = false;
    bf16_t* C; const float* X; float* ssq;
    __device__ __forceinline__ void operator()(const f32x4 (&acc)[2][2][4][2], const Unit& u, int wr, int wc, int fr, int fq) const {
#pragma unroll
        for (int ai = 0; ai < 2; ++ai) {
            f32x4 xv[4][2][2];
#pragma unroll
            for (int m = 0; m < 4; ++m)
#pragma unroll
                for (int bj = 0; bj < 2; ++bj) {
                    const float* xp = X + (size_t)(u.pm * BM + ai * HALF + wr * 64 + m * 16 + fr) * DM + u.pn * BM + bj * HALF + wc * 32 + 8 * fq;
                    xv[m][bj][0] = *(const f32x4*)xp; xv[m][bj][1] = *(const f32x4*)(xp + 4);
                }
            asm volatile("" ::: "memory");
#pragma unroll
            for (int m = 0; m < 4; ++m) {
                const int row = u.pm * BM + ai * HALF + wr * 64 + m * 16 + fr;
                float ss = 0.f;
#pragma unroll
                for (int bj = 0; bj < 2; ++bj) {
                    const int col = u.pn * BM + bj * HALF + wc * 32 + 8 * fq;
                    const f32x4 v0 = acc[ai][bj][m][0] + xv[m][bj][0], v1 = acc[ai][bj][m][1] + xv[m][bj][1];
                    ss += v0[0] * v0[0] + v0[1] * v0[1] + v0[2] * v0[2] + v0[3] * v0[3] + v1[0] * v1[0] + v1[1] * v1[1] + v1[2] * v1[2] + v1[3] * v1[3];
                    u32x4 w; w[0] = pack2(v0[0], v0[1]); w[1] = pack2(v0[2], v0[3]); w[2] = pack2(v1[0], v1[1]); w[3] = pack2(v1[2], v1[3]);
                    *(u32x4*)(C + (size_t)row * DM + col) = w;
                }
                ss += __shfl_xor(ss, 16); ss += __shfl_xor(ss, 32);
                if (fq == 0) atomicAdd(ssq + row, ss);
            }
            asm volatile("" ::: "memory");
        }
    }
};
template <class Epi, class Sched, bool ALIGN_EPI = false, bool SP2 = false>
__device__ __forceinline__ void gemm_phase(PG8_LAS unsigned char* lds, const Gemm g, const Sched& S, const Epi& E) {
    const int tid = threadIdx.x, wid = __builtin_amdgcn_readfirstlane(tid >> 6), lane = tid & 63, wr = wid >> 2, wc = wid & 3, fr = lane & 15, fq = lane >> 4;
    const int K = g.K, nt = K / BK;
    unsigned voffA[2], voffB[2];
#pragma unroll
    for (int i = 0; i < 2; ++i) { int R, C; stage_rc(tid * 16 + i * 8192, R, C); const int Rb = Epi::PERM ? ((R & ~31) + perm32(R & 31)) : R;
        voffA[i] = (unsigned)(R * K + C) * 2u; voffB[i] = (unsigned)(Rb * K + C) * 2u; }
    const size_t kstep = (size_t)(BK * 2);
    const size_t hstep = (size_t)HALF * K * 2;
    const size_t tstep = 2 * hstep;
    const unsigned ldsw = (unsigned)wid * 1024u;
    const int aoff = lds_byte(wr * 64 + fr, fq * 8), boff = lds_byte(wc * 32 + fr, fq * 8);
#define PG8_SA(b, h) (((b) * 2 + (h)) * HTB)
#define PG8_SB(b, h) ((4 + (b) * 2 + (h)) * HTB)
#define PG8_STAGE(bufoff, gbase, voff) do { _Pragma("unroll") for (int _i = 0; _i < 2; ++_i) \
        __builtin_amdgcn_global_load_lds((const unsigned*)((const char*)(gbase) + (voff)[_i]), (PG8_LAS unsigned*)(lds + (bufoff) + ldsw + _i * 8192), 16, 0, 0); } while (0)
#define PG8_LDA(dst, b, h) do { _Pragma("unroll") for (int m = 0; m < 4; ++m) _Pragma("unroll") for (int k = 0; k < 2; ++k) dst[m][k] = *(const PG8_LAS bf16x8*)(lds + PG8_SA(b, h) + aoff + m * 2048 + k * 1024); } while (0)
#define PG8_LDB(dst, b, h) do { _Pragma("unroll") for (int n = 0; n < 2; ++n) _Pragma("unroll") for (int k = 0; k < 2; ++k) dst[n][k] = *(const PG8_LAS bf16x8*)(lds + PG8_SB(b, h) + boff + n * 2048 + k * 1024); } while (0)
#define PG8_MMA(ai, bj, At, Bt) do { __builtin_amdgcn_s_setprio(1); _Pragma("unroll") for (int m = 0; m < 4; ++m) _Pragma("unroll") for (int n = 0; n < 2; ++n) _Pragma("unroll") for (int k = 0; k < 2; ++k) \
        acc[ai][bj][m][n] = __builtin_amdgcn_mfma_f32_16x16x32_bf16(Bt[n][k], At[m][k], acc[ai][bj][m][n], 0, 0, 0); __builtin_amdgcn_s_setprio(0); } while (0)
#define PG8_WAIT_V(n) asm volatile("s_waitcnt vmcnt(" #n ")" ::: "memory")
#define PG8_WAIT_L(n) asm volatile("s_waitcnt lgkmcnt(" #n ")" ::: "memory")
#define PG8_BAR __builtin_amdgcn_s_barrier()
#define PG8_SCHED __builtin_amdgcn_sched_barrier(0)
    Unit cur, nxt; int ui = 0;
    if (!S.next(0, cur)) return;
    f32x4 acc[2][2][4][2];
#pragma unroll
    for (int a = 0; a < 2; ++a)
#pragma unroll
        for (int b = 0; b < 2; ++b)
#pragma unroll
            for (int m = 0; m < 4; ++m)
#pragma unroll
                for (int n = 0; n < 2; ++n) acc[a][b][m][n] = (f32x4){0.f, 0.f, 0.f, 0.f};
    bf16x8 At[4][2], B0[2][2], B1[2][2];
    const char* cA = (const char*)g.A + (size_t)cur.pm * tstep; const char* cB = (const char*)g.Bt + (size_t)cur.pn * tstep;
    S.a_ready(cur);
    if constexpr (SP2) {
        PG8_STAGE(PG8_SB(0, 0), cB, voffB); PG8_STAGE(PG8_SB(0, 1), cB + hstep, voffB); PG8_STAGE(PG8_SA(0, 0), cA, voffA); PG8_STAGE(PG8_SA(0, 1), cA + hstep, voffA);
        if (wr == 1) PG8_BAR;
        PG8_WAIT_V(2); PG8_BAR;
        PG8_STAGE(PG8_SB(1, 0), cB + kstep, voffB); PG8_STAGE(PG8_SA(1, 0), cA + kstep, voffA); PG8_STAGE(PG8_SB(1, 1), cB + hstep + kstep, voffB);
        PG8_WAIT_V(6); PG8_BAR;
    } else {
        PG8_STAGE(PG8_SB(0, 0), cB, voffB); PG8_STAGE(PG8_SA(0, 0), cA, voffA); PG8_STAGE(PG8_SB(0, 1), cB + hstep, voffB); PG8_STAGE(PG8_SA(0, 1), cA + hstep, voffA);
        if (wr == 1) PG8_BAR;
        PG8_WAIT_V(4); PG8_BAR;
        PG8_STAGE(PG8_SB(1, 0), cB + kstep, voffB); PG8_STAGE(PG8_SA(1, 0), cA + kstep, voffA); PG8_STAGE(PG8_SB(1, 1), cB + hstep + kstep, voffB);
        PG8_WAIT_V(6); PG8_BAR;
    }
    for (;;) {
        const bool has_next = S.next(ui + 1, nxt);
        const char* nA = has_next ? (const char*)g.A + (size_t)nxt.pm * tstep : cA; const char* nB = has_next ? (const char*)g.Bt + (size_t)nxt.pn * tstep : cB;
        for (int t = 0; t < nt; t += 2) {
            const bool last = (t == nt - 2);
            const char* a1 = cA + (size_t)(t + 1) * kstep;
            const char* a2 = last ? nA : cA + (size_t)(t + 2) * kstep; const char* b2 = last ? nB : cB + (size_t)(t + 2) * kstep;
            const char* a3 = a2 + kstep; const char* b3 = b2 + kstep;
            if (last && has_next) S.a_ready(nxt);
            if constexpr (SP2) {
            PG8_LDB(B0, 0, 0); PG8_LDB(B1, 0, 1); PG8_SCHED; PG8_LDA(At, 0, 0); PG8_STAGE(PG8_SA(1, 1), a1 + hstep, voffA);
            PG8_WAIT_V(8); PG8_WAIT_L(0); PG8_BAR; PG8_MMA(0, 0, At, B0); PG8_MMA(0, 1, At, B1); PG8_BAR; PG8_SCHED;
            PG8_LDA(At, 0, 1); PG8_STAGE(PG8_SB(0, 0), b2, voffB); PG8_STAGE(PG8_SB(0, 1), b2 + hstep, voffB); PG8_STAGE(PG8_SA(0, 0), a2, voffA);
            PG8_WAIT_V(8); PG8_WAIT_L(0); PG8_BAR; PG8_MMA(1, 0, At, B0); PG8_MMA(1, 1, At, B1); PG8_BAR; PG8_SCHED;
            PG8_LDB(B0, 1, 0); PG8_LDB(B1, 1, 1); PG8_SCHED; PG8_LDA(At, 1, 0); PG8_STAGE(PG8_SA(0, 1), a2 + hstep, voffA);
            PG8_WAIT_V(8); PG8_WAIT_L(0); PG8_BAR; PG8_MMA(0, 0, At, B0); PG8_MMA(0, 1, At, B1); PG8_BAR; PG8_SCHED;
            PG8_LDA(At, 1, 1); PG8_STAGE(PG8_SB(1, 0), b3, voffB); PG8_STAGE(PG8_SB(1, 1), b3 + hstep, voffB); PG8_STAGE(PG8_SA(1, 0), a3, voffA);
            PG8_WAIT_V(8); PG8_WAIT_L(0); PG8_BAR; PG8_MMA(1, 0, At, B0); PG8_MMA(1, 1, At, B1); PG8_BAR; PG8_SCHED;
            } else {
            PG8_LDB(B0, 0, 0); PG8_SCHED; PG8_LDA(At, 0, 0); PG8_STAGE(PG8_SA(1, 1), a1 + hstep, voffA);
            PG8_WAIT_L(8); PG8_BAR; PG8_WAIT_L(0); PG8_MMA(0, 0, At, B0); PG8_BAR; PG8_SCHED;
            PG8_LDB(B1, 0, 1); PG8_STAGE(PG8_SB(0, 0), b2, voffB);
            PG8_BAR; PG8_WAIT_L(0); PG8_MMA(0, 1, At, B1); PG8_BAR;
            PG8_LDA(At, 0, 1); PG8_STAGE(PG8_SA(0, 0), a2, voffA);
            PG8_BAR; PG8_WAIT_L(0); PG8_MMA(1, 0, At, B0); PG8_BAR; PG8_SCHED;
            PG8_STAGE(PG8_SB(0, 1), b2 + hstep, voffB);
            PG8_WAIT_V(6); PG8_BAR; PG8_MMA(1, 1, At, B1); PG8_BAR;
            PG8_LDB(B0, 1, 0); PG8_SCHED; PG8_LDA(At, 1, 0); PG8_STAGE(PG8_SA(0, 1), a2 + hstep, voffA);
            PG8_WAIT_L(8); PG8_BAR; PG8_WAIT_L(0); PG8_MMA(0, 0, At, B0); PG8_BAR; PG8_SCHED;
            PG8_LDB(B1, 1, 1); PG8_STAGE(PG8_SB(1, 0), b3, voffB);
            PG8_BAR; PG8_WAIT_L(0); PG8_MMA(0, 1, At, B1); PG8_BAR;
            PG8_LDA(At, 1, 1); PG8_STAGE(PG8_SA(1, 0), a3, voffA);
            PG8_BAR; PG8_WAIT_L(0); PG8_MMA(1, 0, At, B0); PG8_BAR; PG8_SCHED;
            PG8_STAGE(PG8_SB(1, 1), b3 + hstep, voffB);
            PG8_WAIT_V(6); PG8_BAR; PG8_MMA(1, 1, At, B1); PG8_BAR;
            }
        }
        if constexpr (ALIGN_EPI) { if (wr == 0) PG8_BAR; }
        if constexpr (!Epi::AFTER_DRAIN) { E(acc, cur, wr, wc, fr, fq); S.done(cur); }
        if (!has_next) break;
#pragma unroll
        for (int a = 0; a < 2; ++a)
#pragma unroll
            for (int b = 0; b < 2; ++b)
#pragma unroll
                for (int m = 0; m < 4; ++m)
#pragma unroll
                    for (int n = 0; n < 2; ++n) acc[a][b][m][n] = (f32x4){0.f, 0.f, 0.f, 0.f};
        cur = nxt; cA = nA; cB = nB; ++ui;
        if constexpr (ALIGN_EPI) { if (wr == 1) PG8_BAR; }
    }
    PG8_WAIT_V(0);
    if constexpr (!ALIGN_EPI) { if (wr == 0) PG8_BAR; }
    PG8_BAR;
    if constexpr (Epi::AFTER_DRAIN) { E.fused(acc, cur, wr, wc, fr, fq, lds, wid, lane); S.done(cur); }
#undef PG8_SA
#undef PG8_SB
#undef PG8_STAGE
#undef PG8_LDA
#undef PG8_LDB
#undef PG8_MMA
#undef PG8_WAIT_V
#undef PG8_WAIT_L
#undef PG8_BAR
#undef PG8_SCHED
}
}

__device__ __forceinline__ void lru_unit(const Params& p, char* smem, int c, int b) {
    int tid_ = threadIdx.x; asm volatile("" : "+v"(tid_));
    const int tid = tid_, lane = tid & 63, wave = __builtin_amdgcn_readfirstlane(tid >> 6);
    char* ws = p.ws;
    const bf16_t* P = (const bf16_t*)(ws + OFF_P);
    const bf16_t* WAT = (const bf16_t*)(ws + OFF_WAT); const bf16_t* WXT = (const bf16_t*)(ws + OFF_WXT);
    float* sumA = (float*)(ws + OFF_SUMA); float* sumH = (float*)(ws + OFF_SUMH);
    const float* lp = (const float*)(smem + PRM_LRU);
    bf16_t* AC = (bf16_t*)(ws + OFF_AC); bf16_t* HL = (bf16_t*)(ws + OFF_HL);
    bf16_t* Xc = (bf16_t*)smem;
    float* Z0 = (float*)(smem + 9216);
    float* Z1 = Z0 + 64 * LF;
    float* SegA = Z1 + 64 * LF;
    float* SegH = SegA + 512;
    const int t = tid >> 3, c8 = tid & 7;
    const int pos0 = c == 0 ? 0 : NMETA + 64 * (c - 1);
    const int pos = pos0 + t;
    const bool valid = (c > 0) || (t < NMETA);
    const int row = row_of(b, valid ? pos : 0);
    const int grp = wave >> 2, qm = (wave >> 1) & 1, qn = wave & 1;
    const int r = lane & 31, hh2 = lane >> 5;
    u32x4 nx[4]; bf16x8 nb[4];
    auto fetch = [&](int hd) {
        const int ch0 = hd * 64 + c8 * 8;
#pragma unroll
        for (int d = 0; d < 4; ++d) {
            const int pp = pos - 3 + d;
            u32x4 z; z[0] = 0; z[1] = 0; z[2] = 0; z[3] = 0;
            nx[d] = (valid && pp >= 0) ? *(const u32x4*)(P + (size_t)row_of(b, pp) * DIN + ch0) : z;
        }
        const bf16_t* bp = (grp == 0 ? WAT : WXT) + hd * 4096 + (size_t)(qn * 32 + r) * 64 + hh2 * 8;
#pragma unroll
        for (int ks = 0; ks < 4; ++ks) nb[ks] = *(const bf16x8*)(bp + ks * 16);
    };
    fetch(0);
#pragma unroll 1
    for (int hd = 0; hd < 8; ++hd) {
        const int ch0 = hd * 64 + c8 * 8;
        float xc[8];
        u32x4 cx[4]; bf16x8 cb[4];
#pragma unroll
        for (int d = 0; d < 4; ++d) { cx[d] = nx[d]; cb[d] = nb[d]; }
        if (hd < 7) fetch(hd + 1);
        {
            f32x4 b0 = *(const f32x4*)(lp + 1536 + ch0), b1 = *(const f32x4*)(lp + 1536 + ch0 + 4);
            xc[0] = b0[0]; xc[1] = b0[1]; xc[2] = b0[2]; xc[3] = b0[3]; xc[4] = b1[0]; xc[5] = b1[1]; xc[6] = b1[2]; xc[7] = b1[3];
#pragma unroll
            for (int d = 0; d < 4; ++d) {
                float xv[8]; unpack8(cx[d], xv);
                f32x4 w0 = *(const f32x4*)(lp + 2048 + d * 512 + ch0), w1 = *(const f32x4*)(lp + 2048 + d * 512 + ch0 + 4);
                xc[0] += w0[0] * xv[0]; xc[1] += w0[1] * xv[1]; xc[2] += w0[2] * xv[2]; xc[3] += w0[3] * xv[3];
                xc[4] += w1[0] * xv[4]; xc[5] += w1[1] * xv[5]; xc[6] += w1[2] * xv[6]; xc[7] += w1[3] * xv[7];
            }
            *(u32x4*)(Xc + t * LD + c8 * 8) = pack8(xc);
        }
        __syncthreads();
        {
            f32x16 acc = zero16();
            const bf16_t* ap = Xc + (qm * 32 + r) * LD + hh2 * 8;
#pragma unroll
            for (int ks = 0; ks < 4; ++ks) { bf16x8 av_ = *(const bf16x8*)(ap + ks * 16); acc = MFMA32(av_, cb[ks], acc); }
            store_N_f32(grp == 0 ? Z0 : Z1, acc, qm, qn, lane);
        }
        __syncthreads();
        {
            float za[8], zx[8];
            *(f32x4*)za = *(const f32x4*)(Z0 + t * LF + c8 * 8); *(f32x4*)(za + 4) = *(const f32x4*)(Z0 + t * LF + c8 * 8 + 4);
            *(f32x4*)zx = *(const f32x4*)(Z1 + t * LF + c8 * 8); *(f32x4*)(zx + 4) = *(const f32x4*)(Z1 + t * LF + c8 * 8 + 4);
            float av[8], bv[8];
#pragma unroll
            for (int i = 0; i < 8; ++i) {
                const int ch = ch0 + i;
                const float rg = sigmoidf_(za[i] + lp[ch]), ig = sigmoidf_(zx[i] + lp[512 + ch]);
                const float a = __expf(-8.0f * rg * lp[1024 + ch]);
                const float bb = sqrtf(fmaxf(1.0f - a * a, 0.f)) * ig * xc[i];
                av[i] = valid ? a : 1.0f; bv[i] = valid ? bb : 0.f;
            }
            *(f32x4*)(Z0 + t * LF + c8 * 8) = *(f32x4*)av; *(f32x4*)(Z0 + t * LF + c8 * 8 + 4) = *(f32x4*)(av + 4);
            *(f32x4*)(Z1 + t * LF + c8 * 8) = *(f32x4*)bv; *(f32x4*)(Z1 + t * LF + c8 * 8 + 4) = *(f32x4*)(bv + 4);
        }
        __syncthreads();
        const int sch = tid & 63, seg = tid >> 6;
        {
            float Ac = 1.f, hh = 0.f;
#pragma unroll
            for (int k = 0; k < 8; ++k) {
                const int tt = seg * 8 + k;
                const float a = Z0[tt * LF + sch], bb = Z1[tt * LF + sch];
                hh = a * hh + bb; Ac *= a;
                Z0[tt * LF + sch] = Ac; Z1[tt * LF + sch] = hh;
            }
            SegA[seg * 64 + sch] = Ac; SegH[seg * 64 + sch] = hh;
        }
        __syncthreads();
        {
            float hin = 0.f, Ain = 1.f;
            for (int s2 = 0; s2 < seg; ++s2) { hin = SegA[s2 * 64 + sch] * hin + SegH[s2 * 64 + sch]; Ain *= SegA[s2 * 64 + sch]; }
#pragma unroll
            for (int k = 0; k < 8; ++k) {
                const int tt = seg * 8 + k;
                const float a = Z0[tt * LF + sch];
                Z1[tt * LF + sch] += a * hin; Z0[tt * LF + sch] = a * Ain;
            }
            if (seg == 7) {
                sumA[((size_t)c * 2 + b) * 512 + hd * 64 + sch] = Z0[63 * LF + sch];
                sumH[((size_t)c * 2 + b) * 512 + hd * 64 + sch] = Z1[63 * LF + sch];
            }
        }
        __syncthreads();
        if (c > 0) {
            float a8[8], h8[8];
            *(f32x4*)a8 = *(const f32x4*)(Z0 + t * LF + c8 * 8); *(f32x4*)(a8 + 4) = *(const f32x4*)(Z0 + t * LF + c8 * 8 + 4);
            *(f32x4*)h8 = *(const f32x4*)(Z1 + t * LF + c8 * 8); *(f32x4*)(h8 + 4) = *(const f32x4*)(Z1 + t * LF + c8 * 8 + 4);
            *(u32x4*)(AC + (size_t)row * 512 + ch0) = pack8(a8);
            *(u32x4*)(HL + (size_t)row * 512 + ch0) = pack8(h8);
        }
        __syncthreads();
    }
}
__device__ __forceinline__ void lru_out(const Params& p, char* smem, int c, int b) {
    int tid_ = threadIdx.x; asm volatile("" : "+v"(tid_));
    const int tid = tid_;
    char* ws = p.ws;
    const bf16_t* P = (const bf16_t*)(ws + OFF_P);
    const bf16_t* AC = (const bf16_t*)(ws + OFF_AC); const bf16_t* HL = (const bf16_t*)(ws + OFF_HL);
    float* HS = (float*)smem;
    bf16_t* Y = (bf16_t*)(ws + OFF_XN);
    {
        const float* sumA = (const float*)(ws + OFF_SUMA); const float* sumH = (const float*)(ws + OFF_SUMH);
        float hcur = sumH[tid];
#pragma unroll 1
        for (int c0 = 1; c0 < c; c0 += 32) {
            float av[32], hv[32];
#pragma unroll
            for (int k = 0; k < 32; ++k) { const int cc = min(c0 + k, NCHUNK - 1); av[k] = sumA[((size_t)cc * 2 + b) * 512 + tid]; hv[k] = sumH[((size_t)cc * 2 + b) * 512 + tid]; }
            asm volatile("" : "+v"(hcur) :: "memory");
#pragma unroll
            for (int k = 0; k < 32; ++k) { if (c0 + k < c) hcur = av[k] * hcur + hv[k]; }
        }
        __syncthreads();
        HS[tid] = hcur;
        __syncthreads();
    }
    const int t = tid >> 3, c8 = tid & 7;
    const int row = b * T_SEQ + 64 * (c - 1) + t;
    u32x4 yp[8];
    float ssq = 0.f;
#pragma unroll
    for (int hd = 0; hd < 8; ++hd) {
        const int ch0 = hd * 64 + c8 * 8;
        float a8[8], h8[8], g8[8], yv[8];
        unpack8(*(const u32x4*)(AC + (size_t)row * 512 + ch0), a8);
        unpack8(*(const u32x4*)(HL + (size_t)row * 512 + ch0), h8);
        unpack8(*(const u32x4*)(P + (size_t)row * DIN + 512 + ch0), g8);
        f32x4 s0 = *(const f32x4*)(HS + ch0), s1 = *(const f32x4*)(HS + ch0 + 4);
        const float hs[8] = {s0[0], s0[1], s0[2], s0[3], s1[0], s1[1], s1[2], s1[3]};
#pragma unroll
        for (int i = 0; i < 8; ++i) { yv[i] = (h8[i] + a8[i] * hs[i]) * gelu_tanh(g8[i]); ssq += yv[i] * yv[i]; }
        yp[hd] = pack8(yv);
    }
    ssq = sum8(ssq);
    const float rs = rsqrtf(ssq * (1.0f / 512.0f) + 1e-6f);
#pragma unroll
    for (int hd = 0; hd < 8; ++hd) {
        const int ch0 = hd * 64 + c8 * 8;
        float yv[8]; unpack8(yp[hd], yv);
        f32x4 g0 = *(const f32x4*)(p.lru_gain + ch0), g1 = *(const f32x4*)(p.lru_gain + ch0 + 4);
        yv[0] *= rs * g0[0]; yv[1] *= rs * g0[1]; yv[2] *= rs * g0[2]; yv[3] *= rs * g0[3];
        yv[4] *= rs * g1[0]; yv[5] *= rs * g1[1]; yv[6] *= rs * g1[2]; yv[7] *= rs * g1[3];
        *(u32x4*)(Y + (size_t)row * DM + ch0) = pack8(yv);
    }
    __syncthreads();
}

__device__ __forceinline__ float tanh_fast(float x) { return 1.0f - 2.0f / (__expf(2.0f * x) + 1.0f); }
struct S0Pre { u32x4 cur[5], prv[5]; };
__device__ __forceinline__ void s0_fetch(const Params& p, int c, int b, int hh, int tid, S0Pre& o) {
    const bf16_t* P = (const bf16_t*)(p.ws + OFF_P);
    const int t = tid >> 3, c8 = tid & 7;
    const int pos = (c == 0 ? 0 : NMETA + 64 * (c - 1)) + t;
    const bool valid = (c > 0) || (t < NMETA);
    const bool hasprev = valid && pos > 0;
    const bf16_t* pr = P + (size_t)row_of(b, valid ? pos : 0) * DIN;
    const bf16_t* pp = P + (size_t)row_of(b, hasprev ? pos - 1 : 0) * DIN;
    const int hc0 = hh * 64 + c8 * 8;
    const int cols[5] = {1024 + hc0, 1536 + hc0, 2048 + hc0, 2560 + c8 * 8, 2624 + c8 * 8};
#pragma unroll
    for (int i = 0; i < 5; ++i) { o.cur[i] = *(const u32x4*)(pr + cols[i]); o.prv[i] = *(const u32x4*)(pp + cols[i]); }
}
__device__ __forceinline__ void rwkv_unit(const Params& p, char* smem, int c, int b, int hh, unsigned long long& tacc, S0Pre& pre, bool has_next, int nc, int nb_, int nh) {
#define TT(k) if (TSSTAGE >= 0) { if ((k) == TSSTAGE) tacc -= __builtin_amdgcn_s_memrealtime(); if ((k) == TSSTAGE + 1) tacc += __builtin_amdgcn_s_memrealtime(); }
    TT(0)
    int tid_ = threadIdx.x; asm volatile("" : "+v"(tid_));
    const int tid = tid_, lane = tid & 63, wave = __builtin_amdgcn_readfirstlane(tid >> 6);
    char* ws = p.ws;
    const bf16_t* P = (const bf16_t*)(ws + OFF_P);
    bf16_t* S0 = (bf16_t*)smem;
#define SL(i) (S0 + (i) * SLOT)
    float* F0 = (float*)(smem + 14 * SLOT * 2);
    float* Seg = F0 + 64 * LF;
    float* GC = Seg + 512;
    float* FZa = (float*)SL(2);
    float* FZg = (float*)SL(4);
    const float* prm = (const float*)(smem + PRM_RWKV);
    bf16_t *sLw = SL(0), *sAabb = SL(0), *sLg0 = SL(0);
    bf16_t *sLa = SL(1), *sAak = SL(1), *sLg1 = SL(1);
    bf16_t *sBtT = SL(2), *sKtT = SL(3);
    bf16_t *sAt = SL(4), *sAtT = SL(5);
    bf16_t *sBh = SL(6), *sD0T = SL(6), *sW1T = SL(6);
    bf16_t *sKh = SL(7), *sM1T = SL(7), *sW2T = SL(7);
    bf16_t *sRt = SL(8), *sVT = SL(9), *sTm = SL(10), *sY2T = SL(11), *sArb = SL(12), *sArk = SL(13);
    const int t = tid >> 3, c8 = tid & 7;
    const int pos0 = c == 0 ? 0 : NMETA + 64 * (c - 1);
    const int pos = pos0 + t;
    const bool valid = (c > 0) || (t < NMETA);
    const int row = row_of(b, valid ? pos : 0);
    const int grp = wave >> 2, qm = (wave >> 1) & 1, qn = wave & 1, r = lane & 31, h = lane >> 5;
    const int hc0 = hh * 64 + c8 * 8;
    const int uidx = (b * 128 + (c - 1)) * 8 + hh;
    char* UD = c == 0 ? (ws + OFF_MPQ + (size_t)hh * 16384) : ((char*)p.out + (size_t)uidx * UNIT_BYTES);
    s0_fetch(p, c, b, hh, tid, pre);
    float rv[8], kv[8], vv[8];
    bf16x8 lorab[4];
    {
        const bf16_t* Bt = (const bf16_t*)(ws + (grp == 0 ? OFF_W2T : OFF_A2T)) + hh * 64 * 64 + (size_t)(qn * 32 + r) * 64 + h * 8;
#pragma unroll
        for (int ks = 0; ks < 4; ++ks) lorab[ks] = *(const bf16x8*)(Bt + ks * 16);
    }
    {
        const bool hasprev = valid && pos > 0;
        const int hcq = hc0, cols[5] = {1024 + hcq, 1536 + hcq, 2048 + hcq, 2560 + c8 * 8, 2624 + c8 * 8};
        auto sh8 = [&](int i, float* out) {
            float cur[8], prv[8];
            unpack8(pre.cur[i], cur); unpack8(pre.prv[i], prv);
            f32x4 m0 = *(const f32x4*)(p.mu + cols[i] - 1024), m1 = *(const f32x4*)(p.mu + cols[i] - 1024 + 4);
            float mm[8] = {m0[0], m0[1], m0[2], m0[3], m1[0], m1[1], m1[2], m1[3]};
#pragma unroll
            for (int k = 0; k < 8; ++k) out[k] = valid ? cur[k] + ((hasprev ? prv[k] : 0.f) - cur[k]) * mm[k] : 0.f;
        };
        sh8(0, rv); sh8(1, kv); sh8(2, vv);
        float wl[8], al[8];
        sh8(3, wl); sh8(4, al);
#pragma unroll
        for (int i = 0; i < 8; ++i) wl[i] = tanh_fast(wl[i]);
        *(u32x4*)(sLw + t * LD + c8 * 8) = pack8(wl);
        *(u32x4*)(sLa + t * LD + c8 * 8) = pack8(al);
    }
    __syncthreads();
    TT(1)
    {
        f32x16 acc = zero16();
        const bf16_t* ap = (grp == 0 ? sLw : sLa) + (qm * 32 + r) * LD + h * 8;
#pragma unroll
        for (int ks = 0; ks < 4; ++ks) { bf16x8 a_ = *(const bf16x8*)(ap + ks * 16); acc = MFMA32(a_, lorab[ks], acc); }
        store_N_f32(grp == 0 ? F0 : FZa, acc, qm, qn, lane);
    }
    __syncthreads();
    TT(2)
    float lw[8], av[8], kk[8], kt[8];
    float rk = 0.f;
    {
        float zw[8], za[8];
        *(f32x4*)zw = *(const f32x4*)(F0 + t * LF + c8 * 8); *(f32x4*)(zw + 4) = *(const f32x4*)(F0 + t * LF + c8 * 8 + 4);
        *(f32x4*)za = *(const f32x4*)(FZa + t * LF + c8 * 8); *(f32x4*)(za + 4) = *(const f32x4*)(FZa + t * LF + c8 * 8 + 4);
        float n2 = 0.f;
#pragma unroll
        for (int i = 0; i < 8; ++i) {
            const int ch = hc0 + i;
            lw[i] = valid ? -0.6065306597f * sigmoidf_(zw[i] + prm[ch]) : 0.f;
            av[i] = valid ? sigmoidf_(za[i] + prm[512 + ch]) : 0.f;
            kk[i] = kv[i] * prm[1024 + ch]; n2 += kk[i] * kk[i];
            kt[i] = kv[i] * (1.0f + (av[i] - 1.0f) * prm[1536 + ch]);
            rk += rv[i] * kt[i] * prm[2048 + ch];
        }
        n2 = sum8(n2); rk = sum8(rk);
        const float inv = 1.0f / fmaxf(sqrtf(n2), 1e-12f);
#pragma unroll
        for (int i = 0; i < 8; ++i) kk[i] *= inv;
        *(f32x4*)(F0 + t * LF + c8 * 8) = *(f32x4*)lw; *(f32x4*)(F0 + t * LF + c8 * 8 + 4) = *(f32x4*)(lw + 4);
    }
    __syncthreads();
    TT(3)
    {
        const int sch = tid & 63, seg = tid >> 6;
        float sacc = 0.f;
#pragma unroll
        for (int k = 0; k < 8; ++k) { const int tt = seg * 8 + k; sacc += F0[tt * LF + sch]; F0[tt * LF + sch] = sacc; }
        Seg[seg * 64 + sch] = sacc;
        __syncthreads();
        float pre = 0.f;
        for (int s2 = 0; s2 < seg; ++s2) pre += Seg[s2 * 64 + sch];
#pragma unroll
        for (int k = 0; k < 8; ++k) { const int tt = seg * 8 + k; F0[tt * LF + sch] += pre; }
        if (seg == 7) GC[sch] = sacc + pre;
    }
    __syncthreads();
    TT(4)
    {
        float g[8];
        *(f32x4*)g = *(const f32x4*)(F0 + t * LF + c8 * 8); *(f32x4*)(g + 4) = *(const f32x4*)(F0 + t * LF + c8 * 8 + 4);
        float at[8], bh[8], kh[8], rt[8], bt[8], ktt[8];
#pragma unroll
        for (int i = 0; i < 8; ++i) {
            const float gc = GC[c8 * 8 + i];
            const float em = __expf(-g[i]), ep = __expf(g[i]), epv = __expf(g[i] - lw[i]), ec = __expf(gc - g[i]);
            at[i] = -kk[i] * epv; bh[i] = kk[i] * av[i] * em; kh[i] = kt[i] * em; rt[i] = rv[i] * ep;
            bt[i] = kk[i] * av[i] * ec; ktt[i] = kt[i] * ec;
        }
        *(u32x4*)(sAt + t * LD + c8 * 8) = pack8(at);
        *(u32x4*)(sBh + t * LD + c8 * 8) = pack8(bh);
        *(u32x4*)(sKh + t * LD + c8 * 8) = pack8(kh);
        *(u32x4*)(sRt + t * LD + c8 * 8) = pack8(rt);
#pragma unroll
        for (int i = 0; i < 8; ++i) {
            const int tsw = (((t >> 3) ^ c8) << 3) | (t & 7);
            sAtT[(c8 * 8 + i) * LD + tsw] = f2bf(at[i]);
            sVT[(c8 * 8 + i) * LD + tsw] = f2bf(vv[i]);
            sBtT[(c8 * 8 + i) * LD + tsw] = f2bf(bt[i]);
            sKtT[(c8 * 8 + i) * LD + tsw] = f2bf(ktt[i]);
        }
    }
    __syncthreads();
    TT(5)
    f32x16 accQ = zero16();
    {
        f32x16 acc = zero16(), acc2 = zero16();
        acc = mm_lds<4>(sAt, grp == 0 ? sBh : sKh, qm, qn, lane, acc);
        acc2 = mm_lds<4>(sRt, grp == 0 ? sBh : sKh, qm, qn, lane, acc2);
#pragma unroll
        for (int reg = 0; reg < 16; ++reg) {
            const int tt = qm * 32 + (reg & 3) + 8 * (reg >> 2) + 4 * h, ss = qn * 32 + r;
            if (ss >= tt) acc[reg] = 0.f;
            if (ss > tt) acc2[reg] = 0.f;
        }
        if (grp == 0) accQ = mm_lds_s<4>(sKtT, sVT, qm, qn, lane, accQ, true, true);
        if (grp == 0) { store_N_f32(F0, acc, qm, qn, lane); store_N_bf16(sAabb, acc, qm, qn, lane); store_N_bf16(sArb, acc2, qm, qn, lane); }
        else { store_N_bf16(sAak, acc, qm, qn, lane); store_N_bf16(sArk, acc2, qm, qn, lane); }
    }
    __syncthreads();
    TT(6)
    if (wave == 0) {
        int lane2 = lane; asm volatile("" : "+v"(lane2));
        const int blk = lane2 >> 5, j = lane2 & 31;
        const float* Ab = F0 + (32 * blk) * LF + 32 * blk;
        float xs[32];
#pragma unroll
        for (int tt = 0; tt < 32; ++tt) {
            float sacc = (tt == j) ? 1.f : 0.f;
#pragma unroll
            for (int s2 = 0; s2 < tt; ++s2) sacc += Ab[tt * LF + s2] * xs[s2];
            xs[tt] = sacc;
        }
#pragma unroll
        for (int tt = 0; tt < 32; ++tt) sTm[(32 * blk + tt) * LD + 32 * blk + j] = f2bf(xs[tt]);
        if (blk == 0) {
#pragma unroll
            for (int q = 0; q < 4; ++q) *(u32x4*)(sD0T + j * LD + q * 8) = pack8(xs + q * 8);
        }
    } else if (wave == 1) {
        const int rr = lane >> 1, cc = 32 + (lane & 1) * 16;
        u32x4 z; z[0] = 0; z[1] = 0; z[2] = 0; z[3] = 0;
        *(u32x4*)(sTm + rr * LD + cc) = z; *(u32x4*)(sTm + rr * LD + cc + 8) = z;
    } else if (grp == 1) {
        f32x16 acc = zero16();
        acc = mm_lds_s<4>(sAak, sVT, qm, qn, lane, acc, false, true);
        store_T_bf16(sY2T, acc, qm, qn, lane);
    }
    __syncthreads();
    TT(7)
    if (wave == 0) {
        f32x16 acc = zero16();
        acc = mm_lds<2>(sAabb, sD0T, 1, 0, lane, acc);
        store_T_bf16(sM1T, acc, 0, 0, lane);
    }
    __syncthreads();
    TT(8)
    if (wave == 0) {
        f32x16 acc = zero16();
        const bf16_t* ap = sTm + (32 + r) * LD + 32 + h * 8;
        const bf16_t* bp = sM1T + r * LD + h * 8;
#pragma unroll
        for (int ks = 0; ks < 2; ++ks) { bf16x8 a = *(const bf16x8*)(ap + ks * 16), bb = *(const bf16x8*)(bp + ks * 16); acc = MFMA32(a, bb, acc); }
        store_N_bf16(sTm, acc, 1, 0, lane);
    }
    __syncthreads();
    TT(9)
    {
        u32x4 glc[2], glp[2];
        if (c > 0) {
            const bf16_t* pr = P + (size_t)row * DIN + 2688 + c8 * 16;
            const bf16_t* pp = P + (size_t)row_of(b, pos - 1) * DIN + 2688 + c8 * 16;
            glc[0] = *(const u32x4*)pr; glc[1] = *(const u32x4*)(pr + 8); glp[0] = *(const u32x4*)pp; glp[1] = *(const u32x4*)(pp + 8);
        }
        f32x16 acc = zero16();
        acc = mm_lds_s<4>(sTm, grp == 0 ? sAtT : sY2T, qm, qn, lane, acc, false, grp == 0);
        store_T_bf16(grp == 0 ? sW1T : sW2T, acc, qm, qn, lane);
        if (c > 0) {
            bf16_t* d = ((c8 < 4) ? sLg0 : sLg1) + t * LD + (c8 & 3) * 16;
#pragma unroll
            for (int hf = 0; hf < 2; ++hf) {
                float cur[8], prv[8], gg[8];
                unpack8(glc[hf], cur); unpack8(glp[hf], prv);
#pragma unroll
                for (int i = 0; i < 8; ++i) gg[i] = sigmoidf_(cur[i] + (prv[i] - cur[i]) * p.mu[1664 + c8 * 16 + hf * 8 + i]);
                *(u32x4*)(d + hf * 8) = pack8(gg);
            }
        }
    }
    __syncthreads();
    TT(10)
    if (grp == 0) {
        f32x16 acc = mm_lds_s<4>(sBtT, sW2T, qm, qn, lane, accQ, true, false);
        bf16_t* QC = (bf16_t*)(UD + 8192);
        const int v = qn * 32 + r;
#pragma unroll
        for (int g = 0; g < 4; ++g) {
            const int k = qm * 32 + 8 * g + 4 * h;
            u32x2 w; w[0] = pack2(acc[4 * g], acc[4 * g + 1]); w[1] = pack2(acc[4 * g + 2], acc[4 * g + 3]);
            *(u32x2*)(QC + (((v >> 4) * 2 + (k >> 5)) * 64 + ((k >> 2) & 3) * 16 + (v & 15)) * 8 + ((k >> 4) & 1) * 4) = w;
        }
        if (c > 0) {
            f32x16 ag = zero16();
            ag = mm_lds<4>(sArb, sW1T, qm, qn, lane, ag);
            bf16_t* Gg = (bf16_t*)(UD + 16384);
#pragma unroll
            for (int reg = 0; reg < 16; ++reg) {
                const int tt = qm * 32 + (reg & 3) + 8 * (reg >> 2) + 4 * h, k = qn * 32 + r;
                Gg[tt * 64 + (k >> 5) * 32 + ((k >> 2) & 3) * 8 + ((k >> 4) & 1) * 4 + (k & 3)] = f2bf(ag[reg] + bf2f(sRt[tt * LD + k]));
            }
            f32x16 accg = zero16();
            const bf16_t* G2T = (const bf16_t*)(ws + OFF_G2T) + (size_t)hh * 64 * 128;
            accg = mm_lds_g<4>(sLg0, G2T, 128, qm, qn, lane, accg);
            accg = mm_lds_g<4>(sLg1, G2T + 64, 128, qm, qn, lane, accg);
            store_N_f32(FZg, accg, qm, qn, lane);
        }
    } else {
        f32x16 acc = zero16();
        acc = mm_lds_s<4>(sBtT, sW1T, qm, qn, lane, acc, true, false);
        bf16_t* PA = (bf16_t*)UD;
        const int k2 = qn * 32 + r;
#pragma unroll
        for (int reg = 0; reg < 16; ++reg) {
            const int k1 = qm * 32 + (reg & 3) + 8 * (reg >> 2) + 4 * h;
            float vv2 = acc[reg];
            if (k1 == k2) vv2 += __expf(GC[k1]);
            PA[(((k1 >> 4) * 2 + (k2 >> 5)) * 64 + ((k2 >> 2) & 3) * 16 + (k1 & 15)) * 8 + ((k2 >> 4) & 1) * 4 + (k2 & 3)] = f2bf(vv2);
        }
        if (c > 0) {
            f32x16 ah = zero16();
            ah = mm_lds<4>(sArb, sW2T, qm, qn, lane, ah);
            ah = mm_lds_s<4>(sArk, sVT, qm, qn, lane, ah, false, true);
            bf16_t* HC = (bf16_t*)(UD + 24576) + ((qm * 2 + qn) * 64 + lane) * 16;
            float hf[16];
#pragma unroll
            for (int reg = 0; reg < 16; ++reg) hf[reg] = ah[reg];
            *(u32x4*)HC = pack8(hf); *(u32x4*)(HC + 8) = pack8(hf + 8);
        }
    }
    __syncthreads();
    TT(11)
    if (c > 0) {
        float zg[8], e1[8], e2[8];
        *(f32x4*)zg = *(const f32x4*)(FZg + t * LF + c8 * 8); *(f32x4*)(zg + 4) = *(const f32x4*)(FZg + t * LF + c8 * 8 + 4);
#pragma unroll
        for (int i = 0; i < 8; ++i) { const int ch = hc0 + i; e1[i] = zg[i] * prm[2560 + ch]; e2[i] = zg[i] * (prm[3072 + ch] + rk * vv[i]); }
        *(u32x4*)((bf16_t*)(ws + OFF_E1) + (size_t)row * 512 + hc0) = pack8(e1);
        *(u32x4*)((bf16_t*)(ws + OFF_E2) + (size_t)row * 512 + hc0) = pack8(e2);
    }
    __syncthreads();
    TT(12)
#undef SL
}

__device__ __forceinline__ void rwkv_out_pair(const Params& p, char* smem, int pair) {
    int tid_ = threadIdx.x; asm volatile("" : "+v"(tid_));
    const int tid = tid_, lane = tid & 63, wave = __builtin_amdgcn_readfirstlane(tid >> 6);
    char* ws = p.ws;
    const int su = wave >> 2, qm = (wave >> 1) & 1, qn = wave & 1, r = lane & 31, h = lane >> 5;
    float* Ob = (float*)smem;
    {
        const int uidx = pair * 2 + su;
        const char* UD = (const char*)p.out + (size_t)uidx * UNIT_BYTES;
        const bf16_t* Gg = (const bf16_t*)(UD + 16384) + (qm * 32 + r) * 64 + h * 8;
        const bf16_t* SB = (const bf16_t*)(ws + OFF_SB) + (size_t)uidx * 4096 + (qn * 32 + r) * 64 + h * 8;
        const bf16_t* HC = (const bf16_t*)(UD + 24576) + ((qm * 2 + qn) * 64 + lane) * 16;
        bf16x8 gf[4], sf[4];
#pragma unroll
        for (int ks = 0; ks < 4; ++ks) { gf[ks] = *(const bf16x8*)(Gg + ks * 16); sf[ks] = *(const bf16x8*)(SB + ks * 16); }
        float hf[16];
        unpack8(*(const u32x4*)HC, hf); unpack8(*(const u32x4*)(HC + 8), hf + 8);
        f32x16 acc;
#pragma unroll
        for (int i = 0; i < 16; ++i) acc[i] = hf[i];
#pragma unroll
        for (int ks = 0; ks < 4; ++ks) acc = MFMA32(gf[ks], sf[ks], acc);
        store_N_f32(Ob + su * 64 * LF, acc, qm, qn, lane);
    }
    __syncthreads();
    {
        const int su2 = tid >> 8, t = (tid >> 2) & 63, c16 = tid & 3;
        const int uidx = pair * 2 + su2;
        const int hh = uidx & 7, cm1 = (uidx >> 3) & 127, b = uidx >> 10;
        const int row = b * T_SEQ + 64 * cm1 + t;
        const float* orow = Ob + su2 * 64 * LF + t * LF + c16 * 16;
        float o[16];
#pragma unroll
        for (int q = 0; q < 4; ++q) *(f32x4*)(o + 4 * q) = *(const f32x4*)(orow + 4 * q);
        float sacc = 0.f;
#pragma unroll
        for (int i = 0; i < 16; ++i) sacc += o[i];
        sacc += __shfl_xor(sacc, 1); sacc += __shfl_xor(sacc, 2);
        const float mean = sacc * (1.0f / 64.0f);
        float q2 = 0.f;
#pragma unroll
        for (int i = 0; i < 16; ++i) { const float d = o[i] - mean; q2 += d * d; }
        q2 += __shfl_xor(q2, 1); q2 += __shfl_xor(q2, 2);
        const float rs = rsqrtf(q2 * (1.0f / 64.0f) + 64e-5f);
        const bf16_t* e1p = (const bf16_t*)(ws + OFF_E1) + (size_t)row * 512 + hh * 64 + c16 * 16;
        const bf16_t* e2p = (const bf16_t*)(ws + OFF_E2) + (size_t)row * 512 + hh * 64 + c16 * 16;
        bf16_t* yp = (bf16_t*)(ws + OFF_XN) + (size_t)row * DM + 512 + hh * 64 + c16 * 16;
#pragma unroll
        for (int hf2 = 0; hf2 < 2; ++hf2) {
            float e1[8], e2[8], yv[8];
            unpack8(*(const u32x4*)(e1p + hf2 * 8), e1); unpack8(*(const u32x4*)(e2p + hf2 * 8), e2);
#pragma unroll
            for (int i = 0; i < 8; ++i) yv[i] = (o[hf2 * 8 + i] - mean) * rs * e1[i] + e2[i];
            *(u32x4*)(yp + hf2 * 8) = pack8(yv);
        }
    }
    __syncthreads();
}

struct ChainOp { u32x4 pa[4][2]; u32x4 q[2]; };
template <int MODE>
__device__ __forceinline__ void chain_load(ChainOp& o, const Params& p, int b, int hh, int cg, int lane, int c_) {
    const int c = (MODE & 4) ? 9 : c_;
    const char* U = c == 0 ? (const char*)(p.ws + OFF_MPQ + (size_t)hh * 16384) : ((const char*)p.out + (size_t)((b * 128 + (c - 1)) * 8 + hh) * UNIT_BYTES);
#pragma unroll
    for (int m = 0; m < 4; ++m) {
        o.pa[m][0] = *(const u32x4*)(U + ((size_t)((m * 2 + 0) * 64 + lane)) * 16);
        o.pa[m][1] = *(const u32x4*)(U + ((size_t)((m * 2 + 1) * 64 + lane)) * 16);
    }
    o.q[0] = *(const u32x4*)(U + 8192 + ((size_t)((cg * 2 + 0) * 64 + lane)) * 16);
    o.q[1] = *(const u32x4*)(U + 8192 + ((size_t)((cg * 2 + 1) * 64 + lane)) * 16);
}
template <int MODE>
__device__ __forceinline__ void chain_step(const ChainOp& o, f32x4 (&st)[4], bf16_t* SBb, int cg, int lane, int c) {
    const int q = lane >> 4, vl = lane & 15;
    u32x4 b0, b1;
    b0[0] = pack2(st[0][0], st[0][1]); b0[1] = pack2(st[0][2], st[0][3]); b0[2] = pack2(st[1][0], st[1][1]); b0[3] = pack2(st[1][2], st[1][3]);
    b1[0] = pack2(st[2][0], st[2][1]); b1[1] = pack2(st[2][2], st[2][3]); b1[2] = pack2(st[3][0], st[3][1]); b1[3] = pack2(st[3][2], st[3][3]);
    if (!(MODE & 2)) {
        bf16_t* S = SBb + (size_t)(max(c - 1, 0) * 8) * 4096 + (cg * 16 + vl) * 64 + 8 * q;
        *(u32x4*)S = b0; *(u32x4*)(S + 32) = b1;
    }
    const bf16x8 B0 = __builtin_bit_cast(bf16x8, b0), B1 = __builtin_bit_cast(bf16x8, b1);
    f32x4 acc[4];
#pragma unroll
    for (int m = 0; m < 4; ++m) {
        const unsigned q0 = o.q[m >> 1][(m & 1) * 2], q1 = o.q[m >> 1][(m & 1) * 2 + 1];
        f32x4 qi = {bflo(q0), bfhi(q0), bflo(q1), bfhi(q1)};
        acc[m] = MFMA16(__builtin_bit_cast(bf16x8, o.pa[m][0]), B0, qi);
    }
#pragma unroll
    for (int m = 0; m < 4; ++m) acc[m] = MFMA16(__builtin_bit_cast(bf16x8, o.pa[m][1]), B1, acc[m]);
#pragma unroll
    for (int m = 0; m < 4; ++m) st[m] = acc[m];
}
template <int MODE>
__device__ __forceinline__ void rwkv_chain_wg(const Params& p, char* smem, int chain) {
    const int tid = threadIdx.x, lane = tid & 63, wave = __builtin_amdgcn_readfirstlane(tid >> 6);
    const int b = chain >> 3, hh = chain & 7;
    int* prog = (int*)smem;
#define LDS_LD(ptr) __hip_atomic_load((ptr), __ATOMIC_RELAXED, __HIP_MEMORY_SCOPE_WORKGROUP)
#define LDS_ST(ptr, v) __hip_atomic_store((ptr), (v), __ATOMIC_RELAXED, __HIP_MEMORY_SCOPE_WORKGROUP)
    if (tid == 0) *prog = -1;
    __syncthreads();
    if (wave < 4) {
        const int cg = wave;
        bf16_t* SBb = (bf16_t*)(p.ws + ((MODE & 1) ? OFF_XN : OFF_SB)) + (size_t)(b * 128 * 8 + hh) * 4096;
        f32x4 st[4];
#pragma unroll
        for (int m = 0; m < 4; ++m) st[m] = (f32x4){0.f, 0.f, 0.f, 0.f};
        ChainOp oA, oB, oC, oD;
        chain_load<MODE>(oA, p, b, hh, cg, lane, 0); chain_load<MODE>(oB, p, b, hh, cg, lane, 1);
        chain_load<MODE>(oC, p, b, hh, cg, lane, 2); chain_load<MODE>(oD, p, b, hh, cg, lane, 3);
#pragma unroll 1
        for (int c = 0; c < 128; c += 4) {
            chain_step<MODE>(oA, st, SBb, cg, lane, c);     chain_load<MODE>(oA, p, b, hh, cg, lane, c + 4);
            chain_step<MODE>(oB, st, SBb, cg, lane, c + 1); chain_load<MODE>(oB, p, b, hh, cg, lane, min(c + 5, NCHUNK - 1));
            chain_step<MODE>(oC, st, SBb, cg, lane, c + 2); chain_load<MODE>(oC, p, b, hh, cg, lane, min(c + 6, NCHUNK - 1));
            chain_step<MODE>(oD, st, SBb, cg, lane, c + 3); chain_load<MODE>(oD, p, b, hh, cg, lane, min(c + 7, NCHUNK - 1));
            if (wave == 0 && lane == 0) LDS_ST(prog, c + 3);
        }
        chain_step<MODE>(oA, st, SBb, cg, lane, 128);
        if (MODE & 2) { asm volatile("" :: "v"(st[0][0]), "v"(st[1][0]), "v"(st[2][0]), "v"(st[3][0])); }
    } else if (!(MODE & 8)) {
        const int w = wave - 4;
#pragma unroll 1
        for (int c0 = 4; c0 < NCHUNK; c0 += 8) {
            int spins = 0;
            while (c0 > LDS_LD(prog) + 40 && spins < (1 << 20)) { __builtin_amdgcn_s_sleep(2); ++spins; }
            unsigned acc = 0;
            u32x4 v[32];
#pragma unroll
            for (int k = 0; k < 8; ++k) {
                const int cp = min(c0 + k, NCHUNK - 1);
                const char* U = (const char*)p.out + (size_t)((b * 128 + (cp - 1)) * 8 + hh) * UNIT_BYTES + w * 4096;
#pragma unroll
                for (int i = 0; i < 4; ++i) v[k * 4 + i] = *(const u32x4*)(U + i * 1024 + lane * 16);
            }
#pragma unroll
            for (int k = 0; k < 32; ++k) acc ^= v[k][0];
            asm volatile("" :: "v"(acc));
        }
    }
}
__device__ __forceinline__ void lru_chain(const Params& p, int idx) {
    const int b = idx >> 9, ch = idx & 511;
    const float* __restrict__ sumA = (const float*)(p.ws + OFF_SUMA); const float* __restrict__ sumH = (const float*)(p.ws + OFF_SUMH);
    float* __restrict__ HS = (float*)(p.ws + OFF_HS);
    float hcur = sumH[ch];
    HS[(size_t)(0 * 2 + b) * 512 + ch] = 0.f;
#pragma unroll 1
    for (int c0 = 1; c0 < NCHUNK; c0 += 32) {
        float av[32], hv[32];
#pragma unroll
        for (int k = 0; k < 32; ++k) { av[k] = sumA[((size_t)(c0 + k) * 2 + b) * 512 + ch]; hv[k] = sumH[((size_t)(c0 + k) * 2 + b) * 512 + ch]; }
        asm volatile("" : "+v"(hcur) :: "memory");
#pragma unroll
        for (int k = 0; k < 32; ++k) { HS[((size_t)(c0 + k) * 2 + b) * 512 + ch] = hcur; hcur = av[k] * hcur + hv[k]; }
        asm volatile("" ::: "memory");
    }
}

#define KLD 136
__device__ __forceinline__ unsigned f2ord(float f) { const unsigned u = __float_as_uint(f); return (u & 0x80000000u) ? ~u : (u | 0x80000000u); }
__device__ __forceinline__ float ord2f(unsigned o) { const unsigned u = (o & 0x80000000u) ? (o & 0x7FFFFFFFu) : ~o; return __uint_as_float(u); }
#define CE(a, b) { const unsigned hi_ = max((a), (b)); (b) = min((a), (b)); (a) = hi_; }
__device__ __forceinline__ void ins16(unsigned (&L)[16], unsigned x) {
#pragma unroll
    for (int s = 0; s < 16; ++s) { const unsigned hi_ = max(L[s], x); x = min(L[s], x); L[s] = hi_; }
}
__device__ __forceinline__ void merge_pair16(unsigned (&L)[16]) {
    unsigned Pp[16];
#pragma unroll
    for (int s = 0; s < 16; ++s) Pp[s] = __shfl_xor(L[s], 32);
#pragma unroll
    for (int s = 0; s < 16; ++s) L[s] = max(L[s], Pp[15 - s]);
#pragma unroll
    for (int d = 8; d > 0; d >>= 1)
#pragma unroll
        for (int i = 0; i < 16; ++i) if ((i & d) == 0) CE(L[i], L[i + d]);
}

__device__ __forceinline__ void sort16_desc(unsigned (&T)[16]) {
#pragma unroll
    for (int k = 2; k <= 16; k <<= 1)
#pragma unroll
        for (int j = k >> 1; j > 0; j >>= 1)
#pragma unroll
            for (int i = 0; i < 16; ++i) {
                const int l = i ^ j;
                if (l > i) {
                    const unsigned hi_ = max(T[i], T[l]), lo_ = min(T[i], T[l]);
                    if ((i & k) == 0) { T[i] = hi_; T[l] = lo_; } else { T[i] = lo_; T[l] = hi_; }
                }
            }
}
__device__ __forceinline__ void merge16_desc(unsigned (&L)[16], const unsigned (&T)[16]) {
#pragma unroll
    for (int s = 0; s < 16; ++s) L[s] = max(L[s], T[15 - s]);
#pragma unroll
    for (int d = 8; d > 0; d >>= 1)
#pragma unroll
        for (int i = 0; i < 16; ++i) if ((i & d) == 0) CE(L[i], L[i + d]);
}
__device__ __forceinline__ void peer_topk_unit(const Params& p, char* smem, int tile, int head) {
    int tid_ = threadIdx.x; asm volatile("" : "+v"(tid_));
    const int tid = tid_, lane = tid & 63, wave = __builtin_amdgcn_readfirstlane(tid >> 6), r = lane & 31, h = lane >> 5;
    char* ws = p.ws;
    const bf16_t* KEYS = (const bf16_t*)(ws + OFF_KEYS) + (size_t)head * 2 * 128 * 128;
    const bf16_t* QN = (const bf16_t*)p.out;
    bf16_t* kl = (bf16_t*)smem;
    __syncthreads();
#pragma unroll
    for (int i = 0; i < 8; ++i) { const int q = tid + 512 * i, rowk = q >> 4, c16 = q & 15; *(u32x4*)(kl + rowk * KLD + c16 * 8) = *(const u32x4*)(KEYS + (size_t)rowk * 128 + c16 * 8); }
    __syncthreads();
    const int tok = tile * 256 + wave * 32 + r;
    const bf16_t* qrow = QN + (size_t)tok * 2048 + head * 256;
    float ssq = 0.f;
    unsigned L1[16], L2[16];
#pragma unroll
    for (int sub = 0; sub < 2; ++sub) {
        bf16x8 qf[8];
#pragma unroll
        for (int ks = 0; ks < 8; ++ks) {
            u32x4 qq = *(const u32x4*)(qrow + sub * 128 + ks * 16 + h * 8);
            float f[8]; unpack8(qq, f);
#pragma unroll
            for (int i = 0; i < 8; ++i) ssq += f[i] * f[i];
            qf[ks] = __builtin_bit_cast(bf16x8, qq);
        }
        unsigned (&L)[16] = sub == 0 ? L1 : L2;
#pragma unroll
        for (int s = 0; s < 16; ++s) L[s] = 0u;
#pragma unroll
        for (int mt = 0; mt < 4; ++mt) {
            f32x16 acc = zero16();
            const bf16_t* ap = kl + (sub * 128 + mt * 32 + r) * KLD + h * 8;
#pragma unroll
            for (int ks = 0; ks < 8; ++ks) { bf16x8 a = *(const bf16x8*)(ap + ks * 16); acc = MFMA32(a, qf[ks], acc); }
            unsigned T[16];
#pragma unroll
            for (int reg = 0; reg < 16; ++reg) {
                const int key = mt * 32 + (reg & 3) + 8 * (reg >> 2) + 4 * h;
                T[reg] = (f2ord(acc[reg]) & ~127u) | (unsigned)(127 - key);
            }
            sort16_desc(T);
            if (mt == 0) {
#pragma unroll
                for (int s2 = 0; s2 < 16; ++s2) L[s2] = T[s2];
            } else merge16_desc(L, T);
        }
        merge_pair16(L);
    }
    ssq += __shfl_xor(ssq, 32);
    const float rstd2 = rsqrtf(((const float*)(ws + OFF_SSQ))[tok] * (1.0f / DM) + 1e-6f);
    const float scale = rstd2 * rsqrtf(rstd2 * rstd2 * ssq * (1.0f / 256.0f) + 1e-6f);
    float v1[16], v2[16];
#pragma unroll
    for (int s = 0; s < 16; ++s) { v1[s] = ord2f(L1[s] & ~127u); v2[s] = ord2f(L2[s] & ~127u); }
    unsigned F[16];
#pragma unroll
    for (int s = 0; s < 16; ++s) F[s] = 0u;
    {
        int cnt = 0;
        unsigned pend = 0u;
#pragma unroll
        for (int i = 0; i < 16; ++i)
#pragma unroll
            for (int j = 0; j < 16; ++j) {
                if ((i + 1) * (j + 1) > 16) continue;
                const unsigned e = ((127u - (L1[i] & 127u)) << 7) | (127u - (L2[j] & 127u));
                const unsigned x = (f2ord(v1[i] + v2[j]) & ~16383u) | e;
                if ((cnt & 1) == 0) pend = x;
                else { const unsigned mine = h ? x : pend; ins16(F, mine); }
                ++cnt;
            }
    }
    merge_pair16(F);
    float sc[16], mx, sum = 0.f;
#pragma unroll
    for (int s = 0; s < 16; ++s) sc[s] = ord2f(F[s] & ~16383u) * scale;
    mx = sc[0];
#pragma unroll
    for (int s = 0; s < 16; ++s) { sc[s] = __expf(sc[s] - mx); sum += sc[s]; }
    const float inv = 1.0f / sum;
    unsigned short* EI = (unsigned short*)(ws + OFF_EIDX) + ((size_t)tok * 8 + head) * 16;
    float* GT = (float*)(ws + OFF_GATE) + ((size_t)tok * 8 + head) * 16;
    if (h == 0) {
        u32x4 w0, w1;
#pragma unroll
        for (int s = 0; s < 4; ++s) { w0[s] = (F[2 * s] & 16383u) | ((F[2 * s + 1] & 16383u) << 16); w1[s] = (F[8 + 2 * s] & 16383u) | ((F[8 + 2 * s + 1] & 16383u) << 16); }
        *(u32x4*)EI = w0; *(u32x4*)(EI + 8) = w1;
        *(f32x4*)GT = (f32x4){sc[0] * inv, sc[1] * inv, sc[2] * inv, sc[3] * inv};
        *(f32x4*)(GT + 4) = (f32x4){sc[4] * inv, sc[5] * inv, sc[6] * inv, sc[7] * inv};
    } else {
        *(f32x4*)(GT + 8) = (f32x4){sc[8] * inv, sc[9] * inv, sc[10] * inv, sc[11] * inv};
        *(f32x4*)(GT + 12) = (f32x4){sc[12] * inv, sc[13] * inv, sc[14] * inv, sc[15] * inv};
    }
}

__device__ __forceinline__ void peer_token(const Params& p, float* coefl, int tok, int lane, bool with_peer) {
    char* ws = p.ws;
    const bf16_t* H1 = (const bf16_t*)(ws + OFF_H1B) + (size_t)tok * DM;
    u32x4 hx0 = *(const u32x4*)(H1 + lane * 16), hx1 = *(const u32x4*)(H1 + lane * 16 + 8);
    float y[16];
#pragma unroll
    for (int i = 0; i < 16; ++i) y[i] = 0.f;
    if (with_peer) {
        const float rstd2 = rsqrtf(((const float*)(ws + OFF_SSQ))[tok] * (1.0f / DM) + 1e-6f);
        const unsigned short* EI = (const unsigned short*)(ws + OFF_EIDX) + (size_t)tok * 128;
        const float* GT = (const float*)(ws + OFF_GATE) + (size_t)tok * 128;
        const int e0 = EI[lane], e1 = EI[lane + 64];
        const float g0 = GT[lane], g1 = GT[lane + 64];
        const unsigned char* UB = (const unsigned char*)(ws + OFF_UB); const unsigned char* VB = (const unsigned char*)(ws + OFF_VB);
        const float su0 = ((const float*)(ws + OFF_SU))[e0], su1 = ((const float*)(ws + OFF_SU))[e1];
        const float sv0 = ((const float*)(ws + OFF_SV))[e0], sv1 = ((const float*)(ws + OFF_SV))[e1];
        float xf[16];
        unpack8(hx0, xf); unpack8(hx1, xf + 8);
        f32x2 xf2[8];
#pragma unroll
        for (int i = 0; i < 8; ++i) { xf2[i][0] = xf[2 * i]; xf2[i][1] = xf[2 * i + 1]; }
        float hid0 = 0.f, hid1 = 0.f;
#pragma unroll 1
        for (int half = 0; half < 2; ++half) {
            const int ev = half ? e1 : e0;
#pragma unroll 1
            for (int bb = 0; bb < 4; ++bb) {
                u32x2 ua[16];
#pragma unroll
                for (int k = 0; k < 16; ++k) {
                    const int e = __builtin_amdgcn_readlane(ev, bb * 16 + k);
                    ua[k] = *(const u32x2*)(UB + (size_t)e * (DM / 2) + lane * 8);
                }
                float part[16];
#pragma unroll
                for (int k = 0; k < 16; ++k) {
                    f32x2 s2 = {0.f, 0.f};
#pragma unroll
                    for (int i = 0; i < 2; ++i) {
                        const unsigned w = ua[k][i];
                        s2 = __builtin_elementwise_fma(__builtin_amdgcn_cvt_scalef32_pk_f32_fp4(w, 1.0f, 0), xf2[4 * i], s2);
                        s2 = __builtin_elementwise_fma(__builtin_amdgcn_cvt_scalef32_pk_f32_fp4(w, 1.0f, 1), xf2[4 * i + 1], s2);
                        s2 = __builtin_elementwise_fma(__builtin_amdgcn_cvt_scalef32_pk_f32_fp4(w, 1.0f, 2), xf2[4 * i + 2], s2);
                        s2 = __builtin_elementwise_fma(__builtin_amdgcn_cvt_scalef32_pk_f32_fp4(w, 1.0f, 3), xf2[4 * i + 3], s2);
                    }
                    part[k] = s2[0] + s2[1];
                }
#pragma unroll
                for (int k = 0; k < 8; ++k) { const float send = (lane & 32) ? part[k] : part[k + 8]; const float keep = (lane & 32) ? part[k + 8] : part[k]; part[k] = keep + __shfl_xor(send, 32); }
#pragma unroll
                for (int k = 0; k < 4; ++k) { const float send = (lane & 16) ? part[k] : part[k + 4]; const float keep = (lane & 16) ? part[k + 4] : part[k]; part[k] = keep + __shfl_xor(send, 16); }
#pragma unroll
                for (int k = 0; k < 2; ++k) { const float send = (lane & 8) ? part[k] : part[k + 2]; const float keep = (lane & 8) ? part[k + 2] : part[k]; part[k] = keep + __shfl_xor(send, 8); }
                { const float send = (lane & 4) ? part[0] : part[1]; const float keep = (lane & 4) ? part[1] : part[0]; part[0] = keep + __shfl_xor(send, 4); }
                part[0] += __shfl_xor(part[0], 1); part[0] += __shfl_xor(part[0], 2);
                const int vi = ((lane >> 5) & 1) * 8 + ((lane >> 4) & 1) * 4 + ((lane >> 3) & 1) * 2 + ((lane >> 2) & 1);
                if ((lane & 3) == 0) coefl[half * 64 + bb * 16 + vi] = part[0];
            }
        }
        __builtin_amdgcn_s_waitcnt(0xc07f);
        __builtin_amdgcn_wave_barrier();
        hid0 = coefl[lane]; hid1 = coefl[lane + 64];
        __builtin_amdgcn_wave_barrier();
        coefl[lane] = g0 * gelu_erf(hid0 * rstd2 * su0) * sv0;
        coefl[lane + 64] = g1 * gelu_erf(hid1 * rstd2 * su1) * sv1;
        __builtin_amdgcn_s_waitcnt(0xc07f);
        __builtin_amdgcn_wave_barrier();
#pragma unroll 1
        for (int half = 0; half < 2; ++half) {
            const int ev = half ? e1 : e0;
#pragma unroll 1
            for (int bb = 0; bb < 4; ++bb) {
                u32x2 va[16];
#pragma unroll
                for (int k = 0; k < 16; ++k) {
                    const int e = __builtin_amdgcn_readlane(ev, bb * 16 + k);
                    va[k] = *(const u32x2*)(VB + (size_t)e * (DM / 2) + lane * 8);
                }
#pragma unroll
                for (int k = 0; k < 16; ++k) {
                    const float cf = coefl[half * 64 + bb * 16 + k];
#pragma unroll
                    for (int i = 0; i < 2; ++i) {
                        const unsigned w = va[k][i];
                        const f32x2 a0 = __builtin_amdgcn_cvt_scalef32_pk_f32_fp4(w, 1.0f, 0), a1 = __builtin_amdgcn_cvt_scalef32_pk_f32_fp4(w, 1.0f, 1);
                        const f32x2 a2 = __builtin_amdgcn_cvt_scalef32_pk_f32_fp4(w, 1.0f, 2), a3 = __builtin_amdgcn_cvt_scalef32_pk_f32_fp4(w, 1.0f, 3);
                        y[8 * i] += cf * a0[0]; y[8 * i + 1] += cf * a0[1]; y[8 * i + 2] += cf * a1[0]; y[8 * i + 3] += cf * a1[1];
                        y[8 * i + 4] += cf * a2[0]; y[8 * i + 5] += cf * a2[1]; y[8 * i + 6] += cf * a3[0]; y[8 * i + 7] += cf * a3[1];
                    }
                }
            }
        }
    }
    float hv[16];
    unpack8(hx0, hv); unpack8(hx1, hv + 8);
    float ss = 0.f;
#pragma unroll
    for (int i = 0; i < 16; ++i) { hv[i] += y[i]; ss += hv[i] * hv[i]; }
    ss = wave_sum(ss);
    const float rs = rsqrtf(ss * (1.0f / DM) + 1e-6f);
    float* orow = p.out + (size_t)tok * DM + lane * 16;
#pragma unroll
    for (int q4 = 0; q4 < 4; ++q4) {
        f32x4 g = *(const f32x4*)(p.fg + lane * 16 + q4 * 4);
        f32x4 o = {hv[q4 * 4] * rs * g[0], hv[q4 * 4 + 1] * rs * g[1], hv[q4 * 4 + 2] * rs * g[2], hv[q4 * 4 + 3] * rs * g[3]};
        *(f32x4*)(orow + q4 * 4) = o;
    }
}


#define XB_TMO      128
#define XB_XCNT(j)  (256  + 64 * (j))
#define XB_XSUB(j)  (1280 + 64 * (j))
#define XB_XGEN(j)  (2304 + 64 * (j))
#define XB_TOP      3328
#define XB_TOPGEN   3392
#define XCD_BAR_WORDS 3456
#define XB_SPIN_CAP (1u << 21)
#define LAS __attribute__((address_space(3)))
__device__ __forceinline__ unsigned xb_ld(unsigned* p)              { return __hip_atomic_load(p, __ATOMIC_RELAXED, __HIP_MEMORY_SCOPE_AGENT); }
__device__ __forceinline__ unsigned xb_add(unsigned* p, unsigned v) { return __hip_atomic_fetch_add(p, v, __ATOMIC_RELAXED, __HIP_MEMORY_SCOPE_AGENT); }
__device__ __forceinline__ unsigned xb_xcc_id() { return (unsigned)__builtin_amdgcn_s_getreg((3 << 11) | 20) & 0xFu; }
#define XB_SPIN(cond, bar) do { unsigned _sp = 0; while (cond) { __builtin_amdgcn_s_sleep(1); \
    if ((++_sp & 255u) == 0u) { if (xb_ld(&(bar)[XB_TMO])) break; if (_sp > XB_SPIN_CAP) { atomicAdd(&(bar)[XB_TMO], 1u); break; } } } } while (0)
struct XcdBarrier { unsigned* bar; unsigned x; volatile LAS unsigned* st; };
__device__ __forceinline__ XcdBarrier xcd_barrier_post(unsigned* bar, volatile LAS unsigned* st) {
    XcdBarrier b; b.bar = bar; b.x = xb_xcc_id(); b.st = st;
    if (threadIdx.x == 0) (void)xb_add(&bar[XB_XCNT(b.x)], 1u);
    return b;
}
__device__ __forceinline__ void xcd_barrier_complete(unsigned* bar, unsigned x, unsigned& nloc, unsigned& nx) {
    const unsigned G = gridDim.x * gridDim.y * gridDim.z;
    unsigned sum, cnt, mine, sp = 0u;
    for (;;) {
        sum = 0u; cnt = 0u; mine = 0u;
#pragma unroll
        for (unsigned j = 0; j < 16; ++j) { const unsigned c = xb_ld(&bar[XB_XCNT(j)]); sum += c; cnt += (c > 0u) ? 1u : 0u; mine = (j == x) ? c : mine; }
        if (sum == G) break;
        __builtin_amdgcn_s_sleep(1);
        if ((++sp & 255u) == 0u) { if (xb_ld(&bar[XB_TMO])) break; if (sp > XB_SPIN_CAP) { atomicAdd(&bar[XB_TMO], 1u); break; } }
    }
    nloc = mine > 0u ? mine : 1u; nx = cnt > 0u ? cnt : 1u;
}
__device__ __forceinline__ void xcd_barrier(const XcdBarrier& b) {
    asm volatile("s_waitcnt vmcnt(0)" ::: "memory");
    __syncthreads();
    if (threadIdx.x == 0) {
        unsigned* bar = b.bar;
        __builtin_amdgcn_s_waitcnt(0);
        unsigned nloc = b.st[0], nx = b.st[1];
        if (nloc == 0u) { xcd_barrier_complete(bar, b.x, nloc, nx); b.st[0] = nloc; b.st[1] = nx; }
        const unsigned old = xb_add(&bar[XB_XSUB(b.x)], 1u);
        const unsigned gen = old / nloc;
        if (old + 1u == (gen + 1u) * nloc) {
            __builtin_amdgcn_fence(__ATOMIC_RELEASE, "agent");
            asm volatile("s_waitcnt vmcnt(0)" ::: "memory");
            const unsigned og = xb_add(&bar[XB_TOP], 1u);
            const unsigned tg = og / nx;
            if (og + 1u == (tg + 1u) * nx) xb_add(&bar[XB_TOPGEN], 1u);
            else XB_SPIN(xb_ld(&bar[XB_TOPGEN]) == tg, bar);
            __builtin_amdgcn_fence(__ATOMIC_ACQUIRE, "agent");
            xb_add(&bar[XB_XGEN(b.x)], 1u);
            asm volatile("s_waitcnt vmcnt(0)" ::: "memory");
        } else {
            XB_SPIN(xb_ld(&bar[XB_XGEN(b.x)]) == gen, bar);
            __builtin_amdgcn_fence(__ATOMIC_ACQUIRE, "agent");
            asm volatile("s_waitcnt vmcnt(0)" ::: "memory");
        }
    }
    __syncthreads();
}

__device__ __forceinline__ void run_phase(const Params& p, char* smem, const int phase) {
    int tidl_ = threadIdx.x; asm volatile("" : "+v"(tidl_));
    const int tid = tidl_, lane = tid & 63, wave = __builtin_amdgcn_readfirstlane(tid >> 6), G = gridDim.x;
    char* ws = p.ws;
    switch (phase) {
    case 0: phase_prep(p, smem); break;
    case 1: { pg8::EpiBf16 e{(bf16_t*)(ws + OFF_P), DIN}; pg8::Gemm g{(const bf16_t*)(ws + OFF_XN), (const bf16_t*)(ws + OFF_WINT), MROWS, DIN, DM}; pg8::StaticOrder so; so.init(MROWS, DIN, G, blockIdx.x);
              pg8::gemm_phase<pg8::EpiBf16, pg8::StaticOrder, true, true>((PG8_LAS unsigned char*)smem, g, so, e); } break;
    case 2: {
        unsigned long long tacc2 = 0;
        {
            float* prm = (float*)(smem + PRM_RWKV);
            prm[tid] = p.w0[tid]; prm[512 + tid] = p.a0[tid]; prm[1024 + tid] = p.k_k[tid]; prm[1536 + tid] = p.k_a[tid];
            prm[2048 + tid] = p.r_k[tid]; prm[2560 + tid] = p.gn_w[tid]; prm[3072 + tid] = p.gn_b[tid];
            __syncthreads();
        }
        S0Pre pre;
        if ((int)blockIdx.x < NUNITS) { const int u = blockIdx.x, v = u < 8 ? 0 : u - 8; s0_fetch(p, u < 8 ? 0 : 1 + ((v >> 3) & 127), v >> 10, u < 8 ? u : (v & 7), tid, pre); }
        for (int u = blockIdx.x; u < NUNITS; u += G) {
            const int v = u < 8 ? 0 : u - 8, un = u + G, vn = un - 8;
            rwkv_unit(p, smem, u < 8 ? 0 : 1 + ((v >> 3) & 127), v >> 10, u < 8 ? u : (v & 7), tacc2, pre, un < NUNITS, 1 + ((vn >> 3) & 127), vn >> 10, vn & 7);
        }
#if TSSTAGE >= 0
        if (blockIdx.x == 0 && tid == 0) __hip_atomic_store((unsigned long long*)(ws + OFF_BAR + 14336), tacc2, __ATOMIC_RELAXED, __HIP_MEMORY_SCOPE_AGENT);
#endif
    } break;
    case 3: {
        if (blockIdx.x < 16) { rwkv_chain_wg<8>(p, smem, blockIdx.x); __syncthreads(); }
        else {
            float* lp = (float*)(smem + PRM_LRU);
            lp[tid] = p.ga_b[tid]; lp[512 + tid] = p.gx_b[tid]; lp[1024 + tid] = ((const float*)(ws + OFF_SP))[tid]; lp[1536 + tid] = p.conv_b[tid];
            lp[2048 + tid] = p.conv_w[tid]; lp[2560 + tid] = p.conv_w[512 + tid]; lp[3072 + tid] = p.conv_w[1024 + tid]; lp[3584 + tid] = p.conv_w[1536 + tid];
            __syncthreads();
            for (int v = blockIdx.x - 16; v < 257; v += G - 16) { const int w = v == 0 ? 0 : v - 1; lru_unit(p, smem, v == 0 ? 0 : 1 + (w & 127), w >> 7); }
            if (blockIdx.x >= 33) convert_tables(p, 33);
        }
    } break;
    case 4: {
        for (int u = blockIdx.x; u < 1024 + 256; u += G) {
            if (u < 1024) rwkv_out_pair(p, smem, u);
            else { const int v = u - 1024; lru_out(p, smem, 1 + (v & 127), v >> 7); }
        }
    } break;
    case 5: { pg8::EpiRes e{(bf16_t*)(ws + OFF_H1B), p.x, (float*)(ws + OFF_SSQ)}; pg8::Gemm g{(const bf16_t*)(ws + OFF_XN), (const bf16_t*)(ws + OFF_WOUTT), NTOK, DM, DM}; pg8::StaticOrder so; so.init(NTOK, DM, G, blockIdx.x);
              pg8::gemm_phase<pg8::EpiRes, pg8::StaticOrder, false, true>((PG8_LAS unsigned char*)smem, g, so, e); } break;
    case 6: { pg8::EpiBf16 e{(bf16_t*)p.out, 2048}; pg8::Gemm g{(const bf16_t*)(ws + OFF_H1B), (const bf16_t*)(ws + OFF_WQT), NTOK, 2048, DM}; pg8::StaticOrder so; so.init(NTOK, 2048, G, blockIdx.x);
              pg8::gemm_phase<pg8::EpiBf16, pg8::StaticOrder, true, true>((PG8_LAS unsigned char*)smem, g, so, e); } break;
    case 7: { for (int u = blockIdx.x; u < 64 * 8; u += G) peer_topk_unit(p, smem, u >> 3, u & 7); } break;
    case 8: { float* coefl = (float*)smem + wave * 128; for (int tok = blockIdx.x * 8 + wave; tok < NTOK; tok += G * 8) peer_token(p, coefl, tok, lane, DO_PEER != 0); } break;
    }
}

template <int PH>
__global__ void __launch_bounds__(NTHR) k_phase(Params p) {
    extern __shared__ __attribute__((aligned(16))) char smem[];
    run_phase(p, smem, PH);
}
template <int PH>
static void launch_phase(const Params& p, hipStream_t stream) {
    static bool attr_set = false;
    if (!attr_set) { (void)hipFuncSetAttribute((const void*)k_phase<PH>, hipFuncAttributeMaxDynamicSharedMemorySize, SMEM_BYTES); attr_set = true; }
    k_phase<PH><<<256, NTHR, SMEM_BYTES, stream>>>(p);
}


__global__ void __launch_bounds__(NTHR) k_mega(Params p) {
    extern __shared__ __attribute__((aligned(16))) char smem[];
    volatile LAS unsigned* st = (volatile LAS unsigned*)(smem + SMEM_BYTES - 16);
    if (threadIdx.x == 0) { st[0] = 0u; st[1] = 0u; st[2] = 0u; st[3] = 0u; }
    __syncthreads();
    XcdBarrier bar = xcd_barrier_post((unsigned*)(p.ws + OFF_BAR), st);
#ifndef TSPH
#define TSPH -1
#endif
    unsigned long long ts[10];
#define RUNP(ph, n) if ((n) == 1) { if (ph > 0) xcd_barrier(bar); if (TSPH >= 0) ts[ph] = __builtin_amdgcn_s_memrealtime(); run_phase(p, smem, ph); } else { _Pragma("unroll 1") for (int it = 0; it < (n); ++it) { xcd_barrier(bar); run_phase(p, smem, ph); } }
    RUNP(0, REP0) RUNP(1, REP1) RUNP(2, REP2) RUNP(3, REP3) RUNP(4, REP4) RUNP(5, 1) RUNP(6, REP6) RUNP(7, REP7) RUNP(8, REP8)
    if (TSPH >= 0) {
        xcd_barrier(bar);
        ts[9] = __builtin_amdgcn_s_memrealtime();
        if (blockIdx.x == 0) {
#if TSROLE >= 0 || TSSTAGE >= 0
            const unsigned long long d = __hip_atomic_load((unsigned long long*)(p.ws + OFF_BAR + 14336), __ATOMIC_RELAXED, __HIP_MEMORY_SCOPE_AGENT) * 4ull, t0 = __builtin_amdgcn_s_memrealtime();
#else
            const unsigned long long d = (ts[TSPH + 1] - ts[TSPH]) * 4ull, t0 = __builtin_amdgcn_s_memrealtime();
#endif
            while (__builtin_amdgcn_s_memrealtime() - t0 < d) __builtin_amdgcn_s_sleep(8);
        }
    }
}

extern "C" void kernel_launch(void* const* d_in, const int* in_sizes, int n_in, void* d_out, int out_size, void* d_ws, size_t ws_size, hipStream_t stream) {
    Params p{};
    const float** pp = (const float**)&p;
    for (int i = 0; i < 31; ++i) pp[i] = (const float*)d_in[i];
    p.out = (float*)d_out; p.ws = (char*)d_ws;
#if MULTI_LAUNCH
    launch_phase<0>(p, stream); launch_phase<1>(p, stream); launch_phase<2>(p, stream); launch_phase<3>(p, stream);
    launch_phase<4>(p, stream); launch_phase<5>(p, stream);
    if (DO_PEER) { launch_phase<6>(p, stream); launch_phase<7>(p, stream); }
    launch_phase<8>(p, stream);
#else
    static bool attr_set = false;
    if (!attr_set) { (void)hipFuncSetAttribute((const void*)k_mega, hipFuncAttributeMaxDynamicSharedMemorySize, SMEM_BYTES); attr_set = true; }
    (void)hipMemsetAsync(p.ws + OFF_BAR, 0, XCD_BAR_WORDS * 4, stream);
    void* args[] = {&p};
    hipError_t e = hipLaunchCooperativeKernel((const void*)k_mega, dim3(256), dim3(NTHR), args, SMEM_BYTES, stream);
    if (e != hipSuccess) fprintf(stderr, "cooperative launch failed: %s\n", hipGetErrorString(e));
#endif
}
```

```cpp
#include <hip/hip_runtime.h>
#include <stdint.h>
#include <stdio.h>

#ifndef REP0
#define REP0 1
#endif
#ifndef REP1
#define REP1 1
#endif
#ifndef REP2
#define REP2 1
#endif
#ifndef REP3
#define REP3 1
#endif
#ifndef REP4
#define REP4 1
#endif
#ifndef REP6
#define REP6 1
#endif
#ifndef REP7
#define REP7 1
#endif
#ifndef REP8
#define REP8 1
#endif
#ifndef TSSTAGE
#define TSSTAGE -1
#endif
#ifndef TSROLE
#define TSROLE -1
#endif
#ifndef GEMMFN
#define GEMMFN gemm_phase
#endif
#ifndef CHV
#define CHV 0
#endif
#ifndef CHAINX
#define CHAINX 1
#endif
#ifndef TBLX
#define TBLX 1
#endif
#ifndef MULTI_LAUNCH
#define MULTI_LAUNCH 0
#endif
#ifndef DO_LRU
#define DO_LRU 1
#endif
#ifndef DO_RWKV
#define DO_RWKV 1
#endif
#ifndef DO_PEER
#define DO_PEER 1
#endif

#define NTHR 512
#define T_SEQ 8192
#define NTOK 16384
#define NMETA 16
#define MROWS 16640
#define DM 1024
#define DIN 2816
#define NCHUNK 129
#define LD 72
#define LF 68
#define SLOT (64 * LD)

typedef unsigned short bf16_t;
typedef short bf16x8 __attribute__((ext_vector_type(8)));
typedef float f32x4 __attribute__((ext_vector_type(4)));
typedef float f32x16 __attribute__((ext_vector_type(16)));
typedef unsigned u32x4 __attribute__((ext_vector_type(4)));
typedef unsigned u32x2 __attribute__((ext_vector_type(2)));
typedef __bf16 bf2_t __attribute__((ext_vector_type(2)));
typedef float f32x2 __attribute__((ext_vector_type(2)));

constexpr size_t AL(size_t x) { return (x + 255) & ~(size_t)255; }
constexpr size_t OFF_BAR  = 0;
constexpr size_t OFF_SSQ  = 16384;
constexpr size_t SZ_SUM   = (size_t)NCHUNK * 2 * 512 * 4;
constexpr size_t OFF_SUMA = OFF_SSQ + 65536;
constexpr size_t OFF_SUMH = AL(OFF_SUMA + SZ_SUM);
constexpr size_t OFF_HS   = AL(OFF_SUMH + SZ_SUM);
constexpr size_t OFF_SP   = AL(OFF_HS + SZ_SUM);
constexpr size_t OFF_MPQ  = AL(OFF_SP + 2048);
constexpr size_t OFF_WINT = AL(OFF_MPQ + 8 * 16384);
constexpr size_t OFF_WOUTT = AL(OFF_WINT + (size_t)DIN * DM * 2);
constexpr size_t OFF_WQT  = AL(OFF_WOUTT + (size_t)DM * DM * 2);
constexpr size_t OFF_W2T  = AL(OFF_WQT + (size_t)2048 * DM * 2);
constexpr size_t OFF_A2T  = AL(OFF_W2T + 512 * 64 * 2);
constexpr size_t OFF_G2T  = AL(OFF_A2T + 512 * 64 * 2);
constexpr size_t OFF_WAT  = AL(OFF_G2T + 512 * 128 * 2);
constexpr size_t OFF_WXT  = AL(OFF_WAT + 8 * 64 * 64 * 2);
constexpr size_t OFF_KEYS = AL(OFF_WXT + 8 * 64 * 64 * 2);
constexpr size_t OFF_UB   = AL(OFF_KEYS + 8 * 2 * 128 * 128 * 2);
constexpr size_t OFF_VB   = AL(OFF_UB + (size_t)16384 * DM / 2);
constexpr size_t OFF_SU   = AL(OFF_VB + (size_t)16384 * DM / 2);
constexpr size_t OFF_SV   = AL(OFF_SU + 16384 * 4);
constexpr size_t OFF_XN   = AL(OFF_SV + 16384 * 4);
constexpr size_t OFF_SB   = AL(OFF_XN + (size_t)MROWS * DM * 2);
constexpr size_t OFF_P    = AL(OFF_SB + (size_t)2048 * 8192);
constexpr size_t OFF_H1B  = OFF_P;
constexpr size_t OFF_EIDX = AL(OFF_H1B + (size_t)NTOK * DM * 2);
constexpr size_t OFF_GATE = AL(OFF_EIDX + (size_t)NTOK * 128 * 2);
constexpr size_t OFF_E1   = AL(OFF_P + (size_t)MROWS * DIN * 2);
constexpr size_t OFF_E2   = AL(OFF_E1 + (size_t)NTOK * 512 * 2);
constexpr size_t OFF_AC   = AL(OFF_E2 + (size_t)NTOK * 512 * 2);
constexpr size_t OFF_HL   = AL(OFF_AC + (size_t)NTOK * 512 * 2);
constexpr size_t WS_END   = AL(OFF_HL + (size_t)NTOK * 512 * 2);
constexpr size_t UNIT_BYTES = 32768;
constexpr int NUNITS = 8 + 2048;
static_assert((size_t)2048 * UNIT_BYTES <= (size_t)NTOK * DM * 4, "unit data does not fit in d_out");
static_assert(WS_END <= (size_t)256 * 1024 * 1024, "workspace too large");

constexpr int SMEM_BYTES = 160 * 1024;
constexpr int PRM_RWKV = 148736;
constexpr int PRM_LRU = 65536;

struct Params {
    const float *x, *meta, *g1, *w_in, *conv_w, *conv_b, *ga_w, *ga_b, *gx_w, *gx_b, *lam, *lru_gain, *mu, *w0, *w2, *a0, *a2, *g2,
        *k_k, *k_a, *r_k, *gn_w, *gn_b, *w_out, *g2n, *w_q, *q_gain, *keys, *u, *v, *fg;
    float* out;
    char* ws;
};

__device__ __forceinline__ unsigned short f2bf(float f) { __bf16 b = (__bf16)f; return __builtin_bit_cast(unsigned short, b); }
__device__ __forceinline__ unsigned pack2(float lo, float hi) { bf2_t v; v[0] = (__bf16)lo; v[1] = (__bf16)hi; return __builtin_bit_cast(unsigned, v); }
__device__ __forceinline__ float bflo(unsigned u) { return __uint_as_float(u << 16); }
__device__ __forceinline__ float bfhi(unsigned u) { return __uint_as_float(u & 0xFFFF0000u); }
__device__ __forceinline__ float bf2f(bf16_t b) { return __uint_as_float((unsigned)b << 16); }
__device__ __forceinline__ float wave_sum(float v) {
#pragma unroll
    for (int o = 32; o > 0; o >>= 1) v += __shfl_xor(v, o);
    return v;
}
__device__ __forceinline__ float sum8(float v) { v += __shfl_xor(v, 1); v += __shfl_xor(v, 2); v += __shfl_xor(v, 4); return v; }
__device__ __forceinline__ float sigmoidf_(float x) { return 1.0f / (1.0f + __expf(-x)); }
__device__ __forceinline__ float gelu_tanh(float x) {
    const float u = 0.7978845608f * (x + 0.044715f * x * x * x);
    const float t = 1.0f - 2.0f / (__expf(2.0f * u) + 1.0f);
    return 0.5f * x * (1.0f + t);
}
__device__ __forceinline__ float gelu_erf(float x) { return 0.5f * x * (1.0f + erff(x * 0.70710678118f)); }
__device__ __forceinline__ void unpack8(u32x4 q, float* f) {
    f[0] = bflo(q[0]); f[1] = bfhi(q[0]); f[2] = bflo(q[1]); f[3] = bfhi(q[1]);
    f[4] = bflo(q[2]); f[5] = bfhi(q[2]); f[6] = bflo(q[3]); f[7] = bfhi(q[3]);
}
__device__ __forceinline__ u32x4 pack8(const float* f) {
    u32x4 q; q[0] = pack2(f[0], f[1]); q[1] = pack2(f[2], f[3]); q[2] = pack2(f[4], f[5]); q[3] = pack2(f[6], f[7]); return q;
}
__device__ __forceinline__ int row_of(int b, int pos) { return pos < NMETA ? NTOK + pos : b * T_SEQ + pos - NMETA; }

#define MFMA32(a, b, c) __builtin_amdgcn_mfma_f32_32x32x16_bf16((a), (b), (c), 0, 0, 0)
#define MFMA16(a, b, c) __builtin_amdgcn_mfma_f32_16x16x32_bf16((a), (b), (c), 0, 0, 0)

template <int KS>
__device__ __forceinline__ f32x16 mm_lds(const bf16_t* A, const bf16_t* Bt, int qm, int qn, int lane, f32x16 acc) {
    const int r = lane & 31, h = lane >> 5;
    const bf16_t* ap = A + (qm * 32 + r) * LD + h * 8;
    const bf16_t* bp = Bt + (qn * 32 + r) * LD + h * 8;
#pragma unroll
    for (int ks = 0; ks < KS; ++ks) {
        bf16x8 a = *(const bf16x8*)(ap + ks * 16), b = *(const bf16x8*)(bp + ks * 16);
        acc = MFMA32(a, b, acc);
    }
    return acc;
}
template <int KS>
__device__ __forceinline__ f32x16 mm_lds_s(const bf16_t* A, const bf16_t* Bt, int qm, int qn, int lane, f32x16 acc, bool swzA, bool swzB) {
    const int r = lane & 31, h = lane >> 5;
    const int ra = qm * 32 + r, rb = qn * 32 + r;
    const int xa = swzA ? ((ra >> 3) & 7) : 0, xb = swzB ? ((rb >> 3) & 7) : 0;
    const bf16_t* ap = A + ra * LD;
    const bf16_t* bp = Bt + rb * LD;
#pragma unroll
    for (int ks = 0; ks < KS; ++ks) {
        bf16x8 a = *(const bf16x8*)(ap + (((ks * 2 + h) ^ xa) * 8)), b = *(const bf16x8*)(bp + (((ks * 2 + h) ^ xb) * 8));
        acc = MFMA32(a, b, acc);
    }
    return acc;
}
template <int KS>
__device__ __forceinline__ f32x16 mm_lds_g(const bf16_t* A, const bf16_t* __restrict__ Btg, int ldb, int qm, int qn, int lane, f32x16 acc) {
    const int r = lane & 31, h = lane >> 5;
    const bf16_t* ap = A + (qm * 32 + r) * LD + h * 8;
    const bf16_t* bp = Btg + (size_t)(qn * 32 + r) * ldb + h * 8;
    bf16x8 bfr[KS];
#pragma unroll
    for (int ks = 0; ks < KS; ++ks) bfr[ks] = *(const bf16x8*)(bp + ks * 16);
#pragma unroll
    for (int ks = 0; ks < KS; ++ks) { bf16x8 a = *(const bf16x8*)(ap + ks * 16); acc = MFMA32(a, bfr[ks], acc); }
    return acc;
}
__device__ __forceinline__ void store_N_bf16(bf16_t* dst, const f32x16& c, int qm, int qn, int lane) {
    const int r = lane & 31, h = lane >> 5;
#pragma unroll
    for (int reg = 0; reg < 16; ++reg) dst[(qm * 32 + (reg & 3) + 8 * (reg >> 2) + 4 * h) * LD + qn * 32 + r] = f2bf(c[reg]);
}
__device__ __forceinline__ void store_T_bf16(bf16_t* dst, const f32x16& c, int qm, int qn, int lane) {
    const int r = lane & 31, h = lane >> 5;
#pragma unroll
    for (int g = 0; g < 4; ++g) {
        u32x2 w; w[0] = pack2(c[4 * g], c[4 * g + 1]); w[1] = pack2(c[4 * g + 2], c[4 * g + 3]);
        *(u32x2*)(dst + (qn * 32 + r) * LD + qm * 32 + 8 * g + 4 * h) = w;
    }
}
__device__ __forceinline__ void store_N_f32(float* dst, const f32x16& c, int qm, int qn, int lane) {
    const int r = lane & 31, h = lane >> 5;
#pragma unroll
    for (int reg = 0; reg < 16; ++reg) dst[(qm * 32 + (reg & 3) + 8 * (reg >> 2) + 4 * h) * LF + qn * 32 + r] = c[reg];
}
__device__ __forceinline__ f32x16 zero16() { f32x16 z; for (int i = 0; i < 16; ++i) z[i] = 0.f; return z; }

__device__ __forceinline__ void transpose_tile(const float* __restrict__ src, bf16_t* __restrict__ dst, int K, int N, const float* __restrict__ kscale, int tk, int tn, float* tile) {
    const int tid = threadIdx.x;
#pragma unroll
    for (int i = 0; i < 2; ++i) {
        const int kk = (tid >> 4) + 32 * i, nn = (tid & 15) * 4;
        f32x4 v = *(const f32x4*)(src + (size_t)(tk * 64 + kk) * N + tn * 64 + nn);
        const float s = kscale ? kscale[tk * 64 + kk] : 1.0f;
        tile[kk * 65 + nn] = v[0] * s; tile[kk * 65 + nn + 1] = v[1] * s; tile[kk * 65 + nn + 2] = v[2] * s; tile[kk * 65 + nn + 3] = v[3] * s;
    }
    __syncthreads();
    {
        const int n = tid >> 3, ks = (tid & 7) * 8;
        float f[8];
#pragma unroll
        for (int i = 0; i < 8; ++i) f[i] = tile[(ks + i) * 65 + n];
        *(u32x4*)(dst + (size_t)(tn * 64 + n) * K + tk * 64 + ks) = pack8(f);
    }
    __syncthreads();
}

__device__ __forceinline__ void phase_prep(const Params& p, char* smem) {
    const int tid = threadIdx.x, lane = tid & 63, wave = __builtin_amdgcn_readfirstlane(tid >> 6), G = gridDim.x;
    char* ws = p.ws;
    bf16_t* XN = (bf16_t*)(ws + OFF_XN);
    for (int row = blockIdx.x * 8 + wave; row < MROWS; row += G * 8) {
        u32x2* dst = (u32x2*)(XN + (size_t)row * DM);
        if (row >= NTOK + NMETA) {
#pragma unroll
            for (int i = 0; i < 4; ++i) { u32x2 z; z[0] = 0; z[1] = 0; dst[lane + 64 * i] = z; }
            continue;
        }
        const float* src = row < NTOK ? p.x + (size_t)row * DM : p.meta + (size_t)(row - NTOK) * DM;
        f32x4 v[4]; float ss = 0.f;
#pragma unroll
        for (int i = 0; i < 4; ++i) { v[i] = ((const f32x4*)src)[lane + 64 * i]; ss += v[i][0] * v[i][0] + v[i][1] * v[i][1] + v[i][2] * v[i][2] + v[i][3] * v[i][3]; }
        ss = wave_sum(ss);
        const float rs = rsqrtf(ss * (1.0f / DM) + 1e-6f);
#pragma unroll
        for (int i = 0; i < 4; ++i) {
            f32x4 g = ((const f32x4*)p.g1)[lane + 64 * i];
            u32x2 w; w[0] = pack2(v[i][0] * rs * g[0], v[i][1] * rs * g[1]); w[1] = pack2(v[i][2] * rs * g[2], v[i][3] * rs * g[3]);
            dst[lane + 64 * i] = w;
        }
    }
    {
        float* tile = (float*)smem;
        const int n0 = 16 * 44, n1 = n0 + 16 * 16, n2 = n1 + 16 * 32, n3 = n2 + 8, n4 = n3 + 8, n5 = n4 + 16, n6 = n5 + 8, n7 = n6 + 8;
        for (int t = blockIdx.x; t < n7; t += G) {
            if (t < n0) transpose_tile(p.w_in, (bf16_t*)(ws + OFF_WINT), DM, DIN, nullptr, t / 44, t % 44, tile);
            else if (t < n1) { const int u = t - n0; transpose_tile(p.w_out, (bf16_t*)(ws + OFF_WOUTT), DM, DM, nullptr, u / 16, u % 16, tile); }
            else if (t < n2) { const int u = t - n1; transpose_tile(p.w_q, (bf16_t*)(ws + OFF_WQT), DM, 2048, p.g2n, u / 32, u % 32, tile); }
            else if (t < n3) { const int u = t - n2; transpose_tile(p.w2, (bf16_t*)(ws + OFF_W2T), 64, 512, nullptr, 0, u, tile); }
            else if (t < n4) { const int u = t - n3; transpose_tile(p.a2, (bf16_t*)(ws + OFF_A2T), 64, 512, nullptr, 0, u, tile); }
            else if (t < n5) { const int u = t - n4; transpose_tile(p.g2, (bf16_t*)(ws + OFF_G2T), 128, 512, nullptr, u / 8, u % 8, tile); }
            else if (t < n6) { const int u = t - n5; transpose_tile(p.ga_w + u * 4096, (bf16_t*)(ws + OFF_WAT) + u * 4096, 64, 64, nullptr, 0, 0, tile); }
            else { const int u = t - n6; transpose_tile(p.gx_w + u * 4096, (bf16_t*)(ws + OFF_WXT) + u * 4096, 64, 64, nullptr, 0, 0, tile); }
        }
    }
    {
        const int gt = blockIdx.x * NTHR + tid, gs = G * NTHR;
        bf16_t* KEYS = (bf16_t*)(ws + OFF_KEYS);
        for (int i = gt; i < 8 * 2 * 128 * 128 / 4; i += gs) {
            const int e = i * 4, d = e & 127, sub = (e >> 14) & 1, h = e >> 15;
            f32x4 k = ((const f32x4*)p.keys)[i]; f32x4 g = *(const f32x4*)(p.q_gain + h * 256 + sub * 128 + d);
            u32x2 w; w[0] = pack2(k[0] * g[0], k[1] * g[1]); w[1] = pack2(k[2] * g[2], k[3] * g[3]);
            *(u32x2*)(KEYS + e) = w;
        }
        float* ssq = (float*)(ws + OFF_SSQ);
        for (int i = gt; i < NTOK; i += gs) ssq[i] = 0.f;
        float* SPt = (float*)(ws + OFF_SP);
        for (int i = gt; i < 512; i += gs) SPt[i] = log1pf(__expf(-p.lam[i]));
    }
}


__device__ __forceinline__ void convert_tables(const Params& p, int first) {
    char* ws = p.ws;
    const int lane = threadIdx.x & 63, wave = threadIdx.x >> 6;
    const int gw = (blockIdx.x - first) * 8 + wave, nw = (gridDim.x - first) * 8;
    float g[16];
#pragma unroll
    for (int q = 0; q < 4; ++q) *(f32x4*)(g + 4 * q) = *(const f32x4*)(p.g2n + lane * 16 + 4 * q);
#pragma unroll 1
    for (int r0 = gw; r0 < 32768; r0 += nw * 4) {
        f32x4 xv[4][4];
#pragma unroll
        for (int k = 0; k < 4; ++k) {
            const int rr = min(r0 + k * nw, 32767);
            const float* src = (rr < 16384 ? p.u : p.v) + (size_t)(rr & 16383) * DM + lane * 16;
#pragma unroll
            for (int q = 0; q < 4; ++q) xv[k][q] = *(const f32x4*)(src + 4 * q);
        }
        int keep = r0; asm volatile("" : "+v"(keep) :: "memory");
#pragma unroll
        for (int k = 0; k < 4; ++k) {
            const int rr = keep + k * nw;
            if (rr < 32768) {
                const bool isu = rr < 16384;
                float x[16]; float amax = 0.f;
#pragma unroll
                for (int i = 0; i < 16; ++i) { x[i] = xv[k][i >> 2][i & 3] * (isu ? g[i] : 1.0f); amax = fmaxf(amax, fabsf(x[i])); }
#pragma unroll
                for (int o = 32; o > 0; o >>= 1) amax = fmaxf(amax, __shfl_xor(amax, o));
                const float sc = fmaxf(amax, 1e-30f) * (1.0f / 6.0f), inv = 1.0f / sc;
                unsigned w0 = 0, w1 = 0;
                w0 = __builtin_amdgcn_cvt_scalef32_pk_fp4_f32(w0, x[0] * inv, x[1] * inv, 1.0f, 0);
                w0 = __builtin_amdgcn_cvt_scalef32_pk_fp4_f32(w0, x[2] * inv, x[3] * inv, 1.0f, 1);
                w0 = __builtin_amdgcn_cvt_scalef32_pk_fp4_f32(w0, x[4] * inv, x[5] * inv, 1.0f, 2);
                w0 = __builtin_amdgcn_cvt_scalef32_pk_fp4_f32(w0, x[6] * inv, x[7] * inv, 1.0f, 3);
                w1 = __builtin_amdgcn_cvt_scalef32_pk_fp4_f32(w1, x[8] * inv, x[9] * inv, 1.0f, 0);
                w1 = __builtin_amdgcn_cvt_scalef32_pk_fp4_f32(w1, x[10] * inv, x[11] * inv, 1.0f, 1);
                w1 = __builtin_amdgcn_cvt_scalef32_pk_fp4_f32(w1, x[12] * inv, x[13] * inv, 1.0f, 2);
                w1 = __builtin_amdgcn_cvt_scalef32_pk_fp4_f32(w1, x[14] * inv, x[15] * inv, 1.0f, 3);
                u32x2 w; w[0] = w0; w[1] = w1;
                *(u32x2*)(ws + (isu ? OFF_UB : OFF_VB) + (size_t)(rr & 16383) * (DM / 2) + lane * 8) = w;
                if (lane == 0) ((float*)(ws + (isu ? OFF_SU : OFF_SV)))[rr & 16383] = sc;
            }
        }
    }
}

constexpr int GA_ROWS = 256, GB_ROWS = 128;
constexpr int GBUF = (GA_ROWS + GB_ROWS) * LD;

struct EpiStoreBf16 {
    bf16_t* C; int ldc;
    __device__ __forceinline__ void operator()(const f32x16 (&acc)[2][2], int mb, int nb, int lane) const {
        const int r = lane & 31, h = lane >> 5;
#pragma unroll
        for (int i = 0; i < 2; ++i)
#pragma unroll
            for (int j = 0; j < 2; ++j)
#pragma unroll
                for (int g = 0; g < 4; ++g) {
                    u32x2 w; w[0] = pack2(acc[i][j][4 * g], acc[i][j][4 * g + 1]); w[1] = pack2(acc[i][j][4 * g + 2], acc[i][j][4 * g + 3]);
                    *(u32x2*)(C + (size_t)(mb + i * 32 + r) * ldc + nb + j * 32 + 8 * g + 4 * h) = w;
                }
    }
};
struct EpiResidual {
    bf16_t* C; const float* X; float* ssq;
    __device__ __forceinline__ void operator()(const f32x16 (&acc)[2][2], int mb, int nb, int lane) const {
        const int r = lane & 31, h = lane >> 5;
#pragma unroll
        for (int i = 0; i < 2; ++i) {
            const int row = mb + i * 32 + r; float ss = 0.f;
#pragma unroll
            for (int j = 0; j < 2; ++j)
#pragma unroll
                for (int g = 0; g < 4; ++g) {
                    const int col = nb + j * 32 + 8 * g + 4 * h;
                    f32x4 xv = *(const f32x4*)(X + (size_t)row * DM + col);
                    const float v0 = acc[i][j][4 * g] + xv[0], v1 = acc[i][j][4 * g + 1] + xv[1], v2 = acc[i][j][4 * g + 2] + xv[2], v3 = acc[i][j][4 * g + 3] + xv[3];
                    ss += v0 * v0 + v1 * v1 + v2 * v2 + v3 * v3;
                    u32x2 w; w[0] = pack2(v0, v1); w[1] = pack2(v2, v3);
                    *(u32x2*)(C + (size_t)row * DM + col) = w;
                }
            ss += __shfl_xor(ss, 32);
            if (h == 0) atomicAdd(ssq + row, ss);
        }
    }
};

template <class Epi>
__device__ __forceinline__ void gemm_phase(const bf16_t* __restrict__ A, const bf16_t* __restrict__ Bt, int M, int N, int K, char* smem, const Epi& epi) {
    const int tid = threadIdx.x, lane = tid & 63, wave = __builtin_amdgcn_readfirstlane(tid >> 6);
    const int wm = wave >> 1, wn = wave & 1, r = lane & 31, h = lane >> 5;
    const int nNt = N / 128, ntiles = (M / 256) * nNt, nk = K / 64;
    const int G = gridDim.x;
    const int bid = (G % 8 == 0) ? (blockIdx.x % 8) * (G / 8) + blockIdx.x / 8 : blockIdx.x;
    bf16_t* lds = (bf16_t*)smem;
    for (int tile = bid; tile < ntiles; tile += G) {
        const int pm = tile / nNt, pn = tile % nNt, m0 = pm * 256, n0 = pn * 128;
        const bf16_t* Ag = A + (size_t)m0 * K; const bf16_t* Bg = Bt + (size_t)n0 * K;
        f32x16 acc[2][2];
#pragma unroll
        for (int i = 0; i < 2; ++i)
#pragma unroll
            for (int j = 0; j < 2; ++j) acc[i][j] = zero16();
        u32x4 ra0[4], rb0[2], ra1[4], rb1[2];
#define G_LOAD(RA, RB, KT) { \
            _Pragma("unroll") for (int i = 0; i < 4; ++i) { const int q = tid + 512 * i; RA[i] = *(const u32x4*)(Ag + (size_t)(q >> 3) * K + (KT) * 64 + (q & 7) * 8); } \
            _Pragma("unroll") for (int i = 0; i < 2; ++i) { const int q = tid + 512 * i; RB[i] = *(const u32x4*)(Bg + (size_t)(q >> 3) * K + (KT) * 64 + (q & 7) * 8); } }
#define G_WRITE(RA, RB, BUF) { bf16_t* b_ = lds + (BUF) * GBUF; \
            _Pragma("unroll") for (int i = 0; i < 4; ++i) { const int q = tid + 512 * i; *(u32x4*)(b_ + (q >> 3) * LD + (q & 7) * 8) = RA[i]; } \
            _Pragma("unroll") for (int i = 0; i < 2; ++i) { const int q = tid + 512 * i; *(u32x4*)(b_ + GA_ROWS * LD + (q >> 3) * LD + (q & 7) * 8) = RB[i]; } }
#define G_COMPUTE(BUF) { const bf16_t* a_ = lds + (BUF) * GBUF + (wm * 64 + r) * LD + h * 8; const bf16_t* b_ = lds + (BUF) * GBUF + (GA_ROWS + wn * 64 + r) * LD + h * 8; \
            _Pragma("unroll") for (int ks = 0; ks < 4; ++ks) { \
                bf16x8 af0 = *(const bf16x8*)(a_ + ks * 16), af1 = *(const bf16x8*)(a_ + 32 * LD + ks * 16); \
                bf16x8 bf0 = *(const bf16x8*)(b_ + ks * 16), bf1 = *(const bf16x8*)(b_ + 32 * LD + ks * 16); \
                acc[0][0] = MFMA32(bf0, af0, acc[0][0]); acc[0][1] = MFMA32(bf1, af0, acc[0][1]); \
                acc[1][0] = MFMA32(bf0, af1, acc[1][0]); acc[1][1] = MFMA32(bf1, af1, acc[1][1]); } }
        G_LOAD(ra0, rb0, 0); G_LOAD(ra1, rb1, 1);
        G_WRITE(ra0, rb0, 0);
        __syncthreads();
        for (int kt = 0; kt < nk; kt += 2) {
            if (kt + 2 < nk) G_LOAD(ra0, rb0, kt + 2);
            G_COMPUTE(0);
            G_WRITE(ra1, rb1, 1);
            __syncthreads();
            if (kt + 3 < nk) G_LOAD(ra1, rb1, kt + 3);
            G_COMPUTE(1);
            if (kt + 2 < nk) G_WRITE(ra0, rb0, 0);
            __syncthreads();
        }
        epi(acc, m0 + wm * 64, n0 + wn * 64, lane);
    }
#undef G_LOAD
#undef G_WRITE
#undef G_COMPUTE
}

constexpr int GBUF2 = 512 * LD;
template <class Epi>
__device__ __forceinline__ void gemm_phase256(const bf16_t* __restrict__ A, const bf16_t* __restrict__ Bt, int M, int N, int K, char* smem, const Epi& epi) {
    int tid_ = threadIdx.x; asm volatile("" : "+v"(tid_));
    const int tid = tid_, lane = tid & 63, wave = __builtin_amdgcn_readfirstlane(tid >> 6);
    const int wm = wave >> 2, wn = wave & 3, r = lane & 31, h = lane >> 5;
    const int nNt = N / 256, ntiles = (M / 256) * nNt, nk = K / 64;
    const int G = gridDim.x;
    const int bid = (G % 8 == 0) ? (blockIdx.x % 8) * (G / 8) + blockIdx.x / 8 : blockIdx.x;
    bf16_t* lds = (bf16_t*)smem;
    for (int tile = bid; tile < ntiles; tile += G) {
        const int pm = tile / nNt, pn = tile % nNt, m0 = pm * 256, n0 = pn * 256;
        const bf16_t* Ag = A + (size_t)m0 * K; const bf16_t* Bg = Bt + (size_t)n0 * K;
        f32x16 acc[4][2];
#pragma unroll
        for (int i = 0; i < 4; ++i)
#pragma unroll
            for (int j = 0; j < 2; ++j) acc[i][j] = zero16();
        u32x4 ra0[4], rb0[4];
#define G_LOAD(RA, RB, KT) { \
            _Pragma("unroll") for (int i = 0; i < 4; ++i) { const int q = tid + 512 * i; RA[i] = *(const u32x4*)(Ag + (size_t)(q >> 3) * K + (KT) * 64 + (q & 7) * 8); \
                                                                                      RB[i] = *(const u32x4*)(Bg + (size_t)(q >> 3) * K + (KT) * 64 + (q & 7) * 8); } }
#define G_WRITE(RA, RB, BUF) { bf16_t* b_ = lds + (BUF) * GBUF2; \
            _Pragma("unroll") for (int i = 0; i < 4; ++i) { const int q = tid + 512 * i; *(u32x4*)(b_ + (q >> 3) * LD + (q & 7) * 8) = RA[i]; \
                                                                                      *(u32x4*)(b_ + 256 * LD + (q >> 3) * LD + (q & 7) * 8) = RB[i]; } }
#define G_COMPUTE(BUF) { const bf16_t* a_ = lds + (BUF) * GBUF2 + (wm * 128 + r) * LD + h * 8; const bf16_t* b_ = lds + (BUF) * GBUF2 + (256 + wn * 64 + r) * LD + h * 8; \
            _Pragma("unroll") for (int ks = 0; ks < 4; ++ks) { \
                bf16x8 bf0 = *(const bf16x8*)(b_ + ks * 16), bf1 = *(const bf16x8*)(b_ + 32 * LD + ks * 16); \
                _Pragma("unroll") for (int i = 0; i < 4; ++i) { bf16x8 af = *(const bf16x8*)(a_ + i * 32 * LD + ks * 16); \
                    acc[i][0] = MFMA32(bf0, af, acc[i][0]); acc[i][1] = MFMA32(bf1, af, acc[i][1]); } } }
        G_LOAD(ra0, rb0, 0);
        G_WRITE(ra0, rb0, 0);
        __syncthreads();
        G_LOAD(ra0, rb0, 1);
#pragma unroll 1
        for (int kt = 0; kt < nk; kt += 2) {
            G_COMPUTE(0);
            G_WRITE(ra0, rb0, 1);
            __syncthreads();
            if (kt + 2 < nk) G_LOAD(ra0, rb0, kt + 2);
            G_COMPUTE(1);
            if (kt + 2 < nk) G_WRITE(ra0, rb0, 0);
            __syncthreads();
            if (kt + 3 < nk) G_LOAD(ra0, rb0, kt + 3);
        }
        epi(*(const f32x16 (*)[2][2])(&acc[0]), m0 + wm * 128, n0 + wn * 64, lane);
        epi(*(const f32x16 (*)[2][2])(&acc[2]), m0 + wm * 128 + 64, n0 + wn * 64, lane);
    }
#undef G_LOAD
#undef G_WRITE
#undef G_COMPUTE
}

namespace pg8 {
#define PG8_LAS __attribute__((address_space(3)))
constexpr int BM = 256, BK = 64, HALF = 128, HTB = HALF * BK * 2  , STAGE_BYTES = 8 * HTB, NXCD = 8, WGM = 8;
__host__ __device__ __forceinline__ int lds_byte(int r, int c) { const int st = (r >> 4) * 2 + (c >> 5), rr = r & 15, cc = c & 31, ob = rr * 64 + cc * 2; return st * 1024 + (ob ^ (((ob >> 9) & 1) << 5)); }
__host__ __device__ __forceinline__ void stage_rc(int b, int& R, int& C) { const int st = b / 1024, sb = b % 1024, swz = sb ^ (((sb >> 9) & 1) << 5); R = (st >> 1) * 16 + swz / 64; C = (st & 1) * 32 + (swz % 64) / 2; }
__host__ __device__ __forceinline__ int perm32(int rho) { const int n = rho >> 4, i = rho & 15; return 8 * (i >> 2) + 4 * n + (i & 3); }
struct Unit { int pm, pn; };
struct Gemm { const bf16_t* A; const bf16_t* Bt; int M, N, K; };
struct StaticOrder {
    int nM, nN, nwg, G, c;
    __host__ __device__ void init(int M, int N, int G_, int c_) { nM = M / BM; nN = N / BM; nwg = nM * nN; G = G_; c = c_; }
    __host__ __device__ bool next(int i, Unit& u) const {
        const long L = (long)i * G + c; if (L >= nwg) return false;
        int wgid = (int)L; { const int q = nwg / NXCD, r = nwg % NXCD, xcd = wgid % NXCD, off = wgid / NXCD; wgid = (xcd < r ? xcd * (q + 1) : r * (q + 1) + (xcd - r) * q) + off; }
        const int nig = WGM * nN, gid = wgid / nig, fm = gid * WGM, gsz = (nM - fm) < WGM ? (nM - fm) : WGM;
        u.pm = fm + ((wgid % nig) % gsz); u.pn = (wgid % nig) / gsz; return true;
    }
    __device__ __forceinline__ void a_ready(const Unit&) const {}
    __device__ __forceinline__ void done(const Unit&) const {}
};
struct EpiBf16 {
    static constexpr bool PERM = true, AFTER_DRAIN = false;
    bf16_t* C; int ldc;
    __device__ __forceinline__ void operator()(const f32x4 (&acc)[2][2][4][2], const Unit& u, int wr, int wc, int fr, int fq) const {
#pragma unroll
        for (int ai = 0; ai < 2; ++ai)
#pragma unroll
            for (int m = 0; m < 4; ++m) {
                bf16_t* rowp = C + (size_t)(u.pm * BM + ai * HALF + wr * 64 + m * 16 + fr) * ldc + u.pn * BM + wc * 32 + 8 * fq;
#pragma unroll
                for (int bj = 0; bj < 2; ++bj) {
                    const f32x4 v0 = acc[ai][bj][m][0], v1 = acc[ai][bj][m][1];
                    u32x4 w; w[0] = pack2(v0[0], v0[1]); w[1] = pack2(v0[2], v0[3]); w[2] = pack2(v1[0], v1[1]); w[3] = pack2(v1[2], v1[3]);
                    *(u32x4*)(rowp + bj * HALF) = w;
                }
                asm volatile("" ::: "memory");
            }
    }
};
struct EpiRes {
    static constexpr bool PERM = true, AFTER_DRAIN = false;
    bf16_t* C; const float* X; float* ssq;
    __device__ __forceinline__ void operator()(const f32x4 (&acc)[2][2][4][2], const Unit& u, int wr, int wc, int fr, int fq) const {
#pragma unroll
        for (int ai = 0; ai < 2; ++ai) {
            f32x4 xv[4][2][2];
#pragma unroll
            for (int m = 0; m < 4; ++m)
#pragma unroll
                for (int bj = 0; bj < 2; ++bj) {
                    const float* xp = X + (size_t)(u.pm * BM + ai * HALF + wr * 64 + m * 16 + fr) * DM + u.pn * BM + bj * HALF + wc * 32 + 8 * fq;
                    xv[m][bj][0] = *(const f32x4*)xp; xv[m][bj][1] = *(const f32x4*)(xp + 4);
                }
            asm volatile("" ::: "memory");
#pragma unroll
            for (int m = 0; m < 4; ++m) {
                const int row = u.pm * BM + ai * HALF + wr * 64 + m * 16 + fr;
                float ss = 0.f;
#pragma unroll
                for (int bj = 0; bj < 2; ++bj) {
                    const int col = u.pn * BM + bj * HALF + wc * 32 + 8 * fq;
                    const f32x4 v0 = acc[ai][bj][m][0] + xv[m][bj][0], v1 = acc[ai][bj][m][1] + xv[m][bj][1];
                    ss += v0[0] * v0[0] + v0[1] * v0[1] + v0[2] * v0[2] + v0[3] * v0[3] + v1[0] * v1[0] + v1[1] * v1[1] + v1[2] * v1[2] + v1[3] * v1[3];
                    u32x4 w; w[0] = pack2(v0[0], v0[1]); w[1] = pack2(v0[2], v0[3]); w[2] = pack2(v1[0], v1[1]); w[3] = pack2(v1[2], v1[3]);
                    *(u32x4*)(C + (size_t)row * DM + col) = w;
                }
                ss += __shfl_xor(ss, 16); ss += __shfl_xor(ss, 32);
                if (fq == 0) atomicAdd(ssq + row, ss);
            }
            asm volatile("" ::: "memory");
        }
    }
};
template <class Epi, class Sched, bool ALIGN_EPI = false, bool SP2 = false>
__device__ __forceinline__ void gemm_phase(PG8_LAS unsigned char* lds, const Gemm g, const Sched& S, const Epi& E) {
    const int tid = threadIdx.x, wid = __builtin_amdgcn_readfirstlane(tid >> 6), lane = tid & 63, wr = wid >> 2, wc = wid & 3, fr = lane & 15, fq = lane >> 4;
    const int K = g.K, nt = K / BK;
    unsigned voffA[2], voffB[2];
#pragma unroll
    for (int i = 0; i < 2; ++i) { int R, C; stage_rc(tid * 16 + i * 8192, R, C); const int Rb = Epi::PERM ? ((R & ~31) + perm32(R & 31)) : R;
        voffA[i] = (unsigned)(R * K + C) * 2u; voffB[i] = (unsigned)(Rb * K + C) * 2u; }
    const size_t kstep = (size_t)(BK * 2);
    const size_t hstep = (size_t)HALF * K * 2;
    const size_t tstep = 2 * hstep;
    const unsigned ldsw = (unsigned)wid * 1024u;
    const int aoff = lds_byte(wr * 64 + fr, fq * 8), boff = lds_byte(wc * 32 + fr, fq * 8);
#define PG8_SA(b, h) (((b) * 2 + (h)) * HTB)
#define PG8_SB(b, h) ((4 + (b) * 2 + (h)) * HTB)
#define PG8_STAGE(bufoff, gbase, voff) do { _Pragma("unroll") for (int _i = 0; _i < 2; ++_i) \
        __builtin_amdgcn_global_load_lds((const unsigned*)((const char*)(gbase) + (voff)[_i]), (PG8_LAS unsigned*)(lds + (bufoff) + ldsw + _i * 8192), 16, 0, 0); } while (0)
#define PG8_LDA(dst, b, h) do { _Pragma("unroll") for (int m = 0; m < 4; ++m) _Pragma("unroll") for (int k = 0; k < 2; ++k) dst[m][k] = *(const PG8_LAS bf16x8*)(lds + PG8_SA(b, h) + aoff + m * 2048 + k * 1024); } while (0)
#define PG8_LDB(dst, b, h) do { _Pragma("unroll") for (int n = 0; n < 2; ++n) _Pragma("unroll") for (int k = 0; k < 2; ++k) dst[n][k] = *(const PG8_LAS bf16x8*)(lds + PG8_SB(b, h) + boff + n * 2048 + k * 1024); } while (0)
#define PG8_MMA(ai, bj, At, Bt) do { __builtin_amdgcn_s_setprio(1); _Pragma("unroll") for (int m = 0; m < 4; ++m) _Pragma("unroll") for (int n = 0; n < 2; ++n) _Pragma("unroll") for (int k = 0; k < 2; ++k) \
        acc[ai][bj][m][n] = __builtin_amdgcn_mfma_f32_16x16x32_bf16(Bt[n][k], At[m][k], acc[ai][bj][m][n], 0, 0, 0); __builtin_amdgcn_s_setprio(0); } while (0)
#define PG8_WAIT_V(n) asm volatile("s_waitcnt vmcnt(" #n ")" ::: "memory")
#define PG8_WAIT_L(n) asm volatile("s_waitcnt lgkmcnt(" #n ")" ::: "memory")
#define PG8_BAR __builtin_amdgcn_s_barrier()
#define PG8_SCHED __builtin_amdgcn_sched_barrier(0)
    Unit cur, nxt; int ui = 0;
    if (!S.next(0, cur)) return;
    f32x4 acc[2][2][4][2];
#pragma unroll
    for (int a = 0; a < 2; ++a)
#pragma unroll
        for (int b = 0; b < 2; ++b)
#pragma unroll
            for (int m = 0; m < 4; ++m)
#pragma unroll
                for (int n = 0; n < 2; ++n) acc[a][b][m][n] = (f32x4){0.f, 0.f, 0.f, 0.f};
    bf16x8 At[4][2], B0[2][2], B1[2][2];
    const char* cA = (const char*)g.A + (size_t)cur.pm * tstep; const char* cB = (const char*)g.Bt + (size_t)cur.pn * tstep;
    S.a_ready(cur);
    if constexpr (SP2) {
        PG8_STAGE(PG8_SB(0, 0), cB, voffB); PG8_STAGE(PG8_SB(0, 1), cB + hstep, voffB); PG8_STAGE(PG8_SA(0, 0), cA, voffA); PG8_STAGE(PG8_SA(0, 1), cA + hstep, voffA);
        if (wr == 1) PG8_BAR;
        PG8_WAIT_V(2); PG8_BAR;
        PG8_STAGE(PG8_SB(1, 0), cB + kstep, voffB); PG8_STAGE(PG8_SA(1, 0), cA + kstep, voffA); PG8_STAGE(PG8_SB(1, 1), cB + hstep + kstep, voffB);
        PG8_WAIT_V(6); PG8_BAR;
    } else {
        PG8_STAGE(PG8_SB(0, 0), cB, voffB); PG8_STAGE(PG8_SA(0, 0), cA, voffA); PG8_STAGE(PG8_SB(0, 1), cB + hstep, voffB); PG8_STAGE(PG8_SA(0, 1), cA + hstep, voffA);
        if (wr == 1) PG8_BAR;
        PG8_WAIT_V(4); PG8_BAR;
        PG8_STAGE(PG8_SB(1, 0), cB + kstep, voffB); PG8_STAGE(PG8_SA(1, 0), cA + kstep, voffA); PG8_STAGE(PG8_SB(1, 1), cB + hstep + kstep, voffB);
        PG8_WAIT_V(6); PG8_BAR;
    }
    for (;;) {
        const bool has_next = S.next(ui + 1, nxt);
        const char* nA = has_next ? (const char*)g.A + (size_t)nxt.pm * tstep : cA; const char* nB = has_next ? (const char*)g.Bt + (size_t)nxt.pn * tstep : cB;
        for (int t = 0; t < nt; t += 2) {
            const bool last = (t == nt - 2);
            const char* a1 = cA + (size_t)(t + 1) * kstep;
            const char* a2 = last ? nA : cA + (size_t)(t + 2) * kstep; const char* b2 = last ? nB : cB + (size_t)(t + 2) * kstep;
            const char* a3 = a2 + kstep; const char* b3 = b2 + kstep;
            if (last && has_next) S.a_ready(nxt);
            if constexpr (SP2) {
            PG8_LDB(B0, 0, 0); PG8_LDB(B1, 0, 1); PG8_SCHED; PG8_LDA(At, 0, 0); PG8_STAGE(PG8_SA(1, 1), a1 + hstep, voffA);
            PG8_WAIT_V(8); PG8_WAIT_L(0); PG8_BAR; PG8_MMA(0, 0, At, B0); PG8_MMA(0, 1, At, B1); PG8_BAR; PG8_SCHED;
            PG8_LDA(At, 0, 1); PG8_STAGE(PG8_SB(0, 0), b2, voffB); PG8_STAGE(PG8_SB(0, 1), b2 + hstep, voffB); PG8_STAGE(PG8_SA(0, 0), a2, voffA);
            PG8_WAIT_V(8); PG8_WAIT_L(0); PG8_BAR; PG8_MMA(1, 0, At, B0); PG8_MMA(1, 1, At, B1); PG8_BAR; PG8_SCHED;
            PG8_LDB(B0, 1, 0); PG8_LDB(B1, 1, 1); PG8_SCHED; PG8_LDA(At, 1, 0); PG8_STAGE(PG8_SA(0, 1), a2 + hstep, voffA);
            PG8_WAIT_V(8); PG8_WAIT_L(0); PG8_BAR; PG8_MMA(0, 0, At, B0); PG8_MMA(0, 1, At, B1); PG8_BAR; PG8_SCHED;
            PG8_LDA(At, 1, 1); PG8_STAGE(PG8_SB(1, 0), b3, voffB); PG8_STAGE(PG8_SB(1, 1), b3 + hstep, voffB); PG8_STAGE(PG8_SA(1, 0), a3, voffA);
            PG8_WAIT_V(8); PG8_WAIT_L(0); PG8_BAR; PG8_MMA(1, 0, At, B0); PG8_MMA(1, 1, At, B1); PG8_BAR; PG8_SCHED;
            } else {
            PG8_LDB(B0, 0, 0); PG8_SCHED; PG8_LDA(At, 0, 0); PG8_STAGE(PG8_SA(1, 1), a1 + hstep, voffA);
            PG8_WAIT_L(8); PG8_BAR; PG8_WAIT_L(0); PG8_MMA(0, 0, At, B0); PG8_BAR; PG8_SCHED;
            PG8_LDB(B1, 0, 1); PG8_STAGE(PG8_SB(0, 0), b2, voffB);
            PG8_BAR; PG8_WAIT_L(0); PG8_MMA(0, 1, At, B1); PG8_BAR;
            PG8_LDA(At, 0, 1); PG8_STAGE(PG8_SA(0, 0), a2, voffA);
            PG8_BAR; PG8_WAIT_L(0); PG8_MMA(1, 0, At, B0); PG8_BAR; PG8_SCHED;
            PG8_STAGE(PG8_SB(0, 1), b2 + hstep, voffB);
            PG8_WAIT_V(6); PG8_BAR; PG8_MMA(1, 1, At, B1); PG8_BAR;
            PG8_LDB(B0, 1, 0); PG8_SCHED; PG8_LDA(At, 1, 0); PG8_STAGE(PG8_SA(0, 1), a2 + hstep, voffA);
            PG8_WAIT_L(8); PG8_BAR; PG8_WAIT_L(0); PG8_MMA(0, 0, At, B0); PG8_BAR; PG8_SCHED;
            PG8_LDB(B1, 1, 1); PG8_STAGE(PG8_SB(1, 0), b3, voffB);
            PG8_BAR; PG8_WAIT_L(0); PG8_MMA(0, 1, At, B1); PG8_BAR;
            PG8_LDA(At, 1, 1); PG8_STAGE(PG8_SA(1, 0), a3, voffA);
            PG8_BAR; PG8_WAIT_L(0); PG8_MMA(1, 0, At, B0); PG8_BAR; PG8_SCHED;
            PG8_STAGE(PG8_SB(1, 1), b3 + hstep, voffB);
            PG8_WAIT_V(6); PG8_BAR; PG8_MMA(1, 1, At, B1); PG8_BAR;
            }
        }
        if constexpr (ALIGN_EPI) { if (wr == 0) PG8_BAR; }
        if constexpr (!Epi::AFTER_DRAIN) { E(acc, cur, wr, wc, fr, fq); S.done(cur); }
        if (!has_next) break;
#pragma unroll
        for (int a = 0; a < 2; ++a)
#pragma unroll
            for (int b = 0; b < 2; ++b)
#pragma unroll
                for (int m = 0; m < 4; ++m)
#pragma unroll
                    for (int n = 0; n < 2; ++n) acc[a][b][m][n] = (f32x4){0.f, 0.f, 0.f, 0.f};
        cur = nxt; cA = nA; cB = nB; ++ui;
        if constexpr (ALIGN_EPI) { if (wr == 1) PG8_BAR; }
    }
    PG8_WAIT_V(0);
    if constexpr (!ALIGN_EPI) { if (wr == 0) PG8_BAR; }
    PG8_BAR;
    if constexpr (Epi::AFTER_DRAIN) { E.fused(acc, cur, wr, wc, fr, fq, lds, wid, lane); S.done(cur); }
#undef PG8_SA
#undef PG8_SB
#undef PG8_STAGE
#undef PG8_LDA
#undef PG8_LDB
#undef PG8_MMA
#undef PG8_WAIT_V
#undef PG8_WAIT_L
#undef PG8_BAR
#undef PG8_SCHED
}
}

__device__ __forceinline__ void lru_unit(const Params& p, char* smem, int c, int b) {
    int tid_ = threadIdx.x; asm volatile("" : "+v"(tid_));
    const int tid = tid_, lane = tid & 63, wave = __builtin_amdgcn_readfirstlane(tid >> 6);
    char* ws = p.ws;
    const bf16_t* P = (const bf16_t*)(ws + OFF_P);
    const bf16_t* WAT = (const bf16_t*)(ws + OFF_WAT); const bf16_t* WXT = (const bf16_t*)(ws + OFF_WXT);
    float* sumA = (float*)(ws + OFF_SUMA); float* sumH = (float*)(ws + OFF_SUMH);
    const float* lp = (const float*)(smem + PRM_LRU);
    bf16_t* AC = (bf16_t*)(ws + OFF_AC); bf16_t* HL = (bf16_t*)(ws + OFF_HL);
    bf16_t* Xc = (bf16_t*)smem;
    float* Z0 = (float*)(smem + 9216);
    float* Z1 = Z0 + 64 * LF;
    float* SegA = Z1 + 64 * LF;
    float* SegH = SegA + 512;
    const int t = tid >> 3, c8 = tid & 7;
    const int pos0 = c == 0 ? 0 : NMETA + 64 * (c - 1);
    const int pos = pos0 + t;
    const bool valid = (c > 0) || (t < NMETA);
    const int row = row_of(b, valid ? pos : 0);
    const int grp = wave >> 2, qm = (wave >> 1) & 1, qn = wave & 1;
    const int r = lane & 31, hh2 = lane >> 5;
    u32x4 nx[4]; bf16x8 nb[4];
    auto fetch = [&](int hd) {
        const int ch0 = hd * 64 + c8 * 8;
#pragma unroll
        for (int d = 0; d < 4; ++d) {
            const int pp = pos - 3 + d;
            u32x4 z; z[0] = 0; z[1] = 0; z[2] = 0; z[3] = 0;
            nx[d] = (valid && pp >= 0) ? *(const u32x4*)(P + (size_t)row_of(b, pp) * DIN + ch0) : z;
        }
        const bf16_t* bp = (grp == 0 ? WAT : WXT) + hd * 4096 + (size_t)(qn * 32 + r) * 64 + hh2 * 8;
#pragma unroll
        for (int ks = 0; ks < 4; ++ks) nb[ks] = *(const bf16x8*)(bp + ks * 16);
    };
    fetch(0);
#pragma unroll 1
    for (int hd = 0; hd < 8; ++hd) {
        const int ch0 = hd * 64 + c8 * 8;
        float xc[8];
        u32x4 cx[4]; bf16x8 cb[4];
#pragma unroll
        for (int d = 0; d < 4; ++d) { cx[d] = nx[d]; cb[d] = nb[d]; }
        if (hd < 7) fetch(hd + 1);
        {
            f32x4 b0 = *(const f32x4*)(lp + 1536 + ch0), b1 = *(const f32x4*)(lp + 1536 + ch0 + 4);
            xc[0] = b0[0]; xc[1] = b0[1]; xc[2] = b0[2]; xc[3] = b0[3]; xc[4] = b1[0]; xc[5] = b1[1]; xc[6] = b1[2]; xc[7] = b1[3];
#pragma unroll
            for (int d = 0; d < 4; ++d) {
                float xv[8]; unpack8(cx[d], xv);
                f32x4 w0 = *(const f32x4*)(lp + 2048 + d * 512 + ch0), w1 = *(const f32x4*)(lp + 2048 + d * 512 + ch0 + 4);
                xc[0] += w0[0] * xv[0]; xc[1] += w0[1] * xv[1]; xc[2] += w0[2] * xv[2]; xc[3] += w0[3] * xv[3];
                xc[4] += w1[0] * xv[4]; xc[5] += w1[1] * xv[5]; xc[6] += w1[2] * xv[6]; xc[7] += w1[3] * xv[7];
            }
            *(u32x4*)(Xc + t * LD + c8 * 8) = pack8(xc);
        }
        __syncthreads();
        {
            f32x16 acc = zero16();
            const bf16_t* ap = Xc + (qm * 32 + r) * LD + hh2 * 8;
#pragma unroll
            for (int ks = 0; ks < 4; ++ks) { bf16x8 av_ = *(const bf16x8*)(ap + ks * 16); acc = MFMA32(av_, cb[ks], acc); }
            store_N_f32(grp == 0 ? Z0 : Z1, acc, qm, qn, lane);
        }
        __syncthreads();
        {
            float za[8], zx[8];
            *(f32x4*)za = *(const f32x4*)(Z0 + t * LF + c8 * 8); *(f32x4*)(za + 4) = *(const f32x4*)(Z0 + t * LF + c8 * 8 + 4);
            *(f32x4*)zx = *(const f32x4*)(Z1 + t * LF + c8 * 8); *(f32x4*)(zx + 4) = *(const f32x4*)(Z1 + t * LF + c8 * 8 + 4);
            float av[8], bv[8];
#pragma unroll
            for (int i = 0; i < 8; ++i) {
                const int ch = ch0 + i;
                const float rg = sigmoidf_(za[i] + lp[ch]), ig = sigmoidf_(zx[i] + lp[512 + ch]);
                const float a = __expf(-8.0f * rg * lp[1024 + ch]);
                const float bb = sqrtf(fmaxf(1.0f - a * a, 0.f)) * ig * xc[i];
                av[i] = valid ? a : 1.0f; bv[i] = valid ? bb : 0.f;
            }
            *(f32x4*)(Z0 + t * LF + c8 * 8) = *(f32x4*)av; *(f32x4*)(Z0 + t * LF + c8 * 8 + 4) = *(f32x4*)(av + 4);
            *(f32x4*)(Z1 + t * LF + c8 * 8) = *(f32x4*)bv; *(f32x4*)(Z1 + t * LF + c8 * 8 + 4) = *(f32x4*)(bv + 4);
        }
        __syncthreads();
        const int sch = tid & 63, seg = tid >> 6;
        {
            float Ac = 1.f, hh = 0.f;
#pragma unroll
            for (int k = 0; k < 8; ++k) {
                const int tt = seg * 8 + k;
                const float a = Z0[tt * LF + sch], bb = Z1[tt * LF + sch];
                hh = a * hh + bb; Ac *= a;
                Z0[tt * LF + sch] = Ac; Z1[tt * LF + sch] = hh;
            }
            SegA[seg * 64 + sch] = Ac; SegH[seg * 64 + sch] = hh;
        }
        __syncthreads();
        {
            float hin = 0.f, Ain = 1.f;
            for (int s2 = 0; s2 < seg; ++s2) { hin = SegA[s2 * 64 + sch] * hin + SegH[s2 * 64 + sch]; Ain *= SegA[s2 * 64 + sch]; }
#pragma unroll
            for (int k = 0; k < 8; ++k) {
                const int tt = seg * 8 + k;
                const float a = Z0[tt * LF + sch];
                Z1[tt * LF + sch] += a * hin; Z0[tt * LF + sch] = a * Ain;
            }
            if (seg == 7) {
                sumA[((size_t)c * 2 + b) * 512 + hd * 64 + sch] = Z0[63 * LF + sch];
                sumH[((size_t)c * 2 + b) * 512 + hd * 64 + sch] = Z1[63 * LF + sch];
            }
        }
        __syncthreads();
        if (c > 0) {
            float a8[8], h8[8];
            *(f32x4*)a8 = *(const f32x4*)(Z0 + t * LF + c8 * 8); *(f32x4*)(a8 + 4) = *(const f32x4*)(Z0 + t * LF + c8 * 8 + 4);
            *(f32x4*)h8 = *(const f32x4*)(Z1 + t * LF + c8 * 8); *(f32x4*)(h8 + 4) = *(const f32x4*)(Z1 + t * LF + c8 * 8 + 4);
            *(u32x4*)(AC + (size_t)row * 512 + ch0) = pack8(a8);
            *(u32x4*)(HL + (size_t)row * 512 + ch0) = pack8(h8);
        }
        __syncthreads();
    }
}
__device__ __forceinline__ void lru_out(const Params& p, char* smem, int c, int b) {
    int tid_ = threadIdx.x; asm volatile("" : "+v"(tid_));
    const int tid = tid_;
    char* ws = p.ws;
    const bf16_t* P = (const bf16_t*)(ws + OFF_P);
    const bf16_t* AC = (const bf16_t*)(ws + OFF_AC); const bf16_t* HL = (const bf16_t*)(ws + OFF_HL);
    float* HS = (float*)smem;
    bf16_t* Y = (bf16_t*)(ws + OFF_XN);
    {
        const float* sumA = (const float*)(ws + OFF_SUMA); const float* sumH = (const float*)(ws + OFF_SUMH);
        float hcur = sumH[tid];
#pragma unroll 1
        for (int c0 = 1; c0 < c; c0 += 32) {
            float av[32], hv[32];
#pragma unroll
            for (int k = 0; k < 32; ++k) { const int cc = min(c0 + k, NCHUNK - 1); av[k] = sumA[((size_t)cc * 2 + b) * 512 + tid]; hv[k] = sumH[((size_t)cc * 2 + b) * 512 + tid]; }
            asm volatile("" : "+v"(hcur) :: "memory");
#pragma unroll
            for (int k = 0; k < 32; ++k) { if (c0 + k < c) hcur = av[k] * hcur + hv[k]; }
        }
        __syncthreads();
        HS[tid] = hcur;
        __syncthreads();
    }
    const int t = tid >> 3, c8 = tid & 7;
    const int row = b * T_SEQ + 64 * (c - 1) + t;
    u32x4 yp[8];
    float ssq = 0.f;
#pragma unroll
    for (int hd = 0; hd < 8; ++hd) {
        const int ch0 = hd * 64 + c8 * 8;
        float a8[8], h8[8], g8[8], yv[8];
        unpack8(*(const u32x4*)(AC + (size_t)row * 512 + ch0), a8);
        unpack8(*(const u32x4*)(HL + (size_t)row * 512 + ch0), h8);
        unpack8(*(const u32x4*)(P + (size_t)row * DIN + 512 + ch0), g8);
        f32x4 s0 = *(const f32x4*)(HS + ch0), s1 = *(const f32x4*)(HS + ch0 + 4);
        const float hs[8] = {s0[0], s0[1], s0[2], s0[3], s1[0], s1[1], s1[2], s1[3]};
#pragma unroll
        for (int i = 0; i < 8; ++i) { yv[i] = (h8[i] + a8[i] * hs[i]) * gelu_tanh(g8[i]); ssq += yv[i] * yv[i]; }
        yp[hd] = pack8(yv);
    }
    ssq = sum8(ssq);
    const float rs = rsqrtf(ssq * (1.0f / 512.0f) + 1e-6f);
#pragma unroll
    for (int hd = 0; hd < 8; ++hd) {
        const int ch0 = hd * 64 + c8 * 8;
        float yv[8]; unpack8(yp[hd], yv);
        f32x4 g0 = *(const f32x4*)(p.lru_gain + ch0), g1 = *(const f32x4*)(p.lru_gain + ch0 + 4);
        yv[0] *= rs * g0[0]; yv[1] *= rs * g0[1]; yv[2] *= rs * g0[2]; yv[3] *= rs * g0[3];
        yv[4] *= rs * g1[0]; yv[5] *= rs * g1[1]; yv[6] *= rs * g1[2]; yv[7] *= rs * g1[3];
        *(u32x4*)(Y + (size_t)row * DM + ch0) = pack8(yv);
    }
    __syncthreads();
}

__device__ __forceinline__ float tanh_fast(float x) { return 1.0f - 2.0f / (__expf(2.0f * x) + 1.0f); }
struct S0Pre { u32x4 cur[5], prv[5]; };
__device__ __forceinline__ void s0_fetch(const Params& p, int c, int b, int hh, int tid, S0Pre& o) {
    const bf16_t* P = (const bf16_t*)(p.ws + OFF_P);
    const int t = tid >> 3, c8 = tid & 7;
    const int pos = (c == 0 ? 0 : NMETA + 64 * (c - 1)) + t;
    const bool valid = (c > 0) || (t < NMETA);
    const bool hasprev = valid && pos > 0;
    const bf16_t* pr = P + (size_t)row_of(b, valid ? pos : 0) * DIN;
    const bf16_t* pp = P + (size_t)row_of(b, hasprev ? pos - 1 : 0) * DIN;
    const int hc0 = hh * 64 + c8 * 8;
    const int cols[5] = {1024 + hc0, 1536 + hc0, 2048 + hc0, 2560 + c8 * 8, 2624 + c8 * 8};
#pragma unroll
    for (int i = 0; i < 5; ++i) { o.cur[i] = *(const u32x4*)(pr + cols[i]); o.prv[i] = *(const u32x4*)(pp + cols[i]); }
}
__device__ __forceinline__ void rwkv_unit(const Params& p, char* smem, int c, int b, int hh, unsigned long long& tacc, S0Pre& pre, bool has_next, int nc, int nb_, int nh) {
#define TT(k) if (TSSTAGE >= 0) { if ((k) == TSSTAGE) tacc -= __builtin_amdgcn_s_memrealtime(); if ((k) == TSSTAGE + 1) tacc += __builtin_amdgcn_s_memrealtime(); }
    TT(0)
    int tid_ = threadIdx.x; asm volatile("" : "+v"(tid_));
    const int tid = tid_, lane = tid & 63, wave = __builtin_amdgcn_readfirstlane(tid >> 6);
    char* ws = p.ws;
    const bf16_t* P = (const bf16_t*)(ws + OFF_P);
    bf16_t* S0 = (bf16_t*)smem;
#define SL(i) (S0 + (i) * SLOT)
    float* F0 = (float*)(smem + 14 * SLOT * 2);
    float* Seg = F0 + 64 * LF;
    float* GC = Seg + 512;
    float* FZa = (float*)SL(2);
    float* FZg = (float*)SL(4);
    const float* prm = (const float*)(smem + PRM_RWKV);
    bf16_t *sLw = SL(0), *sAabb = SL(0), *sLg0 = SL(0);
    bf16_t *sLa = SL(1), *sAak = SL(1), *sLg1 = SL(1);
    bf16_t *sBtT = SL(2), *sKtT = SL(3);
    bf16_t *sAt = SL(4), *sAtT = SL(5);
    bf16_t *sBh = SL(6), *sD0T = SL(6), *sW1T = SL(6);
    bf16_t *sKh = SL(7), *sM1T = SL(7), *sW2T = SL(7);
    bf16_t *sRt = SL(8), *sVT = SL(9), *sTm = SL(10), *sY2T = SL(11), *sArb = SL(12), *sArk = SL(13);
    const int t = tid >> 3, c8 = tid & 7;
    const int pos0 = c == 0 ? 0 : NMETA + 64 * (c - 1);
    const int pos = pos0 + t;
    const bool valid = (c > 0) || (t < NMETA);
    const int row = row_of(b, valid ? pos : 0);
    const int grp = wave >> 2, qm = (wave >> 1) & 1, qn = wave & 1, r = lane & 31, h = lane >> 5;
    const int hc0 = hh * 64 + c8 * 8;
    const int uidx = (b * 128 + (c - 1)) * 8 + hh;
    char* UD = c == 0 ? (ws + OFF_MPQ + (size_t)hh * 16384) : ((char*)p.out + (size_t)uidx * UNIT_BYTES);
    s0_fetch(p, c, b, hh, tid, pre);
    float rv[8], kv[8], vv[8];
    bf16x8 lorab[4];
    {
        const bf16_t* Bt = (const bf16_t*)(ws + (grp == 0 ? OFF_W2T : OFF_A2T)) + hh * 64 * 64 + (size_t)(qn * 32 + r) * 64 + h * 8;
#pragma unroll
        for (int ks = 0; ks < 4; ++ks) lorab[ks] = *(const bf16x8*)(Bt + ks * 16);
    }
    {
        const bool hasprev = valid && pos > 0;
        const int hcq = hc0, cols[5] = {1024 + hcq, 1536 + hcq, 2048 + hcq, 2560 + c8 * 8, 2624 + c8 * 8};
        auto sh8 = [&](int i, float* out) {
            float cur[8], prv[8];
            unpack8(pre.cur[i], cur); unpack8(pre.prv[i], prv);
            f32x4 m0 = *(const f32x4*)(p.mu + cols[i] - 1024), m1 = *(const f32x4*)(p.mu + cols[i] - 1024 + 4);
            float mm[8] = {m0[0], m0[1], m0[2], m0[3], m1[0], m1[1], m1[2], m1[3]};
#pragma unroll
            for (int k = 0; k < 8; ++k) out[k] = valid ? cur[k] + ((hasprev ? prv[k] : 0.f) - cur[k]) * mm[k] : 0.f;
        };
        sh8(0, rv); sh8(1, kv); sh8(2, vv);
        float wl[8], al[8];
        sh8(3, wl); sh8(4, al);
#pragma unroll
        for (int i = 0; i < 8; ++i) wl[i] = tanh_fast(wl[i]);
        *(u32x4*)(sLw + t * LD + c8 * 8) = pack8(wl);
        *(u32x4*)(sLa + t * LD + c8 * 8) = pack8(al);
    }
    __syncthreads();
    TT(1)
    {
        f32x16 acc = zero16();
        const bf16_t* ap = (grp == 0 ? sLw : sLa) + (qm * 32 + r) * LD + h * 8;
#pragma unroll
        for (int ks = 0; ks < 4; ++ks) { bf16x8 a_ = *(const bf16x8*)(ap + ks * 16); acc = MFMA32(a_, lorab[ks], acc); }
        store_N_f32(grp == 0 ? F0 : FZa, acc, qm, qn, lane);
    }
    __syncthreads();
    TT(2)
    float lw[8], av[8], kk[8], kt[8];
    float rk = 0.f;
    {
        float zw[8], za[8];
        *(f32x4*)zw = *(const f32x4*)(F0 + t * LF + c8 * 8); *(f32x4*)(zw + 4) = *(const f32x4*)(F0 + t * LF + c8 * 8 + 4);
        *(f32x4*)za = *(const f32x4*)(FZa + t * LF + c8 * 8); *(f32x4*)(za + 4) = *(const f32x4*)(FZa + t * LF + c8 * 8 + 4);
        float n2 = 0.f;
#pragma unroll
        for (int i = 0; i < 8; ++i) {
            const int ch = hc0 + i;
            lw[i] = valid ? -0.6065306597f * sigmoidf_(zw[i] + prm[ch]) : 0.f;
            av[i] = valid ? sigmoidf_(za[i] + prm[512 + ch]) : 0.f;
            kk[i] = kv[i] * prm[1024 + ch]; n2 += kk[i] * kk[i];
            kt[i] = kv[i] * (1.0f + (av[i] - 1.0f) * prm[1536 + ch]);
            rk += rv[i] * kt[i] * prm[2048 + ch];
        }
        n2 = sum8(n2); rk = sum8(rk);
        const float inv = 1.0f / fmaxf(sqrtf(n2), 1e-12f);
#pragma unroll
        for (int i = 0; i < 8; ++i) kk[i] *= inv;
        *(f32x4*)(F0 + t * LF + c8 * 8) = *(f32x4*)lw; *(f32x4*)(F0 + t * LF + c8 * 8 + 4) = *(f32x4*)(lw + 4);
    }
    __syncthreads();
    TT(3)
    {
        const int sch = tid & 63, seg = tid >> 6;
        float sacc = 0.f;
#pragma unroll
        for (int k = 0; k < 8; ++k) { const int tt = seg * 8 + k; sacc += F0[tt * LF + sch]; F0[tt * LF + sch] = sacc; }
        Seg[seg * 64 + sch] = sacc;
        __syncthreads();
        float pre = 0.f;
        for (int s2 = 0; s2 < seg; ++s2) pre += Seg[s2 * 64 + sch];
#pragma unroll
        for (int k = 0; k < 8; ++k) { const int tt = seg * 8 + k; F0[tt * LF + sch] += pre; }
        if (seg == 7) GC[sch] = sacc + pre;
    }
    __syncthreads();
    TT(4)
    {
        float g[8];
        *(f32x4*)g = *(const f32x4*)(F0 + t * LF + c8 * 8); *(f32x4*)(g + 4) = *(const f32x4*)(F0 + t * LF + c8 * 8 + 4);
        float at[8], bh[8], kh[8], rt[8], bt[8], ktt[8];
#pragma unroll
        for (int i = 0; i < 8; ++i) {
            const float gc = GC[c8 * 8 + i];
            const float em = __expf(-g[i]), ep = __expf(g[i]), epv = __expf(g[i] - lw[i]), ec = __expf(gc - g[i]);
            at[i] = -kk[i] * epv; bh[i] = kk[i] * av[i] * em; kh[i] = kt[i] * em; rt[i] = rv[i] * ep;
            bt[i] = kk[i] * av[i] * ec; ktt[i] = kt[i] * ec;
        }
        *(u32x4*)(sAt + t * LD + c8 * 8) = pack8(at);
        *(u32x4*)(sBh + t * LD + c8 * 8) = pack8(bh);
        *(u32x4*)(sKh + t * LD + c8 * 8) = pack8(kh);
        *(u32x4*)(sRt + t * LD + c8 * 8) = pack8(rt);
#pragma unroll
        for (int i = 0; i < 8; ++i) {
            const int tsw = (((t >> 3) ^ c8) << 3) | (t & 7);
            sAtT[(c8 * 8 + i) * LD + tsw] = f2bf(at[i]);
            sVT[(c8 * 8 + i) * LD + tsw] = f2bf(vv[i]);
            sBtT[(c8 * 8 + i) * LD + tsw] = f2bf(bt[i]);
            sKtT[(c8 * 8 + i) * LD + tsw] = f2bf(ktt[i]);
        }
    }
    __syncthreads();
    TT(5)
    f32x16 accQ = zero16();
    {
        f32x16 acc = zero16(), acc2 = zero16();
        acc = mm_lds<4>(sAt, grp == 0 ? sBh : sKh, qm, qn, lane, acc);
        acc2 = mm_lds<4>(sRt, grp == 0 ? sBh : sKh, qm, qn, lane, acc2);
#pragma unroll
        for (int reg = 0; reg < 16; ++reg) {
            const int tt = qm * 32 + (reg & 3) + 8 * (reg >> 2) + 4 * h, ss = qn * 32 + r;
            if (ss >= tt) acc[reg] = 0.f;
            if (ss > tt) acc2[reg] = 0.f;
        }
        if (grp == 0) accQ = mm_lds_s<4>(sKtT, sVT, qm, qn, lane, accQ, true, true);
        if (grp == 0) { store_N_f32(F0, acc, qm, qn, lane); store_N_bf16(sAabb, acc, qm, qn, lane); store_N_bf16(sArb, acc2, qm, qn, lane); }
        else { store_N_bf16(sAak, acc, qm, qn, lane); store_N_bf16(sArk, acc2, qm, qn, lane); }
    }
    __syncthreads();
    TT(6)
    if (wave == 0) {
        int lane2 = lane; asm volatile("" : "+v"(lane2));
        const int blk = lane2 >> 5, j = lane2 & 31;
        const float* Ab = F0 + (32 * blk) * LF + 32 * blk;
        float xs[32];
#pragma unroll
        for (int tt = 0; tt < 32; ++tt) {
            float sacc = (tt == j) ? 1.f : 0.f;
#pragma unroll
            for (int s2 = 0; s2 < tt; ++s2) sacc += Ab[tt * LF + s2] * xs[s2];
            xs[tt] = sacc;
        }
#pragma unroll
        for (int tt = 0; tt < 32; ++tt) sTm[(32 * blk + tt) * LD + 32 * blk + j] = f2bf(xs[tt]);
        if (blk == 0) {
#pragma unroll
            for (int q = 0; q < 4; ++q) *(u32x4*)(sD0T + j * LD + q * 8) = pack8(xs + q * 8);
        }
    } else if (wave == 1) {
        const int rr = lane >> 1, cc = 32 + (lane & 1) * 16;
        u32x4 z; z[0] = 0; z[1] = 0; z[2] = 0; z[3] = 0;
        *(u32x4*)(sTm + rr * LD + cc) = z; *(u32x4*)(sTm + rr * LD + cc + 8) = z;
    } else if (grp == 1) {
        f32x16 acc = zero16();
        acc = mm_lds_s<4>(sAak, sVT, qm, qn, lane, acc, false, true);
        store_T_bf16(sY2T, acc, qm, qn, lane);
    }
    __syncthreads();
    TT(7)
    if (wave == 0) {
        f32x16 acc = zero16();
        acc = mm_lds<2>(sAabb, sD0T, 1, 0, lane, acc);
        store_T_bf16(sM1T, acc, 0, 0, lane);
    }
    __syncthreads();
    TT(8)
    if (wave == 0) {
        f32x16 acc = zero16();
        const bf16_t* ap = sTm + (32 + r) * LD + 32 + h * 8;
        const bf16_t* bp = sM1T + r * LD + h * 8;
#pragma unroll
        for (int ks = 0; ks < 2; ++ks) { bf16x8 a = *(const bf16x8*)(ap + ks * 16), bb = *(const bf16x8*)(bp + ks * 16); acc = MFMA32(a, bb, acc); }
        store_N_bf16(sTm, acc, 1, 0, lane);
    }
    __syncthreads();
    TT(9)
    {
        u32x4 glc[2], glp[2];
        if (c > 0) {
            const bf16_t* pr = P + (size_t)row * DIN + 2688 + c8 * 16;
            const bf16_t* pp = P + (size_t)row_of(b, pos - 1) * DIN + 2688 + c8 * 16;
            glc[0] = *(const u32x4*)pr; glc[1] = *(const u32x4*)(pr + 8); glp[0] = *(const u32x4*)pp; glp[1] = *(const u32x4*)(pp + 8);
        }
        f32x16 acc = zero16();
        acc = mm_lds_s<4>(sTm, grp == 0 ? sAtT : sY2T, qm, qn, lane, acc, false, grp == 0);
        store_T_bf16(grp == 0 ? sW1T : sW2T, acc, qm, qn, lane);
        if (c > 0) {
            bf16_t* d = ((c8 < 4) ? sLg0 : sLg1) + t * LD + (c8 & 3) * 16;
#pragma unroll
            for (int hf = 0; hf < 2; ++hf) {
                float cur[8], prv[8], gg[8];
                unpack8(glc[hf], cur); unpack8(glp[hf], prv);
#pragma unroll
                for (int i = 0; i < 8; ++i) gg[i] = sigmoidf_(cur[i] + (prv[i] - cur[i]) * p.mu[1664 + c8 * 16 + hf * 8 + i]);
                *(u32x4*)(d + hf * 8) = pack8(gg);
            }
        }
    }
    __syncthreads();
    TT(10)
    if (grp == 0) {
        f32x16 acc = mm_lds_s<4>(sBtT, sW2T, qm, qn, lane, accQ, true, false);
        bf16_t* QC = (bf16_t*)(UD + 8192);
        const int v = qn * 32 + r;
#pragma unroll
        for (int g = 0; g < 4; ++g) {
            const int k = qm * 32 + 8 * g + 4 * h;
            u32x2 w; w[0] = pack2(acc[4 * g], acc[4 * g + 1]); w[1] = pack2(acc[4 * g + 2], acc[4 * g + 3]);
            *(u32x2*)(QC + (((v >> 4) * 2 + (k >> 5)) * 64 + ((k >> 2) & 3) * 16 + (v & 15)) * 8 + ((k >> 4) & 1) * 4) = w;
        }
        if (c > 0) {
            f32x16 ag = zero16();
            ag = mm_lds<4>(sArb, sW1T, qm, qn, lane, ag);
            bf16_t* Gg = (bf16_t*)(UD + 16384);
#pragma unroll
            for (int reg = 0; reg < 16; ++reg) {
                const int tt = qm * 32 + (reg & 3) + 8 * (reg >> 2) + 4 * h, k = qn * 32 + r;
                Gg[tt * 64 + (k >> 5) * 32 + ((k >> 2) & 3) * 8 + ((k >> 4) & 1) * 4 + (k & 3)] = f2bf(ag[reg] + bf2f(sRt[tt * LD + k]));
            }
            f32x16 accg = zero16();
            const bf16_t* G2T = (const bf16_t*)(ws + OFF_G2T) + (size_t)hh * 64 * 128;
            accg = mm_lds_g<4>(sLg0, G2T, 128, qm, qn, lane, accg);
            accg = mm_lds_g<4>(sLg1, G2T + 64, 128, qm, qn, lane, accg);
            store_N_f32(FZg, accg, qm, qn, lane);
        }
    } else {
        f32x16 acc = zero16();
        acc = mm_lds_s<4>(sBtT, sW1T, qm, qn, lane, acc, true, false);
        bf16_t* PA = (bf16_t*)UD;
        const int k2 = qn * 32 + r;
#pragma unroll
        for (int reg = 0; reg < 16; ++reg) {
            const int k1 = qm * 32 + (reg & 3) + 8 * (reg >> 2) + 4 * h;
            float vv2 = acc[reg];
            if (k1 == k2) vv2 += __expf(GC[k1]);
            PA[(((k1 >> 4) * 2 + (k2 >> 5)) * 64 + ((k2 >> 2) & 3) * 16 + (k1 & 15)) * 8 + ((k2 >> 4) & 1) * 4 + (k2 & 3)] = f2bf(vv2);
        }
        if (c > 0) {
            f32x16 ah = zero16();
            ah = mm_lds<4>(sArb, sW2T, qm, qn, lane, ah);
            ah = mm_lds_s<4>(sArk, sVT, qm, qn, lane, ah, false, true);
            bf16_t* HC = (bf16_t*)(UD + 24576) + ((qm * 2 + qn) * 64 + lane) * 16;
            float hf[16];
#pragma unroll
            for (int reg = 0; reg < 16; ++reg) hf[reg] = ah[reg];
            *(u32x4*)HC = pack8(hf); *(u32x4*)(HC + 8) = pack8(hf + 8);
        }
    }
    __syncthreads();
    TT(11)
    if (c > 0) {
        float zg[8], e1[8], e2[8];
        *(f32x4*)zg = *(const f32x4*)(FZg + t * LF + c8 * 8); *(f32x4*)(zg + 4) = *(const f32x4*)(FZg + t * LF + c8 * 8 + 4);
#pragma unroll
        for (int i = 0; i < 8; ++i) { const int ch = hc0 + i; e1[i] = zg[i] * prm[2560 + ch]; e2[i] = zg[i] * (prm[3072 + ch] + rk * vv[i]); }
        *(u32x4*)((bf16_t*)(ws + OFF_E1) + (size_t)row * 512 + hc0) = pack8(e1);
        *(u32x4*)((bf16_t*)(ws + OFF_E2) + (size_t)row * 512 + hc0) = pack8(e2);
    }
    __syncthreads();
    TT(12)
#undef SL
}

__device__ __forceinline__ void rwkv_out_pair(const Params& p, char* smem, int pair) {
    int tid_ = threadIdx.x; asm volatile("" : "+v"(tid_));
    const int tid = tid_, lane = tid & 63, wave = __builtin_amdgcn_readfirstlane(tid >> 6);
    char* ws = p.ws;
    const int su = wave >> 2, qm = (wave >> 1) & 1, qn = wave & 1, r = lane & 31, h = lane >> 5;
    float* Ob = (float*)smem;
    {
        const int uidx = pair * 2 + su;
        const char* UD = (const char*)p.out + (size_t)uidx * UNIT_BYTES;
        const bf16_t* Gg = (const bf16_t*)(UD + 16384) + (qm * 32 + r) * 64 + h * 8;
        const bf16_t* SB = (const bf16_t*)(ws + OFF_SB) + (size_t)uidx * 4096 + (qn * 32 + r) * 64 + h * 8;
        const bf16_t* HC = (const bf16_t*)(UD + 24576) + ((qm * 2 + qn) * 64 + lane) * 16;
        bf16x8 gf[4], sf[4];
#pragma unroll
        for (int ks = 0; ks < 4; ++ks) { gf[ks] = *(const bf16x8*)(Gg + ks * 16); sf[ks] = *(const bf16x8*)(SB + ks * 16); }
        float hf[16];
        unpack8(*(const u32x4*)HC, hf); unpack8(*(const u32x4*)(HC + 8), hf + 8);
        f32x16 acc;
#pragma unroll
        for (int i = 0; i < 16; ++i) acc[i] = hf[i];
#pragma unroll
        for (int ks = 0; ks < 4; ++ks) acc = MFMA32(gf[ks], sf[ks], acc);
        store_N_f32(Ob + su * 64 * LF, acc, qm, qn, lane);
    }
    __syncthreads();
    {
        const int su2 = tid >> 8, t = (tid >> 2) & 63, c16 = tid & 3;
        const int uidx = pair * 2 + su2;
        const int hh = uidx & 7, cm1 = (uidx >> 3) & 127, b = uidx >> 10;
        const int row = b * T_SEQ + 64 * cm1 + t;
        const float* orow = Ob + su2 * 64 * LF + t * LF + c16 * 16;
        float o[16];
#pragma unroll
        for (int q = 0; q < 4; ++q) *(f32x4*)(o + 4 * q) = *(const f32x4*)(orow + 4 * q);
        float sacc = 0.f;
#pragma unroll
        for (int i = 0; i < 16; ++i) sacc += o[i];
        sacc += __shfl_xor(sacc, 1); sacc += __shfl_xor(sacc, 2);
        const float mean = sacc * (1.0f / 64.0f);
        float q2 = 0.f;
#pragma unroll
        for (int i = 0; i < 16; ++i) { const float d = o[i] - mean; q2 += d * d; }
        q2 += __shfl_xor(q2, 1); q2 += __shfl_xor(q2, 2);
        const float rs = rsqrtf(q2 * (1.0f / 64.0f) + 64e-5f);
        const bf16_t* e1p = (const bf16_t*)(ws + OFF_E1) + (size_t)row * 512 + hh * 64 + c16 * 16;
        const bf16_t* e2p = (const bf16_t*)(ws + OFF_E2) + (size_t)row * 512 + hh * 64 + c16 * 16;
        bf16_t* yp = (bf16_t*)(ws + OFF_XN) + (size_t)row * DM + 512 + hh * 64 + c16 * 16;
#pragma unroll
        for (int hf2 = 0; hf2 < 2; ++hf2) {
            float e1[8], e2[8], yv[8];
            unpack8(*(const u32x4*)(e1p + hf2 * 8), e1); unpack8(*(const u32x4*)(e2p + hf2 * 8), e2);
#pragma unroll
            for (int i = 0; i < 8; ++i) yv[i] = (o[hf2 * 8 + i] - mean) * rs * e1[i] + e2[i];
            *(u32x4*)(yp + hf2 * 8) = pack8(yv);
        }
    }
    __syncthreads();
}

struct ChainOp { u32x4 pa[4][2]; u32x4 q[2]; };
template <int MODE>
__device__ __forceinline__ void chain_load(ChainOp& o, const Params& p, int b, int hh, int cg, int lane, int c_) {
    const int c = (MODE & 4) ? 9 : c_;
    const char* U = c == 0 ? (const char*)(p.ws + OFF_MPQ + (size_t)hh * 16384) : ((const char*)p.out + (size_t)((b * 128 + (c - 1)) * 8 + hh) * UNIT_BYTES);
#pragma unroll
    for (int m = 0; m < 4; ++m) {
        o.pa[m][0] = *(const u32x4*)(U + ((size_t)((m * 2 + 0) * 64 + lane)) * 16);
        o.pa[m][1] = *(const u32x4*)(U + ((size_t)((m * 2 + 1) * 64 + lane)) * 16);
    }
    o.q[0] = *(const u32x4*)(U + 8192 + ((size_t)((cg * 2 + 0) * 64 + lane)) * 16);
    o.q[1] = *(const u32x4*)(U + 8192 + ((size_t)((cg * 2 + 1) * 64 + lane)) * 16);
}
template <int MODE>
__device__ __forceinline__ void chain_step(const ChainOp& o, f32x4 (&st)[4], bf16_t* SBb, int cg, int lane, int c) {
    const int q = lane >> 4, vl = lane & 15;
    u32x4 b0, b1;
    b0[0] = pack2(st[0][0], st[0][1]); b0[1] = pack2(st[0][2], st[0][3]); b0[2] = pack2(st[1][0], st[1][1]); b0[3] = pack2(st[1][2], st[1][3]);
    b1[0] = pack2(st[2][0], st[2][1]); b1[1] = pack2(st[2][2], st[2][3]); b1[2] = pack2(st[3][0], st[3][1]); b1[3] = pack2(st[3][2], st[3][3]);
    if (!(MODE & 2)) {
        bf16_t* S = SBb + (size_t)(max(c - 1, 0) * 8) * 4096 + (cg * 16 + vl) * 64 + 8 * q;
        *(u32x4*)S = b0; *(u32x4*)(S + 32) = b1;
    }
    const bf16x8 B0 = __builtin_bit_cast(bf16x8, b0), B1 = __builtin_bit_cast(bf16x8, b1);
    f32x4 acc[4];
#pragma unroll
    for (int m = 0; m < 4; ++m) {
        const unsigned q0 = o.q[m >> 1][(m & 1) * 2], q1 = o.q[m >> 1][(m & 1) * 2 + 1];
        f32x4 qi = {bflo(q0), bfhi(q0), bflo(q1), bfhi(q1)};
        acc[m] = MFMA16(__builtin_bit_cast(bf16x8, o.pa[m][0]), B0, qi);
    }
#pragma unroll
    for (int m = 0; m < 4; ++m) acc[m] = MFMA16(__builtin_bit_cast(bf16x8, o.pa[m][1]), B1, acc[m]);
#pragma unroll
    for (int m = 0; m < 4; ++m) st[m] = acc[m];
}
template <int MODE>
__device__ __forceinline__ void rwkv_chain_wg(const Params& p, char* smem, int chain, unsigned* lateflag) {
    const int tid = threadIdx.x, lane = tid & 63, wave = __builtin_amdgcn_readfirstlane(tid >> 6);
    const int b = chain >> 3, hh = chain & 7;
    int* prog = (int*)smem;
#define LDS_LD(ptr) __hip_atomic_load((ptr), __ATOMIC_RELAXED, __HIP_MEMORY_SCOPE_WORKGROUP)
#define LDS_ST(ptr, v) __hip_atomic_store((ptr), (v), __ATOMIC_RELAXED, __HIP_MEMORY_SCOPE_WORKGROUP)
    if (tid == 0) *prog = -1;
    __syncthreads();
    if (wave < 4) {
        const int cg = wave;
        bf16_t* SBb = (bf16_t*)(p.ws + ((MODE & 1) ? OFF_XN : OFF_SB)) + (size_t)(b * 128 * 8 + hh) * 4096;
        f32x4 st[4];
#pragma unroll
        for (int m = 0; m < 4; ++m) st[m] = (f32x4){0.f, 0.f, 0.f, 0.f};
        ChainOp oA, oB, oC, oD;
        chain_load<MODE>(oA, p, b, hh, cg, lane, 0); chain_load<MODE>(oB, p, b, hh, cg, lane, 1);
        chain_load<MODE>(oC, p, b, hh, cg, lane, 2); chain_load<MODE>(oD, p, b, hh, cg, lane, 3);
#pragma unroll 1
        for (int c = 0; c < 96; c += 4) {
            chain_step<MODE>(oA, st, SBb, cg, lane, c);     chain_load<MODE>(oA, p, b, hh, cg, lane, min(c + 4, 95));
            chain_step<MODE>(oB, st, SBb, cg, lane, c + 1); chain_load<MODE>(oB, p, b, hh, cg, lane, min(c + 5, 95));
            chain_step<MODE>(oC, st, SBb, cg, lane, c + 2); chain_load<MODE>(oC, p, b, hh, cg, lane, min(c + 6, 95));
            chain_step<MODE>(oD, st, SBb, cg, lane, c + 3); chain_load<MODE>(oD, p, b, hh, cg, lane, min(c + 7, 95));
        }
        {
            const unsigned need = b == 0 ? 33u : 32u;
            unsigned spins = 0;
            while (__hip_atomic_load(lateflag + 16 * chain, __ATOMIC_RELAXED, __HIP_MEMORY_SCOPE_AGENT) < need && spins < (1u << 22)) { __builtin_amdgcn_s_sleep(8); ++spins; }
            __builtin_amdgcn_fence(__ATOMIC_ACQUIRE, "agent");
            asm volatile("s_waitcnt vmcnt(0)" ::: "memory");
        }
        chain_load<MODE>(oA, p, b, hh, cg, lane, 96); chain_load<MODE>(oB, p, b, hh, cg, lane, 97);
        chain_load<MODE>(oC, p, b, hh, cg, lane, 98); chain_load<MODE>(oD, p, b, hh, cg, lane, 99);
#pragma unroll 1
        for (int c = 96; c < 128; c += 4) {
            chain_step<MODE>(oA, st, SBb, cg, lane, c);     chain_load<MODE>(oA, p, b, hh, cg, lane, c + 4);
            chain_step<MODE>(oB, st, SBb, cg, lane, c + 1); chain_load<MODE>(oB, p, b, hh, cg, lane, min(c + 5, NCHUNK - 1));
            chain_step<MODE>(oC, st, SBb, cg, lane, c + 2); chain_load<MODE>(oC, p, b, hh, cg, lane, min(c + 6, NCHUNK - 1));
            chain_step<MODE>(oD, st, SBb, cg, lane, c + 3); chain_load<MODE>(oD, p, b, hh, cg, lane, min(c + 7, NCHUNK - 1));
        }
        chain_step<MODE>(oA, st, SBb, cg, lane, 128);
        if (MODE & 2) { asm volatile("" :: "v"(st[0][0]), "v"(st[1][0]), "v"(st[2][0]), "v"(st[3][0])); }
    } else if (!(MODE & 8)) {
        const int w = wave - 4;
#pragma unroll 1
        for (int c0 = 4; c0 < NCHUNK; c0 += 8) {
            int spins = 0;
            while (c0 > LDS_LD(prog) + 40 && spins < (1 << 20)) { __builtin_amdgcn_s_sleep(2); ++spins; }
            unsigned acc = 0;
            u32x4 v[32];
#pragma unroll
            for (int k = 0; k < 8; ++k) {
                const int cp = min(c0 + k, NCHUNK - 1);
                const char* U = (const char*)p.out + (size_t)((b * 128 + (cp - 1)) * 8 + hh) * UNIT_BYTES + w * 4096;
#pragma unroll
                for (int i = 0; i < 4; ++i) v[k * 4 + i] = *(const u32x4*)(U + i * 1024 + lane * 16);
            }
#pragma unroll
            for (int k = 0; k < 32; ++k) acc ^= v[k][0];
            asm volatile("" :: "v"(acc));
        }
    }
}
__device__ __forceinline__ void lru_chain(const Params& p, int idx) {
    const int b = idx >> 9, ch = idx & 511;
    const float* __restrict__ sumA = (const float*)(p.ws + OFF_SUMA); const float* __restrict__ sumH = (const float*)(p.ws + OFF_SUMH);
    float* __restrict__ HS = (float*)(p.ws + OFF_HS);
    float hcur = sumH[ch];
    HS[(size_t)(0 * 2 + b) * 512 + ch] = 0.f;
#pragma unroll 1
    for (int c0 = 1; c0 < NCHUNK; c0 += 32) {
        float av[32], hv[32];
#pragma unroll
        for (int k = 0; k < 32; ++k) { av[k] = sumA[((size_t)(c0 + k) * 2 + b) * 512 + ch]; hv[k] = sumH[((size_t)(c0 + k) * 2 + b) * 512 + ch]; }
        asm volatile("" : "+v"(hcur) :: "memory");
#pragma unroll
        for (int k = 0; k < 32; ++k) { HS[((size_t)(c0 + k) * 2 + b) * 512 + ch] = hcur; hcur = av[k] * hcur + hv[k]; }
        asm volatile("" ::: "memory");
    }
}

#define KLD 136
__device__ __forceinline__ unsigned f2ord(float f) { const unsigned u = __float_as_uint(f); return (u & 0x80000000u) ? ~u : (u | 0x80000000u); }
__device__ __forceinline__ float ord2f(unsigned o) { const unsigned u = (o & 0x80000000u) ? (o & 0x7FFFFFFFu) : ~o; return __uint_as_float(u); }
#define CE(a, b) { const unsigned hi_ = max((a), (b)); (b) = min((a), (b)); (a) = hi_; }
__device__ __forceinline__ void ins16(unsigned (&L)[16], unsigned x) {
#pragma unroll
    for (int s = 0; s < 16; ++s) { const unsigned hi_ = max(L[s], x); x = min(L[s], x); L[s] = hi_; }
}
__device__ __forceinline__ void merge_pair16(unsigned (&L)[16]) {
    unsigned Pp[16];
#pragma unroll
    for (int s = 0; s < 16; ++s) Pp[s] = __shfl_xor(L[s], 32);
#pragma unroll
    for (int s = 0; s < 16; ++s) L[s] = max(L[s], Pp[15 - s]);
#pragma unroll
    for (int d = 8; d > 0; d >>= 1)
#pragma unroll
        for (int i = 0; i < 16; ++i) if ((i & d) == 0) CE(L[i], L[i + d]);
}

__device__ __forceinline__ void sort16_desc(unsigned (&T)[16]) {
#pragma unroll
    for (int k = 2; k <= 16; k <<= 1)
#pragma unroll
        for (int j = k >> 1; j > 0; j >>= 1)
#pragma unroll
            for (int i = 0; i < 16; ++i) {
                const int l = i ^ j;
                if (l > i) {
                    const unsigned hi_ = max(T[i], T[l]), lo_ = min(T[i], T[l]);
                    if ((i & k) == 0) { T[i] = hi_; T[l] = lo_; } else { T[i] = lo_; T[l] = hi_; }
                }
            }
}
__device__ __forceinline__ void merge16_desc(unsigned (&L)[16], const unsigned (&T)[16]) {
#pragma unroll
    for (int s = 0; s < 16; ++s) L[s] = max(L[s], T[15 - s]);
#pragma unroll
    for (int d = 8; d > 0; d >>= 1)
#pragma unroll
        for (int i = 0; i < 16; ++i) if ((i & d) == 0) CE(L[i], L[i + d]);
}
__device__ __forceinline__ void peer_topk_unit(const Params& p, char* smem, int tile, int head) {
    int tid_ = threadIdx.x; asm volatile("" : "+v"(tid_));
    const int tid = tid_, lane = tid & 63, wave = __builtin_amdgcn_readfirstlane(tid >> 6), r = lane & 31, h = lane >> 5;
    char* ws = p.ws;
    const bf16_t* KEYS = (const bf16_t*)(ws + OFF_KEYS) + (size_t)head * 2 * 128 * 128;
    const bf16_t* QN = (const bf16_t*)p.out;
    bf16_t* kl = (bf16_t*)smem;
    __syncthreads();
#pragma unroll
    for (int i = 0; i < 8; ++i) { const int q = tid + 512 * i, rowk = q >> 4, c16 = q & 15; *(u32x4*)(kl + rowk * KLD + c16 * 8) = *(const u32x4*)(KEYS + (size_t)rowk * 128 + c16 * 8); }
    __syncthreads();
    const int tok = tile * 256 + wave * 32 + r;
    const bf16_t* qrow = QN + (size_t)tok * 2048 + head * 256;
    float ssq = 0.f;
    unsigned L1[16], L2[16];
#pragma unroll
    for (int sub = 0; sub < 2; ++sub) {
        bf16x8 qf[8];
#pragma unroll
        for (int ks = 0; ks < 8; ++ks) {
            u32x4 qq = *(const u32x4*)(qrow + sub * 128 + ks * 16 + h * 8);
            float f[8]; unpack8(qq, f);
#pragma unroll
            for (int i = 0; i < 8; ++i) ssq += f[i] * f[i];
            qf[ks] = __builtin_bit_cast(bf16x8, qq);
        }
        unsigned (&L)[16] = sub == 0 ? L1 : L2;
#pragma unroll
        for (int s = 0; s < 16; ++s) L[s] = 0u;
#pragma unroll
        for (int mt = 0; mt < 4; ++mt) {
            f32x16 acc = zero16();
            const bf16_t* ap = kl + (sub * 128 + mt * 32 + r) * KLD + h * 8;
#pragma unroll
            for (int ks = 0; ks < 8; ++ks) { bf16x8 a = *(const bf16x8*)(ap + ks * 16); acc = MFMA32(a, qf[ks], acc); }
            unsigned T[16];
#pragma unroll
            for (int reg = 0; reg < 16; ++reg) {
                const int key = mt * 32 + (reg & 3) + 8 * (reg >> 2) + 4 * h;
                T[reg] = (f2ord(acc[reg]) & ~127u) | (unsigned)(127 - key);
            }
            sort16_desc(T);
            if (mt == 0) {
#pragma unroll
                for (int s2 = 0; s2 < 16; ++s2) L[s2] = T[s2];
            } else merge16_desc(L, T);
        }
        merge_pair16(L);
    }
    ssq += __shfl_xor(ssq, 32);
    const float rstd2 = rsqrtf(((const float*)(ws + OFF_SSQ))[tok] * (1.0f / DM) + 1e-6f);
    const float scale = rstd2 * rsqrtf(rstd2 * rstd2 * ssq * (1.0f / 256.0f) + 1e-6f);
    float v1[16], v2[16];
#pragma unroll
    for (int s = 0; s < 16; ++s) { v1[s] = ord2f(L1[s] & ~127u); v2[s] = ord2f(L2[s] & ~127u); }
    unsigned F[16];
#pragma unroll
    for (int s = 0; s < 16; ++s) F[s] = 0u;
    {
        int cnt = 0;
        unsigned pend = 0u;
#pragma unroll
        for (int i = 0; i < 16; ++i)
#pragma unroll
            for (int j = 0; j < 16; ++j) {
                if ((i + 1) * (j + 1) > 16) continue;
                const unsigned e = ((127u - (L1[i] & 127u)) << 7) | (127u - (L2[j] & 127u));
                const unsigned x = (f2ord(v1[i] + v2[j]) & ~16383u) | e;
                if ((cnt & 1) == 0) pend = x;
                else { const unsigned mine = h ? x : pend; ins16(F, mine); }
                ++cnt;
            }
    }
    merge_pair16(F);
    float sc[16], mx, sum = 0.f;
#pragma unroll
    for (int s = 0; s < 16; ++s) sc[s] = ord2f(F[s] & ~16383u) * scale;
    mx = sc[0];
#pragma unroll
    for (int s = 0; s < 16; ++s) { sc[s] = __expf(sc[s] - mx); sum += sc[s]; }
    const float inv = 1.0f / sum;
    unsigned short* EI = (unsigned short*)(ws + OFF_EIDX) + ((size_t)tok * 8 + head) * 16;
    float* GT = (float*)(ws + OFF_GATE) + ((size_t)tok * 8 + head) * 16;
    if (h == 0) {
        u32x4 w0, w1;
#pragma unroll
        for (int s = 0; s < 4; ++s) { w0[s] = (F[2 * s] & 16383u) | ((F[2 * s + 1] & 16383u) << 16); w1[s] = (F[8 + 2 * s] & 16383u) | ((F[8 + 2 * s + 1] & 16383u) << 16); }
        *(u32x4*)EI = w0; *(u32x4*)(EI + 8) = w1;
        *(f32x4*)GT = (f32x4){sc[0] * inv, sc[1] * inv, sc[2] * inv, sc[3] * inv};
        *(f32x4*)(GT + 4) = (f32x4){sc[4] * inv, sc[5] * inv, sc[6] * inv, sc[7] * inv};
    } else {
        *(f32x4*)(GT + 8) = (f32x4){sc[8] * inv, sc[9] * inv, sc[10] * inv, sc[11] * inv};
        *(f32x4*)(GT + 12) = (f32x4){sc[12] * inv, sc[13] * inv, sc[14] * inv, sc[15] * inv};
    }
}

__device__ __forceinline__ void peer_token(const Params& p, float* coefl, int tok, int lane, bool with_peer) {
    char* ws = p.ws;
    const bf16_t* H1 = (const bf16_t*)(ws + OFF_H1B) + (size_t)tok * DM;
    u32x4 hx0 = *(const u32x4*)(H1 + lane * 16), hx1 = *(const u32x4*)(H1 + lane * 16 + 8);
    float y[16];
#pragma unroll
    for (int i = 0; i < 16; ++i) y[i] = 0.f;
    if (with_peer) {
        const float rstd2 = rsqrtf(((const float*)(ws + OFF_SSQ))[tok] * (1.0f / DM) + 1e-6f);
        const unsigned short* EI = (const unsigned short*)(ws + OFF_EIDX) + (size_t)tok * 128;
        const float* GT = (const float*)(ws + OFF_GATE) + (size_t)tok * 128;
        const int e0 = EI[lane], e1 = EI[lane + 64];
        const float g0 = GT[lane], g1 = GT[lane + 64];
        const unsigned char* UB = (const unsigned char*)(ws + OFF_UB); const unsigned char* VB = (const unsigned char*)(ws + OFF_VB);
        const float su0 = ((const float*)(ws + OFF_SU))[e0], su1 = ((const float*)(ws + OFF_SU))[e1];
        const float sv0 = ((const float*)(ws + OFF_SV))[e0], sv1 = ((const float*)(ws + OFF_SV))[e1];
        float xf[16];
        unpack8(hx0, xf); unpack8(hx1, xf + 8);
        f32x2 xf2[8];
#pragma unroll
        for (int i = 0; i < 8; ++i) { xf2[i][0] = xf[2 * i]; xf2[i][1] = xf[2 * i + 1]; }
        float hid0 = 0.f, hid1 = 0.f;
#pragma unroll 1
        for (int half = 0; half < 2; ++half) {
            const int ev = half ? e1 : e0;
#pragma unroll 1
            for (int bb = 0; bb < 4; ++bb) {
                u32x2 ua[16];
#pragma unroll
                for (int k = 0; k < 16; ++k) {
                    const int e = __builtin_amdgcn_readlane(ev, bb * 16 + k);
                    ua[k] = *(const u32x2*)(UB + (size_t)e * (DM / 2) + lane * 8);
                }
                float part[16];
#pragma unroll
                for (int k = 0; k < 16; ++k) {
                    f32x2 s2 = {0.f, 0.f};
#pragma unroll
                    for (int i = 0; i < 2; ++i) {
                        const unsigned w = ua[k][i];
                        s2 = __builtin_elementwise_fma(__builtin_amdgcn_cvt_scalef32_pk_f32_fp4(w, 1.0f, 0), xf2[4 * i], s2);
                        s2 = __builtin_elementwise_fma(__builtin_amdgcn_cvt_scalef32_pk_f32_fp4(w, 1.0f, 1), xf2[4 * i + 1], s2);
                        s2 = __builtin_elementwise_fma(__builtin_amdgcn_cvt_scalef32_pk_f32_fp4(w, 1.0f, 2), xf2[4 * i + 2], s2);
                        s2 = __builtin_elementwise_fma(__builtin_amdgcn_cvt_scalef32_pk_f32_fp4(w, 1.0f, 3), xf2[4 * i + 3], s2);
                    }
                    part[k] = s2[0] + s2[1];
                }
#pragma unroll
                for (int k = 0; k < 8; ++k) { const float send = (lane & 32) ? part[k] : part[k + 8]; const float keep = (lane & 32) ? part[k + 8] : part[k]; part[k] = keep + __shfl_xor(send, 32); }
#pragma unroll
                for (int k = 0; k < 4; ++k) { const float send = (lane & 16) ? part[k] : part[k + 4]; const float keep = (lane & 16) ? part[k + 4] : part[k]; part[k] = keep + __shfl_xor(send, 16); }
#pragma unroll
                for (int k = 0; k < 2; ++k) { const float send = (lane & 8) ? part[k] : part[k + 2]; const float keep = (lane & 8) ? part[k + 2] : part[k]; part[k] = keep + __shfl_xor(send, 8); }
                { const float send = (lane & 4) ? part[0] : part[1]; const float keep = (lane & 4) ? part[1] : part[0]; part[0] = keep + __shfl_xor(send, 4); }
                part[0] += __shfl_xor(part[0], 1); part[0] += __shfl_xor(part[0], 2);
                const int vi = ((lane >> 5) & 1) * 8 + ((lane >> 4) & 1) * 4 + ((lane >> 3) & 1) * 2 + ((lane >> 2) & 1);
                if ((lane & 3) == 0) coefl[half * 64 + bb * 16 + vi] = part[0];
            }
        }
        __builtin_amdgcn_s_waitcnt(0xc07f);
        __builtin_amdgcn_wave_barrier();
        hid0 = coefl[lane]; hid1 = coefl[lane + 64];
        __builtin_amdgcn_wave_barrier();
        coefl[lane] = g0 * gelu_erf(hid0 * rstd2 * su0) * sv0;
        coefl[lane + 64] = g1 * gelu_erf(hid1 * rstd2 * su1) * sv1;
        __builtin_amdgcn_s_waitcnt(0xc07f);
        __builtin_amdgcn_wave_barrier();
#pragma unroll 1
        for (int half = 0; half < 2; ++half) {
            const int ev = half ? e1 : e0;
#pragma unroll 1
            for (int bb = 0; bb < 4; ++bb) {
                u32x2 va[16];
#pragma unroll
                for (int k = 0; k < 16; ++k) {
                    const int e = __builtin_amdgcn_readlane(ev, bb * 16 + k);
                    va[k] = *(const u32x2*)(VB + (size_t)e * (DM / 2) + lane * 8);
                }
#pragma unroll
                for (int k = 0; k < 16; ++k) {
                    const float cf = coefl[half * 64 + bb * 16 + k];
#pragma unroll
                    for (int i = 0; i < 2; ++i) {
                        const unsigned w = va[k][i];
                        const f32x2 a0 = __builtin_amdgcn_cvt_scalef32_pk_f32_fp4(w, 1.0f, 0), a1 = __builtin_amdgcn_cvt_scalef32_pk_f32_fp4(w, 1.0f, 1);
                        const f32x2 a2 = __builtin_amdgcn_cvt_scalef32_pk_f32_fp4(w, 1.0f, 2), a3 = __builtin_amdgcn_cvt_scalef32_pk_f32_fp4(w, 1.0f, 3);
                        y[8 * i] += cf * a0[0]; y[8 * i + 1] += cf * a0[1]; y[8 * i + 2] += cf * a1[0]; y[8 * i + 3] += cf * a1[1];
                        y[8 * i + 4] += cf * a2[0]; y[8 * i + 5] += cf * a2[1]; y[8 * i + 6] += cf * a3[0]; y[8 * i + 7] += cf * a3[1];
                    }
                }
            }
        }
    }
    float hv[16];
    unpack8(hx0, hv); unpack8(hx1, hv + 8);
    float ss = 0.f;
#pragma unroll
    for (int i = 0; i < 16; ++i) { hv[i] += y[i]; ss += hv[i] * hv[i]; }
    ss = wave_sum(ss);
    const float rs = rsqrtf(ss * (1.0f / DM) + 1e-6f);
    float* orow = p.out + (size_t)tok * DM + lane * 16;
#pragma unroll
    for (int q4 = 0; q4 < 4; ++q4) {
        f32x4 g = *(const f32x4*)(p.fg + lane * 16 + q4 * 4);
        f32x4 o = {hv[q4 * 4] * rs * g[0], hv[q4 * 4 + 1] * rs * g[1], hv[q4 * 4 + 2] * rs * g[2], hv[q4 * 4 + 3] * rs * g[3]};
        *(f32x4*)(orow + q4 * 4) = o;
    }
}


#define XB_TMO      128
#define XB_XCNT(j)  (256  + 64 * (j))
#define XB_XSUB(j)  (1280 + 64 * (j))
#define XB_XGEN(j)  (2304 + 64 * (j))
#define XB_TOP      3328
#define XB_TOPGEN   3392
#define XCD_BAR_WORDS 3456
#define XB_SPIN_CAP (1u << 21)
#define LAS __attribute__((address_space(3)))
__device__ __forceinline__ unsigned xb_ld(unsigned* p)              { return __hip_atomic_load(p, __ATOMIC_RELAXED, __HIP_MEMORY_SCOPE_AGENT); }
__device__ __forceinline__ unsigned xb_add(unsigned* p, unsigned v) { return __hip_atomic_fetch_add(p, v, __ATOMIC_RELAXED, __HIP_MEMORY_SCOPE_AGENT); }
__device__ __forceinline__ unsigned xb_xcc_id() { return (unsigned)__builtin_amdgcn_s_getreg((3 << 11) | 20) & 0xFu; }
#define XB_SPIN(cond, bar) do { unsigned _sp = 0; while (cond) { __builtin_amdgcn_s_sleep(1); \
    if ((++_sp & 255u) == 0u) { if (xb_ld(&(bar)[XB_TMO])) break; if (_sp > XB_SPIN_CAP) { atomicAdd(&(bar)[XB_TMO], 1u); break; } } } } while (0)
struct XcdBarrier { unsigned* bar; unsigned x; volatile LAS unsigned* st; };
__device__ __forceinline__ XcdBarrier xcd_barrier_post(unsigned* bar, volatile LAS unsigned* st) {
    XcdBarrier b; b.bar = bar; b.x = xb_xcc_id(); b.st = st;
    if (threadIdx.x == 0) (void)xb_add(&bar[XB_XCNT(b.x)], 1u);
    return b;
}
__device__ __forceinline__ void xcd_barrier_complete(unsigned* bar, unsigned x, unsigned& nloc, unsigned& nx) {
    const unsigned G = gridDim.x * gridDim.y * gridDim.z;
    unsigned sum, cnt, mine, sp = 0u;
    for (;;) {
        sum = 0u; cnt = 0u; mine = 0u;
#pragma unroll
        for (unsigned j = 0; j < 16; ++j) { const unsigned c = xb_ld(&bar[XB_XCNT(j)]); sum += c; cnt += (c > 0u) ? 1u : 0u; mine = (j == x) ? c : mine; }
        if (sum == G) break;
        __builtin_amdgcn_s_sleep(1);
        if ((++sp & 255u) == 0u) { if (xb_ld(&bar[XB_TMO])) break; if (sp > XB_SPIN_CAP) { atomicAdd(&bar[XB_TMO], 1u); break; } }
    }
    nloc = mine > 0u ? mine : 1u; nx = cnt > 0u ? cnt : 1u;
}
__device__ __forceinline__ void xcd_barrier(const XcdBarrier& b) {
    asm volatile("s_waitcnt vmcnt(0)" ::: "memory");
    __syncthreads();
    if (threadIdx.x == 0) {
        unsigned* bar = b.bar;
        __builtin_amdgcn_s_waitcnt(0);
        unsigned nloc = b.st[0], nx = b.st[1];
        if (nloc == 0u) { xcd_barrier_complete(bar, b.x, nloc, nx); b.st[0] = nloc; b.st[1] = nx; }
        const unsigned old = xb_add(&bar[XB_XSUB(b.x)], 1u);
        const unsigned gen = old / nloc;
        if (old + 1u == (gen + 1u) * nloc) {
            __builtin_amdgcn_fence(__ATOMIC_RELEASE, "agent");
            asm volatile("s_waitcnt vmcnt(0)" ::: "memory");
            const unsigned og = xb_add(&bar[XB_TOP], 1u);
            const unsigned tg = og / nx;
            if (og + 1u == (tg + 1u) * nx) xb_add(&bar[XB_TOPGEN], 1u);
            else XB_SPIN(xb_ld(&bar[XB_TOPGEN]) == tg, bar);
            __builtin_amdgcn_fence(__ATOMIC_ACQUIRE, "agent");
            xb_add(&bar[XB_XGEN(b.x)], 1u);
            asm volatile("s_waitcnt vmcnt(0)" ::: "memory");
        } else {
            XB_SPIN(xb_ld(&bar[XB_XGEN(b.x)]) == gen, bar);
            __builtin_amdgcn_fence(__ATOMIC_ACQUIRE, "agent");
            asm volatile("s_waitcnt vmcnt(0)" ::: "memory");
        }
    }
    __syncthreads();
}

__device__ __forceinline__ void run_phase(const Params& p, char* smem, const int phase) {
    int tidl_ = threadIdx.x; asm volatile("" : "+v"(tidl_));
    const int tid = tidl_, lane = tid & 63, wave = __builtin_amdgcn_readfirstlane(tid >> 6), G = gridDim.x;
    char* ws = p.ws;
    switch (phase) {
    case 0: phase_prep(p, smem); break;
    case 1: { pg8::EpiBf16 e{(bf16_t*)(ws + OFF_P), DIN}; pg8::Gemm g{(const bf16_t*)(ws + OFF_XN), (const bf16_t*)(ws + OFF_WINT), MROWS, DIN, DM}; pg8::StaticOrder so; so.init(MROWS, DIN, G, blockIdx.x);
              pg8::gemm_phase<pg8::EpiBf16, pg8::StaticOrder, true, true>((PG8_LAS unsigned char*)smem, g, so, e); } break;
    case 2: {
        unsigned long long tacc2 = 0;
        {
            float* prm = (float*)(smem + PRM_RWKV);
            prm[tid] = p.w0[tid]; prm[512 + tid] = p.a0[tid]; prm[1024 + tid] = p.k_k[tid]; prm[1536 + tid] = p.k_a[tid];
            prm[2048 + tid] = p.r_k[tid]; prm[2560 + tid] = p.gn_w[tid]; prm[3072 + tid] = p.gn_b[tid];
            __syncthreads();
        }
        S0Pre pre;
        if ((int)blockIdx.x < NUNITS) { const int u = blockIdx.x, v = u < 8 ? 0 : u - 8; s0_fetch(p, u < 8 ? 0 : 1 + ((v >> 3) & 127), v >> 10, u < 8 ? u : (v & 7), tid, pre); }
        for (int idx = blockIdx.x; idx < 1536; idx += G) {
            int c, b, hh;
            if (idx < 8) { c = 0; b = 0; hh = idx; }
            else { const int v = idx - 8; if (v < 1520) { c = 1 + (v >> 4); b = (v >> 3) & 1; hh = v & 7; } else { c = 96; b = 1; hh = v - 1520; } }
            rwkv_unit(p, smem, c, b, hh, tacc2, pre, false, 0, 0, 0);
        }
#if TSSTAGE >= 0
        if (blockIdx.x == 0 && tid == 0) __hip_atomic_store((unsigned long long*)(ws + OFF_BAR + 14336), tacc2, __ATOMIC_RELAXED, __HIP_MEMORY_SCOPE_AGENT);
#endif
    } break;
    case 3: {
        unsigned* latecnt = (unsigned*)(ws + OFF_BAR + 14848);
        if (blockIdx.x < 16) { rwkv_chain_wg<8>(p, smem, blockIdx.x, latecnt); __syncthreads(); }
        else {
            const int w = blockIdx.x - 16;
            {
                float* prm = (float*)(smem + PRM_RWKV);
                prm[tid] = p.w0[tid]; prm[512 + tid] = p.a0[tid]; prm[1024 + tid] = p.k_k[tid]; prm[1536 + tid] = p.k_a[tid];
                prm[2048 + tid] = p.r_k[tid]; prm[2560 + tid] = p.gn_w[tid]; prm[3072 + tid] = p.gn_b[tid];
                __syncthreads();
                unsigned long long tdummy = 0; S0Pre pre;
                for (int j = w; j < 520; j += 240) {
                    int c, b, hh;
                    if (j < 8) { c = 96; b = 0; hh = j; } else { const int v = j - 8; c = 97 + (v >> 4); b = (v >> 3) & 1; hh = v & 7; }
                    rwkv_unit(p, smem, c, b, hh, tdummy, pre, false, 0, 0, 0);
                }
                asm volatile("s_waitcnt vmcnt(0)" ::: "memory");
                __syncthreads();
                if (tid == 0) {
                    __builtin_amdgcn_fence(__ATOMIC_RELEASE, "agent");
                    asm volatile("s_waitcnt vmcnt(0)" ::: "memory");
                    for (int j = w; j < 520; j += 240) {
                        int b, hh;
                        if (j < 8) { b = 0; hh = j; } else { const int v = j - 8; b = (v >> 3) & 1; hh = v & 7; }
                        __hip_atomic_fetch_add(latecnt + 16 * (b * 8 + hh), 1u, __ATOMIC_RELAXED, __HIP_MEMORY_SCOPE_AGENT);
                    }
                }
                __syncthreads();
            }
            float* lp = (float*)(smem + PRM_LRU);
            lp[tid] = p.ga_b[tid]; lp[512 + tid] = p.gx_b[tid]; lp[1024 + tid] = ((const float*)(ws + OFF_SP))[tid]; lp[1536 + tid] = p.conv_b[tid];
            lp[2048 + tid] = p.conv_w[tid]; lp[2560 + tid] = p.conv_w[512 + tid]; lp[3072 + tid] = p.conv_w[1024 + tid]; lp[3584 + tid] = p.conv_w[1536 + tid];
            __syncthreads();
            for (int v = w; v < 257; v += 240) { const int w2 = v == 0 ? 0 : v - 1; lru_unit(p, smem, v == 0 ? 0 : 1 + (w2 & 127), w2 >> 7); }
            if (w >= 40) convert_tables(p, 56);
        }
    } break;
    case 4: {
        for (int u = blockIdx.x; u < 1024 + 256; u += G) {
            if (u < 1024) rwkv_out_pair(p, smem, u);
            else { const int v = u - 1024; lru_out(p, smem, 1 + (v & 127), v >> 7); }
        }
    } break;
    case 5: { pg8::EpiRes e{(bf16_t*)(ws + OFF_H1B), p.x, (float*)(ws + OFF_SSQ)}; pg8::Gemm g{(const bf16_t*)(ws + OFF_XN), (const bf16_t*)(ws + OFF_WOUTT), NTOK, DM, DM}; pg8::StaticOrder so; so.init(NTOK, DM, G, blockIdx.x);
              pg8::gemm_phase<pg8::EpiRes, pg8::StaticOrder, false, true>((PG8_LAS unsigned char*)smem, g, so, e); } break;
    case 6: { pg8::EpiBf16 e{(bf16_t*)p.out, 2048}; pg8::Gemm g{(const bf16_t*)(ws + OFF_H1B), (const bf16_t*)(ws + OFF_WQT), NTOK, 2048, DM}; pg8::StaticOrder so; so.init(NTOK, 2048, G, blockIdx.x);
              pg8::gemm_phase<pg8::EpiBf16, pg8::StaticOrder, true, true>((PG8_LAS unsigned char*)smem, g, so, e); } break;
    case 7: { for (int u = blockIdx.x; u < 64 * 8; u += G) peer_topk_unit(p, smem, u >> 3, u & 7); } break;
    case 8: { float* coefl = (float*)smem + wave * 128; for (int tok = blockIdx.x * 8 + wave; tok < NTOK; tok += G * 8) peer_token(p, coefl, tok, lane, DO_PEER != 0); } break;
    }
}

template <int PH>
__global__ void __launch_bounds__(NTHR) k_phase(Params p) {
    extern __shared__ __attribute__((aligned(16))) char smem[];
    run_phase(p, smem, PH);
}
template <int PH>
static void launch_phase(const Params& p, hipStream_t stream) {
    static bool attr_set = false;
    if (!attr_set) { (void)hipFuncSetAttribute((const void*)k_phase<PH>, hipFuncAttributeMaxDynamicSharedMemorySize, SMEM_BYTES); attr_set = true; }
    k_phase<PH><<<256, NTHR, SMEM_BYTES, stream>>>(p);
}


__global__ void __launch_bounds__(NTHR) k_mega(Params p) {
    extern __shared__ __attribute__((aligned(16))) char smem[];
    volatile LAS unsigned* st = (volatile LAS unsigned*)(smem + SMEM_BYTES - 16);
    if (threadIdx.x == 0) { st[0] = 0u; st[1] = 0u; st[2] = 0u; st[3] = 0u; }
    __syncthreads();
    XcdBarrier bar = xcd_barrier_post((unsigned*)(p.ws + OFF_BAR), st);
#ifndef TSPH
#define TSPH -1
#endif
    unsigned long long ts[10];
#define RUNP(ph, n) if ((n) == 1) { if (ph > 0) xcd_barrier(bar); if (TSPH >= 0) ts[ph] = __builtin_amdgcn_s_memrealtime(); run_phase(p, smem, ph); } else { _Pragma("unroll 1") for (int it = 0; it < (n); ++it) { xcd_barrier(bar); run_phase(p, smem, ph); } }
    RUNP(0, REP0) RUNP(1, REP1) RUNP(2, REP2) RUNP(3, REP3) RUNP(4, REP4) RUNP(5, 1) RUNP(6, REP6) RUNP(7, REP7) RUNP(8, REP8)
    if (TSPH >= 0) {
        xcd_barrier(bar);
        ts[9] = __builtin_amdgcn_s_memrealtime();
        if (blockIdx.x == 0) {
#if TSROLE >= 0 || TSSTAGE >= 0
            const unsigned long long d = __hip_atomic_load((unsigned long long*)(p.ws + OFF_BAR + 14336), __ATOMIC_RELAXED, __HIP_MEMORY_SCOPE_AGENT) * 4ull, t0 = __builtin_amdgcn_s_memrealtime();
#else
            const unsigned long long d = (ts[TSPH + 1] - ts[TSPH]) * 4ull, t0 = __builtin_amdgcn_s_memrealtime();
#endif
            while (__builtin_amdgcn_s_memrealtime() - t0 < d) __builtin_amdgcn_s_sleep(8);
        }
    }
}

extern "C" void kernel_launch(void* const* d_in, const int* in_sizes, int n_in, void* d_out, int out_size, void* d_ws, size_t ws_size, hipStream_t stream) {
    Params p{};
    const float** pp = (const float**)&p;
    for (int i = 0; i < 31; ++i) pp[i] = (const float*)d_in[i];
    p.out = (float*)d_out; p.ws = (char*)d_ws;
#if MULTI_LAUNCH
    launch_phase<0>(p, stream); launch_phase<1>(p, stream); launch_phase<2>(p, stream); launch_phase<3>(p, stream);
    launch_phase<4>(p, stream); launch_phase<5>(p, stream);
    if (DO_PEER) { launch_phase<6>(p, stream); launch_phase<7>(p, stream); }
    launch_phase<8>(p, stream);
#else
    static bool attr_set = false;
    if (!attr_set) { (void)hipFuncSetAttribute((const void*)k_mega, hipFuncAttributeMaxDynamicSharedMemorySize, SMEM_BYTES); attr_set = true; }
    (void)hipMemsetAsync(p.ws + OFF_BAR, 0, 16384, stream);
    void* args[] = {&p};
    hipError_t e = hipLaunchCooperativeKernel((const void*)k_mega, dim3(256), dim3(NTHR), args, SMEM_BYTES, stream);
    if (e != hipSuccess) fprintf(stderr, "cooperative launch failed: %s\n", hipGetErrorString(e));
#endif
}
```

```cpp
#include <hip/hip_runtime.h>
#include <stdint.h>
#include <stdio.h>

#ifndef REP0
#define REP0 1
#endif
#ifndef REP1
#define REP1 1
#endif
#ifndef REP2
#define REP2 1
#endif
#ifndef REP3
#define REP3 1
#endif
#ifndef REP4
#define REP4 1
#endif
#ifndef REP6
#define REP6 1
#endif
#ifndef REP7
#define REP7 1
#endif
#ifndef REP8
#define REP8 1
#endif
#ifndef TSSTAGE
#define TSSTAGE -1
#endif
#ifndef TSROLE
#define TSROLE -1
#endif
#ifndef TSSUB
#define TSSUB 0
#endif
#ifndef CHPROBE
#define CHPROBE 0
#endif
#ifndef GEMMFN
#define GEMMFN gemm_phase
#endif
#ifndef CHV
#define CHV 0
#endif
#ifndef CHAINX
#define CHAINX 1
#endif
#ifndef TBLX
#define TBLX 1
#endif
#ifndef MULTI_LAUNCH
#define MULTI_LAUNCH 0
#endif
#ifndef DO_LRU
#define DO_LRU 1
#endif
#ifndef DO_RWKV
#define DO_RWKV 1
#endif
#ifndef DO_PEER
#define DO_PEER 1
#endif

#define NTHR 512
#define T_SEQ 8192
#define NTOK 16384
#define NMETA 16
#define MROWS 16640
#define DM 1024
#define DIN 2816
#define NCHUNK 129
#define LD 72
#define LF 68
#define SLOT (64 * LD)

typedef unsigned short bf16_t;
typedef short bf16x8 __attribute__((ext_vector_type(8)));
typedef float f32x4 __attribute__((ext_vector_type(4)));
typedef float f32x16 __attribute__((ext_vector_type(16)));
typedef unsigned u32x4 __attribute__((ext_vector_type(4)));
typedef unsigned u32x2 __attribute__((ext_vector_type(2)));
typedef __bf16 bf2_t __attribute__((ext_vector_type(2)));
typedef float f32x2 __attribute__((ext_vector_type(2)));

constexpr size_t AL(size_t x) { return (x + 255) & ~(size_t)255; }
constexpr size_t OFF_BAR  = 0;
constexpr size_t OFF_SSQ  = 16384;
constexpr size_t SZ_SUM   = (size_t)NCHUNK * 2 * 512 * 4;
constexpr size_t OFF_SUMA = OFF_SSQ + 65536;
constexpr size_t OFF_SUMH = AL(OFF_SUMA + SZ_SUM);
constexpr size_t OFF_HS   = AL(OFF_SUMH + SZ_SUM);
constexpr size_t OFF_SP   = AL(OFF_HS + SZ_SUM);
constexpr size_t OFF_MPQ  = AL(OFF_SP + 2048);
constexpr size_t OFF_WINT = AL(OFF_MPQ + 8 * 16384);
constexpr size_t OFF_WOUTT = AL(OFF_WINT + (size_t)DIN * DM * 2);
constexpr size_t OFF_WQT  = AL(OFF_WOUTT + (size_t)DM * DM * 2);
constexpr size_t OFF_W2T  = AL(OFF_WQT + (size_t)2048 * DM * 2);
constexpr size_t OFF_A2T  = AL(OFF_W2T + 512 * 64 * 2);
constexpr size_t OFF_G2T  = AL(OFF_A2T + 512 * 64 * 2);
constexpr size_t OFF_WAT  = AL(OFF_G2T + 512 * 128 * 2);
constexpr size_t OFF_WXT  = AL(OFF_WAT + 8 * 64 * 64 * 2);
constexpr size_t OFF_KEYS = AL(OFF_WXT + 8 * 64 * 64 * 2);
constexpr size_t TQ_BYTES = (size_t)16384 * 128;
constexpr size_t OFF_UB   = AL(OFF_KEYS + 8 * 2 * 128 * 128 * 2);
constexpr size_t OFF_VB   = AL(OFF_UB + (size_t)16384 * DM / 2);
constexpr size_t OFF_SU   = AL(OFF_VB + (size_t)16384 * DM / 2);
constexpr size_t OFF_SV   = AL(OFF_SU + 16384 * 4);
constexpr size_t OFF_XN   = AL(OFF_SV + 16384 * 4);
constexpr size_t OFF_SB   = AL(OFF_XN + (size_t)MROWS * DM * 2);
constexpr size_t OFF_P    = AL(OFF_SB + (size_t)2048 * 8192);
constexpr size_t OFF_H1B  = OFF_P;
constexpr size_t OFF_EIDX = AL(OFF_H1B + (size_t)NTOK * DM * 2);
constexpr size_t OFF_GATE = AL(OFF_EIDX + (size_t)NTOK * 128 * 2);
constexpr size_t OFF_E1   = AL(OFF_P + (size_t)MROWS * DIN * 2);
constexpr size_t OFF_E2   = AL(OFF_E1 + (size_t)NTOK * 512 * 2);
constexpr size_t OFF_AC   = AL(OFF_E2 + (size_t)NTOK * 512 * 2);
constexpr size_t OFF_HL   = AL(OFF_AC + (size_t)NTOK * 512 * 2);
constexpr size_t WS_END   = AL(OFF_HL + (size_t)NTOK * 512 * 2);
constexpr size_t UNIT_BYTES = 32768;
constexpr int NUNITS = 8 + 2048;
static_assert((size_t)2048 * UNIT_BYTES <= (size_t)NTOK * DM * 4, "unit data does not fit in d_out");
static_assert(WS_END <= (size_t)256 * 1024 * 1024, "workspace too large");

constexpr int SMEM_BYTES = 160 * 1024;
constexpr int PRM_RWKV = 148736;
constexpr int PRM_LRU = 65536;

struct Params {
    const float *x, *meta, *g1, *w_in, *conv_w, *conv_b, *ga_w, *ga_b, *gx_w, *gx_b, *lam, *lru_gain, *mu, *w0, *w2, *a0, *a2, *g2,
        *k_k, *k_a, *r_k, *gn_w, *gn_b, *w_out, *g2n, *w_q, *q_gain, *keys, *u, *v, *fg;
    float* out;
    char* ws;
};

__device__ __forceinline__ unsigned short f2bf(float f) { __bf16 b = (__bf16)f; return __builtin_bit_cast(unsigned short, b); }
__device__ __forceinline__ unsigned pack2(float lo, float hi) { bf2_t v; v[0] = (__bf16)lo; v[1] = (__bf16)hi; return __builtin_bit_cast(unsigned, v); }
__device__ __forceinline__ float bflo(unsigned u) { return __uint_as_float(u << 16); }
__device__ __forceinline__ float bfhi(unsigned u) { return __uint_as_float(u & 0xFFFF0000u); }
__device__ __forceinline__ float bf2f(bf16_t b) { return __uint_as_float((unsigned)b << 16); }
__device__ __forceinline__ float wave_sum(float v) {
#pragma unroll
    for (int o = 32; o > 0; o >>= 1) v += __shfl_xor(v, o);
    return v;
}
__device__ __forceinline__ float sum8(float v) { v += __shfl_xor(v, 1); v += __shfl_xor(v, 2); v += __shfl_xor(v, 4); return v; }
__device__ __forceinline__ float sigmoidf_(float x) { return __builtin_amdgcn_rcpf(1.0f + __builtin_amdgcn_exp2f(-1.44269504f * x)); }
__device__ __forceinline__ float gelu_tanh(float x) {
    const float u = 0.7978845608f * (x + 0.044715f * x * x * x);
    const float t = 1.0f - 2.0f * __builtin_amdgcn_rcpf(__builtin_amdgcn_exp2f(2.88539008f * u) + 1.0f);
    return 0.5f * x * (1.0f + t);
}
__device__ __forceinline__ float gelu_erf(float x) { return 0.5f * x * (1.0f + erff(x * 0.70710678118f)); }
__device__ __forceinline__ void unpack8(u32x4 q, float* f) {
    f[0] = bflo(q[0]); f[1] = bfhi(q[0]); f[2] = bflo(q[1]); f[3] = bfhi(q[1]);
    f[4] = bflo(q[2]); f[5] = bfhi(q[2]); f[6] = bflo(q[3]); f[7] = bfhi(q[3]);
}
__device__ __forceinline__ u32x4 pack8(const float* f) {
    u32x4 q; q[0] = pack2(f[0], f[1]); q[1] = pack2(f[2], f[3]); q[2] = pack2(f[4], f[5]); q[3] = pack2(f[6], f[7]); return q;
}
__device__ __forceinline__ int row_of(int b, int pos) { return pos < NMETA ? NTOK + pos : b * T_SEQ + pos - NMETA; }

#define MFMA32(a, b, c) __builtin_amdgcn_mfma_f32_32x32x16_bf16((a), (b), (c), 0, 0, 0)
#define MFMA16(a, b, c) __builtin_amdgcn_mfma_f32_16x16x32_bf16((a), (b), (c), 0, 0, 0)

template <int KS>
__device__ __forceinline__ f32x16 mm_lds(const bf16_t* A, const bf16_t* Bt, int qm, int qn, int lane, f32x16 acc) {
    const int r = lane & 31, h = lane >> 5;
    const bf16_t* ap = A + (qm * 32 + r) * LD + h * 8;
    const bf16_t* bp = Bt + (qn * 32 + r) * LD + h * 8;
#pragma unroll
    for (int ks = 0; ks < KS; ++ks) {
        bf16x8 a = *(const bf16x8*)(ap + ks * 16), b = *(const bf16x8*)(bp + ks * 16);
        acc = MFMA32(a, b, acc);
    }
    return acc;
}
template <int KS>
__device__ __forceinline__ f32x16 mm_lds_s(const bf16_t* A, const bf16_t* Bt, int qm, int qn, int lane, f32x16 acc, bool swzA, bool swzB) {
    const int r = lane & 31, h = lane >> 5;
    const int ra = qm * 32 + r, rb = qn * 32 + r;
    const int xa = swzA ? ((ra >> 3) & 7) : 0, xb = swzB ? ((rb >> 3) & 7) : 0;
    const bf16_t* ap = A + ra * LD;
    const bf16_t* bp = Bt + rb * LD;
#pragma unroll
    for (int ks = 0; ks < KS; ++ks) {
        bf16x8 a = *(const bf16x8*)(ap + (((ks * 2 + h) ^ xa) * 8)), b = *(const bf16x8*)(bp + (((ks * 2 + h) ^ xb) * 8));
        acc = MFMA32(a, b, acc);
    }
    return acc;
}
template <int KS>
__device__ __forceinline__ f32x16 mm_lds_g(const bf16_t* A, const bf16_t* __restrict__ Btg, int ldb, int qm, int qn, int lane, f32x16 acc) {
    const int r = lane & 31, h = lane >> 5;
    const bf16_t* ap = A + (qm * 32 + r) * LD + h * 8;
    const bf16_t* bp = Btg + (size_t)(qn * 32 + r) * ldb + h * 8;
    bf16x8 bfr[KS];
#pragma unroll
    for (int ks = 0; ks < KS; ++ks) bfr[ks] = *(const bf16x8*)(bp + ks * 16);
#pragma unroll
    for (int ks = 0; ks < KS; ++ks) { bf16x8 a = *(const bf16x8*)(ap + ks * 16); acc = MFMA32(a, bfr[ks], acc); }
    return acc;
}
__device__ __forceinline__ void store_N_bf16(bf16_t* dst, const f32x16& c, int qm, int qn, int lane) {
    const int r = lane & 31, h = lane >> 5;
#pragma unroll
    for (int reg = 0; reg < 16; ++reg) dst[(qm * 32 + (reg & 3) + 8 * (reg >> 2) + 4 * h) * LD + qn * 32 + r] = f2bf(c[reg]);
}
__device__ __forceinline__ void store_T_bf16(bf16_t* dst, const f32x16& c, int qm, int qn, int lane) {
    const int r = lane & 31, h = lane >> 5;
#pragma unroll
    for (int g = 0; g < 4; ++g) {
        u32x2 w; w[0] = pack2(c[4 * g], c[4 * g + 1]); w[1] = pack2(c[4 * g + 2], c[4 * g + 3]);
        *(u32x2*)(dst + (qn * 32 + r) * LD + qm * 32 + 8 * g + 4 * h) = w;
    }
}
__device__ __forceinline__ void store_N_f32(float* dst, const f32x16& c, int qm, int qn, int lane) {
    const int r = lane & 31, h = lane >> 5;
#pragma unroll
    for (int reg = 0; reg < 16; ++reg) dst[(qm * 32 + (reg & 3) + 8 * (reg >> 2) + 4 * h) * LF + qn * 32 + r] = c[reg];
}
__device__ __forceinline__ f32x16 zero16() { f32x16 z; for (int i = 0; i < 16; ++i) z[i] = 0.f; return z; }

__device__ __forceinline__ void transpose_tile(const float* __restrict__ src, bf16_t* __restrict__ dst, int K, int N, const float* __restrict__ kscale, int tk, int tn, float* tile) {
    const int tid = threadIdx.x;
#pragma unroll
    for (int i = 0; i < 2; ++i) {
        const int kk = (tid >> 4) + 32 * i, nn = (tid & 15) * 4;
        f32x4 v = *(const f32x4*)(src + (size_t)(tk * 64 + kk) * N + tn * 64 + nn);
        const float s = kscale ? kscale[tk * 64 + kk] : 1.0f;
        tile[kk * 65 + nn] = v[0] * s; tile[kk * 65 + nn + 1] = v[1] * s; tile[kk * 65 + nn + 2] = v[2] * s; tile[kk * 65 + nn + 3] = v[3] * s;
    }
    __syncthreads();
    {
        const int n = tid >> 3, ks = (tid & 7) * 8;
        float f[8];
#pragma unroll
        for (int i = 0; i < 8; ++i) f[i] = tile[(ks + i) * 65 + n];
        *(u32x4*)(dst + (size_t)(tn * 64 + n) * K + tk * 64 + ks) = pack8(f);
    }
    __syncthreads();
}

__device__ __forceinline__ void prep_transposes(const Params& p, char* smem, const int t0, const int t1, const int me, const int nwg) {
    const int tid = threadIdx.x;
    char* ws = p.ws;
    {
        const int n0 = 16 * 44, n1 = n0 + 16 * 16, n2 = n1 + 16 * 32, n3 = n2 + 8, n4 = n3 + 8, n5 = n4 + 16, n6 = n5 + 8, n7 = n6 + 8;
        struct TD { const float* src; bf16_t* dst; const float* ks; int K, N, tk, tn; };
        auto desc = [&](int t) -> TD {
            TD d; d.ks = nullptr;
            if (t < n0) { d.src = p.w_in; d.dst = (bf16_t*)(ws + OFF_WINT); d.K = DM; d.N = DIN; d.tk = t / 44; d.tn = t % 44; }
            else if (t < n1) { const int u = t - n0; d.src = p.w_out; d.dst = (bf16_t*)(ws + OFF_WOUTT); d.K = DM; d.N = DM; d.tk = u / 16; d.tn = u % 16; }
            else if (t < n2) { const int u = t - n1; d.src = p.w_q; d.dst = (bf16_t*)(ws + OFF_WQT); d.K = DM; d.N = 2048; d.ks = p.g2n; d.tk = u / 32; d.tn = u % 32; }
            else if (t < n3) { const int u = t - n2; d.src = p.w2; d.dst = (bf16_t*)(ws + OFF_W2T); d.K = 64; d.N = 512; d.tk = 0; d.tn = u; }
            else if (t < n4) { const int u = t - n3; d.src = p.a2; d.dst = (bf16_t*)(ws + OFF_A2T); d.K = 64; d.N = 512; d.tk = 0; d.tn = u; }
            else if (t < n5) { const int u = t - n4; d.src = p.g2; d.dst = (bf16_t*)(ws + OFF_G2T); d.K = 128; d.N = 512; d.tk = u / 8; d.tn = u % 8; }
            else if (t < n6) { const int u = t - n5; d.src = p.ga_w + u * 4096; d.dst = (bf16_t*)(ws + OFF_WAT) + u * 4096; d.K = 64; d.N = 64; d.tk = 0; d.tn = 0; }
            else { const int u = t - n6; d.src = p.gx_w + u * 4096; d.dst = (bf16_t*)(ws + OFF_WXT) + u * 4096; d.K = 64; d.N = 64; d.tk = 0; d.tn = 0; }
            return d;
        };
        auto ldt = [&](const TD& d, f32x4 (&v)[2]) {
#pragma unroll
            for (int i = 0; i < 2; ++i) {
                const int kk = (tid >> 4) + 32 * i, nn = (tid & 15) * 4;
                v[i] = *(const f32x4*)(d.src + (size_t)(d.tk * 64 + kk) * d.N + d.tn * 64 + nn);
                const float sc = d.ks ? d.ks[d.tk * 64 + kk] : 1.0f;
                v[i] = v[i] * sc;
            }
        };
        int buf = 0;
        if (t0 + me < t1) {
            TD dn = desc(t0 + me);
            f32x4 vn[2];
            ldt(dn, vn);
#pragma unroll 1
            for (int t = t0 + me; t < t1; t += nwg) {
                const TD d = dn;
                float* tile = (float*)smem + buf * (64 * 65 + 16);
#pragma unroll
                for (int i = 0; i < 2; ++i) {
                    const int kk = (tid >> 4) + 32 * i, nn = (tid & 15) * 4;
                    tile[kk * 65 + nn] = vn[i][0]; tile[kk * 65 + nn + 1] = vn[i][1]; tile[kk * 65 + nn + 2] = vn[i][2]; tile[kk * 65 + nn + 3] = vn[i][3];
                }
                __syncthreads();
                if (t + nwg < t1) { dn = desc(t + nwg); ldt(dn, vn); }
                {
                    const int n = tid >> 3, ks = (tid & 7) * 8;
                    float f[8];
#pragma unroll
                    for (int i = 0; i < 8; ++i) f[i] = tile[(ks + i) * 65 + n];
                    *(u32x4*)(d.dst + (size_t)(d.tn * 64 + n) * d.K + d.tk * 64 + ks) = pack8(f);
                }
                buf ^= 1;
            }
        }
        __syncthreads();
    }
}
__device__ __forceinline__ void phase_prep(const Params& p, char* smem) {
    const int tid = threadIdx.x, lane = tid & 63, wave = __builtin_amdgcn_readfirstlane(tid >> 6), G = gridDim.x;
    char* ws = p.ws;
    bf16_t* XN = (bf16_t*)(ws + OFF_XN);
    {
        auto rsrc = [&](int row) -> const f32x4* {
            return (const f32x4*)(row < NTOK ? p.x + (size_t)row * DM : p.meta + (size_t)(row < NTOK + NMETA ? row - NTOK : 0) * DM);
        };
        f32x4 gv[4];
#pragma unroll
        for (int i = 0; i < 4; ++i) gv[i] = ((const f32x4*)p.g1)[lane + 64 * i];
        const int row0 = blockIdx.x * 8 + wave;
        f32x4 vn[4];
#pragma unroll
        for (int i = 0; i < 4; ++i) vn[i] = rsrc(min(row0, MROWS - 1))[lane + 64 * i];
#pragma unroll 1
        for (int row = row0; row < MROWS; row += G * 8) {
            u32x2* dst = (u32x2*)(XN + (size_t)row * DM);
            f32x4 v[4];
#pragma unroll
            for (int i = 0; i < 4; ++i) v[i] = vn[i];
            {
                const int nrow = min(row + G * 8, MROWS - 1);
#pragma unroll
                for (int i = 0; i < 4; ++i) vn[i] = rsrc(nrow)[lane + 64 * i];
            }
            if (row >= NTOK + NMETA) {
#pragma unroll
                for (int i = 0; i < 4; ++i) { u32x2 z; z[0] = 0; z[1] = 0; dst[lane + 64 * i] = z; }
                continue;
            }
            float ss = 0.f;
#pragma unroll
            for (int i = 0; i < 4; ++i) ss += v[i][0] * v[i][0] + v[i][1] * v[i][1] + v[i][2] * v[i][2] + v[i][3] * v[i][3];
            ss = wave_sum(ss);
            const float rs = rsqrtf(ss * (1.0f / DM) + 1e-6f);
#pragma unroll
            for (int i = 0; i < 4; ++i) {
                const f32x4 g = gv[i];
                u32x2 w; w[0] = pack2(v[i][0] * rs * g[0], v[i][1] * rs * g[1]); w[1] = pack2(v[i][2] * rs * g[2], v[i][3] * rs * g[3]);
                dst[lane + 64 * i] = w;
            }
        }
    }
    prep_transposes(p, smem, 0, 16 * 44 + 16 * 16, blockIdx.x, G);
    prep_transposes(p, smem, 16 * 44 + 16 * 16 + 16 * 32, 16 * 44 + 16 * 16 + 16 * 32 + 48, blockIdx.x, G);
    {
        const int gt = blockIdx.x * NTHR + tid, gs = G * NTHR;
        bf16_t* KEYS = (bf16_t*)(ws + OFF_KEYS);
        for (int i = gt; i < 8 * 2 * 128 * 128 / 4; i += gs) {
            const int e = i * 4, d = e & 127, sub = (e >> 14) & 1, h = e >> 15;
            f32x4 k = ((const f32x4*)p.keys)[i]; f32x4 g = *(const f32x4*)(p.q_gain + h * 256 + sub * 128 + d);
            u32x2 w; w[0] = pack2(k[0] * g[0], k[1] * g[1]); w[1] = pack2(k[2] * g[2], k[3] * g[3]);
            *(u32x2*)(KEYS + e) = w;
        }
        float* ssq = (float*)(ws + OFF_SSQ);
        for (int i = gt; i < NTOK; i += gs) ssq[i] = 0.f;
        float* SPt = (float*)(ws + OFF_SP);
        for (int i = gt; i < 512; i += gs) SPt[i] = log1pf(__expf(-p.lam[i]));
    }
}


__device__ __forceinline__ void convert_tables(const Params& p, int first) {
    char* ws = p.ws;
    const int lane = threadIdx.x & 63, wave = threadIdx.x >> 6;
    const int gw = (blockIdx.x - first) * 8 + wave, nw = (gridDim.x - first) * 8;
    float g[16];
#pragma unroll
    for (int q = 0; q < 4; ++q) *(f32x4*)(g + 4 * q) = *(const f32x4*)(p.g2n + lane * 16 + 4 * q);
#pragma unroll 1
    for (int r0 = gw; r0 < 32768; r0 += nw * 4) {
        f32x4 xv[4][4];
#pragma unroll
        for (int k = 0; k < 4; ++k) {
            const int rr = min(r0 + k * nw, 32767);
            const float* src = (rr < 16384 ? p.u : p.v) + (size_t)(rr & 16383) * DM + lane * 16;
#pragma unroll
            for (int q = 0; q < 4; ++q) xv[k][q] = *(const f32x4*)(src + 4 * q);
        }
        int keep = r0; asm volatile("" : "+v"(keep) :: "memory");
#pragma unroll
        for (int k = 0; k < 4; ++k) {
            const int rr = keep + k * nw;
            if (rr < 32768) {
                const bool isu = rr < 16384;
                float x[16]; float amax = 0.f;
#pragma unroll
                for (int i = 0; i < 16; ++i) { x[i] = xv[k][i >> 2][i & 3] * (isu ? g[i] : 1.0f); amax = fmaxf(amax, fabsf(x[i])); }
#pragma unroll
                for (int o = 32; o > 0; o >>= 1) amax = fmaxf(amax, __shfl_xor(amax, o));
                const float sc = fmaxf(amax, 1e-30f) * (1.0f / 6.0f), inv = 1.0f / sc;
                unsigned w0 = 0, w1 = 0;
                w0 = __builtin_amdgcn_cvt_scalef32_pk_fp4_f32(w0, x[0] * inv, x[1] * inv, 1.0f, 0);
                w0 = __builtin_amdgcn_cvt_scalef32_pk_fp4_f32(w0, x[2] * inv, x[3] * inv, 1.0f, 1);
                w0 = __builtin_amdgcn_cvt_scalef32_pk_fp4_f32(w0, x[4] * inv, x[5] * inv, 1.0f, 2);
                w0 = __builtin_amdgcn_cvt_scalef32_pk_fp4_f32(w0, x[6] * inv, x[7] * inv, 1.0f, 3);
                w1 = __builtin_amdgcn_cvt_scalef32_pk_fp4_f32(w1, x[8] * inv, x[9] * inv, 1.0f, 0);
                w1 = __builtin_amdgcn_cvt_scalef32_pk_fp4_f32(w1, x[10] * inv, x[11] * inv, 1.0f, 1);
                w1 = __builtin_amdgcn_cvt_scalef32_pk_fp4_f32(w1, x[12] * inv, x[13] * inv, 1.0f, 2);
                w1 = __builtin_amdgcn_cvt_scalef32_pk_fp4_f32(w1, x[14] * inv, x[15] * inv, 1.0f, 3);
                u32x2 w; w[0] = w0; w[1] = w1;
                *(u32x2*)(ws + (isu ? OFF_UB : OFF_VB) + (size_t)(lane >> 4) * TQ_BYTES + (size_t)(rr & 16383) * 128 + (lane & 15) * 8) = w;
                if (lane == 0) ((float*)(ws + (isu ? OFF_SU : OFF_SV)))[rr & 16383] = sc;
            }
        }
    }
}

constexpr int GA_ROWS = 256, GB_ROWS = 128;
constexpr int GBUF = (GA_ROWS + GB_ROWS) * LD;

struct EpiStoreBf16 {
    bf16_t* C; int ldc;
    __device__ __forceinline__ void operator()(const f32x16 (&acc)[2][2], int mb, int nb, int lane) const {
        const int r = lane & 31, h = lane >> 5;
#pragma unroll
        for (int i = 0; i < 2; ++i)
#pragma unroll
            for (int j = 0; j < 2; ++j)
#pragma unroll
                for (int g = 0; g < 4; ++g) {
                    u32x2 w; w[0] = pack2(acc[i][j][4 * g], acc[i][j][4 * g + 1]); w[1] = pack2(acc[i][j][4 * g + 2], acc[i][j][4 * g + 3]);
                    *(u32x2*)(C + (size_t)(mb + i * 32 + r) * ldc + nb + j * 32 + 8 * g + 4 * h) = w;
                }
    }
};
struct EpiResidual {
    bf16_t* C; const float* X; float* ssq;
    __device__ __forceinline__ void operator()(const f32x16 (&acc)[2][2], int mb, int nb, int lane) const {
        const int r = lane & 31, h = lane >> 5;
#pragma unroll
        for (int i = 0; i < 2; ++i) {
            const int row = mb + i * 32 + r; float ss = 0.f;
#pragma unroll
            for (int j = 0; j < 2; ++j)
#pragma unroll
                for (int g = 0; g < 4; ++g) {
                    const int col = nb + j * 32 + 8 * g + 4 * h;
                    f32x4 xv = *(const f32x4*)(X + (size_t)row * DM + col);
                    const float v0 = acc[i][j][4 * g] + xv[0], v1 = acc[i][j][4 * g + 1] + xv[1], v2 = acc[i][j][4 * g + 2] + xv[2], v3 = acc[i][j][4 * g + 3] + xv[3];
                    ss += v0 * v0 + v1 * v1 + v2 * v2 + v3 * v3;
                    u32x2 w; w[0] = pack2(v0, v1); w[1] = pack2(v2, v3);
                    *(u32x2*)(C + (size_t)row * DM + col) = w;
                }
            ss += __shfl_xor(ss, 32);
            if (h == 0) atomicAdd(ssq + row, ss);
        }
    }
};

template <class Epi>
__device__ __forceinline__ void gemm_phase(const bf16_t* __restrict__ A, const bf16_t* __restrict__ Bt, int M, int N, int K, char* smem, const Epi& epi) {
    const int tid = threadIdx.x, lane = tid & 63, wave = __builtin_amdgcn_readfirstlane(tid >> 6);
    const int wm = wave >> 1, wn = wave & 1, r = lane & 31, h = lane >> 5;
    const int nNt = N / 128, ntiles = (M / 256) * nNt, nk = K / 64;
    const int G = gridDim.x;
    const int bid = (G % 8 == 0) ? (blockIdx.x % 8) * (G / 8) + blockIdx.x / 8 : blockIdx.x;
    bf16_t* lds = (bf16_t*)smem;
    for (int tile = bid; tile < ntiles; tile += G) {
        const int pm = tile / nNt, pn = tile % nNt, m0 = pm * 256, n0 = pn * 128;
        const bf16_t* Ag = A + (size_t)m0 * K; const bf16_t* Bg = Bt + (size_t)n0 * K;
        f32x16 acc[2][2];
#pragma unroll
        for (int i = 0; i < 2; ++i)
#pragma unroll
            for (int j = 0; j < 2; ++j) acc[i][j] = zero16();
        u32x4 ra0[4], rb0[2], ra1[4], rb1[2];
#define G_LOAD(RA, RB, KT) { \
            _Pragma("unroll") for (int i = 0; i < 4; ++i) { const int q = tid + 512 * i; RA[i] = *(const u32x4*)(Ag + (size_t)(q >> 3) * K + (KT) * 64 + (q & 7) * 8); } \
            _Pragma("unroll") for (int i = 0; i < 2; ++i) { const int q = tid + 512 * i; RB[i] = *(const u32x4*)(Bg + (size_t)(q >> 3) * K + (KT) * 64 + (q & 7) * 8); } }
#define G_WRITE(RA, RB, BUF) { bf16_t* b_ = lds + (BUF) * GBUF; \
            _Pragma("unroll") for (int i = 0; i < 4; ++i) { const int q = tid + 512 * i; *(u32x4*)(b_ + (q >> 3) * LD + (q & 7) * 8) = RA[i]; } \
            _Pragma("unroll") for (int i = 0; i < 2; ++i) { const int q = tid + 512 * i; *(u32x4*)(b_ + GA_ROWS * LD + (q >> 3) * LD + (q & 7) * 8) = RB[i]; } }
#define G_COMPUTE(BUF) { const bf16_t* a_ = lds + (BUF) * GBUF + (wm * 64 + r) * LD + h * 8; const bf16_t* b_ = lds + (BUF) * GBUF + (GA_ROWS + wn * 64 + r) * LD + h * 8; \
            _Pragma("unroll") for (int ks = 0; ks < 4; ++ks) { \
                bf16x8 af0 = *(const bf16x8*)(a_ + ks * 16), af1 = *(const bf16x8*)(a_ + 32 * LD + ks * 16); \
                bf16x8 bf0 = *(const bf16x8*)(b_ + ks * 16), bf1 = *(const bf16x8*)(b_ + 32 * LD + ks * 16); \
                acc[0][0] = MFMA32(bf0, af0, acc[0][0]); acc[0][1] = MFMA32(bf1, af0, acc[0][1]); \
                acc[1][0] = MFMA32(bf0, af1, acc[1][0]); acc[1][1] = MFMA32(bf1, af1, acc[1][1]); } }
        G_LOAD(ra0, rb0, 0); G_LOAD(ra1, rb1, 1);
        G_WRITE(ra0, rb0, 0);
        __syncthreads();
        for (int kt = 0; kt < nk; kt += 2) {
            if (kt + 2 < nk) G_LOAD(ra0, rb0, kt + 2);
            G_COMPUTE(0);
            G_WRITE(ra1, rb1, 1);
            __syncthreads();
            if (kt + 3 < nk) G_LOAD(ra1, rb1, kt + 3);
            G_COMPUTE(1);
            if (kt + 2 < nk) G_WRITE(ra0, rb0, 0);
            __syncthreads();
        }
        epi(acc, m0 + wm * 64, n0 + wn * 64, lane);
    }
#undef G_LOAD
#undef G_WRITE
#undef G_COMPUTE
}

constexpr int GBUF2 = 512 * LD;
template <class Epi>
__device__ __forceinline__ void gemm_phase256(const bf16_t* __restrict__ A, const bf16_t* __restrict__ Bt, int M, int N, int K, char* smem, const Epi& epi) {
    int tid_ = threadIdx.x; asm volatile("" : "+v"(tid_));
    const int tid = tid_, lane = tid & 63, wave = __builtin_amdgcn_readfirstlane(tid >> 6);
    const int wm = wave >> 2, wn = wave & 3, r = lane & 31, h = lane >> 5;
    const int nNt = N / 256, ntiles = (M / 256) * nNt, nk = K / 64;
    const int G = gridDim.x;
    const int bid = (G % 8 == 0) ? (blockIdx.x % 8) * (G / 8) + blockIdx.x / 8 : blockIdx.x;
    bf16_t* lds = (bf16_t*)smem;
    for (int tile = bid; tile < ntiles; tile += G) {
        const int pm = tile / nNt, pn = tile % nNt, m0 = pm * 256, n0 = pn * 256;
        const bf16_t* Ag = A + (size_t)m0 * K; const bf16_t* Bg = Bt + (size_t)n0 * K;
        f32x16 acc[4][2];
#pragma unroll
        for (int i = 0; i < 4; ++i)
#pragma unroll
            for (int j = 0; j < 2; ++j) acc[i][j] = zero16();
        u32x4 ra0[4], rb0[4];
#define G_LOAD(RA, RB, KT) { \
            _Pragma("unroll") for (int i = 0; i < 4; ++i) { const int q = tid + 512 * i; RA[i] = *(const u32x4*)(Ag + (size_t)(q >> 3) * K + (KT) * 64 + (q & 7) * 8); \
                                                                                      RB[i] = *(const u32x4*)(Bg + (size_t)(q >> 3) * K + (KT) * 64 + (q & 7) * 8); } }
#define G_WRITE(RA, RB, BUF) { bf16_t* b_ = lds + (BUF) * GBUF2; \
            _Pragma("unroll") for (int i = 0; i < 4; ++i) { const int q = tid + 512 * i; *(u32x4*)(b_ + (q >> 3) * LD + (q & 7) * 8) = RA[i]; \
                                                                                      *(u32x4*)(b_ + 256 * LD + (q >> 3) * LD + (q & 7) * 8) = RB[i]; } }
#define G_COMPUTE(BUF) { const bf16_t* a_ = lds + (BUF) * GBUF2 + (wm * 128 + r) * LD + h * 8; const bf16_t* b_ = lds + (BUF) * GBUF2 + (256 + wn * 64 + r) * LD + h * 8; \
            _Pragma("unroll") for (int ks = 0; ks < 4; ++ks) { \
                bf16x8 bf0 = *(const bf16x8*)(b_ + ks * 16), bf1 = *(const bf16x8*)(b_ + 32 * LD + ks * 16); \
                _Pragma("unroll") for (int i = 0; i < 4; ++i) { bf16x8 af = *(const bf16x8*)(a_ + i * 32 * LD + ks * 16); \
                    acc[i][0] = MFMA32(bf0, af, acc[i][0]); acc[i][1] = MFMA32(bf1, af, acc[i][1]); } } }
        G_LOAD(ra0, rb0, 0);
        G_WRITE(ra0, rb0, 0);
        __syncthreads();
        G_LOAD(ra0, rb0, 1);
#pragma unroll 1
        for (int kt = 0; kt < nk; kt += 2) {
            G_COMPUTE(0);
            G_WRITE(ra0, rb0, 1);
            __syncthreads();
            if (kt + 2 < nk) G_LOAD(ra0, rb0, kt + 2);
            G_COMPUTE(1);
            if (kt + 2 < nk) G_WRITE(ra0, rb0, 0);
            __syncthreads();
            if (kt + 3 < nk) G_LOAD(ra0, rb0, kt + 3);
        }
        epi(*(const f32x16 (*)[2][2])(&acc[0]), m0 + wm * 128, n0 + wn * 64, lane);
        epi(*(const f32x16 (*)[2][2])(&acc[2]), m0 + wm * 128 + 64, n0 + wn * 64, lane);
    }
#undef G_LOAD
#undef G_WRITE
#undef G_COMPUTE
}

namespace pg8 {
#define PG8_LAS __attribute__((address_space(3)))
constexpr int BM = 256, BK = 64, HALF = 128, HTB = HALF * BK * 2  , STAGE_BYTES = 8 * HTB, NXCD = 8, WGM = 8;
__host__ __device__ __forceinline__ int lds_byte(int r, int c) { const int st = (r >> 4) * 2 + (c >> 5), rr = r & 15, cc = c & 31, ob = rr * 64 + cc * 2; return st * 1024 + (ob ^ (((ob >> 9) & 1) << 5)); }
__host__ __device__ __forceinline__ void stage_rc(int b, int& R, int& C) { const int st = b / 1024, sb = b % 1024, swz = sb ^ (((sb >> 9) & 1) << 5); R = (st >> 1) * 16 + swz / 64; C = (st & 1) * 32 + (swz % 64) / 2; }
__host__ __device__ __forceinline__ int perm32(int rho) { const int n = rho >> 4, i = rho & 15; return 8 * (i >> 2) + 4 * n + (i & 3); }
struct Unit { int pm, pn; };
struct Gemm { const bf16_t* A; const bf16_t* Bt; int M, N, K; };
struct StaticOrder {
    int nM, nN, nwg, G, c, wgm;
    __host__ __device__ void init(int M, int N, int G_, int c_, int wgm_ = WGM) { nM = M / BM; nN = N / BM; nwg = nM * nN; G = G_; c = c_; wgm = wgm_; }
    __host__ __device__ bool next(int i, Unit& u) const {
        const long L = (long)i * G + c; if (L >= nwg) return false;
        int wgid = (int)L; { const int q = nwg / NXCD, r = nwg % NXCD, xcd = wgid % NXCD, off = wgid / NXCD; wgid = (xcd < r ? xcd * (q + 1) : r * (q + 1) + (xcd - r) * q) + off; }
        const int nig = wgm * nN, gid = wgid / nig, fm = gid * wgm, gsz = (nM - fm) < wgm ? (nM - fm) : wgm;
        u.pm = fm + ((wgid % nig) % gsz); u.pn = (wgid % nig) / gsz; return true;
    }
    __device__ __forceinline__ void a_ready(const Unit&) const {}
    __device__ __forceinline__ void done(const Unit&) const {}
};
struct EpiBf16 {
    static constexpr bool PERM = true, AFTER_DRAIN = false;
    bf16_t* C; int ldc;
    __device__ __forceinline__ void operator()(const f32x4 (&acc)[2][2][4][2], const Unit& u, int wr, int wc, int fr, int fq) const {
#pragma unroll
        for (int ai = 0; ai < 2; ++ai)
#pragma unroll
            for (int m = 0; m < 4; ++m) {
                bf16_t* rowp = C + (size_t)(u.pm * BM + ai * HALF + wr * 64 + m * 16 + fr) * ldc + u.pn * BM + wc * 32 + 8 * fq;
#pragma unroll
                for (int bj = 0; bj < 2; ++bj) {
                    const f32x4 v0 = acc[ai][bj][m][0], v1 = acc[ai][bj][m][1];
                    u32x4 w; w[0] = pack2(v0[0], v0[1]); w[1] = pack2(v0[2], v0[3]); w[2] = pack2(v1[0], v1[1]); w[3] = pack2(v1[2], v1[3]);
                    *(u32x4*)(rowp + bj * HALF) = w;
                }
                asm volatile("" ::: "memory");
            }
    }
};
struct EpiRes {
    static constexpr bool PERM = true, AFTER_DRAIN = false;
    bf16_t* C; const float* X; float* ssq;
    __device__ __forceinline__ void operator()(const f32x4 (&acc)[2][2][4][2], const Unit& u, int wr, int wc, int fr, int fq) const {
#pragma unroll
        for (int ai = 0; ai < 2; ++ai) {
            f32x4 xv[4][2][2];
#pragma unroll
            for (int m = 0; m < 4; ++m)
#pragma unroll
                for (int bj = 0; bj < 2; ++bj) {
                    const float* xp = X + (size_t)(u.pm * BM + ai * HALF + wr * 64 + m * 16 + fr) * DM + u.pn * BM + bj * HALF + wc * 32 + 8 * fq;
                    xv[m][bj][0] = *(const f32x4*)xp; xv[m][bj][1] = *(const f32x4*)(xp + 4);
                }
            asm volatile("" ::: "memory");
#pragma unroll
            for (int m = 0; m < 4; ++m) {
                const int row = u.pm * BM + ai * HALF + wr * 64 + m * 16 + fr;
                float ss = 0.f;
#pragma unroll
                for (int bj = 0; bj < 2; ++bj) {
                    const int col = u.pn * BM + bj * HALF + wc * 32 + 8 * fq;
                    const f32x4 v0 = acc[ai][bj][m][0] + xv[m][bj][0], v1 = acc[ai][bj][m][1] + xv[m][bj][1];
                    ss += v0[0] * v0[0] + v0[1] * v0[1] + v0[2] * v0[2] + v0[3] * v0[3] + v1[0] * v1[0] + v1[1] * v1[1] + v1[2] * v1[2] + v1[3] * v1[3];
                    u32x4 w; w[0] = pack2(v0[0], v0[1]); w[1] = pack2(v0[2], v0[3]); w[2] = pack2(v1[0], v1[1]); w[3] = pack2(v1[2], v1[3]);
                    *(u32x4*)(C + (size_t)row * DM + col) = w;
                }
                ss += __shfl_xor(ss, 16); ss += __shfl_xor(ss, 32);
                if (fq == 0) atomicAdd(ssq + row, ss);
            }
            asm volatile("" ::: "memory");
        }
    }
};
template <class Epi, class Sched, bool ALIGN_EPI = false, bool SP2 = false>
__device__ __forceinline__ void gemm_phase(PG8_LAS unsigned char* lds, const Gemm g, const Sched& S, const Epi& E) {
    const int tid = threadIdx.x, wid = __builtin_amdgcn_readfirstlane(tid >> 6), lane = tid & 63, wr = wid >> 2, wc = wid & 3, fr = lane & 15, fq = lane >> 4;
    const int K = g.K, nt = K / BK;
    unsigned voffA[2], voffB[2];
#pragma unroll
    for (int i = 0; i < 2; ++i) { int R, C; stage_rc(tid * 16 + i * 8192, R, C); const int Rb = Epi::PERM ? ((R & ~31) + perm32(R & 31)) : R;
        voffA[i] = (unsigned)(R * K + C) * 2u; voffB[i] = (unsigned)(Rb * K + C) * 2u; }
    const size_t kstep = (size_t)(BK * 2);
    const size_t hstep = (size_t)HALF * K * 2;
    const size_t tstep = 2 * hstep;
    const unsigned ldsw = (unsigned)wid * 1024u;
    const int aoff = lds_byte(wr * 64 + fr, fq * 8), boff = lds_byte(wc * 32 + fr, fq * 8);
#define PG8_SA(b, h) (((b) * 2 + (h)) * HTB)
#define PG8_SB(b, h) ((4 + (b) * 2 + (h)) * HTB)
#define PG8_STAGE(bufoff, gbase, voff) do { _Pragma("unroll") for (int _i = 0; _i < 2; ++_i) \
        __builtin_amdgcn_global_load_lds((const unsigned*)((const char*)(gbase) + (voff)[_i]), (PG8_LAS unsigned*)(lds + (bufoff) + ldsw + _i * 8192), 16, 0, 0); } while (0)
#define PG8_LDA(dst, b, h) do { _Pragma("unroll") for (int m = 0; m < 4; ++m) _Pragma("unroll") for (int k = 0; k < 2; ++k) dst[m][k] = *(const PG8_LAS bf16x8*)(lds + PG8_SA(b, h) + aoff + m * 2048 + k * 1024); } while (0)
#define PG8_LDB(dst, b, h) do { _Pragma("unroll") for (int n = 0; n < 2; ++n) _Pragma("unroll") for (int k = 0; k < 2; ++k) dst[n][k] = *(const PG8_LAS bf16x8*)(lds + PG8_SB(b, h) + boff + n * 2048 + k * 1024); } while (0)
#define PG8_MMA(ai, bj, At, Bt) do { __builtin_amdgcn_s_setprio(1); _Pragma("unroll") for (int m = 0; m < 4; ++m) _Pragma("unroll") for (int n = 0; n < 2; ++n) _Pragma("unroll") for (int k = 0; k < 2; ++k) \
        acc[ai][bj][m][n] = __builtin_amdgcn_mfma_f32_16x16x32_bf16(Bt[n][k], At[m][k], acc[ai][bj][m][n], 0, 0, 0); __builtin_amdgcn_s_setprio(0); } while (0)
#define PG8_WAIT_V(n) asm volatile("s_waitcnt vmcnt(" #n ")" ::: "memory")
#define PG8_WAIT_L(n) asm volatile("s_waitcnt lgkmcnt(" #n ")" ::: "memory")
#define PG8_BAR __builtin_amdgcn_s_barrier()
#define PG8_SCHED __builtin_amdgcn_sched_barrier(0)
    Unit cur, nxt; int ui = 0;
    if (!S.next(0, cur)) return;
    f32x4 acc[2][2][4][2];
#pragma unroll
    for (int a = 0; a < 2; ++a)
#pragma unroll
        for (int b = 0; b < 2; ++b)
#pragma unroll
            for (int m = 0; m < 4; ++m)
#pragma unroll
                for (int n = 0; n < 2; ++n) acc[a][b][m][n] = (f32x4){0.f, 0.f, 0.f, 0.f};
    bf16x8 At[4][2], B0[2][2], B1[2][2];
    const char* cA = (const char*)g.A + (size_t)cur.pm * tstep; const char* cB = (const char*)g.Bt + (size_t)cur.pn * tstep;
    S.a_ready(cur);
    if constexpr (SP2) {
        PG8_STAGE(PG8_SB(0, 0), cB, voffB); PG8_STAGE(PG8_SB(0, 1), cB + hstep, voffB); PG8_STAGE(PG8_SA(0, 0), cA, voffA); PG8_STAGE(PG8_SA(0, 1), cA + hstep, voffA);
        if (wr == 1) PG8_BAR;
        PG8_WAIT_V(2); PG8_BAR;
        PG8_STAGE(PG8_SB(1, 0), cB + kstep, voffB); PG8_STAGE(PG8_SA(1, 0), cA + kstep, voffA); PG8_STAGE(PG8_SB(1, 1), cB + hstep + kstep, voffB);
        PG8_WAIT_V(6); PG8_BAR;
    } else {
        PG8_STAGE(PG8_SB(0, 0), cB, voffB); PG8_STAGE(PG8_SA(0, 0), cA, voffA); PG8_STAGE(PG8_SB(0, 1), cB + hstep, voffB); PG8_STAGE(PG8_SA(0, 1), cA + hstep, voffA);
        if (wr == 1) PG8_BAR;
        PG8_WAIT_V(4); PG8_BAR;
        PG8_STAGE(PG8_SB(1, 0), cB + kstep, voffB); PG8_STAGE(PG8_SA(1, 0), cA + kstep, voffA); PG8_STAGE(PG8_SB(1, 1), cB + hstep + kstep, voffB);
        PG8_WAIT_V(6); PG8_BAR;
    }
    for (;;) {
        const bool has_next = S.next(ui + 1, nxt);
        const char* nA = has_next ? (const char*)g.A + (size_t)nxt.pm * tstep : cA; const char* nB = has_next ? (const char*)g.Bt + (size_t)nxt.pn * tstep : cB;
        for (int t = 0; t < nt; t += 2) {
            const bool last = (t == nt - 2);
            const char* a1 = cA + (size_t)(t + 1) * kstep;
            const char* a2 = last ? nA : cA + (size_t)(t + 2) * kstep; const char* b2 = last ? nB : cB + (size_t)(t + 2) * kstep;
            const char* a3 = a2 + kstep; const char* b3 = b2 + kstep;
            if (last && has_next) S.a_ready(nxt);
            if constexpr (SP2) {
            PG8_LDB(B0, 0, 0); PG8_LDB(B1, 0, 1); PG8_SCHED; PG8_LDA(At, 0, 0); PG8_STAGE(PG8_SA(1, 1), a1 + hstep, voffA);
            PG8_WAIT_V(8); PG8_WAIT_L(0); PG8_BAR; PG8_MMA(0, 0, At, B0); PG8_MMA(0, 1, At, B1); PG8_BAR; PG8_SCHED;
            PG8_LDA(At, 0, 1); PG8_STAGE(PG8_SB(0, 0), b2, voffB); PG8_STAGE(PG8_SB(0, 1), b2 + hstep, voffB); PG8_STAGE(PG8_SA(0, 0), a2, voffA);
            PG8_WAIT_V(8); PG8_WAIT_L(0); PG8_BAR; PG8_MMA(1, 0, At, B0); PG8_MMA(1, 1, At, B1); PG8_BAR; PG8_SCHED;
            PG8_LDB(B0, 1, 0); PG8_LDB(B1, 1, 1); PG8_SCHED; PG8_LDA(At, 1, 0); PG8_STAGE(PG8_SA(0, 1), a2 + hstep, voffA);
            PG8_WAIT_V(8); PG8_WAIT_L(0); PG8_BAR; PG8_MMA(0, 0, At, B0); PG8_MMA(0, 1, At, B1); PG8_BAR; PG8_SCHED;
            PG8_LDA(At, 1, 1); PG8_STAGE(PG8_SB(1, 0), b3, voffB); PG8_STAGE(PG8_SB(1, 1), b3 + hstep, voffB); PG8_STAGE(PG8_SA(1, 0), a3, voffA);
            PG8_WAIT_V(8); PG8_WAIT_L(0); PG8_BAR; PG8_MMA(1, 0, At, B0); PG8_MMA(1, 1, At, B1); PG8_BAR; PG8_SCHED;
            } else {
            PG8_LDB(B0, 0, 0); PG8_SCHED; PG8_LDA(At, 0, 0); PG8_STAGE(PG8_SA(1, 1), a1 + hstep, voffA);
            PG8_WAIT_L(8); PG8_BAR; PG8_WAIT_L(0); PG8_MMA(0, 0, At, B0); PG8_BAR; PG8_SCHED;
            PG8_LDB(B1, 0, 1); PG8_STAGE(PG8_SB(0, 0), b2, voffB);
            PG8_BAR; PG8_WAIT_L(0); PG8_MMA(0, 1, At, B1); PG8_BAR;
            PG8_LDA(At, 0, 1); PG8_STAGE(PG8_SA(0, 0), a2, voffA);
            PG8_BAR; PG8_WAIT_L(0); PG8_MMA(1, 0, At, B0); PG8_BAR; PG8_SCHED;
            PG8_STAGE(PG8_SB(0, 1), b2 + hstep, voffB);
            PG8_WAIT_V(6); PG8_BAR; PG8_MMA(1, 1, At, B1); PG8_BAR;
            PG8_LDB(B0, 1, 0); PG8_SCHED; PG8_LDA(At, 1, 0); PG8_STAGE(PG8_SA(0, 1), a2 + hstep, voffA);
            PG8_WAIT_L(8); PG8_BAR; PG8_WAIT_L(0); PG8_MMA(0, 0, At, B0); PG8_BAR; PG8_SCHED;
            PG8_LDB(B1, 1, 1); PG8_STAGE(PG8_SB(1, 0), b3, voffB);
            PG8_BAR; PG8_WAIT_L(0); PG8_MMA(0, 1, At, B1); PG8_BAR;
            PG8_LDA(At, 1, 1); PG8_STAGE(PG8_SA(1, 0), a3, voffA);
            PG8_BAR; PG8_WAIT_L(0); PG8_MMA(1, 0, At, B0); PG8_BAR; PG8_SCHED;
            PG8_STAGE(PG8_SB(1, 1), b3 + hstep, voffB);
            PG8_WAIT_V(6); PG8_BAR; PG8_MMA(1, 1, At, B1); PG8_BAR;
            }
        }
        if constexpr (ALIGN_EPI) { if (wr == 0) PG8_BAR; }
        if constexpr (!Epi::AFTER_DRAIN) { E(acc, cur, wr, wc, fr, fq); S.done(cur); }
        if (!has_next) break;
#pragma unroll
        for (int a = 0; a < 2; ++a)
#pragma unroll
            for (int b = 0; b < 2; ++b)
#pragma unroll
                for (int m = 0; m < 4; ++m)
#pragma unroll
                    for (int n = 0; n < 2; ++n) acc[a][b][m][n] = (f32x4){0.f, 0.f, 0.f, 0.f};
        cur = nxt; cA = nA; cB = nB; ++ui;
        if constexpr (ALIGN_EPI) { if (wr == 1) PG8_BAR; }
    }
    PG8_WAIT_V(0);
    if constexpr (!ALIGN_EPI) { if (wr == 0) PG8_BAR; }
    PG8_BAR;
    if constexpr (Epi::AFTER_DRAIN) { E.fused(acc, cur, wr, wc, fr, fq, lds, wid, lane); S.done(cur); }
#undef PG8_SA
#undef PG8_SB
#undef PG8_STAGE
#undef PG8_LDA
#undef PG8_LDB
#undef PG8_MMA
#undef PG8_WAIT_V
#undef PG8_WAIT_L
#undef PG8_BAR
#undef PG8_SCHED
}
}

__device__ __forceinline__ void lru_unit(const Params& p, char* smem, int c, int b) {
    int tid_ = threadIdx.x; asm volatile("" : "+v"(tid_));
    const int tid = tid_, lane = tid & 63, wave = __builtin_amdgcn_readfirstlane(tid >> 6);
    char* ws = p.ws;
    const bf16_t* P = (const bf16_t*)(ws + OFF_P);
    const bf16_t* WAT = (const bf16_t*)(ws + OFF_WAT); const bf16_t* WXT = (const bf16_t*)(ws + OFF_WXT);
    float* sumA = (float*)(ws + OFF_SUMA); float* sumH = (float*)(ws + OFF_SUMH);
    const float* lp_ = (const float*)(smem + PRM_LRU);
    bf16_t* AC = (bf16_t*)(ws + OFF_AC); bf16_t* HL = (bf16_t*)(ws + OFF_HL);
    char* img = smem + PRM_LRU + 16384 + wave * 9728;
    const int r = lane & 31, hf = lane >> 5, hd = wave;
    const int pos0 = c == 0 ? 0 : NMETA + 64 * (c - 1);
    {
        u32x4 sv[9];
#pragma unroll
        for (int q = 0; q < 9; ++q) {
            const int i = q * 8 + (lane >> 3), pp = pos0 - 3 + i;
            const bool ok = pp >= 0 && (c > 0 || pp < NMETA);
            sv[q] = *(const u32x4*)(P + (size_t)row_of(b, ok ? pp : 0) * DIN + hd * 64 + (lane & 7) * 8);
            if (!ok) { sv[q][0] = 0; sv[q][1] = 0; sv[q][2] = 0; sv[q][3] = 0; }
        }
#pragma unroll
        for (int q = 0; q < 9; ++q) {
            const int i = q * 8 + (lane >> 3);
            if (i < 67) *(u32x4*)(img + i * 144 + (lane & 7) * 16) = sv[q];
        }
    }
    bf16x8 ba[2][4], bx[2][4];
#pragma unroll
    for (int n = 0; n < 2; ++n) {
        const bf16_t* bpa = WAT + hd * 4096 + (size_t)(n * 32 + r) * 64 + hf * 8;
        const bf16_t* bpx = WXT + hd * 4096 + (size_t)(n * 32 + r) * 64 + hf * 8;
#pragma unroll
        for (int ks = 0; ks < 4; ++ks) { ba[n][ks] = *(const bf16x8*)(bpa + ks * 16); bx[n][ks] = *(const bf16x8*)(bpx + ks * 16); }
    }
    float gabL[2], gxbL[2], spvL[2], cA[2], cH[2];
#pragma unroll
    for (int n = 0; n < 2; ++n) {
        const int chn = hd * 64 + n * 32 + r;
        gabL[n] = -1.44269504f * lp_[chn]; gxbL[n] = -1.44269504f * lp_[512 + chn]; spvL[n] = -8.0f * 1.44269504f * lp_[1024 + chn];
        cA[n] = 1.f; cH[n] = 0.f;
    }
    __builtin_amdgcn_wave_barrier();
#pragma unroll 1
    for (int m = 0; m < 2; ++m) {
        int lo_ = 0; asm volatile("" : "+v"(lo_));
        const float* lp = lp_ + lo_;
        bf16x8 af[4];
#pragma unroll
        for (int ks = 0; ks < 4; ++ks) {
            const int chA = hd * 64 + ks * 16 + hf * 8;
            float xc[8];
            {
                f32x4 b0 = *(const f32x4*)(lp + 1536 + chA), b1 = *(const f32x4*)(lp + 1536 + chA + 4);
                xc[0] = b0[0]; xc[1] = b0[1]; xc[2] = b0[2]; xc[3] = b0[3]; xc[4] = b1[0]; xc[5] = b1[1]; xc[6] = b1[2]; xc[7] = b1[3];
            }
#pragma unroll
            for (int d = 0; d < 4; ++d) {
                float xv[8]; unpack8(*(const u32x4*)(img + (m * 32 + r + d) * 144 + ks * 32 + hf * 16), xv);
                f32x4 w0 = *(const f32x4*)(lp + 2048 + d * 512 + chA), w1 = *(const f32x4*)(lp + 2048 + d * 512 + chA + 4);
                xc[0] += w0[0] * xv[0]; xc[1] += w0[1] * xv[1]; xc[2] += w0[2] * xv[2]; xc[3] += w0[3] * xv[3];
                xc[4] += w1[0] * xv[4]; xc[5] += w1[1] * xv[5]; xc[6] += w1[2] * xv[6]; xc[7] += w1[3] * xv[7];
            }
            const u32x4 au = pack8(xc);
            af[ks] = __builtin_bit_cast(bf16x8, au);
            asm volatile("" ::: "memory");
        }
#pragma unroll
        for (int n = 0; n < 2; ++n) {
            f32x16 accA = zero16(), accX = zero16(), accI = zero16();
#pragma unroll
            for (int ks = 0; ks < 4; ++ks) {
                const int dd = n * 32 + r - ks * 16 - hf * 8;
                u32x4 iu;
#pragma unroll
                for (int j = 0; j < 4; ++j) iu[j] = (dd >> 1) == j ? ((dd & 1) ? 0x3F800000u : 0x00003F80u) : 0u;
                accA = MFMA32(af[ks], ba[n][ks], accA);
                accX = MFMA32(af[ks], bx[n][ks], accX);
                if ((ks >> 1) == n) accI = MFMA32(af[ks], __builtin_bit_cast(bf16x8, iu), accI);
            }
            const int chn = hd * 64 + n * 32 + r;
#pragma unroll
            for (int j = 0; j < 4; ++j) {
                float ca[4], hl[4];
                float SA = 1.f, SH = 0.f;
#pragma unroll
                for (int k = 0; k < 4; ++k) {
                    const int reg = 4 * j + k, t = m * 32 + 8 * j + 4 * hf + k;
                    const float rg = __builtin_amdgcn_rcpf(1.0f + __builtin_amdgcn_exp2f(accA[reg] * -1.44269504f + gabL[n]));
                    const float ig = __builtin_amdgcn_rcpf(1.0f + __builtin_amdgcn_exp2f(accX[reg] * -1.44269504f + gxbL[n]));
                    float a = __builtin_amdgcn_exp2f(rg * spvL[n]);
                    float bb = __builtin_amdgcn_sqrtf(fmaxf(1.0f - a * a, 0.f)) * ig * accI[reg];
                    const bool valid = (c > 0) || (t < NMETA);
                    a = valid ? a : 1.0f; bb = valid ? bb : 0.f;
                    SH = a * SH + bb; SA *= a; ca[k] = SA; hl[k] = SH;
                }
                const float pA = __shfl_xor(SA, 32), pH = __shfl_xor(SH, 32);
                const float s0A = hf ? pA : SA, s0H = hf ? pH : SH, s1A = hf ? SA : pA, s1H = hf ? SH : pH;
                const float midA = cA[n] * s0A, midH = s0A * cH[n] + s0H;
                const float myA = hf ? midA : cA[n], myH = hf ? midH : cH[n];
                cA[n] = midA * s1A; cH[n] = s1A * midH + s1H;
                if (c > 0) {
                    const size_t o = (size_t)(b * T_SEQ + 64 * (c - 1) + m * 32 + 8 * j + 4 * hf) * 512 + chn;
                    bf16_t* acp = AC + o; bf16_t* hlp = HL + o;
#pragma unroll
                    for (int k = 0; k < 4; ++k) {
                        acp[k * 512] = (bf16_t)(pack2(ca[k] * myA, 0.f) & 0xFFFFu);
                        hlp[k * 512] = (bf16_t)(pack2(hl[k] + ca[k] * myH, 0.f) & 0xFFFFu);
                    }
                }
            }
            __builtin_amdgcn_sched_barrier(0);
        }
    }
    if (hf == 0) {
#pragma unroll
        for (int n = 0; n < 2; ++n) { const int chn = hd * 64 + n * 32 + r; sumA[((size_t)c * 2 + b) * 512 + chn] = cA[n]; sumH[((size_t)c * 2 + b) * 512 + chn] = cH[n]; }
    }
}
__device__ __forceinline__ void lru_out(const Params& p, char* smem, int c, int b) {
    int tid_ = threadIdx.x; asm volatile("" : "+v"(tid_));
    const int tid = tid_;
    char* ws = p.ws;
    const bf16_t* P = (const bf16_t*)(ws + OFF_P);
    const bf16_t* AC = (const bf16_t*)(ws + OFF_AC); const bf16_t* HL = (const bf16_t*)(ws + OFF_HL);
    float* HS = (float*)smem;
    bf16_t* Y = (bf16_t*)(ws + OFF_XN);
    {
        const float* sumA = (const float*)(ws + OFF_SUMA); const float* sumH = (const float*)(ws + OFF_SUMH);
        float hcur = sumH[tid];
#pragma unroll 1
        for (int c0 = 1; c0 < c; c0 += 32) {
            float av[32], hv[32];
#pragma unroll
            for (int k = 0; k < 32; ++k) { const int cc = min(c0 + k, NCHUNK - 1); av[k] = sumA[((size_t)cc * 2 + b) * 512 + tid]; hv[k] = sumH[((size_t)cc * 2 + b) * 512 + tid]; }
            asm volatile("" : "+v"(hcur) :: "memory");
#pragma unroll
            for (int k = 0; k < 32; ++k) { if (c0 + k < c) hcur = av[k] * hcur + hv[k]; }
        }
        __syncthreads();
        HS[tid] = hcur;
        __syncthreads();
    }
    const int t = tid >> 3, c8 = tid & 7;
    const int row = b * T_SEQ + 64 * (c - 1) + t;
    u32x4 yp[8];
    float ssq = 0.f;
#pragma unroll
    for (int hd = 0; hd < 8; ++hd) {
        const int ch0 = hd * 64 + c8 * 8;
        float a8[8], h8[8], g8[8], yv[8];
        unpack8(*(const u32x4*)(AC + (size_t)row * 512 + ch0), a8);
        unpack8(*(const u32x4*)(HL + (size_t)row * 512 + ch0), h8);
        unpack8(*(const u32x4*)(P + (size_t)row * DIN + 512 + ch0), g8);
        f32x4 s0 = *(const f32x4*)(HS + ch0), s1 = *(const f32x4*)(HS + ch0 + 4);
        const float hs[8] = {s0[0], s0[1], s0[2], s0[3], s1[0], s1[1], s1[2], s1[3]};
#pragma unroll
        for (int i = 0; i < 8; ++i) { yv[i] = (h8[i] + a8[i] * hs[i]) * gelu_tanh(g8[i]); ssq += yv[i] * yv[i]; }
        yp[hd] = pack8(yv);
    }
    ssq = sum8(ssq);
    const float rs = rsqrtf(ssq * (1.0f / 512.0f) + 1e-6f);
#pragma unroll
    for (int hd = 0; hd < 8; ++hd) {
        const int ch0 = hd * 64 + c8 * 8;
        float yv[8]; unpack8(yp[hd], yv);
        f32x4 g0 = *(const f32x4*)(p.lru_gain + ch0), g1 = *(const f32x4*)(p.lru_gain + ch0 + 4);
        yv[0] *= rs * g0[0]; yv[1] *= rs * g0[1]; yv[2] *= rs * g0[2]; yv[3] *= rs * g0[3];
        yv[4] *= rs * g1[0]; yv[5] *= rs * g1[1]; yv[6] *= rs * g1[2]; yv[7] *= rs * g1[3];
        *(u32x4*)(Y + (size_t)row * DM + ch0) = pack8(yv);
    }
    __syncthreads();
}

__device__ __forceinline__ void rwkv_stage_params(const Params& p, float* prm, int tid) {
    const int hw = blockIdx.x & 7;
    if (tid < 448) {
        const int k = tid >> 6, i = tid & 63;
        const float* src = k == 0 ? p.w0 : k == 1 ? p.a0 : k == 2 ? p.k_k : k == 3 ? p.k_a : k == 4 ? p.r_k : k == 5 ? p.gn_w : p.gn_b;
        prm[tid] = src[hw * 64 + i];
        prm[448 + tid] = p.mu[tid < 192 ? (tid >> 6) * 512 + hw * 64 + (tid & 63) : 1536 + (tid - 192)];
    }
}
__device__ __forceinline__ float tanh_fast(float x) { return 1.0f - 2.0f * __builtin_amdgcn_rcpf(__builtin_amdgcn_exp2f(2.88539008f * x) + 1.0f); }
struct S0Pre { u32x4 cur[5], prv[5]; };
__device__ __forceinline__ void s0_fetch(const Params& p, int c, int b, int hh, int tid, S0Pre& o) {
    const bf16_t* P = (const bf16_t*)(p.ws + OFF_P);
    const int t = tid >> 3, c8 = tid & 7;
    const int pos = (c == 0 ? 0 : NMETA + 64 * (c - 1)) + t;
    const bool valid = (c > 0) || (t < NMETA);
    const bool hasprev = valid && pos > 0;
    const bf16_t* pr = P + (size_t)row_of(b, valid ? pos : 0) * DIN;
    const bf16_t* pp = P + (size_t)row_of(b, hasprev ? pos - 1 : 0) * DIN;
    const int hc0 = hh * 64 + c8 * 8;
    const int cols[5] = {1024 + hc0, 1536 + hc0, 2048 + hc0, 2560 + c8 * 8, 2624 + c8 * 8};
#pragma unroll
    for (int i = 0; i < 5; ++i) { o.cur[i] = *(const u32x4*)(pr + cols[i]); o.prv[i] = *(const u32x4*)(pp + cols[i]); }
}
__device__ __forceinline__ void rwkv_unit(const Params& p, char* smem, int c, int b, int hh, unsigned long long& tacc, S0Pre& pre, bool has_next, int nc, int nb_, int nh) {
#define TT(k) if (TSSTAGE >= 0) { if ((k) == TSSTAGE) tacc -= __builtin_amdgcn_s_memrealtime(); if ((k) == TSSTAGE + 1) tacc += __builtin_amdgcn_s_memrealtime(); }
    TT(0)
    int tid_ = threadIdx.x; asm volatile("" : "+v"(tid_));
    const int tid = tid_, lane = tid & 63, wave = __builtin_amdgcn_readfirstlane(tid >> 6);
    char* ws = p.ws;
    const bf16_t* P = (const bf16_t*)(ws + OFF_P);
    bf16_t* S0 = (bf16_t*)smem;
#define SL(i) (S0 + (i) * SLOT)
    float* F0 = (float*)(smem + 14 * SLOT * 2);
    float* Seg = F0 + 64 * LF;
    float* GC = Seg + 512;
    float* FZa = (float*)SL(2);
    float* FZg = (float*)SL(4);
    const float* prm = (const float*)(smem + PRM_RWKV);
    bf16_t *sLw = SL(0), *sAabb = SL(0), *sLg0 = SL(0);
    bf16_t *sLa = SL(1), *sAak = SL(1), *sLg1 = SL(1);
    bf16_t *sBtT = SL(2), *sKtT = SL(3);
    bf16_t *sAt = SL(4), *sAtT = SL(5);
    bf16_t *sBh = SL(6), *sD0T = SL(6), *sW1T = SL(6);
    bf16_t *sKh = SL(7), *sM1T = SL(7), *sW2T = SL(7);
    bf16_t *sRt = SL(8), *sVT = SL(9), *sTm = SL(10), *sY2T = SL(11), *sArb = SL(12), *sArk = SL(13);
    const int t = tid >> 3, c8 = tid & 7;
    const int pos0 = c == 0 ? 0 : NMETA + 64 * (c - 1);
    const int pos = pos0 + t;
    const bool valid = (c > 0) || (t < NMETA);
    const int row = row_of(b, valid ? pos : 0);
    const int grp = wave >> 2, qm = (wave >> 1) & 1, qn = wave & 1, r = lane & 31, h = lane >> 5;
    const int hc0 = hh * 64 + c8 * 8;
    const int uidx = (b * 128 + (c - 1)) * 8 + hh;
    char* UD = c == 0 ? (ws + OFF_MPQ + (size_t)hh * 16384) : ((char*)p.out + (size_t)uidx * UNIT_BYTES);
    float rv[8], kv[8], vv[8];
    bf16x8 lorab[4];
    {
        const bf16_t* Bt = (const bf16_t*)(ws + (grp == 0 ? OFF_W2T : OFF_A2T)) + hh * 64 * 64 + (size_t)(qn * 32 + r) * 64 + h * 8;
#pragma unroll
        for (int ks = 0; ks < 4; ++ks) lorab[ks] = *(const bf16x8*)(Bt + ks * 16);
    }
    {
        const bool hasprev = valid && pos > 0;
        const int hcq = hc0, cols[5] = {1024 + hcq, 1536 + hcq, 2048 + hcq, 2560 + c8 * 8, 2624 + c8 * 8};
        auto sh8 = [&](int i, float* out) {
            float cur[8], prv[8];
            unpack8(pre.cur[i], cur); unpack8(pre.prv[i], prv);
            const float* mq = prm + 448 + (i < 3 ? i * 64 : 192 + (i - 3) * 64) + c8 * 8;
            f32x4 m0 = *(const f32x4*)mq, m1 = *(const f32x4*)(mq + 4);
            float mm[8] = {m0[0], m0[1], m0[2], m0[3], m1[0], m1[1], m1[2], m1[3]};
#pragma unroll
            for (int k = 0; k < 8; ++k) out[k] = valid ? cur[k] + ((hasprev ? prv[k] : 0.f) - cur[k]) * mm[k] : 0.f;
        };
        sh8(0, rv); sh8(1, kv); sh8(2, vv);
        float wl[8], al[8];
        sh8(3, wl); sh8(4, al);
#pragma unroll
        for (int i = 0; i < 8; ++i) wl[i] = tanh_fast(wl[i]);
        *(u32x4*)(sLw + t * LD + c8 * 8) = pack8(wl);
        *(u32x4*)(sLa + t * LD + c8 * 8) = pack8(al);
    }
    __syncthreads();
    TT(1)
    {
        f32x16 acc = zero16();
        const bf16_t* ap = (grp == 0 ? sLw : sLa) + (qm * 32 + r) * LD + h * 8;
#pragma unroll
        for (int ks = 0; ks < 4; ++ks) { bf16x8 a_ = *(const bf16x8*)(ap + ks * 16); acc = MFMA32(a_, lorab[ks], acc); }
        store_N_f32(grp == 0 ? F0 : FZa, acc, qm, qn, lane);
    }
    __syncthreads();
    TT(2)
    float lw[8], av[8], kk[8], kt[8];
    float rk = 0.f;
    {
        float zw[8], za[8];
        *(f32x4*)zw = *(const f32x4*)(F0 + t * LF + c8 * 8); *(f32x4*)(zw + 4) = *(const f32x4*)(F0 + t * LF + c8 * 8 + 4);
        *(f32x4*)za = *(const f32x4*)(FZa + t * LF + c8 * 8); *(f32x4*)(za + 4) = *(const f32x4*)(FZa + t * LF + c8 * 8 + 4);
        float n2 = 0.f;
#pragma unroll
        for (int i = 0; i < 8; ++i) {
            const int cl = c8 * 8 + i;
            lw[i] = valid ? -0.6065306597f * sigmoidf_(zw[i] + prm[cl]) : 0.f;
            av[i] = valid ? sigmoidf_(za[i] + prm[64 + cl]) : 0.f;
            kk[i] = kv[i] * prm[128 + cl]; n2 += kk[i] * kk[i];
            kt[i] = kv[i] * (1.0f + (av[i] - 1.0f) * prm[192 + cl]);
            rk += rv[i] * kt[i] * prm[256 + cl];
        }
        n2 = sum8(n2); rk = sum8(rk);
        const float inv = __builtin_amdgcn_rcpf(fmaxf(__builtin_amdgcn_sqrtf(n2), 1e-12f));
#pragma unroll
        for (int i = 0; i < 8; ++i) kk[i] *= inv;
        *(f32x4*)(F0 + t * LF + c8 * 8) = *(f32x4*)lw; *(f32x4*)(F0 + t * LF + c8 * 8 + 4) = *(f32x4*)(lw + 4);
    }
    __syncthreads();
    TT(3)
    {
        const int sch = tid & 63, seg = tid >> 6;
        float sacc = 0.f;
#pragma unroll
        for (int k = 0; k < 8; ++k) { const int tt = seg * 8 + k; sacc += F0[tt * LF + sch]; F0[tt * LF + sch] = sacc; }
        Seg[seg * 64 + sch] = sacc;
        __syncthreads();
        float pre = 0.f;
        for (int s2 = 0; s2 < seg; ++s2) pre += Seg[s2 * 64 + sch];
#pragma unroll
        for (int k = 0; k < 8; ++k) { const int tt = seg * 8 + k; F0[tt * LF + sch] += pre; }
        if (seg == 7) GC[sch] = sacc + pre;
    }
    __syncthreads();
    TT(4)
    {
        float g[8];
        *(f32x4*)g = *(const f32x4*)(F0 + t * LF + c8 * 8); *(f32x4*)(g + 4) = *(const f32x4*)(F0 + t * LF + c8 * 8 + 4);
        float at[8], bh[8], kh[8], rt[8], bt[8], ktt[8];
#pragma unroll
        for (int i = 0; i < 8; ++i) {
            const float gc = GC[c8 * 8 + i];
            const float em = __expf(-g[i]), ep = __expf(g[i]), epv = __expf(g[i] - lw[i]), ec = __expf(gc - g[i]);
            at[i] = -kk[i] * epv; bh[i] = kk[i] * av[i] * em; kh[i] = kt[i] * em; rt[i] = rv[i] * ep;
            bt[i] = kk[i] * av[i] * ec; ktt[i] = kt[i] * ec;
        }
        *(u32x4*)(sAt + t * LD + c8 * 8) = pack8(at);
        *(u32x4*)(sBh + t * LD + c8 * 8) = pack8(bh);
        *(u32x4*)(sKh + t * LD + c8 * 8) = pack8(kh);
        *(u32x4*)(sRt + t * LD + c8 * 8) = pack8(rt);
#pragma unroll
        for (int i = 0; i < 8; ++i) {
            const int tsw = (((t >> 3) ^ c8) << 3) | (t & 7);
            sAtT[(c8 * 8 + i) * LD + tsw] = f2bf(at[i]);
            sVT[(c8 * 8 + i) * LD + tsw] = f2bf(vv[i]);
            sBtT[(c8 * 8 + i) * LD + tsw] = f2bf(bt[i]);
            sKtT[(c8 * 8 + i) * LD + tsw] = f2bf(ktt[i]);
        }
    }
    __syncthreads();
    TT(5)
    f32x16 accQ = zero16();
    {
        f32x16 acc = zero16(), acc2 = zero16();
        acc = mm_lds<4>(sAt, grp == 0 ? sBh : sKh, qm, qn, lane, acc);
        acc2 = mm_lds<4>(sRt, grp == 0 ? sBh : sKh, qm, qn, lane, acc2);
#pragma unroll
        for (int reg = 0; reg < 16; ++reg) {
            const int tt = qm * 32 + (reg & 3) + 8 * (reg >> 2) + 4 * h, ss = qn * 32 + r;
            if (ss >= tt) acc[reg] = 0.f;
            if (ss > tt) acc2[reg] = 0.f;
        }
        if (grp == 0) accQ = mm_lds_s<4>(sKtT, sVT, qm, qn, lane, accQ, true, true);
        if (grp == 0) { store_N_f32(F0, acc, qm, qn, lane); store_N_bf16(sAabb, acc, qm, qn, lane); store_N_bf16(sArb, acc2, qm, qn, lane); }
        else { store_N_bf16(sAak, acc, qm, qn, lane); store_N_bf16(sArk, acc2, qm, qn, lane); }
    }
    __syncthreads();
    TT(6)
    s0_fetch(p, nc, nb_, nh, tid, pre);
    if (wave == 0) {
        int lane2 = lane; asm volatile("" : "+v"(lane2));
        const int blk = lane2 >> 5, j = lane2 & 31;
        const float* Ab = F0 + (32 * blk) * LF + 32 * blk;
        float xs[32];
#pragma unroll
        for (int tt = 0; tt < 32; ++tt) {
            float sa[4] = {(tt == j) ? 1.f : 0.f, 0.f, 0.f, 0.f};
#pragma unroll
            for (int s2 = 0; s2 < tt; ++s2) sa[s2 & 3] += Ab[tt * LF + s2] * xs[s2];
            xs[tt] = (sa[0] + sa[1]) + (sa[2] + sa[3]);
        }
#pragma unroll
        for (int tt = 0; tt < 32; ++tt) sTm[(32 * blk + tt) * LD + 32 * blk + j] = f2bf(xs[tt]);
        if (blk == 0) {
#pragma unroll
            for (int q = 0; q < 4; ++q) *(u32x4*)(sD0T + j * LD + q * 8) = pack8(xs + q * 8);
        }
    } else if (wave == 1) {
        const int rr = lane >> 1, cc = 32 + (lane & 1) * 16;
        u32x4 z; z[0] = 0; z[1] = 0; z[2] = 0; z[3] = 0;
        *(u32x4*)(sTm + rr * LD + cc) = z; *(u32x4*)(sTm + rr * LD + cc + 8) = z;
    } else if (grp == 1) {
        f32x16 acc = zero16();
        acc = mm_lds_s<4>(sAak, sVT, qm, qn, lane, acc, false, true);
        store_T_bf16(sY2T, acc, qm, qn, lane);
    }
    if (wave == 0) { __builtin_amdgcn_s_waitcnt(0xc07f); __builtin_amdgcn_wave_barrier(); asm volatile("" ::: "memory"); }
    TT(7)
    if (wave == 0) {
        f32x16 acc = zero16();
        acc = mm_lds<2>(sAabb, sD0T, 1, 0, lane, acc);
        store_T_bf16(sM1T, acc, 0, 0, lane);
    }
    if (wave == 0) { __builtin_amdgcn_s_waitcnt(0xc07f); __builtin_amdgcn_wave_barrier(); asm volatile("" ::: "memory"); }
    TT(8)
    if (wave == 0) {
        f32x16 acc = zero16();
        const bf16_t* ap = sTm + (32 + r) * LD + 32 + h * 8;
        const bf16_t* bp = sM1T + r * LD + h * 8;
#pragma unroll
        for (int ks = 0; ks < 2; ++ks) { bf16x8 a = *(const bf16x8*)(ap + ks * 16), bb = *(const bf16x8*)(bp + ks * 16); acc = MFMA32(a, bb, acc); }
        store_N_bf16(sTm, acc, 1, 0, lane);
    }
    __syncthreads();
    TT(9)
    {
        u32x4 glc[2], glp[2];
        {
            const bf16_t* pr = P + (size_t)row * DIN + 2688 + c8 * 16;
            const bf16_t* pp = P + (size_t)row_of(b, max(pos - 1, 0)) * DIN + 2688 + c8 * 16;
            glc[0] = *(const u32x4*)pr; glc[1] = *(const u32x4*)(pr + 8); glp[0] = *(const u32x4*)pp; glp[1] = *(const u32x4*)(pp + 8);
        }
        f32x16 acc = zero16();
        acc = mm_lds_s<4>(sTm, grp == 0 ? sAtT : sY2T, qm, qn, lane, acc, false, grp == 0);
        store_T_bf16(grp == 0 ? sW1T : sW2T, acc, qm, qn, lane);
        {
            bf16_t* d = ((c8 < 4) ? sLg0 : sLg1) + t * LD + (c8 & 3) * 16;
#pragma unroll
            for (int hf = 0; hf < 2; ++hf) {
                float cur[8], prv[8], gg[8];
                unpack8(glc[hf], cur); unpack8(glp[hf], prv);
#pragma unroll
                for (int i = 0; i < 8; ++i) gg[i] = sigmoidf_(cur[i] + (prv[i] - cur[i]) * prm[448 + 320 + c8 * 16 + hf * 8 + i]);
                *(u32x4*)(d + hf * 8) = pack8(gg);
            }
        }
    }
    __syncthreads();
    TT(10)
    if (grp == 0) {
        f32x16 acc = mm_lds_s<4>(sBtT, sW2T, qm, qn, lane, accQ, true, false);
        bf16_t* QC = (bf16_t*)(UD + 8192);
        const int v = qn * 32 + r;
#pragma unroll
        for (int g = 0; g < 4; ++g) {
            const int k = qm * 32 + 8 * g + 4 * h;
            u32x2 w; w[0] = pack2(acc[4 * g], acc[4 * g + 1]); w[1] = pack2(acc[4 * g + 2], acc[4 * g + 3]);
            *(u32x2*)(QC + (((v >> 4) * 2 + (k >> 5)) * 64 + ((k >> 2) & 3) * 16 + (v & 15)) * 8 + ((k >> 4) & 1) * 4) = w;
        }
        if (c > 0) {
            f32x16 ag = zero16();
            ag = mm_lds<4>(sW1T, sArb, qm, qn, lane, ag);
            bf16_t* Gg = (bf16_t*)(UD + 16384);
            const int tt = qn * 32 + r;
#pragma unroll
            for (int g = 0; g < 4; ++g) {
                const int k = qm * 32 + 8 * g + 4 * h;
                const u32x2 rt2 = *(const u32x2*)(sRt + tt * LD + k);
                u32x2 w; w[0] = pack2(ag[4 * g] + bflo(rt2[0]), ag[4 * g + 1] + bfhi(rt2[0])); w[1] = pack2(ag[4 * g + 2] + bflo(rt2[1]), ag[4 * g + 3] + bfhi(rt2[1]));
                *(u32x2*)(Gg + tt * 64 + (k >> 5) * 32 + ((k >> 2) & 3) * 8 + ((k >> 4) & 1) * 4) = w;
            }
            f32x16 accg = zero16();
            const bf16_t* G2T = (const bf16_t*)(ws + OFF_G2T) + (size_t)hh * 64 * 128;
            accg = mm_lds_g<4>(sLg0, G2T, 128, qm, qn, lane, accg);
            accg = mm_lds_g<4>(sLg1, G2T + 64, 128, qm, qn, lane, accg);
            store_N_f32(FZg, accg, qm, qn, lane);
        }
    } else {
        f32x16 acc = zero16();
        acc = mm_lds_s<4>(sW1T, sBtT, qm, qn, lane, acc, false, true);
        bf16_t* PA = (bf16_t*)UD;
        const int k1 = qn * 32 + r;
        const float dg = __expf(GC[k1]);
#pragma unroll
        for (int g = 0; g < 4; ++g) {
            const int k2 = qm * 32 + 8 * g + 4 * h;
            float v4[4];
#pragma unroll
            for (int i = 0; i < 4; ++i) v4[i] = acc[4 * g + i] + ((k2 + i == k1) ? dg : 0.f);
            u32x2 w; w[0] = pack2(v4[0], v4[1]); w[1] = pack2(v4[2], v4[3]);
            *(u32x2*)(PA + (((k1 >> 4) * 2 + (k2 >> 5)) * 64 + ((k2 >> 2) & 3) * 16 + (k1 & 15)) * 8 + ((k2 >> 4) & 1) * 4) = w;
        }
        if (c > 0) {
            f32x16 ah = zero16();
            ah = mm_lds<4>(sArb, sW2T, qm, qn, lane, ah);
            ah = mm_lds_s<4>(sArk, sVT, qm, qn, lane, ah, false, true);
            bf16_t* HC = (bf16_t*)(UD + 24576) + ((qm * 2 + qn) * 64 + lane) * 16;
            float hf[16];
#pragma unroll
            for (int reg = 0; reg < 16; ++reg) hf[reg] = ah[reg];
            *(u32x4*)HC = pack8(hf); *(u32x4*)(HC + 8) = pack8(hf + 8);
        }
    }
    __syncthreads();
    TT(11)
    if (c > 0) {
        float zg[8], e1[8], e2[8];
        *(f32x4*)zg = *(const f32x4*)(FZg + t * LF + c8 * 8); *(f32x4*)(zg + 4) = *(const f32x4*)(FZg + t * LF + c8 * 8 + 4);
#pragma unroll
        for (int i = 0; i < 8; ++i) { const int cl = c8 * 8 + i; e1[i] = zg[i] * prm[320 + cl]; e2[i] = zg[i] * (prm[384 + cl] + rk * vv[i]); }
        *(u32x4*)((bf16_t*)(ws + OFF_E1) + (size_t)row * 512 + hc0) = pack8(e1);
        *(u32x4*)((bf16_t*)(ws + OFF_E2) + (size_t)row * 512 + hc0) = pack8(e2);
    }
    __syncthreads();
    TT(12)
#undef SL
}

__device__ __forceinline__ void rwkv_out_pair(const Params& p, char* smem, int pair) {
    int tid_ = threadIdx.x; asm volatile("" : "+v"(tid_));
    const int tid = tid_, lane = tid & 63, wave = __builtin_amdgcn_readfirstlane(tid >> 6);
    char* ws = p.ws;
    const int su = wave >> 2, qm = (wave >> 1) & 1, qn = wave & 1, r = lane & 31, h = lane >> 5;
    float* Ob = (float*)smem;
    {
        const int uidx = pair * 2 + su;
        const char* UD = (const char*)p.out + (size_t)uidx * UNIT_BYTES;
        const bf16_t* Gg = (const bf16_t*)(UD + 16384) + (qm * 32 + r) * 64 + h * 8;
        const bf16_t* SB = (const bf16_t*)(ws + OFF_SB) + (size_t)uidx * 4096 + (qn * 32 + r) * 64 + h * 8;
        const bf16_t* HC = (const bf16_t*)(UD + 24576) + ((qm * 2 + qn) * 64 + lane) * 16;
        bf16x8 gf[4], sf[4];
#pragma unroll
        for (int ks = 0; ks < 4; ++ks) { gf[ks] = *(const bf16x8*)(Gg + ks * 16); sf[ks] = *(const bf16x8*)(SB + ks * 16); }
        float hf[16];
        unpack8(*(const u32x4*)HC, hf); unpack8(*(const u32x4*)(HC + 8), hf + 8);
        f32x16 acc;
#pragma unroll
        for (int i = 0; i < 16; ++i) acc[i] = hf[i];
#pragma unroll
        for (int ks = 0; ks < 4; ++ks) acc = MFMA32(gf[ks], sf[ks], acc);
        store_N_f32(Ob + su * 64 * LF, acc, qm, qn, lane);
    }
    __syncthreads();
    {
        const int su2 = tid >> 8, t = (tid >> 2) & 63, c16 = tid & 3;
        const int uidx = pair * 2 + su2;
        const int hh = uidx & 7, cm1 = (uidx >> 3) & 127, b = uidx >> 10;
        const int row = b * T_SEQ + 64 * cm1 + t;
        const float* orow = Ob + su2 * 64 * LF + t * LF + c16 * 16;
        float o[16];
#pragma unroll
        for (int q = 0; q < 4; ++q) *(f32x4*)(o + 4 * q) = *(const f32x4*)(orow + 4 * q);
        float sacc = 0.f;
#pragma unroll
        for (int i = 0; i < 16; ++i) sacc += o[i];
        sacc += __shfl_xor(sacc, 1); sacc += __shfl_xor(sacc, 2);
        const float mean = sacc * (1.0f / 64.0f);
        float q2 = 0.f;
#pragma unroll
        for (int i = 0; i < 16; ++i) { const float d = o[i] - mean; q2 += d * d; }
        q2 += __shfl_xor(q2, 1); q2 += __shfl_xor(q2, 2);
        const float rs = rsqrtf(q2 * (1.0f / 64.0f) + 64e-5f);
        const bf16_t* e1p = (const bf16_t*)(ws + OFF_E1) + (size_t)row * 512 + hh * 64 + c16 * 16;
        const bf16_t* e2p = (const bf16_t*)(ws + OFF_E2) + (size_t)row * 512 + hh * 64 + c16 * 16;
        bf16_t* yp = (bf16_t*)(ws + OFF_XN) + (size_t)row * DM + 512 + hh * 64 + c16 * 16;
#pragma unroll
        for (int hf2 = 0; hf2 < 2; ++hf2) {
            float e1[8], e2[8], yv[8];
            unpack8(*(const u32x4*)(e1p + hf2 * 8), e1); unpack8(*(const u32x4*)(e2p + hf2 * 8), e2);
#pragma unroll
            for (int i = 0; i < 8; ++i) yv[i] = (o[hf2 * 8 + i] - mean) * rs * e1[i] + e2[i];
            *(u32x4*)(yp + hf2 * 8) = pack8(yv);
        }
    }
    __syncthreads();
}

struct ChainOp { u32x4 pa[4][2]; u32x4 q[2]; };
template <int MODE>
__device__ __forceinline__ void chain_load(ChainOp& o, const Params& p, int b, int hh, int cg, int lane, int c_) {
    const int c = (MODE & 4) ? 9 : c_;
    const char* U = c == 0 ? (const char*)(p.ws + OFF_MPQ + (size_t)hh * 16384) : ((const char*)p.out + (size_t)((b * 128 + (c - 1)) * 8 + hh) * UNIT_BYTES);
#pragma unroll
    for (int m = 0; m < 4; ++m) {
        o.pa[m][0] = *(const u32x4*)(U + ((size_t)((m * 2 + 0) * 64 + lane)) * 16);
        o.pa[m][1] = *(const u32x4*)(U + ((size_t)((m * 2 + 1) * 64 + lane)) * 16);
    }
    o.q[0] = *(const u32x4*)(U + 8192 + ((size_t)((cg * 2 + 0) * 64 + lane)) * 16);
    o.q[1] = *(const u32x4*)(U + 8192 + ((size_t)((cg * 2 + 1) * 64 + lane)) * 16);
}
template <int MODE>
__device__ __forceinline__ void chain_step(const ChainOp& o, f32x4 (&st)[4], bf16_t* SBb, int cg, int lane, int c) {
    const int q = lane >> 4, vl = lane & 15;
    u32x4 b0, b1;
    b0[0] = pack2(st[0][0], st[0][1]); b0[1] = pack2(st[0][2], st[0][3]); b0[2] = pack2(st[1][0], st[1][1]); b0[3] = pack2(st[1][2], st[1][3]);
    b1[0] = pack2(st[2][0], st[2][1]); b1[1] = pack2(st[2][2], st[2][3]); b1[2] = pack2(st[3][0], st[3][1]); b1[3] = pack2(st[3][2], st[3][3]);
    if (!(MODE & 2)) {
        bf16_t* S = SBb + (size_t)(max(c - 1, 0) * 8) * 4096 + (cg * 16 + vl) * 64 + 8 * q;
        *(u32x4*)S = b0; *(u32x4*)(S + 32) = b1;
    }
    const bf16x8 B0 = __builtin_bit_cast(bf16x8, b0), B1 = __builtin_bit_cast(bf16x8, b1);
    f32x4 acc[4];
#pragma unroll
    for (int m = 0; m < 4; ++m) {
        const unsigned q0 = o.q[m >> 1][(m & 1) * 2], q1 = o.q[m >> 1][(m & 1) * 2 + 1];
        f32x4 qi = {bflo(q0), bfhi(q0), bflo(q1), bfhi(q1)};
        acc[m] = MFMA16(__builtin_bit_cast(bf16x8, o.pa[m][0]), B0, qi);
    }
#pragma unroll
    for (int m = 0; m < 4; ++m) acc[m] = MFMA16(__builtin_bit_cast(bf16x8, o.pa[m][1]), B1, acc[m]);
#pragma unroll
    for (int m = 0; m < 4; ++m) st[m] = acc[m];
}
constexpr int CH_RING = 8, CH_R = 12;
constexpr int CH_FLAGS = CH_RING * 16384;
__device__ __forceinline__ void chain_lds_load(ChainOp& o, const char* slot, int cg, int lane) {
#pragma unroll
    for (int m = 0; m < 4; ++m) {
        o.pa[m][0] = *(const u32x4*)(slot + ((m * 2 + 0) * 64 + lane) * 16);
        o.pa[m][1] = *(const u32x4*)(slot + ((m * 2 + 1) * 64 + lane) * 16);
    }
    o.q[0] = *(const u32x4*)(slot + 8192 + ((cg * 2 + 0) * 64 + lane) * 16);
    o.q[1] = *(const u32x4*)(slot + 8192 + ((cg * 2 + 1) * 64 + lane) * 16);
}
template <int MODE>
__device__ __forceinline__ void rwkv_chain_wg(const Params& p, char* smem, int chain, unsigned* latecnt) {
    const int tid = threadIdx.x, lane = tid & 63, wave = __builtin_amdgcn_readfirstlane(tid >> 6);
    const int b = chain >> 3, hh = chain & 7;
    int* ready = (int*)(smem + CH_FLAGS);
    int* prog = (int*)(smem + CH_FLAGS + 64);
#define LDS_LD(ptr) __hip_atomic_load((ptr), __ATOMIC_RELAXED, __HIP_MEMORY_SCOPE_WORKGROUP)
#define LDS_ST(ptr, v) __hip_atomic_store((ptr), (v), __ATOMIC_RELAXED, __HIP_MEMORY_SCOPE_WORKGROUP)
    if (tid < 4) { ready[tid] = 0; prog[tid] = 0; }
    __syncthreads();
    if (wave < 4) {
        const int cg = wave;
        bf16_t* SBb = (bf16_t*)(p.ws + ((MODE & 1) ? OFF_XN : OFF_SB)) + (size_t)(b * 128 * 8 + hh) * 4096;
        f32x4 st[4];
#pragma unroll
        for (int m = 0; m < 4; ++m) st[m] = (f32x4){0.f, 0.f, 0.f, 0.f};
        auto wait_ready = [&](int s) {
            int spins = 0;
            while (spins < (1 << 22)) {
                const int r0 = LDS_LD(ready), r1 = LDS_LD(ready + 1), r2 = LDS_LD(ready + 2), r3 = LDS_LD(ready + 3);
                if (min(min(r0, r1), min(r2, r3)) > s) break;
                __builtin_amdgcn_s_sleep(1); ++spins;
            }
            asm volatile("" ::: "memory");
        };
        ChainOp oA, oB;
        wait_ready(0); chain_lds_load(oA, smem, cg, lane);
#pragma unroll 1
        for (int c = 0; c < 128; c += 2) {
            wait_ready(c + 1); chain_lds_load(oB, smem + ((c + 1) & (CH_RING - 1)) * 16384, cg, lane);
            chain_step<MODE>(oA, st, SBb, cg, lane, c);
            asm volatile("" ::: "memory");
            if (lane == 0) LDS_ST(prog + cg, c + 1);
            wait_ready(c + 2); chain_lds_load(oA, smem + ((c + 2) & (CH_RING - 1)) * 16384, cg, lane);
            chain_step<MODE>(oB, st, SBb, cg, lane, c + 1);
            asm volatile("" ::: "memory");
            if (lane == 0) LDS_ST(prog + cg, c + 2);
        }
        chain_step<MODE>(oA, st, SBb, cg, lane, 128);
        if (MODE & 2) { asm volatile("" :: "v"(st[0][0]), "v"(st[1][0]), "v"(st[2][0]), "v"(st[3][0])); }
    } else {
        const int w = wave - 4;
        u32x4 v[CH_R][4];
        auto unit_ptr = [&](int c_) -> const char* {
            const int c = (MODE & 4) ? 9 : c_;
            return (c == 0 ? (const char*)(p.ws + OFF_MPQ + (size_t)hh * 16384) : ((const char*)p.out + (size_t)((b * 128 + (c - 1)) * 8 + hh) * UNIT_BYTES)) + w * 4096 + lane * 16;
        };
#pragma unroll
        for (int k = 0; k < CH_R; ++k) {
            const char* U = unit_ptr(k);
#pragma unroll
            for (int i = 0; i < 4; ++i) v[k][i] = *(const u32x4*)(U + i * 1024);
        }
#pragma unroll 1
        for (int s0 = 0; s0 < NCHUNK; s0 += CH_R) {
#pragma unroll
            for (int k = 0; k < CH_R; ++k) {
                const int s = s0 + k;
                if (s < NCHUNK) {
                    int spins = 0;
                    while (spins < (1 << 22)) {
                        const int p0 = LDS_LD(prog), p1 = LDS_LD(prog + 1), p2 = LDS_LD(prog + 2), p3 = LDS_LD(prog + 3);
                        if (min(min(p0, p1), min(p2, p3)) > s - CH_RING) break;
                        __builtin_amdgcn_s_sleep(1); ++spins;
                    }
                    asm volatile("" ::: "memory");
                    char* slot = smem + (s & (CH_RING - 1)) * 16384 + w * 4096 + lane * 16;
#pragma unroll
                    for (int i = 0; i < 4; ++i) *(u32x4*)(slot + i * 1024) = v[k][i];
                    asm volatile("" ::: "memory");
                    if (lane == 0) LDS_ST(ready + w, s + 1);
                }
                const int sn = s + CH_R;
                if (!(MODE & 4) && sn == 96) {
                    const unsigned need = b == 0 ? 33u : 32u;
                    unsigned spins = 0;
                    while (__hip_atomic_load(latecnt + 16 * chain, __ATOMIC_RELAXED, __HIP_MEMORY_SCOPE_AGENT) < need && spins < (1u << 22)) { __builtin_amdgcn_s_sleep(8); ++spins; }
                    __builtin_amdgcn_fence(__ATOMIC_ACQUIRE, "agent");
                    asm volatile("s_waitcnt vmcnt(0)" ::: "memory");
                }
                const char* U = unit_ptr(min(sn, NCHUNK - 1));
#pragma unroll
                for (int i = 0; i < 4; ++i) v[k][i] = *(const u32x4*)(U + i * 1024);
            }
        }
    }
}
__device__ __forceinline__ void lru_chain(const Params& p, int idx) {
    const int b = idx >> 9, ch = idx & 511;
    const float* __restrict__ sumA = (const float*)(p.ws + OFF_SUMA); const float* __restrict__ sumH = (const float*)(p.ws + OFF_SUMH);
    float* __restrict__ HS = (float*)(p.ws + OFF_HS);
    float hcur = sumH[ch];
    HS[(size_t)(0 * 2 + b) * 512 + ch] = 0.f;
#pragma unroll 1
    for (int c0 = 1; c0 < NCHUNK; c0 += 32) {
        float av[32], hv[32];
#pragma unroll
        for (int k = 0; k < 32; ++k) { av[k] = sumA[((size_t)(c0 + k) * 2 + b) * 512 + ch]; hv[k] = sumH[((size_t)(c0 + k) * 2 + b) * 512 + ch]; }
        asm volatile("" : "+v"(hcur) :: "memory");
#pragma unroll
        for (int k = 0; k < 32; ++k) { HS[((size_t)(c0 + k) * 2 + b) * 512 + ch] = hcur; hcur = av[k] * hcur + hv[k]; }
        asm volatile("" ::: "memory");
    }
}

#define KLD 136
__device__ __forceinline__ unsigned f2ord(float f) { const unsigned u = __float_as_uint(f); return (u & 0x80000000u) ? ~u : (u | 0x80000000u); }
__device__ __forceinline__ float ord2f(unsigned o) { const unsigned u = (o & 0x80000000u) ? (o & 0x7FFFFFFFu) : ~o; return __uint_as_float(u); }
#define CE(a, b) { const unsigned hi_ = max((a), (b)); (b) = min((a), (b)); (a) = hi_; }
__device__ __forceinline__ void ins16(unsigned (&L)[16], unsigned x) {
#pragma unroll
    for (int s = 0; s < 16; ++s) { const unsigned hi_ = max(L[s], x); x = min(L[s], x); L[s] = hi_; }
}
__device__ __forceinline__ void merge_pair16(unsigned (&L)[16]) {
    unsigned Pp[16];
#pragma unroll
    for (int s = 0; s < 16; ++s) Pp[s] = __shfl_xor(L[s], 32);
#pragma unroll
    for (int s = 0; s < 16; ++s) L[s] = max(L[s], Pp[15 - s]);
#pragma unroll
    for (int d = 8; d > 0; d >>= 1)
#pragma unroll
        for (int i = 0; i < 16; ++i) if ((i & d) == 0) CE(L[i], L[i + d]);
}

__device__ __forceinline__ void sort16_desc(unsigned (&T)[16]) {
    CE(T[0], T[1]) CE(T[2], T[3]) CE(T[0], T[2]) CE(T[1], T[3]) CE(T[1], T[2]) CE(T[4], T[5]) CE(T[6], T[7]) CE(T[4], T[6]) CE(T[5], T[7]) CE(T[5], T[6])
    CE(T[0], T[4]) CE(T[2], T[6]) CE(T[2], T[4]) CE(T[1], T[5]) CE(T[3], T[7]) CE(T[3], T[5]) CE(T[1], T[2]) CE(T[3], T[4]) CE(T[5], T[6]) CE(T[8], T[9])
    CE(T[10], T[11]) CE(T[8], T[10]) CE(T[9], T[11]) CE(T[9], T[10]) CE(T[12], T[13]) CE(T[14], T[15]) CE(T[12], T[14]) CE(T[13], T[15]) CE(T[13], T[14])
    CE(T[8], T[12]) CE(T[10], T[14]) CE(T[10], T[12]) CE(T[9], T[13]) CE(T[11], T[15]) CE(T[11], T[13]) CE(T[9], T[10]) CE(T[11], T[12]) CE(T[13], T[14])
    CE(T[0], T[8]) CE(T[4], T[12]) CE(T[4], T[8]) CE(T[2], T[10]) CE(T[6], T[14]) CE(T[6], T[10]) CE(T[2], T[4]) CE(T[6], T[8]) CE(T[10], T[12]) CE(T[1], T[9])
    CE(T[5], T[13]) CE(T[5], T[9]) CE(T[3], T[11]) CE(T[7], T[15]) CE(T[7], T[11]) CE(T[3], T[5]) CE(T[7], T[9]) CE(T[11], T[13]) CE(T[1], T[2]) CE(T[3], T[4])
    CE(T[5], T[6]) CE(T[7], T[8]) CE(T[9], T[10]) CE(T[11], T[12]) CE(T[13], T[14])
}
__device__ __forceinline__ void merge16_desc(unsigned (&L)[16], const unsigned (&T)[16]) {
#pragma unroll
    for (int s = 0; s < 16; ++s) L[s] = max(L[s], T[15 - s]);
#pragma unroll
    for (int d = 8; d > 0; d >>= 1)
#pragma unroll
        for (int i = 0; i < 16; ++i) if ((i & d) == 0) CE(L[i], L[i + d]);
}
__device__ __forceinline__ void peer_topk_unit(const Params& p, char* smem, int tile, int head, const bool load_keys) {
    int tid_ = threadIdx.x; asm volatile("" : "+v"(tid_));
    const int tid = tid_, lane = tid & 63, wave = __builtin_amdgcn_readfirstlane(tid >> 6), r = lane & 31, h = lane >> 5;
    char* ws = p.ws;
    const bf16_t* KEYS = (const bf16_t*)(ws + OFF_KEYS) + (size_t)head * 2 * 128 * 128;
    const bf16_t* QN = (const bf16_t*)p.out;
    bf16_t* kl = (bf16_t*)smem;
    if (load_keys) {
        __syncthreads();
#pragma unroll
        for (int i = 0; i < 8; ++i) { const int q = tid + 512 * i, rowk = q >> 4, c16 = q & 15; *(u32x4*)(kl + rowk * KLD + c16 * 8) = *(const u32x4*)(KEYS + (size_t)rowk * 128 + c16 * 8); }
        __syncthreads();
    }
    const int tok = tile * 256 + wave * 32 + r;
    const bf16_t* qrow = QN + (size_t)tok * 2048 + head * 256;
    float ssq = 0.f;
    unsigned L1[16], L2[16];
#pragma unroll
    for (int sub = 0; sub < 2; ++sub) {
        bf16x8 qf[8];
#pragma unroll
        for (int ks = 0; ks < 8; ++ks) {
            u32x4 qq = *(const u32x4*)(qrow + sub * 128 + ks * 16 + h * 8);
            float f[8]; unpack8(qq, f);
#pragma unroll
            for (int i = 0; i < 8; ++i) ssq += f[i] * f[i];
            qf[ks] = __builtin_bit_cast(bf16x8, qq);
        }
        unsigned (&L)[16] = sub == 0 ? L1 : L2;
#pragma unroll
        for (int s = 0; s < 16; ++s) L[s] = 0u;
#pragma unroll
        for (int mt = 0; mt < 4; ++mt) {
            f32x16 acc = zero16();
            const bf16_t* ap = kl + (sub * 128 + mt * 32 + r) * KLD + h * 8;
#pragma unroll
            for (int ks = 0; ks < 8; ++ks) { bf16x8 a = *(const bf16x8*)(ap + ks * 16); acc = MFMA32(a, qf[ks], acc); }
            unsigned T[16];
#pragma unroll
            for (int reg = 0; reg < 16; ++reg) {
                const int key = mt * 32 + (reg & 3) + 8 * (reg >> 2) + 4 * h;
                T[reg] = (f2ord(acc[reg]) & ~127u) | (unsigned)(127 - key);
            }
            sort16_desc(T);
            if (mt == 0) {
#pragma unroll
                for (int s2 = 0; s2 < 16; ++s2) L[s2] = T[s2];
            } else merge16_desc(L, T);
        }
        merge_pair16(L);
    }
    ssq += __shfl_xor(ssq, 32);
    const float rstd2 = rsqrtf(((const float*)(ws + OFF_SSQ))[tok] * (1.0f / DM) + 1e-6f);
    const float scale = rstd2 * rsqrtf(rstd2 * rstd2 * ssq * (1.0f / 256.0f) + 1e-6f);
    float v1[16], v2[16];
#pragma unroll
    for (int s = 0; s < 16; ++s) { v1[s] = ord2f(L1[s] & ~127u); v2[s] = ord2f(L2[s] & ~127u); }
    unsigned F[16], F2[16];
#pragma unroll
    for (int s = 0; s < 16; ++s) { F[s] = 0u; F2[s] = 0u; }
    {
        int cnt = 0;
        unsigned pend = 0u;
#pragma unroll
        for (int i = 0; i < 16; ++i)
#pragma unroll
            for (int j = 0; j < 16; ++j) {
                if ((i + 1) * (j + 1) > 16) continue;
                const unsigned e = ((127u - (L1[i] & 127u)) << 7) | (127u - (L2[j] & 127u));
                const unsigned x = (f2ord(v1[i] + v2[j]) & ~16383u) | e;
                if ((cnt & 1) == 0) pend = x;
                else { const unsigned mine = h ? x : pend; const int slot = cnt >> 1; if (slot < 16) F[slot] = mine; else F2[slot - 16] = mine; }
                ++cnt;
            }
    }
    sort16_desc(F); sort16_desc(F2);
    merge16_desc(F, F2);
    merge_pair16(F);
    float sc[16], mx, sum = 0.f;
#pragma unroll
    for (int s = 0; s < 16; ++s) sc[s] = ord2f(F[s] & ~16383u) * scale;
    mx = sc[0];
#pragma unroll
    for (int s = 0; s < 16; ++s) { sc[s] = __expf(sc[s] - mx); sum += sc[s]; }
    const float inv = 1.0f / sum;
    unsigned short* EI = (unsigned short*)(ws + OFF_EIDX) + ((size_t)tok * 8 + head) * 16;
    float* GT = (float*)(ws + OFF_GATE) + ((size_t)tok * 8 + head) * 16;
    if (h == 0) {
        u32x4 w0, w1;
#pragma unroll
        for (int s = 0; s < 4; ++s) { w0[s] = (F[2 * s] & 16383u) | ((F[2 * s + 1] & 16383u) << 16); w1[s] = (F[8 + 2 * s] & 16383u) | ((F[8 + 2 * s + 1] & 16383u) << 16); }
        *(u32x4*)EI = w0; *(u32x4*)(EI + 8) = w1;
        *(f32x4*)GT = (f32x4){sc[0] * inv, sc[1] * inv, sc[2] * inv, sc[3] * inv};
        *(f32x4*)(GT + 4) = (f32x4){sc[4] * inv, sc[5] * inv, sc[6] * inv, sc[7] * inv};
    } else {
        *(f32x4*)(GT + 8) = (f32x4){sc[8] * inv, sc[9] * inv, sc[10] * inv, sc[11] * inv};
        *(f32x4*)(GT + 12) = (f32x4){sc[12] * inv, sc[13] * inv, sc[14] * inv, sc[15] * inv};
    }
}

typedef int v8i_t __attribute__((ext_vector_type(8)));
typedef int v2i_t __attribute__((ext_vector_type(2)));
typedef int v4i_t __attribute__((ext_vector_type(4)));
#define LAS_ __attribute__((address_space(3)))
__device__ __forceinline__ void peer_hidden_quarter(const Params& p, char* xqb, char* img, const int q, const int tok0, const int tstride, const int ntok, int lane_) {
    int lane = lane_; asm volatile("" : "+v"(lane));
    char* ws = p.ws;
    const unsigned char* UBq = (const unsigned char*)(ws + OFF_UB) + (size_t)q * TQ_BYTES;
    const unsigned short* EIb = (const unsigned short*)(ws + OFF_EIDX);
    const bf16_t* H1b = (const bf16_t*)(ws + OFF_H1B);
    float* HIDG = (float*)(ws + OFF_SB);
    const int mrow = lane & 15, kq = lane >> 4;
    const int tlast = tok0 + (ntok - 1) * tstride;
    int e0 = EIb[(size_t)tok0 * 128 + lane], e1 = EIb[(size_t)tok0 * 128 + lane + 64];
    int e0n, e1n;
    { const int tn = min(tok0 + tstride, tlast); e0n = EIb[(size_t)tn * 128 + lane]; e1n = EIb[(size_t)tn * 128 + lane + 64]; }
    u32x4 gb[16];
#pragma unroll
    for (int i = 0; i < 16; ++i) {
        const unsigned ro = (unsigned)(__builtin_amdgcn_ds_bpermute(((8 * i + (lane >> 3)) & 63) << 2, i < 8 ? e0 : e1) * 128 + (lane & 7) * 16);
        gb[i] = *(const u32x4*)(UBq + ro);
    }
    u32x2 hxn = *(const u32x2*)(H1b + (size_t)tok0 * DM + q * 256 + lane * 4);
#pragma unroll 1
    for (int k = 0; k < ntok; ++k) {
        const int tok = tok0 + k * tstride;
        const u32x2 hx = hxn;
        hxn = *(const u32x2*)(H1b + (size_t)min(tok + tstride, tlast) * DM + q * 256 + lane * 4);
        float* hp = HIDG + (size_t)tok * 128 + 16 * (mrow & 7) + 4 * kq;
        f32x4 hold = {0.f, 0.f, 0.f, 0.f};
        if (q > 0 && mrow < 8) hold = *(const f32x4*)hp;
        __builtin_amdgcn_wave_barrier();
#pragma unroll
        for (int i = 0; i < 16; ++i) {
            char* d = img + (8 * i + (lane >> 3)) * 136 + (lane & 7) * 16;
            u32x2 lo, hi; lo[0] = gb[i][0]; lo[1] = gb[i][1]; hi[0] = gb[i][2]; hi[1] = gb[i][3];
            *(u32x2*)d = lo; *(u32x2*)(d + 8) = hi;
        }
        if (k + 1 < ntok) {
#pragma unroll
            for (int i = 0; i < 16; ++i) {
                const unsigned ro = (unsigned)(__builtin_amdgcn_ds_bpermute(((8 * i + (lane >> 3)) & 63) << 2, i < 8 ? e0n : e1n) * 128 + (lane & 7) * 16);
                gb[i] = *(const u32x4*)(UBq + ro);
            }
        }
        { const int tn = min(tok + 2 * tstride, tlast); e0n = EIb[(size_t)tn * 128 + lane]; e1n = EIb[(size_t)tn * 128 + lane + 64]; }
        {
            float xf[4] = {bflo(hx[0]), bfhi(hx[0]), bflo(hx[1]), bfhi(hx[1])};
#pragma unroll
            for (int i = 0; i < 4; ++i) xf[i] = fminf(fmaxf(xf[i], -448.f), 448.f);
            int w = __builtin_amdgcn_cvt_pk_fp8_f32(xf[0], xf[1], 0, false);
            w = __builtin_amdgcn_cvt_pk_fp8_f32(xf[2], xf[3], w, true);
            *(int*)(xqb + lane * 4) = w;
        }
        __builtin_amdgcn_s_waitcnt(0xc07f);
        __builtin_amdgcn_wave_barrier();
        v8i_t bq2[2];
#pragma unroll
        for (int k2 = 0; k2 < 2; ++k2) {
            const u32x4 lo = *(const u32x4*)(xqb + k2 * 128 + kq * 16), hi = *(const u32x4*)(xqb + k2 * 128 + 64 + kq * 16);
            bq2[k2] = (v8i_t){(int)lo[0], (int)lo[1], (int)lo[2], (int)lo[3], (int)hi[0], (int)hi[1], (int)hi[2], (int)hi[3]};
        }
        f32x4 hsel = {0.f, 0.f, 0.f, 0.f};
#pragma unroll
        for (int mb = 0; mb < 8; ++mb) {
            f32x4 hacc = {0.f, 0.f, 0.f, 0.f};
#pragma unroll
            for (int k2 = 0; k2 < 2; ++k2) {
                const char* ra = img + (16 * mb + mrow) * 136 + k2 * 64 + kq * 16;
                const u32x2 a0 = *(const u32x2*)ra, a1 = *(const u32x2*)(ra + 8);
                const v4i_t a4 = (v4i_t){(int)a0[0], (int)a0[1], (int)a1[0], (int)a1[1]};
                const v8i_t av = __builtin_shufflevector(a4, a4, 0, 1, 2, 3, -1, -1, -1, -1);
                hacc = __builtin_amdgcn_mfma_scale_f32_16x16x128_f8f6f4(av, bq2[k2], hacc, 4, 0, 0, 127, 0, 127);
            }
            hsel = (mrow == mb) ? hacc : hsel;
        }
        if (mrow < 8) *(f32x4*)hp = hsel + hold;
    }
}
__device__ __forceinline__ void peer_value_sweep(const Params& p, float* coefl, char* img, const int tok0, const int tstride, const int ntok, int lane_) {
    int lane0 = lane_; asm volatile("" : "+v"(lane0));
    char* ws = p.ws;
    const unsigned short* EIb = (const unsigned short*)(ws + OFF_EIDX);
    const float* GTb = (const float*)(ws + OFF_GATE);
    const float* HIDG = (const float*)(ws + OFF_SB);
    const float* SSQb = (const float*)(ws + OFF_SSQ);
    const float* SUb = (const float*)(ws + OFF_SU); const float* SVb = (const float*)(ws + OFF_SV);
    const unsigned char* VB = (const unsigned char*)(ws + OFF_VB);
    const bf16_t* H1b = (const bf16_t*)(ws + OFF_H1B);
        const int tlast = tok0 + (ntok - 1) * tstride;
    int e0 = EIb[(size_t)tok0 * 128 + lane0], e1 = EIb[(size_t)tok0 * 128 + lane0 + 64];
    float g0 = GTb[(size_t)tok0 * 128 + lane0], g1 = GTb[(size_t)tok0 * 128 + lane0 + 64];
    float h0 = HIDG[(size_t)tok0 * 128 + lane0], h1 = HIDG[(size_t)tok0 * 128 + lane0 + 64];
    float sq = SSQb[tok0];
    float su0 = SUb[e0], su1 = SUb[e1], sv0 = SVb[e0], sv1 = SVb[e1];
    const int t1 = min(tok0 + tstride, tlast);
    int e0n = EIb[(size_t)t1 * 128 + lane0], e1n = EIb[(size_t)t1 * 128 + lane0 + 64];
    float g0n = GTb[(size_t)t1 * 128 + lane0], g1n = GTb[(size_t)t1 * 128 + lane0 + 64];
    float h0n = HIDG[(size_t)t1 * 128 + lane0], h1n = HIDG[(size_t)t1 * 128 + lane0 + 64];
    float sqn = SSQb[t1];
#pragma unroll 1
    for (int k = 0; k < ntok; ++k) {
        int lane = lane_; asm volatile("" : "+v"(lane));
        const int n16 = lane & 15, g4 = lane >> 4;
        const int tok = tok0 + k * tstride;
        const bf16_t* H1 = H1b + (size_t)tok * DM;
        unsigned short h1v[16];
#pragma unroll
        for (int j = 0; j < 16; ++j) h1v[j] = H1[64 * j + lane];
        const float su0n = SUb[e0n], su1n = SUb[e1n], sv0n = SVb[e0n], sv1n = SVb[e1n];
        int er[16];
#pragma unroll
        for (int i = 0; i < 16; ++i) er[i] = __builtin_amdgcn_ds_bpermute(((8 * i + (lane >> 3)) & 63) << 2, i < 8 ? e0 : e1) * 128 + (lane & 7) * 16;
        u32x4 gb[16];
#pragma unroll
        for (int i = 0; i < 16; ++i) gb[i] = *(const u32x4*)(VB + (unsigned)er[i]);
        {
            const float rstd2 = rsqrtf(sq * (1.0f / DM) + 1e-6f);
            __builtin_amdgcn_wave_barrier();
            coefl[lane] = g0 * gelu_erf(h0 * rstd2 * su0) * sv0;
            coefl[lane + 64] = g1 * gelu_erf(h1 * rstd2 * su1) * sv1;
        }
        __builtin_amdgcn_s_waitcnt(0xc07f);
        __builtin_amdgcn_wave_barrier();
        v8i_t acf;
        {
            float c0[16], c1[16];
#pragma unroll
            for (int q4 = 0; q4 < 4; ++q4) { *(f32x4*)(c0 + 4 * q4) = *(const f32x4*)(coefl + 16 * g4 + 4 * q4); *(f32x4*)(c1 + 4 * q4) = *(const f32x4*)(coefl + 64 + 16 * g4 + 4 * q4); }
#pragma unroll
            for (int i = 0; i < 16; ++i) { c0[i] = fminf(fmaxf(c0[i] * 128.f, -448.f), 448.f); c1[i] = fminf(fmaxf(c1[i] * 128.f, -448.f), 448.f); }
#pragma unroll
            for (int j = 0; j < 4; ++j) {
                int w = __builtin_amdgcn_cvt_pk_fp8_f32(c0[4 * j], c0[4 * j + 1], 0, false);
                w = __builtin_amdgcn_cvt_pk_fp8_f32(c0[4 * j + 2], c0[4 * j + 3], w, true);
                acf[j] = w;
                int w2 = __builtin_amdgcn_cvt_pk_fp8_f32(c1[4 * j], c1[4 * j + 1], 0, false);
                w2 = __builtin_amdgcn_cvt_pk_fp8_f32(c1[4 * j + 2], c1[4 * j + 3], w2, true);
                acf[4 + j] = w2;
            }
        }
        float yk[16];
#pragma unroll
        for (int i = 0; i < 16; ++i) yk[i] = 0.f;
#pragma unroll
        for (int q = 0; q < 4; ++q) {
            __builtin_amdgcn_wave_barrier();
#pragma unroll
            for (int i = 0; i < 16; ++i) {
                char* d = img + (8 * i + (lane >> 3)) * 136 + (lane & 7) * 16;
                u32x2 lo, hi; lo[0] = gb[i][0]; lo[1] = gb[i][1]; hi[0] = gb[i][2]; hi[1] = gb[i][3];
                *(u32x2*)d = lo; *(u32x2*)(d + 8) = hi;
            }
            if (q < 3) {
#pragma unroll
                for (int i = 0; i < 16; ++i) gb[i] = *(const u32x4*)(VB + (size_t)(q + 1) * TQ_BYTES + (unsigned)er[i]);
            }
            __builtin_amdgcn_wave_barrier();
#pragma unroll
            for (int t = 0; t < 16; ++t) {
                const char* ra = img + (32 * g4 + n16) * 136 + t * 8;
                const v2i_t r0 = __builtin_amdgcn_ds_read_tr4_b64_v2i32((LAS_ v2i_t*)ra);
                const v2i_t r1 = __builtin_amdgcn_ds_read_tr4_b64_v2i32((LAS_ v2i_t*)(ra + 16 * 136));
                const v8i_t bv = (v8i_t){r0[0], r0[1], r1[0], r1[1], 0, 0, 0, 0};
                f32x4 acc = {0.f, 0.f, 0.f, 0.f};
                acc = __builtin_amdgcn_mfma_scale_f32_16x16x128_f8f6f4(acf, bv, acc, 0, 4, 0, 120, 0, 127);
                if ((t & 7) == 7) __builtin_amdgcn_sched_barrier(0);
                yk[4 * q + (t >> 2)] = (g4 == (t & 3)) ? acc[0] : yk[4 * q + (t >> 2)];
            }
        }
        float hv[16];
        float ss = 0.f;
#pragma unroll
        for (int j = 0; j < 16; ++j) { hv[j] = bf2f(h1v[j]) + yk[j]; ss += hv[j] * hv[j]; }
        ss = wave_sum(ss);
        const float rs = rsqrtf(ss * (1.0f / DM) + 1e-6f);
        float* orow = p.out + (size_t)tok * DM + lane;
#pragma unroll
        for (int j = 0; j < 16; ++j) orow[64 * j] = hv[j] * rs * p.fg[64 * j + lane];
        e0 = e0n; e1 = e1n; g0 = g0n; g1 = g1n; h0 = h0n; h1 = h1n; sq = sqn; su0 = su0n; su1 = su1n; sv0 = sv0n; sv1 = sv1n;
        const int t2 = min(tok + 2 * tstride, tlast);
        e0n = EIb[(size_t)t2 * 128 + lane]; e1n = EIb[(size_t)t2 * 128 + lane + 64];
        g0n = GTb[(size_t)t2 * 128 + lane]; g1n = GTb[(size_t)t2 * 128 + lane + 64];
        h0n = HIDG[(size_t)t2 * 128 + lane]; h1n = HIDG[(size_t)t2 * 128 + lane + 64];
        sqn = SSQb[t2];
    }
}
template <int MODE>
__device__ __forceinline__ void peer_token(const Params& p, float* coefl, char* xqb, char* img, int tok, int lane_, bool with_peer) {
    int lane = lane_; asm volatile("" : "+v"(lane));
    char* ws = p.ws;
    const bf16_t* H1 = (const bf16_t*)(ws + OFF_H1B) + (size_t)tok * DM;
    u32x4 hx0, hx1;
    if (MODE != 2) { hx0 = *(const u32x4*)(H1 + lane * 16); hx1 = *(const u32x4*)(H1 + lane * 16 + 8); }
    float* cg = (float*)(ws + OFF_SB) + (size_t)tok * 128;
    float yk[16];
#pragma unroll
    for (int i = 0; i < 16; ++i) yk[i] = 0.f;
    if (with_peer) {
        const float rstd2 = rsqrtf(((const float*)(ws + OFF_SSQ))[tok] * (1.0f / DM) + 1e-6f);
        const unsigned short* EI = (const unsigned short*)(ws + OFF_EIDX) + (size_t)tok * 128;
        const float* GT = (const float*)(ws + OFF_GATE) + (size_t)tok * 128;
        const int e0 = EI[lane], e1 = EI[lane + 64];
        const float g0 = GT[lane], g1 = GT[lane + 64];
        const unsigned char* UB = (const unsigned char*)(ws + OFF_UB); const unsigned char* VB = (const unsigned char*)(ws + OFF_VB);
        const float su0 = ((const float*)(ws + OFF_SU))[e0], su1 = ((const float*)(ws + OFF_SU))[e1];
        const float sv0 = ((const float*)(ws + OFF_SV))[e0], sv1 = ((const float*)(ws + OFF_SV))[e1];
        const int mrow = lane & 15, kq = lane >> 4;
        float hid0 = 0.f, hid1 = 0.f;
        if (MODE != 2) {
        float xf[16];
        unpack8(hx0, xf); unpack8(hx1, xf + 8);
        f32x2 xf2[8];
#pragma unroll
        for (int i = 0; i < 8; ++i) { xf2[i][0] = xf[2 * i]; xf2[i][1] = xf[2 * i + 1]; }
        {
            u32x4 xq;
#pragma unroll
            for (int j = 0; j < 4; ++j) {
                const float x0 = fminf(fmaxf(xf[4 * j], -448.f), 448.f), x1 = fminf(fmaxf(xf[4 * j + 1], -448.f), 448.f), x2 = fminf(fmaxf(xf[4 * j + 2], -448.f), 448.f), x3 = fminf(fmaxf(xf[4 * j + 3], -448.f), 448.f);
                int w = __builtin_amdgcn_cvt_pk_fp8_f32(x0, x1, 0, false);
                w = __builtin_amdgcn_cvt_pk_fp8_f32(x2, x3, w, true);
                xq[j] = (unsigned)w;
            }
            *(u32x4*)(xqb + lane * 16) = xq;
        }
        __builtin_amdgcn_s_waitcnt(0xc07f);
        __builtin_amdgcn_wave_barrier();
        }
        int er[16];
#pragma unroll
        for (int i = 0; i < 16; ++i) er[i] = __builtin_amdgcn_ds_bpermute(((8 * i + (lane >> 3)) & 63) << 2, i < 8 ? e0 : e1) * (DM / 2) + (lane & 7) * 16;
        u32x4 gb[16];
#pragma unroll
        for (int i = 0; i < 16; ++i) gb[i] = *(const u32x4*)((MODE == 2 ? VB : UB) + (unsigned)er[i]);
        if (MODE != 2) {
            f32x4 hacc[8];
#pragma unroll
            for (int mb = 0; mb < 8; ++mb) hacc[mb] = (f32x4){0.f, 0.f, 0.f, 0.f};
#pragma unroll 1
            for (int q = 0; q < 4; ++q) {
                __builtin_amdgcn_wave_barrier();
#pragma unroll
                for (int i = 0; i < 16; ++i) {
                    char* d = img + (8 * i + (lane >> 3)) * 136 + (lane & 7) * 16;
                    u32x2 lo, hi; lo[0] = gb[i][0]; lo[1] = gb[i][1]; hi[0] = gb[i][2]; hi[1] = gb[i][3];
                    *(u32x2*)d = lo; *(u32x2*)(d + 8) = hi;
                }
                {
                    const unsigned char* nb = q < 3 ? UB + (q + 1) * 128 : VB;
                    if (MODE == 0 || q < 3) {
#pragma unroll
                        for (int i = 0; i < 16; ++i) gb[i] = *(const u32x4*)(nb + (unsigned)er[i]);
                    }
                }
                __builtin_amdgcn_wave_barrier();
                v8i_t bq2[2];
#pragma unroll
                for (int k2 = 0; k2 < 2; ++k2) {
                    const u32x4 lo = *(const u32x4*)(xqb + (2 * q + k2) * 128 + kq * 16), hi = *(const u32x4*)(xqb + (2 * q + k2) * 128 + 64 + kq * 16);
                    bq2[k2] = (v8i_t){(int)lo[0], (int)lo[1], (int)lo[2], (int)lo[3], (int)hi[0], (int)hi[1], (int)hi[2], (int)hi[3]};
                }
#pragma unroll
                for (int mb = 0; mb < 8; ++mb) {
#pragma unroll
                    for (int k2 = 0; k2 < 2; ++k2) {
                        const char* ra = img + (16 * mb + mrow) * 136 + k2 * 64 + kq * 16;
                        const u32x2 a0 = *(const u32x2*)ra, a1 = *(const u32x2*)(ra + 8);
                        const v4i_t a4 = (v4i_t){(int)a0[0], (int)a0[1], (int)a1[0], (int)a1[1]};
                        const v8i_t av = __builtin_shufflevector(a4, a4, 0, 1, 2, 3, -1, -1, -1, -1);
                        hacc[mb] = __builtin_amdgcn_mfma_scale_f32_16x16x128_f8f6f4(av, bq2[k2], hacc[mb], 4, 0, 0, 127, 0, 127);
                    }
                }
            }
            if (mrow == 0) {
#pragma unroll
                for (int mb = 0; mb < 8; ++mb) *(f32x4*)(coefl + 16 * mb + 4 * kq) = hacc[mb];
            }
        }
        if (MODE != 2) {
            __builtin_amdgcn_s_waitcnt(0xc07f);
            __builtin_amdgcn_wave_barrier();
            hid0 = coefl[lane]; hid1 = coefl[lane + 64];
            __builtin_amdgcn_wave_barrier();
            const float cf0 = g0 * gelu_erf(hid0 * rstd2 * su0) * sv0, cf1 = g1 * gelu_erf(hid1 * rstd2 * su1) * sv1;
            if (MODE == 1) { cg[lane] = cf0; cg[lane + 64] = cf1; return; }
            coefl[lane] = cf0; coefl[lane + 64] = cf1;
        } else {
            hid0 = cg[lane]; hid1 = cg[lane + 64];
            coefl[lane] = g0 * gelu_erf(hid0 * rstd2 * su0) * sv0; coefl[lane + 64] = g1 * gelu_erf(hid1 * rstd2 * su1) * sv1;
        }
        __builtin_amdgcn_s_waitcnt(0xc07f);
        __builtin_amdgcn_wave_barrier();
        {
            const int n16 = lane & 15, g4 = lane >> 4;
            v8i_t acf;
            {
                float c0[16], c1[16];
#pragma unroll
                for (int q4 = 0; q4 < 4; ++q4) { *(f32x4*)(c0 + 4 * q4) = *(const f32x4*)(coefl + 16 * g4 + 4 * q4); *(f32x4*)(c1 + 4 * q4) = *(const f32x4*)(coefl + 64 + 16 * g4 + 4 * q4); }
#pragma unroll
                for (int i = 0; i < 16; ++i) { c0[i] = fminf(fmaxf(c0[i] * 128.f, -448.f), 448.f); c1[i] = fminf(fmaxf(c1[i] * 128.f, -448.f), 448.f); }
#pragma unroll
                for (int j = 0; j < 4; ++j) {
                    int w = __builtin_amdgcn_cvt_pk_fp8_f32(c0[4 * j], c0[4 * j + 1], 0, false);
                    w = __builtin_amdgcn_cvt_pk_fp8_f32(c0[4 * j + 2], c0[4 * j + 3], w, true);
                    acf[j] = w;
                    int w2 = __builtin_amdgcn_cvt_pk_fp8_f32(c1[4 * j], c1[4 * j + 1], 0, false);
                    w2 = __builtin_amdgcn_cvt_pk_fp8_f32(c1[4 * j + 2], c1[4 * j + 3], w2, true);
                    acf[4 + j] = w2;
                }
            }
#pragma unroll
            for (int q = 0; q < 4; ++q) {
                __builtin_amdgcn_wave_barrier();
#pragma unroll
                for (int i = 0; i < 16; ++i) {
                    char* d = img + (8 * i + (lane >> 3)) * 136 + (lane & 7) * 16;
                    u32x2 lo, hi; lo[0] = gb[i][0]; lo[1] = gb[i][1]; hi[0] = gb[i][2]; hi[1] = gb[i][3];
                    *(u32x2*)d = lo; *(u32x2*)(d + 8) = hi;
                }
                if (q < 3) {
#pragma unroll
                    for (int i = 0; i < 16; ++i) gb[i] = *(const u32x4*)(VB + (unsigned)er[i] + (q + 1) * 128);
                }
                __builtin_amdgcn_wave_barrier();
#pragma unroll
                for (int t = 0; t < 16; ++t) {
                    const char* ra = img + (32 * g4 + n16) * 136 + t * 8;
                    const v2i_t r0 = __builtin_amdgcn_ds_read_tr4_b64_v2i32((LAS_ v2i_t*)ra);
                    const v2i_t r1 = __builtin_amdgcn_ds_read_tr4_b64_v2i32((LAS_ v2i_t*)(ra + 16 * 136));
                    const v8i_t bv = (v8i_t){r0[0], r0[1], r1[0], r1[1], 0, 0, 0, 0};
                    f32x4 acc = {0.f, 0.f, 0.f, 0.f};
                    acc = __builtin_amdgcn_mfma_scale_f32_16x16x128_f8f6f4(acf, bv, acc, 0, 4, 0, 120, 0, 127);
                    if ((t & 7) == 7) __builtin_amdgcn_sched_barrier(0);
                    yk[4 * q + (t >> 2)] = (g4 == (t & 3)) ? acc[0] : yk[4 * q + (t >> 2)];
                }
            }
        }
    }
    float hv[16];
    float ss = 0.f;
#pragma unroll
    for (int j = 0; j < 16; ++j) { hv[j] = bf2f(H1[64 * j + lane]) + yk[j]; ss += hv[j] * hv[j]; }
    ss = wave_sum(ss);
    const float rs = rsqrtf(ss * (1.0f / DM) + 1e-6f);
    float* orow = p.out + (size_t)tok * DM + lane;
#pragma unroll
    for (int j = 0; j < 16; ++j) orow[64 * j] = hv[j] * rs * p.fg[64 * j + lane];
}


#define XB_TMO      128
#define XB_XCNT(j)  (256  + 64 * (j))
#define XB_XSUB(j)  (1280 + 64 * (j))
#define XB_XGEN(j)  (2304 + 64 * (j))
#define XB_TOP      3328
#define XB_TOPGEN   3392
#define XCD_BAR_WORDS 3456
#define XB_SPIN_CAP (1u << 21)
#define LAS __attribute__((address_space(3)))
__device__ __forceinline__ unsigned xb_ld(unsigned* p)              { return __hip_atomic_load(p, __ATOMIC_RELAXED, __HIP_MEMORY_SCOPE_AGENT); }
__device__ __forceinline__ unsigned xb_add(unsigned* p, unsigned v) { return __hip_atomic_fetch_add(p, v, __ATOMIC_RELAXED, __HIP_MEMORY_SCOPE_AGENT); }
__device__ __forceinline__ unsigned xb_xcc_id() { return (unsigned)__builtin_amdgcn_s_getreg((3 << 11) | 20) & 0xFu; }
#define XB_SPIN(cond, bar) do { unsigned _sp = 0; while (cond) { __builtin_amdgcn_s_sleep(1); \
    if ((++_sp & 255u) == 0u) { if (xb_ld(&(bar)[XB_TMO])) break; if (_sp > XB_SPIN_CAP) { atomicAdd(&(bar)[XB_TMO], 1u); break; } } } } while (0)
struct XcdBarrier { unsigned* bar; unsigned x; volatile LAS unsigned* st; };
__device__ __forceinline__ XcdBarrier xcd_barrier_post(unsigned* bar, volatile LAS unsigned* st) {
    XcdBarrier b; b.bar = bar; b.x = xb_xcc_id(); b.st = st;
    if (threadIdx.x == 0) (void)xb_add(&bar[XB_XCNT(b.x)], 1u);
    return b;
}
__device__ __forceinline__ void xcd_barrier_complete(unsigned* bar, unsigned x, unsigned& nloc, unsigned& nx) {
    const unsigned G = gridDim.x * gridDim.y * gridDim.z;
    unsigned sum, cnt, mine, sp = 0u;
    for (;;) {
        sum = 0u; cnt = 0u; mine = 0u;
#pragma unroll
        for (unsigned j = 0; j < 16; ++j) { const unsigned c = xb_ld(&bar[XB_XCNT(j)]); sum += c; cnt += (c > 0u) ? 1u : 0u; mine = (j == x) ? c : mine; }
        if (sum == G) break;
        __builtin_amdgcn_s_sleep(1);
        if ((++sp & 255u) == 0u) { if (xb_ld(&bar[XB_TMO])) break; if (sp > XB_SPIN_CAP) { atomicAdd(&bar[XB_TMO], 1u); break; } }
    }
    nloc = mine > 0u ? mine : 1u; nx = cnt > 0u ? cnt : 1u;
}
__device__ __forceinline__ void xcd_barrier(const XcdBarrier& b) {
    asm volatile("s_waitcnt vmcnt(0)" ::: "memory");
    __syncthreads();
    if (threadIdx.x == 0) {
        unsigned* bar = b.bar;
        __builtin_amdgcn_s_waitcnt(0);
        unsigned nloc = b.st[0], nx = b.st[1];
        if (nloc == 0u) { xcd_barrier_complete(bar, b.x, nloc, nx); b.st[0] = nloc; b.st[1] = nx; }
        const unsigned old = xb_add(&bar[XB_XSUB(b.x)], 1u);
        const unsigned gen = old / nloc;
        if (old + 1u == (gen + 1u) * nloc) {
            __builtin_amdgcn_fence(__ATOMIC_RELEASE, "agent");
            asm volatile("s_waitcnt vmcnt(0)" ::: "memory");
            const unsigned og = xb_add(&bar[XB_TOP], 1u);
            const unsigned tg = og / nx;
            if (og + 1u == (tg + 1u) * nx) xb_add(&bar[XB_TOPGEN], 1u);
            else XB_SPIN(xb_ld(&bar[XB_TOPGEN]) == tg, bar);
            __builtin_amdgcn_fence(__ATOMIC_ACQUIRE, "agent");
            xb_add(&bar[XB_XGEN(b.x)], 1u);
            asm volatile("s_waitcnt vmcnt(0)" ::: "memory");
        } else {
            XB_SPIN(xb_ld(&bar[XB_XGEN(b.x)]) == gen, bar);
            __builtin_amdgcn_fence(__ATOMIC_ACQUIRE, "agent");
            asm volatile("s_waitcnt vmcnt(0)" ::: "memory");
        }
    }
    __syncthreads();
}

__device__ __forceinline__ void run_phase(const Params& p, char* smem, const int phase) {
    int tidl_ = threadIdx.x; asm volatile("" : "+v"(tidl_));
    const int tid = tidl_, lane = tid & 63, wave = __builtin_amdgcn_readfirstlane(tid >> 6), G = gridDim.x;
    char* ws = p.ws;
    switch (phase) {
    case 0: phase_prep(p, smem); break;
    case 1: { pg8::EpiBf16 e{(bf16_t*)(ws + OFF_P), DIN}; pg8::Gemm g{(const bf16_t*)(ws + OFF_XN), (const bf16_t*)(ws + OFF_WINT), MROWS, DIN, DM}; pg8::StaticOrder so; so.init(MROWS, DIN, G, blockIdx.x);
              pg8::gemm_phase<pg8::EpiBf16, pg8::StaticOrder, true, true>((PG8_LAS unsigned char*)smem, g, so, e);
              {
                  const int nfull = (MROWS / 256) * (DIN / 256) - 2 * G;
                  if ((int)blockIdx.x >= nfull) prep_transposes(p, smem, 16 * 44 + 16 * 16, 16 * 44 + 16 * 16 + 16 * 32, blockIdx.x - nfull, G - nfull);
              } } break;
    case 2: {
        unsigned long long tacc2 = 0;
        {
            float* prm = (float*)(smem + PRM_RWKV);
            rwkv_stage_params(p, prm, tid);
            __syncthreads();
        }
        S0Pre pre;
        auto dec2 = [](int idx, int& c, int& b, int& hh) {
            if (idx < 8) { c = 0; b = 0; hh = idx; }
            else { const int v = idx - 8; if (v < 1520) { c = 1 + (v >> 4); b = (v >> 3) & 1; hh = v & 7; } else { c = 96; b = 1; hh = v - 1520; } }
        };
        { int c, b, hh; dec2(blockIdx.x + 5 * G, c, b, hh); s0_fetch(p, c, b, hh, tid, pre); }
        for (int idx = blockIdx.x + 5 * G; idx >= 0; idx -= G) {
            int c, b, hh, nc, nb, nh;
            dec2(idx, c, b, hh);
            const bool has_next = idx - G >= 0;
            dec2(has_next ? idx - G : idx, nc, nb, nh);
            rwkv_unit(p, smem, c, b, hh, tacc2, pre, has_next, nc, nb, nh);
        }
#if TSSTAGE >= 0
        if (blockIdx.x == 0 && tid == 0) __hip_atomic_store((unsigned long long*)(ws + OFF_BAR + 14336), tacc2, __ATOMIC_RELAXED, __HIP_MEMORY_SCOPE_AGENT);
#endif
    } break;
    case 3: {
        unsigned* latecnt = (unsigned*)(ws + OFF_BAR + 14848);
#if TSROLE >= 0
        volatile unsigned long long* tsl = (volatile unsigned long long*)(smem + SMEM_BYTES - 64);
        if (tid == 0) { tsl[0] = __builtin_amdgcn_s_memrealtime(); tsl[1] = tsl[0]; tsl[2] = tsl[0]; }
#endif
        if (blockIdx.x < 16) {
#if CHPROBE
            { const unsigned long long t0_ = __builtin_amdgcn_s_memrealtime(); rwkv_chain_wg<CHPROBE>(p, smem, blockIdx.x, latecnt); __syncthreads();
              if (blockIdx.x == 0 && tid == 0) __hip_atomic_store((unsigned long long*)(ws + OFF_BAR + 14336), __builtin_amdgcn_s_memrealtime() - t0_, __ATOMIC_RELAXED, __HIP_MEMORY_SCOPE_AGENT); }
#endif
            rwkv_chain_wg<0>(p, smem, blockIdx.x, latecnt); __syncthreads(); }
        else {
            const int w = blockIdx.x - 16;
            {
                float* prm = (float*)(smem + PRM_RWKV);
                rwkv_stage_params(p, prm, tid);
                __syncthreads();
                unsigned long long tdummy = 0; S0Pre pre;
                auto dec3 = [](int j, int& c, int& b, int& hh) {
                    if (j < 8) { c = 96; b = 0; hh = j; } else { const int v = j - 8; c = 97 + (v >> 4); b = (v >> 3) & 1; hh = v & 7; }
                };
                { int c, b, hh; dec3(w, c, b, hh); s0_fetch(p, c, b, hh, tid, pre); }
                for (int j = w; j < 520; j += 240) {
                    int c, b, hh, nc, nb, nh;
                    dec3(j, c, b, hh);
                    const bool has_next = j + 240 < 520;
                    dec3(has_next ? j + 240 : j, nc, nb, nh);
                    rwkv_unit(p, smem, c, b, hh, tdummy, pre, has_next, nc, nb, nh);
                }
                asm volatile("s_waitcnt vmcnt(0)" ::: "memory");
                __syncthreads();
                if (tid == 0) {
                    __builtin_amdgcn_fence(__ATOMIC_RELEASE, "agent");
                    asm volatile("s_waitcnt vmcnt(0)" ::: "memory");
                    for (int j = w; j < 520; j += 240) {
                        int b, hh;
                        if (j < 8) { b = 0; hh = j; } else { const int v = j - 8; b = (v >> 3) & 1; hh = v & 7; }
                        __hip_atomic_fetch_add(latecnt + 16 * (b * 8 + hh), 1u, __ATOMIC_RELAXED, __HIP_MEMORY_SCOPE_AGENT);
                    }
                }
                __syncthreads();
            }
#if TSROLE >= 0
            if (tid == 0) tsl[1] = __builtin_amdgcn_s_memrealtime();
#endif
            float* lp = (float*)(smem + PRM_LRU);
            lp[tid] = p.ga_b[tid]; lp[512 + tid] = p.gx_b[tid]; lp[1024 + tid] = ((const float*)(ws + OFF_SP))[tid]; lp[1536 + tid] = p.conv_b[tid];
            lp[2048 + tid] = p.conv_w[tid]; lp[2560 + tid] = p.conv_w[512 + tid]; lp[3072 + tid] = p.conv_w[1024 + tid]; lp[3584 + tid] = p.conv_w[1536 + tid];
            __syncthreads();
            for (int v = w; v < 257; v += 240) { const int w2 = v == 0 ? 0 : v - 1; lru_unit(p, smem, v == 0 ? 0 : 1 + (w2 & 127), w2 >> 7); }
#if TSROLE >= 0
            __syncthreads(); if (tid == 0) tsl[2] = __builtin_amdgcn_s_memrealtime();
#endif
            if (w >= 40) convert_tables(p, 56);
        }
#if TSROLE >= 0
        __syncthreads();
        if (!CHPROBE && blockIdx.x == TSROLE && tid == 0) { const unsigned long long t_d = __builtin_amdgcn_s_memrealtime(), t_a = tsl[0], t_b = tsl[1], t_c = tsl[2]; __hip_atomic_store((unsigned long long*)(ws + OFF_BAR + 14336), TSSUB == 0 ? t_d - t_a : TSSUB == 1 ? t_b - t_a : TSSUB == 2 ? t_c - t_b : t_d - t_c, __ATOMIC_RELAXED, __HIP_MEMORY_SCOPE_AGENT); }
#endif
    } break;
    case 4: {
        for (int u = blockIdx.x; u < 1024 + 256; u += G) {
            if (u < 1024) rwkv_out_pair(p, smem, u);
            else { const int v = u - 1024; lru_out(p, smem, 1 + (v & 127), v >> 7); }
        }
    } break;
    case 5: { pg8::EpiRes e{(bf16_t*)(ws + OFF_H1B), p.x, (float*)(ws + OFF_SSQ)}; pg8::Gemm g{(const bf16_t*)(ws + OFF_XN), (const bf16_t*)(ws + OFF_WOUTT), NTOK, DM, DM}; pg8::StaticOrder so; so.init(NTOK, DM, G, blockIdx.x);
              pg8::gemm_phase<pg8::EpiRes, pg8::StaticOrder, false, true>((PG8_LAS unsigned char*)smem, g, so, e); } break;
    case 6: { pg8::EpiBf16 e{(bf16_t*)p.out, 2048}; pg8::Gemm g{(const bf16_t*)(ws + OFF_H1B), (const bf16_t*)(ws + OFF_WQT), NTOK, 2048, DM}; pg8::StaticOrder so; so.init(NTOK, 2048, G, blockIdx.x, 4);
              pg8::gemm_phase<pg8::EpiBf16, pg8::StaticOrder, true, true>((PG8_LAS unsigned char*)smem, g, so, e); } break;
    case 7: { for (int u = blockIdx.x; u < 64 * 8; u += G) peer_topk_unit(p, smem, u >> 3, u & 7, u == (int)blockIdx.x || (G & 7) != 0); } break;
    case 8: { float* coefl = (float*)smem + wave * 128; char* xqb = smem + 4096 + wave * 1024; char* img = smem + 12288 + wave * 17408;
#pragma unroll 1
        for (int q = 0; q < 4; ++q) peer_hidden_quarter(p, xqb, img, q, blockIdx.x * 8 + wave, G * 8, NTOK / (G * 8), lane);
        peer_value_sweep(p, coefl, img, blockIdx.x * 8 + wave, G * 8, NTOK / (G * 8), lane); } break;
    }
}

template <int PH>
__global__ void __launch_bounds__(NTHR) k_phase(Params p) {
    extern __shared__ __attribute__((aligned(16))) char smem[];
    run_phase(p, smem, PH);
}
template <int PH>
static void launch_phase(const Params& p, hipStream_t stream) {
    static bool attr_set = false;
    if (!attr_set) { (void)hipFuncSetAttribute((const void*)k_phase<PH>, hipFuncAttributeMaxDynamicSharedMemorySize, SMEM_BYTES); attr_set = true; }
    k_phase<PH><<<256, NTHR, SMEM_BYTES, stream>>>(p);
}


__global__ void __launch_bounds__(NTHR) k_mega(Params p) {
    extern __shared__ __attribute__((aligned(16))) char smem[];
    volatile LAS unsigned* st = (volatile LAS unsigned*)(smem + SMEM_BYTES - 16);
    if (threadIdx.x == 0) { st[0] = 0u; st[1] = 0u; st[2] = 0u; st[3] = 0u; }
    __syncthreads();
    XcdBarrier bar = xcd_barrier_post((unsigned*)(p.ws + OFF_BAR), st);
#ifndef TSPH
#define TSPH -1
#endif
    unsigned long long ts[10];
#define RUNP(ph, n) if ((n) == 1) { if (ph > 0) xcd_barrier(bar); if (TSPH >= 0) ts[ph] = __builtin_amdgcn_s_memrealtime(); run_phase(p, smem, ph); } else { _Pragma("unroll 1") for (int it = 0; it < (n); ++it) { xcd_barrier(bar); run_phase(p, smem, ph); } }
    RUNP(0, REP0) RUNP(1, REP1) RUNP(2, REP2) RUNP(3, REP3) RUNP(4, REP4) RUNP(5, 1) RUNP(6, REP6) RUNP(7, REP7) RUNP(8, REP8)
    if (TSPH >= 0) {
        xcd_barrier(bar);
        ts[9] = __builtin_amdgcn_s_memrealtime();
        if (blockIdx.x == 0) {
#if TSROLE >= 0 || TSSTAGE >= 0
            const unsigned long long d = __hip_atomic_load((unsigned long long*)(p.ws + OFF_BAR + 14336), __ATOMIC_RELAXED, __HIP_MEMORY_SCOPE_AGENT) * 4ull, t0 = __builtin_amdgcn_s_memrealtime();
#else
            const unsigned long long d = (ts[TSPH + 1] - ts[TSPH]) * 4ull, t0 = __builtin_amdgcn_s_memrealtime();
#endif
            while (__builtin_amdgcn_s_memrealtime() - t0 < d) __builtin_amdgcn_s_sleep(8);
        }
    }
}

extern "C" void kernel_launch(void* const* d_in, const int* in_sizes, int n_in, void* d_out, int out_size, void* d_ws, size_t ws_size, hipStream_t stream) {
    Params p{};
    const float** pp = (const float**)&p;
    for (int i = 0; i < 31; ++i) pp[i] = (const float*)d_in[i];
    p.out = (float*)d_out; p.ws = (char*)d_ws;
#if MULTI_LAUNCH
    launch_phase<0>(p, stream); launch_phase<1>(p, stream); launch_phase<2>(p, stream); launch_phase<3>(p, stream);
    launch_phase<4>(p, stream); launch_phase<5>(p, stream);
    if (DO_PEER) { launch_phase<6>(p, stream); launch_phase<7>(p, stream); }
    launch_phase<8>(p, stream);
#else
    static bool attr_set = false;
    if (!attr_set) { (void)hipFuncSetAttribute((const void*)k_mega, hipFuncAttributeMaxDynamicSharedMemorySize, SMEM_BYTES); attr_set = true; }
    (void)hipMemsetAsync(p.ws + OFF_BAR, 0, 16384, stream);
    void* args[] = {&p};
    hipError_t e = hipLaunchCooperativeKernel((const void*)k_mega, dim3(256), dim3(NTHR), args, SMEM_BYTES, stream);
    if (e != hipSuccess) fprintf(stderr, "cooperative launch failed: %s\n", hipGetErrorString(e));
#endif
}
```
